# Optimizing an MI355X kernel written in HIP

```python
import jax, jax.numpy as jnp
from jax import lax
import numpy as np

D_MODEL = 1024
BATCH = 16
SEQ = 2048
DEPTH = 2

GRID_W = 64
CTX_LEN = 256
HEAD_DIM = 64
ATT_WIDTH = D_MODEL // 2
ML_WIDTH = D_MODEL // 4
POOL_WIDTH = D_MODEL - ATT_WIDTH - ML_WIDTH
MIX_WIDTH = ATT_WIDTH + ML_WIDTH + POOL_WIDTH
ATT_HEADS = ATT_WIDTH // HEAD_DIM
ATT_KV_HEADS = ATT_HEADS // 4
KV_WIDTH = ATT_KV_HEADS * HEAD_DIM
ML_HEADS = ML_WIDTH // HEAD_DIM
POOL_WINDOWS = (2, 4, 8, 16)
POOL_GROUPS = len(POOL_WINDOWS)
POOL_GROUP_DIM = POOL_WIDTH // POOL_GROUPS
N_GATES = 4 * ML_HEADS
IN_SPLITS = (ATT_WIDTH, KV_WIDTH, KV_WIDTH, ML_WIDTH, ML_WIDTH, ML_WIDTH, ML_WIDTH, N_GATES, POOL_WIDTH)
IN_WIDTH = sum(IN_SPLITS)
IN_OFFSETS = tuple(int(o) for o in np.cumsum(IN_SPLITS)[:-1])
D_FF = -(-8 * D_MODEL // (3 * 256)) * 256
Q_BLOCK = 128
CHUNK = 128
ROPE_THETA = 10000.0
EPS = 1e-6

kernel_name = 'hymba_style_attn_mlstm_pool_prefix_dit'

F32 = jnp.float32


def rms_norm(x, g):
    xf = x.astype(F32)
    y = xf * lax.rsqrt(jnp.mean(xf * xf, -1, keepdims=True) + EPS)
    return (y * g.astype(F32)).astype(x.dtype)


def axial_rope_tables(rows):
    half = HEAD_DIM // 2
    inv_freq = 1.0 / (ROPE_THETA ** (jnp.arange(0, half, 2, dtype=F32) / half))
    row = jnp.repeat(jnp.arange(rows, dtype=F32), GRID_W)
    col = jnp.tile(jnp.arange(GRID_W, dtype=F32), rows)
    a_row = row[:, None] * inv_freq
    a_col = col[:, None] * inv_freq
    ang = jnp.concatenate([a_row, a_row, a_col, a_col], -1)
    return jnp.cos(ang), jnp.sin(ang)


def apply_rope(x, cos, sin):
    q = HEAD_DIM // 4
    xr = x.reshape(x.shape[:-1] + (2, 2, q))
    rot = jnp.stack([-xr[..., 1, :], xr[..., 0, :]], -2).reshape(x.shape)
    out = x.astype(F32) * cos[:, None, :] + rot.astype(F32) * sin[:, None, :]
    return out.astype(x.dtype)


def block_attention(q, k, v):
    B, T, Hq, d = q.shape
    Hk = k.shape[2]
    G = Hq // Hk
    nb = T // Q_BLOCK
    qb = q.reshape(B, nb, Q_BLOCK, Hk, G, d).swapaxes(0, 1)
    scale = d ** -0.5

    def one_block(qi):
        s = jnp.einsum('bqhgd,bkhd->bhgqk', qi, k, preferred_element_type=F32) * scale
        p = jax.nn.softmax(s, -1).astype(v.dtype)
        return jnp.einsum('bhgqk,bkhd->bqhgd', p, v)

    o = lax.map(one_block, qb)
    return o.swapaxes(0, 1).reshape(B, T, Hq * d)


def mlstm_scan(q, k, v, log_i, log_f, state):
    B, H, T, d = q.shape
    nc = T // CHUNK

    def split(a):
        a = a.astype(F32)
        return jnp.moveaxis(a.reshape(a.shape[:2] + (nc, CHUNK) + a.shape[3:]), 2, 0)

    xs = (split(q), split(k * d ** -0.5), split(v), split(log_i), split(log_f))
    tril = jnp.tril(jnp.ones((CHUNK, CHUNK), bool))

    def step(carry, inp):
        C, n, m = carry
        qc, kc, vc, li, lf = inp
        b = jnp.cumsum(lf, -1)
        dmat = jnp.where(tril, b[..., :, None] - b[..., None, :] + li[..., None, :], -jnp.inf)
        inter = b + m[..., None]
        m_t = jnp.maximum(inter, jnp.max(dmat, -1))
        w_inter = jnp.exp(inter - m_t)
        s = jnp.einsum('bhtd,bhsd->bhts', qc, kc) * jnp.exp(dmat - m_t[..., None])
        num = w_inter[..., None] * jnp.einsum('bhvk,bhtk->bhtv', C, qc) + jnp.einsum('bhts,bhsv->bhtv', s, vc)
        den = w_inter * jnp.einsum('bhk,bhtk->bht', n, qc) + jnp.sum(s, -1)
        h = num / jnp.maximum(jnp.abs(den), jnp.exp(-m_t))[..., None]
        b_last = b[..., -1]
        g = b_last[..., None] - b + li
        m_new = jnp.maximum(b_last + m, jnp.max(g, -1))
        a = jnp.exp(b_last + m - m_new)
        wk = jnp.exp(g - m_new[..., None])
        C_new = a[..., None, None] * C + jnp.einsum('bhs,bhsv,bhsk->bhvk', wk, vc, kc)
        n_new = a[..., None] * n + jnp.einsum('bhs,bhsk->bhk', wk, kc)
        return (C_new, n_new, m_new), h

    state, hs = lax.scan(step, state, xs)
    return jnp.moveaxis(hs, 0, 2).reshape(B, H, T, d), state


def bidir_mlstm(q_c, k_c, v_c, g_c, q_l, k_l, v_l, g_l):
    B, H, _, d = q_l.shape
    zero = (jnp.zeros((B, H, d, d), F32), jnp.zeros((B, H, d), F32), jnp.zeros((B, H), F32))
    outs_c, outs_l = [], []
    for direc in range(2):
        rev = (lambda a: jnp.flip(a, 2)) if direc else (lambda a: a)
        li_c, lf_c = g_c[2 * direc], jax.nn.log_sigmoid(g_c[2 * direc + 1])
        li_l, lf_l = g_l[2 * direc], jax.nn.log_sigmoid(g_l[2 * direc + 1])
        h_c, st = mlstm_scan(rev(q_c), rev(k_c), rev(v_c), rev(li_c), rev(lf_c), zero)
        h_l, _ = mlstm_scan(rev(q_l), rev(k_l), rev(v_l), rev(li_l), rev(lf_l), st)
        outs_c.append(rev(h_c))
        outs_l.append(rev(h_l))
    return outs_c[0] + outs_c[1], outs_l[0] + outs_l[1]


def mlstm_readout(h, o_pre, ml_norm):
    B, H, T, d = h.shape
    hn = rms_norm(h.transpose(0, 2, 1, 3), ml_norm.reshape(H, d)).reshape(B, T, H * d)
    return (hn * jax.nn.sigmoid(o_pre.astype(F32))).astype(o_pre.dtype)


def pool_mix(u, pool_w, pool_scale):
    B, T, _ = u.shape
    uf = u.astype(F32)
    cs = jnp.concatenate([jnp.zeros((B, 1, POOL_WIDTH), F32), jnp.cumsum(uf, 1)], 1)
    t = jnp.arange(T)
    outs = []
    for gi, w in enumerate(POOL_WINDOWS):
        lo = jnp.maximum(t - w // 2, 0)
        hi = jnp.minimum(t + w // 2, T)
        sl = slice(gi * POOL_GROUP_DIM, (gi + 1) * POOL_GROUP_DIM)
        csg = cs[:, :, sl]
        mean = (csg[:, hi] - csg[:, lo]) / (hi - lo).astype(F32)[None, :, None]
        outs.append(mean - uf[:, :, sl])
    p = jnp.stack(outs, 2)
    y = jnp.einsum('btgi,gio->btgo', p, pool_w.astype(F32)).reshape(B, T, POOL_WIDTH)
    return (y * pool_scale.astype(F32)).astype(u.dtype)


def swiglu(h, w_g, w_u, w_d):
    return (jax.nn.silu(h @ w_g) * (h @ w_u)) @ w_d


def hybrid_layer(xl, xc, c, c_ctx, w_ada, b_ada, norm_mix, w_in, b_gates, q_norm, k_norm, ml_norm,
                 pool_w, pool_scale, w_out, norm_ffn, w_ffn_gate, w_ffn_up, w_ffn_down, cos, sin, with_ctx_out):
    B, T, _ = xl.shape
    Tc = xc.shape[1]
    mod_l = (jax.nn.silu(c) @ w_ada + b_ada)[:, None, :]
    mod_c = jax.nn.silu(c_ctx) @ w_ada + b_ada
    sh1_l, sc1_l, g1_l, sh2_l, sc2_l, g2_l = jnp.split(mod_l, 6, -1)
    sh1_c, sc1_c, g1_c, sh2_c, sc2_c, g2_c = jnp.split(mod_c, 6, -1)

    hl = rms_norm(xl, norm_mix) * (1.0 + sc1_l) + sh1_l
    hc = rms_norm(xc, norm_mix) * (1.0 + sc1_c) + sh1_c
    aq_l, ak_l, av_l, mq_l, mk_l, mv_l, mo_l, mg_l, pp_l = jnp.split(hl @ w_in, IN_OFFSETS, -1)
    aq_c, ak_c, av_c, mq_c, mk_c, mv_c, mo_c, mg_c, pp_c = jnp.split(hc @ w_in, IN_OFFSETS, -1)

    q_l = apply_rope(rms_norm(aq_l.reshape(B, T, ATT_HEADS, HEAD_DIM), q_norm), cos, sin)
    k_l = apply_rope(rms_norm(ak_l.reshape(B, T, ATT_KV_HEADS, HEAD_DIM), k_norm), cos, sin)
    v_l = av_l.reshape(B, T, ATT_KV_HEADS, HEAD_DIM)
    k_c = rms_norm(ak_c.reshape(B, Tc, ATT_KV_HEADS, HEAD_DIM), k_norm)
    v_c = av_c.reshape(B, Tc, ATT_KV_HEADS, HEAD_DIM)
    att_l = block_attention(q_l, jnp.concatenate([k_l, k_c], 1), jnp.concatenate([v_l, v_c], 1))

    def ml_heads(a, n):
        return a.reshape(B, n, ML_HEADS, HEAD_DIM).transpose(0, 2, 1, 3)

    def ml_gates(gp, n):
        return (gp + b_gates).astype(F32).reshape(B, n, 4, ML_HEADS).transpose(2, 0, 3, 1)

    hm_c, hm_l = bidir_mlstm(ml_heads(mq_c, Tc), ml_heads(mk_c, Tc), ml_heads(mv_c, Tc), ml_gates(mg_c, Tc),
                             ml_heads(mq_l, T), ml_heads(mk_l, T), ml_heads(mv_l, T), ml_gates(mg_l, T))
    ml_l = mlstm_readout(hm_l, mo_l, ml_norm)

    pool_l = pool_mix(pp_l, pool_w, pool_scale)

    xl = xl + g1_l * (jnp.concatenate([att_l, ml_l, pool_l], -1) @ w_out)
    h2l = rms_norm(xl, norm_ffn) * (1.0 + sc2_l) + sh2_l
    xl = xl + g2_l * swiglu(h2l, w_ffn_gate, w_ffn_up, w_ffn_down)

    if with_ctx_out:
        q_c = rms_norm(aq_c.reshape(B, Tc, ATT_HEADS, HEAD_DIM), q_norm)
        att_c = block_attention(q_c, k_c, v_c)
        ml_c = mlstm_readout(hm_c, mo_c, ml_norm)
        pool_c = pool_mix(pp_c, pool_w, pool_scale)
        xc = xc + g1_c * (jnp.concatenate([att_c, ml_c, pool_c], -1) @ w_out)
        h2c = rms_norm(xc, norm_ffn) * (1.0 + sc2_c) + sh2_c
        xc = xc + g2_c * swiglu(h2c, w_ffn_gate, w_ffn_up, w_ffn_down)
    return xl, xc


def setup_inputs(seed: int = 0) -> dict:
    key = jax.random.key(seed)
    ks = jax.random.split(key, 22)

    def dense(k, shape, fan_in, mult=1.0):
        return mult * jax.random.normal(k, shape, F32) * fan_in ** -0.5

    def gain(k, shape):
        return 1.0 + 0.05 * jax.random.normal(k, shape, F32)

    f_bias = jnp.linspace(3.0, 6.0, ML_HEADS, dtype=F32)
    gate_base = jnp.stack([jnp.zeros_like(f_bias), f_bias, jnp.zeros_like(f_bias), f_bias])
    b_gates = (gate_base[None] + 0.1 * jax.random.normal(ks[8], (DEPTH, 4, ML_HEADS), F32)).reshape(DEPTH, N_GATES)
    return {
        'x': jax.random.normal(ks[0], (BATCH, SEQ, D_MODEL), F32),
        'c': jax.random.normal(ks[1], (BATCH, D_MODEL), F32),
        'ctx': jax.random.normal(ks[2], (BATCH, CTX_LEN, D_MODEL), F32),
        'c_ctx': jax.random.normal(ks[3], (D_MODEL,), F32),
        'w_ada': dense(ks[4], (DEPTH, D_MODEL, 6 * D_MODEL), D_MODEL, 0.5),
        'b_ada': 0.02 * jax.random.normal(ks[5], (DEPTH, 6 * D_MODEL), F32),
        'norm_mix': gain(ks[6], (DEPTH, D_MODEL)),
        'w_in': dense(ks[7], (DEPTH, D_MODEL, IN_WIDTH), D_MODEL),
        'b_gates': b_gates,
        'q_norm': gain(ks[9], (DEPTH, HEAD_DIM)),
        'k_norm': gain(ks[10], (DEPTH, HEAD_DIM)),
        'ml_norm': gain(ks[11], (DEPTH, ML_WIDTH)),
        'pool_w': dense(ks[12], (DEPTH, POOL_GROUPS, POOL_GROUP_DIM, POOL_GROUP_DIM), POOL_GROUP_DIM),
        'pool_scale': 1.0 + 0.1 * jax.random.normal(ks[13], (DEPTH, POOL_WIDTH), F32),
        'w_out': dense(ks[14], (DEPTH, MIX_WIDTH, D_MODEL), MIX_WIDTH),
        'norm_ffn': gain(ks[15], (DEPTH, D_MODEL)),
        'w_ffn_gate': dense(ks[16], (DEPTH, D_MODEL, D_FF), D_MODEL),
        'w_ffn_up': dense(ks[17], (DEPTH, D_MODEL, D_FF), D_MODEL),
        'w_ffn_down': dense(ks[18], (DEPTH, D_FF, D_MODEL), D_FF),
        'final_norm': gain(ks[19], (D_MODEL,)),
    }


def reference(x, c, ctx, c_ctx, w_ada, b_ada, norm_mix, w_in, b_gates, q_norm, k_norm, ml_norm,
              pool_w, pool_scale, w_out, norm_ffn, w_ffn_gate, w_ffn_up, w_ffn_down, final_norm):
    ROWS = x.shape[1] // GRID_W
    cos, sin = axial_rope_tables(ROWS)
    xl, xc = x, ctx
    for layer in range(DEPTH):
        xl, xc = hybrid_layer(xl, xc, c, c_ctx, w_ada[layer], b_ada[layer], norm_mix[layer], w_in[layer],
                              b_gates[layer], q_norm[layer], k_norm[layer], ml_norm[layer], pool_w[layer],
                              pool_scale[layer], w_out[layer], norm_ffn[layer], w_ffn_gate[layer],
                              w_ffn_up[layer], w_ffn_down[layer], cos, sin, layer < DEPTH - 1)
    return rms_norm(xl, final_norm)
```

```cpp
#include <hip/hip_runtime.h>
#include <hip/hip_cooperative_groups.h>
#include <hip/hip_bf16.h>
#include <cstdio>
#include <cstdint>
#include <cmath>
namespace cg = cooperative_groups;

constexpr int DMODEL = 1024, NBATCH = 16, TLAT = 2048, TCTX = 256, NLAT = NBATCH * TLAT, NCTX = NBATCH * TCTX, MTOT = NLAT + NCTX;
constexpr int N1 = 2304, DFF = 2816, NGU = 2 * DFF, TKV = TLAT + TCTX, INW = 2064;
constexpr float EPS = 1e-6f;
constexpr size_t MiB = 1u << 20;
constexpr size_t WS_CTL = 0, WS_MOD = 1 * MiB, WS_ROPE = 2 * MiB, WS_W1 = 4 * MiB, WS_WO = 13 * MiB, WS_WGU = 17 * MiB, WS_WD = 39 * MiB,
                 WS_XC = 50 * MiB, WS_XN = 66 * MiB, WS_QB = 138 * MiB, WS_KB = 174 * MiB, WS_VB = 183 * MiB, WS_MLB = 192 * MiB, WS_PZ = 264 * MiB,
                 WS_GT = 282 * MiB, WS_HS = 285 * MiB, WS_MIX = 321 * MiB, WS_HID = 138 * MiB, WS_HS1 = 393 * MiB, WS_XS = 429 * MiB, WS_END = 501 * MiB;
constexpr size_t W1_BYTES = (size_t)N1 * 1024 * 2, WO_BYTES = (size_t)1024 * 1024 * 2, WGU_BYTES = (size_t)NGU * 1024 * 2, WD_BYTES = (size_t)1024 * DFF * 2;

#define LAS __attribute__((address_space(3)))
typedef unsigned short bf16_t;
typedef float f32x4 __attribute__((ext_vector_type(4)));
typedef unsigned u32x4 __attribute__((ext_vector_type(4)));
typedef short bf16x8 __attribute__((ext_vector_type(8)));

__device__ __forceinline__ unsigned f2bf(float f) { unsigned u = __builtin_bit_cast(unsigned, f); return (u + 0x7fffu + ((u >> 16) & 1u)) >> 16; }
typedef float f32x2_hw __attribute__((ext_vector_type(2))); typedef __bf16 bf16x2_hw __attribute__((ext_vector_type(2)));
__device__ __forceinline__ unsigned pk2(float lo, float hi) { f32x2_hw v = {lo, hi}; bf16x2_hw b = __builtin_convertvector(v, bf16x2_hw); return __builtin_bit_cast(unsigned, b); }
__device__ __forceinline__ unsigned f2bf_hw(float f) { return pk2(f, 0.f) & 0xffffu; }
__device__ __forceinline__ float bf2f(unsigned v) { return __builtin_bit_cast(float, v << 16); }
__device__ __forceinline__ float silu_f(float x) { return x * __builtin_amdgcn_rcpf(1.0f + __expf(-x)); }
__device__ __forceinline__ float sigmoid_f(float x) { return __builtin_amdgcn_rcpf(1.0f + __expf(-x)); }
__device__ __forceinline__ float wave_sum(float v) {
#pragma unroll
    for (int o = 1; o < 64; o <<= 1) v += __shfl_xor(v, o);
    return v;
}
__device__ __forceinline__ int opaque_tid() { int t = threadIdx.x; asm volatile("" : "+v"(t)); return t; }
namespace pg8 {
#define PG8_LAS __attribute__((address_space(3)))
typedef unsigned short bf16_t;
typedef short bf16x8 __attribute__((ext_vector_type(8)));
typedef float f32x4 __attribute__((ext_vector_type(4)));
typedef unsigned u32x4 __attribute__((ext_vector_type(4)));
constexpr int BM = 256, BK = 64, HALF = 128, HTB = HALF * BK * 2  , STAGE_BYTES = 8 * HTB, NXCD = 8, WGM = 8;

__host__ __device__ __forceinline__ int lds_byte(int r, int c) { const int st = (r >> 4) * 2 + (c >> 5), rr = r & 15, cc = c & 31, ob = rr * 64 + cc * 2; return st * 1024 + (ob ^ (((ob >> 9) & 1) << 5)); }
__host__ __device__ __forceinline__ void stage_rc(int b, int& R, int& C) { const int st = b / 1024, sb = b % 1024, swz = sb ^ (((sb >> 9) & 1) << 5); R = (st >> 1) * 16 + swz / 64; C = (st & 1) * 32 + (swz % 64) / 2; }
__host__ __device__ __forceinline__ int perm32(int rho) { const int n = rho >> 4, i = rho & 15; return 8 * (i >> 2) + 4 * n + (i & 3); }

struct Unit { int pm, pn; };
struct Gemm { const bf16_t* A; const bf16_t* Bt; int M, N, K; int ld; };

struct StaticOrder {
    int nM, nN, nwg, G, c;
    __host__ __device__ void init(int M, int N, int G_, int c_) { nM = M / BM; nN = N / BM; nwg = nM * nN; G = G_; c = c_; }
    __host__ __device__ bool next(int i, Unit& u) const {
        const long L = (long)i * G + c; if (L >= nwg) return false;
        int wgid = (int)L; { const int q = nwg / NXCD, r = nwg % NXCD, xcd = wgid % NXCD, off = wgid / NXCD; wgid = (xcd < r ? xcd * (q + 1) : r * (q + 1) + (xcd - r) * q) + off; }
        const int nig = WGM * nN, gid = wgid / nig, fm = gid * WGM, gsz = (nM - fm) < WGM ? (nM - fm) : WGM;
        u.pm = fm + ((wgid % nig) % gsz); u.pn = (wgid % nig) / gsz; return true;
    }
    __device__ __forceinline__ void a_ready(const Unit&) const {}
    __device__ __forceinline__ void done(const Unit&) const {}
};

__device__ __forceinline__ unsigned cvt_pk_bf16(float lo, float hi) { unsigned r; asm volatile("v_cvt_pk_bf16_f32 %0, %1, %2" : "=v"(r) : "v"(lo), "v"(hi)); return r; }
typedef float f32x2 __attribute__((ext_vector_type(2)));
struct G1Order {
    StaticOrder so; int G, c, next_n, npn; int pl0, pl1, pl2, pl3, pl4, pl5, pl6, pl7;
    __device__ void init(int G_, int c_, bool layer0) { so.init(NLAT, N1, G_, c_); G = G_; c = c_;
        if (layer0) { npn = 8; pl0 = 0; pl1 = 1; pl2 = 2; pl3 = 3; pl4 = 4; pl5 = 5; pl6 = 6; pl7 = 7; }
        else { npn = 5; pl0 = 2; pl1 = 3; pl2 = 4; pl3 = 5; pl4 = 8; pl5 = 0; pl6 = 0; pl7 = 0; }
        next_n = 16 * npn; }
    __device__ bool next(int i, Unit& u) const {
        const int L = i * G + c;
        if (L < so.nwg) return so.next(i, u);
        const int e = L - so.nwg; if (e >= next_n) return false;
        const int q = e % npn; u.pm = 128 + e / npn;
        u.pn = (q == 0) ? pl0 : (q == 1) ? pl1 : (q == 2) ? pl2 : (q == 3) ? pl3 : (q == 4) ? pl4 : (q == 5) ? pl5 : (q == 6) ? pl6 : pl7; return true; }
    __device__ __forceinline__ void a_ready(const Unit&) const {}
    __device__ __forceinline__ void done(const Unit&) const {}
};
struct EpiIn {
    static constexpr bool PERM = true, AFTER_DRAIN = false;
    bf16_t *QB, *KB, *VB, *MLB, *PZ; float* GT;
    const float *qn, *kn, *bg; const float* CS;
    float c2;
    __device__ __forceinline__ void operator()(const f32x4 (&acc)[2][2][4][2], const Unit& u, int wr, int wc, int fr, int fq) const {
        const int pn = u.pn, pm = u.pm;
        const bool lat = pm < 128;
        const int rt0 = wr * 64 + fr;
        const size_t grow0 = (size_t)pm * 256 + rt0;
        const size_t kv0 = lat ? ((size_t)(pm >> 3) * TKV + (size_t)(pm & 7) * 256 + rt0) : ((size_t)(pm - 128) * TKV + TLAT + rt0);
        if (pn < 2 || (pn == 2 && wc < 2)) {
            const bool isq = pn < 2;
            const float* nw = isq ? qn : kn;
            f32x4 wv[2][2];
#pragma unroll
            for (int bj = 0; bj < 2; ++bj)
#pragma unroll
                for (int n = 0; n < 2; ++n) wv[bj][n] = *(const f32x4*)(nw + 32 * bj + 8 * fq + 4 * n);
            const float sgn = (fq < 2) ? -1.f : 1.f;
            const float osc = isq ? c2 : 1.f;
#pragma unroll
            for (int ai = 0; ai < 2; ++ai)
#pragma unroll
                for (int m = 0; m < 4; ++m) {
                    float ss = 0.f;
#pragma unroll
                    for (int bj = 0; bj < 2; ++bj)
#pragma unroll
                        for (int n = 0; n < 2; ++n) { const f32x4 v = acc[ai][bj][m][n]; ss += (v[0] * v[0] + v[1] * v[1]) + (v[2] * v[2] + v[3] * v[3]); }
                    ss += __shfl_xor(ss, 16); ss += __shfl_xor(ss, 32);
                    const float rstd = rsqrtf(ss * (1.0f / 64.0f) + EPS);
                    const int roff = ai * 128 + m * 16;
#pragma unroll
                    for (int bj = 0; bj < 2; ++bj) {
                        f32x4 y[2];
#pragma unroll
                        for (int n = 0; n < 2; ++n) y[n] = acc[ai][bj][m][n] * rstd * wv[bj][n];
                        if (lat) {
                            const int pos = (bj == 0) ? ((pm & 7) * 4 + 2 * ai + wr) : (m * 16 + fr);
                            const float* cs = CS + (size_t)pos * 32 + 16 * (fq & 1);
#pragma unroll
                            for (int n = 0; n < 2; ++n) {
                                const f32x4 t0 = *(const f32x4*)(cs + 8 * n), t1 = *(const f32x4*)(cs + 8 * n + 4);
                                f32x4 p;
                                p[0] = __shfl_xor(y[n][0], 32); p[1] = __shfl_xor(y[n][1], 32); p[2] = __shfl_xor(y[n][2], 32); p[3] = __shfl_xor(y[n][3], 32);
                                f32x4 o;
                                o[0] = y[n][0] * t0[0] + sgn * p[0] * t0[1];
                                o[1] = y[n][1] * t0[2] + sgn * p[1] * t0[3];
                                o[2] = y[n][2] * t1[0] + sgn * p[2] * t1[1];
                                o[3] = y[n][3] * t1[2] + sgn * p[3] * t1[3];
                                y[n] = o;
                            }
                        }
                        u32x4 w;
                        w.x = cvt_pk_bf16(y[0][0] * osc, y[0][1] * osc); w.y = cvt_pk_bf16(y[0][2] * osc, y[0][3] * osc);
                        w.z = cvt_pk_bf16(y[1][0] * osc, y[1][1] * osc); w.w = cvt_pk_bf16(y[1][2] * osc, y[1][3] * osc);
                        bf16_t* dst = isq ? (QB + (grow0 + roff) * 512 + (4 * pn + wc) * 64 + 32 * bj + 8 * fq)
                                          : (KB + (kv0 + roff) * 128 + wc * 64 + 32 * bj + 8 * fq);
                        *(u32x4*)dst = w;
                    }
                    asm volatile("" ::: "memory");
                }
        } else if (pn <= 7) {
            bf16_t* base; size_t ld; size_t r0; int cb; float sc = 1.f;
            if (pn == 2) { base = VB; ld = 128; r0 = kv0; cb = (wc - 2) * 64; }
            else if (pn == 7) { base = PZ; ld = 256; r0 = grow0; cb = wc * 64; }
            else { base = MLB; ld = 1024; r0 = grow0; cb = (pn - 3) * 256 + wc * 64; if (pn == 4) sc = 0.125f; }
#pragma unroll
            for (int ai = 0; ai < 2; ++ai)
#pragma unroll
                for (int m = 0; m < 4; ++m)
#pragma unroll
                    for (int bj = 0; bj < 2; ++bj) {
                        const f32x4 v0 = acc[ai][bj][m][0] * sc, v1 = acc[ai][bj][m][1] * sc;
                        u32x4 w; w.x = cvt_pk_bf16(v0[0], v0[1]); w.y = cvt_pk_bf16(v0[2], v0[3]); w.z = cvt_pk_bf16(v1[0], v1[1]); w.w = cvt_pk_bf16(v1[2], v1[3]);
                        *(u32x4*)(base + (r0 + ai * 128 + m * 16) * ld + cb + 32 * bj + 8 * fq) = w;
                    }
        } else {
            if (wc == 0 && fq < 2) {
                const f32x4 b0 = *(const f32x4*)(bg + 8 * fq), b1 = *(const f32x4*)(bg + 8 * fq + 4);
#pragma unroll
                for (int ai = 0; ai < 2; ++ai)
#pragma unroll
                    for (int m = 0; m < 4; ++m) {
                        float* g = GT + (grow0 + ai * 128 + m * 16) * 16 + 8 * fq;
                        *(f32x4*)g = acc[ai][0][m][0] + b0; *(f32x4*)(g + 4) = acc[ai][0][m][1] + b1;
                    }
            }
        }
    }
};
struct EpiRes {
    static constexpr bool PERM = false, AFTER_DRAIN = false;
    const float *base_l, *base_c; float *out_l, *out_c; const float* gate;
    __device__ __forceinline__ void operator()(const f32x4 (&acc)[2][2][4][2], const Unit& u, int wr, int wc, int fr, int fq) const {
        const int pn = u.pn, pm = u.pm; const bool lat = pm < 128;
        const float* gv = gate + (size_t)(lat ? (pm >> 3) : 16) * 6144;
        const float* bp = lat ? base_l + (size_t)pm * 256 * 1024 : base_c + (size_t)(pm - 128) * 256 * 1024;
        float* op = lat ? out_l + (size_t)pm * 256 * 1024 : out_c + (size_t)(pm - 128) * 256 * 1024;
        const int col0 = pn * BM + wc * 32 + 4 * fq;
        f32x4 g4[2][2];
#pragma unroll
        for (int bj = 0; bj < 2; ++bj)
#pragma unroll
            for (int n = 0; n < 2; ++n) g4[bj][n] = *(const f32x4*)(gv + col0 + bj * HALF + n * 16);
#pragma unroll
        for (int ai = 0; ai < 2; ++ai)
#pragma unroll
            for (int m = 0; m < 4; ++m) { const size_t off = (size_t)(ai * HALF + wr * 64 + m * 16 + fr) * 1024 + col0;
#pragma unroll
                for (int bj = 0; bj < 2; ++bj)
#pragma unroll
                    for (int n = 0; n < 2; ++n) { const f32x4 x = *(const f32x4*)(bp + off + bj * HALF + n * 16); *(f32x4*)(op + off + bj * HALF + n * 16) = x + g4[bj][n] * acc[ai][bj][m][n]; }
                if (m & 1) asm volatile("" ::: "memory"); }
    }
};
struct EpiGU {
    static constexpr bool PERM = true, AFTER_DRAIN = false;
    bf16_t* H;
    __device__ __forceinline__ void operator()(const f32x4 (&acc)[2][2][4][2], const Unit& u, int wr, int wc, int fr, int fq) const {
        const size_t row0 = (size_t)u.pm * BM + wr * 64 + fr; const int col0 = u.pn * 128 + wc * 32 + 8 * fq;
#pragma unroll
        for (int ai = 0; ai < 2; ++ai)
#pragma unroll
            for (int m = 0; m < 4; ++m) {
                f32x4 v[2];
#pragma unroll
                for (int n = 0; n < 2; ++n) { const f32x4 g = acc[ai][0][m][n], up = acc[ai][1][m][n];
                    v[n][0] = g[0] * __builtin_amdgcn_rcpf(1.0f + __expf(-g[0])) * up[0]; v[n][1] = g[1] * __builtin_amdgcn_rcpf(1.0f + __expf(-g[1])) * up[1];
                    v[n][2] = g[2] * __builtin_amdgcn_rcpf(1.0f + __expf(-g[2])) * up[2]; v[n][3] = g[3] * __builtin_amdgcn_rcpf(1.0f + __expf(-g[3])) * up[3]; }
                u32x4 w; w.x = cvt_pk_bf16(v[0][0], v[0][1]); w.y = cvt_pk_bf16(v[0][2], v[0][3]); w.z = cvt_pk_bf16(v[1][0], v[1][1]); w.w = cvt_pk_bf16(v[1][2], v[1][3]);
                *(u32x4*)(H + (row0 + ai * HALF + m * 16) * DFF + col0) = w;
            }
    }
};
template <bool IN_BF16, bool OUT_BF16> struct EpiRes2 {
    static constexpr bool PERM = true, AFTER_DRAIN = false;
    const float *bl, *bc; bf16_t* xs; float* ol; const float* gate;
    __device__ __forceinline__ void operator()(const f32x4 (&acc)[2][2][4][2], const Unit& u, int wr, int wc, int fr, int fq) const {
        const int pn = u.pn, pm = u.pm; const bool lat = pm < 128;
        const float* gv = gate + (size_t)(lat ? (pm >> 3) : 16) * 6144;
        const int col0 = pn * BM + wc * 32 + 8 * fq;
        const size_t row0 = (size_t)pm * BM + wr * 64 + fr;
        const float* bf = lat ? bl + row0 * 1024 : bc + (row0 - NLAT) * 1024;
        f32x4 g4[2][2];
#pragma unroll
        for (int bj = 0; bj < 2; ++bj)
#pragma unroll
            for (int n = 0; n < 2; ++n) g4[bj][n] = *(const f32x4*)(gv + col0 + bj * HALF + 4 * n);
#pragma unroll
        for (int ai = 0; ai < 2; ++ai)
#pragma unroll
            for (int m = 0; m < 4; ++m) { const size_t ro = (size_t)(ai * HALF + m * 16) * 1024;
#pragma unroll
                for (int bj = 0; bj < 2; ++bj) { const int c = col0 + bj * HALF;
                    f32x4 x0, x1;
                    if (IN_BF16) { const u32x4 v = *(const u32x4*)(xs + row0 * 1024 + ro + c);
                        x0 = (f32x4){__builtin_bit_cast(float, v.x << 16), __builtin_bit_cast(float, v.x & 0xffff0000u), __builtin_bit_cast(float, v.y << 16), __builtin_bit_cast(float, v.y & 0xffff0000u)};
                        x1 = (f32x4){__builtin_bit_cast(float, v.z << 16), __builtin_bit_cast(float, v.z & 0xffff0000u), __builtin_bit_cast(float, v.w << 16), __builtin_bit_cast(float, v.w & 0xffff0000u)}; }
                    else { x0 = *(const f32x4*)(bf + ro + c); x1 = *(const f32x4*)(bf + ro + c + 4); }
                    x0 = x0 + g4[bj][0] * acc[ai][bj][m][0]; x1 = x1 + g4[bj][1] * acc[ai][bj][m][1];
                    if (OUT_BF16) { u32x4 w; w.x = cvt_pk_bf16(x0[0], x0[1]); w.y = cvt_pk_bf16(x0[2], x0[3]); w.z = cvt_pk_bf16(x1[0], x1[1]); w.w = cvt_pk_bf16(x1[2], x1[3]);
                        *(u32x4*)(xs + row0 * 1024 + ro + c) = w; }
                    else { *(f32x4*)(ol + row0 * 1024 + ro + c) = x0; *(f32x4*)(ol + row0 * 1024 + ro + c + 4) = x1; } }
                if (IN_BF16 ? (m == 3) : (m & 1)) asm volatile("" ::: "memory"); }
    }
};
struct TailOrder {
    int c, c0;
    __device__ bool next(int i, Unit& u) const { const int e = c - c0; if (i != 0 || e < 0 || e >= 64) return false; u.pn = e & 3; u.pm = 128 + (e >> 2); return true; }
    __device__ __forceinline__ void a_ready(const Unit&) const {}
    __device__ __forceinline__ void done(const Unit&) const {}
};
struct EpiPart {
    static constexpr bool PERM = true, AFTER_DRAIN = false;
    float* P;
    __device__ __forceinline__ void operator()(const f32x4 (&acc)[2][2][4][2], const Unit& u, int wr, int wc, int fr, int fq) const {
        float* op = P + ((size_t)(u.pm - 128) * BM + wr * 64 + fr) * 1024 + u.pn * BM + wc * 32 + 8 * fq;
#pragma unroll
        for (int ai = 0; ai < 2; ++ai)
#pragma unroll
            for (int m = 0; m < 4; ++m)
#pragma unroll
                for (int bj = 0; bj < 2; ++bj) { float* o = op + (size_t)(ai * HALF + m * 16) * 1024 + bj * HALF; *(f32x4*)o = acc[ai][bj][m][0]; *(f32x4*)(o + 4) = acc[ai][bj][m][1]; }
    }
};
template <class Epi, class Sched, bool ALIGN_EPI = false, bool SP2 = false>
__device__ __forceinline__ void gemm_phase(PG8_LAS unsigned char* lds, const Gemm g, const Sched& S, const Epi& E) {
    const int tid = opaque_tid(), wid = __builtin_amdgcn_readfirstlane(tid >> 6), lane = tid & 63, wr = wid >> 2, wc = wid & 3, fr = lane & 15, fq = lane >> 4;
    const int K = g.ld ? g.ld : g.K, nt = g.K / BK;
    unsigned voffA[2], voffB[2];
#pragma unroll
    for (int i = 0; i < 2; ++i) { int R, C; stage_rc(tid * 16 + i * 8192, R, C); const int Rb = Epi::PERM ? ((R & ~31) + perm32(R & 31)) : R;
        voffA[i] = (unsigned)(R * K + C) * 2u; voffB[i] = (unsigned)(Rb * K + C) * 2u; }
    const size_t kstep = (size_t)(BK * 2);
    const size_t hstep = (size_t)HALF * K * 2;
    const size_t tstep = 2 * hstep;
    const unsigned ldsw = (unsigned)wid * 1024u;
    const int aoff = lds_byte(wr * 64 + fr, fq * 8), boff = lds_byte(wc * 32 + fr, fq * 8);
#define PG8_SA(b, h) (((b) * 2 + (h)) * HTB)
#define PG8_SB(b, h) ((4 + (b) * 2 + (h)) * HTB)
#define PG8_STAGE(bufoff, gbase, voff) do { _Pragma("unroll") for (int _i = 0; _i < 2; ++_i) \
        __builtin_amdgcn_global_load_lds((const unsigned*)((const char*)(gbase) + (voff)[_i]), (PG8_LAS unsigned*)(lds + (bufoff) + ldsw + _i * 8192), 16, 0, 0); } while (0)
#define PG8_LDA(dst, b, h) do { _Pragma("unroll") for (int m = 0; m < 4; ++m) _Pragma("unroll") for (int k = 0; k < 2; ++k) dst[m][k] = *(const PG8_LAS bf16x8*)(lds + PG8_SA(b, h) + aoff + m * 2048 + k * 1024); } while (0)
#define PG8_LDB(dst, b, h) do { _Pragma("unroll") for (int n = 0; n < 2; ++n) _Pragma("unroll") for (int k = 0; k < 2; ++k) dst[n][k] = *(const PG8_LAS bf16x8*)(lds + PG8_SB(b, h) + boff + n * 2048 + k * 1024); } while (0)
#define PG8_MMA(ai, bj, At, Bt) do { __builtin_amdgcn_s_setprio(1); _Pragma("unroll") for (int m = 0; m < 4; ++m) _Pragma("unroll") for (int n = 0; n < 2; ++n) _Pragma("unroll") for (int k = 0; k < 2; ++k) \
        acc[ai][bj][m][n] = __builtin_amdgcn_mfma_f32_16x16x32_bf16(Bt[n][k], At[m][k], acc[ai][bj][m][n], 0, 0, 0); __builtin_amdgcn_s_setprio(0); } while (0)
#define PG8_WAIT_V(n) asm volatile("s_waitcnt vmcnt(" #n ")" ::: "memory")
#define PG8_WAIT_L(n) asm volatile("s_waitcnt lgkmcnt(" #n ")" ::: "memory")
#define PG8_BAR __builtin_amdgcn_s_barrier()
#define PG8_SCHED __builtin_amdgcn_sched_barrier(0)
    Unit cur, nxt; int ui = 0;
    if (!S.next(0, cur)) return;
    f32x4 acc[2][2][4][2];
#pragma unroll
    for (int a = 0; a < 2; ++a)
#pragma unroll
        for (int b = 0; b < 2; ++b)
#pragma unroll
            for (int m = 0; m < 4; ++m)
#pragma unroll
                for (int n = 0; n < 2; ++n) acc[a][b][m][n] = (f32x4){0.f, 0.f, 0.f, 0.f};
    bf16x8 At[4][2], B0[2][2], B1[2][2];
    const char* cA = (const char*)g.A + (size_t)cur.pm * tstep; const char* cB = (const char*)g.Bt + (size_t)cur.pn * tstep;
    S.a_ready(cur);
    if constexpr (SP2) {
        PG8_STAGE(PG8_SB(0, 0), cB, voffB); PG8_STAGE(PG8_SB(0, 1), cB + hstep, voffB); PG8_STAGE(PG8_SA(0, 0), cA, voffA); PG8_STAGE(PG8_SA(0, 1), cA + hstep, voffA);
        if (wr == 1) PG8_BAR;
        PG8_WAIT_V(2); PG8_BAR;
        PG8_STAGE(PG8_SB(1, 0), cB + kstep, voffB); PG8_STAGE(PG8_SA(1, 0), cA + kstep, voffA); PG8_STAGE(PG8_SB(1, 1), cB + hstep + kstep, voffB);
        PG8_WAIT_V(6); PG8_BAR;
    } else {
        PG8_STAGE(PG8_SB(0, 0), cB, voffB); PG8_STAGE(PG8_SA(0, 0), cA, voffA); PG8_STAGE(PG8_SB(0, 1), cB + hstep, voffB); PG8_STAGE(PG8_SA(0, 1), cA + hstep, voffA);
        if (wr == 1) PG8_BAR;
        PG8_WAIT_V(4); PG8_BAR;
        PG8_STAGE(PG8_SB(1, 0), cB + kstep, voffB); PG8_STAGE(PG8_SA(1, 0), cA + kstep, voffA); PG8_STAGE(PG8_SB(1, 1), cB + hstep + kstep, voffB);
        PG8_WAIT_V(6); PG8_BAR;
    }
    for (;;) {
        const bool has_next = S.next(ui + 1, nxt);
        const char* nA = has_next ? (const char*)g.A + (size_t)nxt.pm * tstep : cA; const char* nB = has_next ? (const char*)g.Bt + (size_t)nxt.pn * tstep : cB;
        for (int t = 0; t < nt; t += 2) {
            const bool last = (t == nt - 2);
            const char* a1 = cA + (size_t)(t + 1) * kstep;
            const char* a2 = last ? nA : cA + (size_t)(t + 2) * kstep; const char* b2 = last ? nB : cB + (size_t)(t + 2) * kstep;
            const char* a3 = a2 + kstep; const char* b3 = b2 + kstep;
            if (last && has_next) S.a_ready(nxt);
            if constexpr (SP2) {
            PG8_LDB(B0, 0, 0); PG8_LDB(B1, 0, 1); PG8_SCHED; PG8_LDA(At, 0, 0); PG8_STAGE(PG8_SA(1, 1), a1 + hstep, voffA);
            PG8_WAIT_V(8); PG8_WAIT_L(0); PG8_BAR; PG8_MMA(0, 0, At, B0); PG8_MMA(0, 1, At, B1); PG8_BAR; PG8_SCHED;
            PG8_LDA(At, 0, 1); PG8_STAGE(PG8_SB(0, 0), b2, voffB); PG8_STAGE(PG8_SB(0, 1), b2 + hstep, voffB); PG8_STAGE(PG8_SA(0, 0), a2, voffA);
            PG8_WAIT_V(8); PG8_WAIT_L(0); PG8_BAR; PG8_MMA(1, 0, At, B0); PG8_MMA(1, 1, At, B1); PG8_BAR; PG8_SCHED;
            PG8_LDB(B0, 1, 0); PG8_LDB(B1, 1, 1); PG8_SCHED; PG8_LDA(At, 1, 0); PG8_STAGE(PG8_SA(0, 1), a2 + hstep, voffA);
            PG8_WAIT_V(8); PG8_WAIT_L(0); PG8_BAR; PG8_MMA(0, 0, At, B0); PG8_MMA(0, 1, At, B1); PG8_BAR; PG8_SCHED;
            PG8_LDA(At, 1, 1); PG8_STAGE(PG8_SB(1, 0), b3, voffB); PG8_STAGE(PG8_SB(1, 1), b3 + hstep, voffB); PG8_STAGE(PG8_SA(1, 0), a3, voffA);
            PG8_WAIT_V(8); PG8_WAIT_L(0); PG8_BAR; PG8_MMA(1, 0, At, B0); PG8_MMA(1, 1, At, B1); PG8_BAR; PG8_SCHED;
            } else {
            PG8_LDB(B0, 0, 0); PG8_SCHED; PG8_LDA(At, 0, 0); PG8_STAGE(PG8_SA(1, 1), a1 + hstep, voffA);
            PG8_WAIT_L(8); PG8_BAR; PG8_WAIT_L(0); PG8_MMA(0, 0, At, B0); PG8_BAR; PG8_SCHED;
            PG8_LDB(B1, 0, 1); PG8_STAGE(PG8_SB(0, 0), b2, voffB);
            PG8_BAR; PG8_WAIT_L(0); PG8_MMA(0, 1, At, B1); PG8_BAR;
            PG8_LDA(At, 0, 1); PG8_STAGE(PG8_SA(0, 0), a2, voffA);
            PG8_BAR; PG8_WAIT_L(0); PG8_MMA(1, 0, At, B0); PG8_BAR; PG8_SCHED;
            PG8_STAGE(PG8_SB(0, 1), b2 + hstep, voffB);
            PG8_WAIT_V(6); PG8_BAR; PG8_MMA(1, 1, At, B1); PG8_BAR;
            PG8_LDB(B0, 1, 0); PG8_SCHED; PG8_LDA(At, 1, 0); PG8_STAGE(PG8_SA(0, 1), a2 + hstep, voffA);
            PG8_WAIT_L(8); PG8_BAR; PG8_WAIT_L(0); PG8_MMA(0, 0, At, B0); PG8_BAR; PG8_SCHED;
            PG8_LDB(B1, 1, 1); PG8_STAGE(PG8_SB(1, 0), b3, voffB);
            PG8_BAR; PG8_WAIT_L(0); PG8_MMA(0, 1, At, B1); PG8_BAR;
            PG8_LDA(At, 1, 1); PG8_STAGE(PG8_SA(1, 0), a3, voffA);
            PG8_BAR; PG8_WAIT_L(0); PG8_MMA(1, 0, At, B0); PG8_BAR; PG8_SCHED;
            PG8_STAGE(PG8_SB(1, 1), b3 + hstep, voffB);
            PG8_WAIT_V(6); PG8_BAR; PG8_MMA(1, 1, At, B1); PG8_BAR;
            }
        }
        if constexpr (ALIGN_EPI) { if (wr == 0) PG8_BAR; }
        if constexpr (!Epi::AFTER_DRAIN) { E(acc, cur, wr, wc, fr, fq); S.done(cur); }
        if (!has_next) break;
#pragma unroll
        for (int a = 0; a < 2; ++a)
#pragma unroll
            for (int b = 0; b < 2; ++b)
#pragma unroll
                for (int m = 0; m < 4; ++m)
#pragma unroll
                    for (int n = 0; n < 2; ++n) acc[a][b][m][n] = (f32x4){0.f, 0.f, 0.f, 0.f};
        cur = nxt; cA = nA; cB = nB; ++ui;
        if constexpr (ALIGN_EPI) { if (wr == 1) PG8_BAR; }
    }
    PG8_WAIT_V(0);
    if constexpr (!ALIGN_EPI) { if (wr == 0) PG8_BAR; }
    PG8_BAR;
    if constexpr (Epi::AFTER_DRAIN) { E.fused(acc, cur, wr, wc, fr, fq, lds, wid, lane); S.done(cur); }
#undef PG8_SA
#undef PG8_SB
#undef PG8_STAGE
#undef PG8_LDA
#undef PG8_LDB
#undef PG8_MMA
#undef PG8_WAIT_V
#undef PG8_WAIT_L
#undef PG8_BAR
#undef PG8_SCHED
}
}

namespace attn_body {
using bf16=__hip_bfloat16;
using bf16x8=__attribute__((ext_vector_type(8)))short;
using s16x4=__attribute__((ext_vector_type(4)))short;
using f32x16=__attribute__((ext_vector_type(16)))float;
using u32x4=__attribute__((ext_vector_type(4)))unsigned;
constexpr int D=64,QP=512,KP=128,OP=1024;
constexpr int NW=8,QBLK=32,QB=QBLK*NW,KVBLK=64;
__device__ __forceinline__ int crow(int r,int hi){return (r&3)+8*(r>>2)+4*hi;}
#define SBAR() __builtin_amdgcn_sched_barrier(0)
constexpr int NSLOT=3, SLOTB=8192;
constexpr int LDS_K=0, LDS_V=NSLOT*SLOTB, LDS_WS=2*NSLOT*SLOTB, LDS_OST=LDS_WS+NW*64*4, LDS_BYTES=LDS_OST+NW*4096;
constexpr float C2=0.125f*1.4426950408889634f;
__device__ __forceinline__ void glds16(const void*gsrc,unsigned lds_dst){unsigned keep;
  asm volatile("s_mov_b32 %0, m0\n\ts_mov_b32 m0, %2\n\ts_nop 0\n\tglobal_load_lds_dwordx4 %1, off\n\ts_mov_b32 m0, %0":"=&s"(keep):"v"(gsrc),"s"(lds_dst):"memory");}
__device__ __forceinline__ float max3f(float a,float b,float c){float r;asm("v_max3_f32 %0, %1, %2, %3":"=v"(r):"v"(a),"v"(b),"v"(c));return r;}
__device__ __forceinline__ float max2f(float a,float b){float r;asm("v_max_f32_e32 %0, %1, %2":"=v"(r):"v"(a),"v"(b));return r;}
__device__ __forceinline__ float fadd_s(float a,float b){float r;asm("v_add_f32_e32 %0, %1, %2":"=v"(r):"v"(a),"v"(b));return r;}
__device__ __forceinline__ float fsub_s(float a,float b){float r;asm("v_sub_f32_e32 %0, %1, %2":"=v"(r):"v"(a),"v"(b));return r;}
typedef float f32x2_t __attribute__((ext_vector_type(2))); typedef __bf16 bf16x2_t __attribute__((ext_vector_type(2)));
__device__ __forceinline__ unsigned cvtpk_s(float lo,float hi){f32x2_t v={lo,hi};bf16x2_t b=__builtin_convertvector(v,bf16x2_t);return __builtin_bit_cast(unsigned,b);}
#define WAIT_BAR(N) asm volatile("s_waitcnt vmcnt(" #N ") lgkmcnt(0)\n\ts_barrier":::"memory")

__device__ __forceinline__ void qkt(f32x16&p0,f32x16&p1,const char*Kslot,const bf16x8*qr,const f32x16&negm,int r32,int hi){
  const char*kb=Kslot+hi*1024+r32*16;
  #pragma unroll
  for(int d0=0;d0<4;++d0){
    const bf16x8 b0=*reinterpret_cast<const bf16x8*>(kb+d0*2048);
    const bf16x8 b1=*reinterpret_cast<const bf16x8*>(kb+d0*2048+512);
    if(d0==0){p0=__builtin_amdgcn_mfma_f32_32x32x16_bf16(b0,qr[0],negm,0,0,0);p1=__builtin_amdgcn_mfma_f32_32x32x16_bf16(b1,qr[0],negm,0,0,0);}
    else{p0=__builtin_amdgcn_mfma_f32_32x32x16_bf16(b0,qr[d0],p0,0,0,0);p1=__builtin_amdgcn_mfma_f32_32x32x16_bf16(b1,qr[d0],p1,0,0,0);}}
}
typedef __attribute__((address_space(3))) const char* lds_cptr;
typedef short v4i16_t __attribute__((ext_vector_type(4)));
__device__ __forceinline__ void kload8(bf16x8*kf,lds_cptr kp){
  kf[0]=*(const __attribute__((address_space(3))) bf16x8*)(kp);      kf[1]=*(const __attribute__((address_space(3))) bf16x8*)(kp+512);
  kf[2]=*(const __attribute__((address_space(3))) bf16x8*)(kp+2048); kf[3]=*(const __attribute__((address_space(3))) bf16x8*)(kp+2560);
  kf[4]=*(const __attribute__((address_space(3))) bf16x8*)(kp+4096); kf[5]=*(const __attribute__((address_space(3))) bf16x8*)(kp+4608);
  kf[6]=*(const __attribute__((address_space(3))) bf16x8*)(kp+6144); kf[7]=*(const __attribute__((address_space(3))) bf16x8*)(kp+6656);
}
__device__ __forceinline__ void kload2(bf16x8*kf,lds_cptr kp,int j){ kf[2*j]=*(const __attribute__((address_space(3))) bf16x8*)(kp+j*2048); kf[2*j+1]=*(const __attribute__((address_space(3))) bf16x8*)(kp+j*2048+512); }
__device__ __forceinline__ s16x4 vtr(lds_cptr p){ return __builtin_bit_cast(s16x4,__builtin_amdgcn_ds_read_tr16_b64_v4i16((__attribute__((address_space(3))) v4i16_t*)p)); }
__device__ __forceinline__ float rowmax(const f32x16&p0,const f32x16&p1){
  float a=max3f(p0[0],p0[1],p1[0]),b=max3f(p0[2],p0[3],p1[1]);a=max3f(a,p1[2],p1[3]);
  #pragma unroll
  for(int r=4;r<16;r+=4){a=max3f(a,p0[r],p0[r+1]);b=max3f(b,p0[r+2],p0[r+3]);a=max3f(a,p1[r],p1[r+1]);b=max3f(b,p1[r+2],p1[r+3]);}
  const float m=max2f(a,b);
  auto rr=__builtin_amdgcn_permlane32_swap(__float_as_uint(m),__float_as_uint(m),false,false);
  return max2f(__uint_as_float(rr[0]),__uint_as_float(rr[1]));
}
__device__ __forceinline__ void pv(f32x16*o,int vb,bf16x8 pa0,bf16x8 pa1,bf16x8 pa2,bf16x8 pa3){
  #pragma unroll
  for(int d0=0;d0<2;++d0){s16x4 lo[4],hi[4];
    #pragma unroll
    for(int ks=0;ks<4;++ks){
      asm volatile("ds_read_b64_tr_b16 %0,%1 offset:%c2":"=&v"(lo[ks]):"v"(vb),"i"(d0*4096+ks*1024):"memory");
      asm volatile("ds_read_b64_tr_b16 %0,%1 offset:%c2":"=&v"(hi[ks]):"v"(vb),"i"(d0*4096+ks*1024+512):"memory");}
    asm volatile("s_waitcnt lgkmcnt(0)":::"memory");SBAR();
    #define PK(k) (bf16x8){lo[k][0],lo[k][1],lo[k][2],lo[k][3],hi[k][0],hi[k][1],hi[k][2],hi[k][3]}
    o[d0]=__builtin_amdgcn_mfma_f32_32x32x16_bf16(pa0,PK(0),o[d0],0,0,0);
    o[d0]=__builtin_amdgcn_mfma_f32_32x32x16_bf16(pa1,PK(1),o[d0],0,0,0);
    o[d0]=__builtin_amdgcn_mfma_f32_32x32x16_bf16(pa2,PK(2),o[d0],0,0,0);
    o[d0]=__builtin_amdgcn_mfma_f32_32x32x16_bf16(pa3,PK(3),o[d0],0,0,0);
    #undef PK
  }
}

#ifndef ATTN_STORE16
#define ATTN_STORE16(p,v) (*(u32x4*)(p)=(v))
#endif
template<int THRL> __device__ __forceinline__ void attn_unit(const bf16*Q,const bf16*__restrict__ K,const bf16*__restrict__ V,bf16*O,const int NT,char*shm){
  const int tid=opaque_tid(),lane=tid&63,r32=lane&31,hi=lane>>5; const int wid=__builtin_amdgcn_readfirstlane(tid>>6);
  const bf16*Qw=Q+(long)(wid*QBLK)*QP;
  const bf16*Kh=K,*Vh=V;
  const unsigned lds0=(unsigned)(uintptr_t)shm;
  float*wsf=(float*)(shm+LDS_WS)+wid*64;
  const bf16*ksrc=Kh+(long)lane*KP+wid*8;
  const bf16*vsrc=Vh+(long)(16*(wid&3)+(lane>>2))*KP+(wid>>2)*32+(lane&3)*8;
  const unsigned kdst=lds0+LDS_K+wid*1024, vdst=lds0+LDS_V+wid*1024;
  #define DMA_K(t,slot) glds16(ksrc+(long)(t)*KVBLK*KP,(unsigned)__builtin_amdgcn_readfirstlane(kdst+(slot)))
  #define DMA_V(t,slot) glds16(vsrc+(long)(t)*KVBLK*KP,(unsigned)__builtin_amdgcn_readfirstlane(vdst+(slot)))
  const int vb0=(int)(lds0+LDS_V)+((lane>>4)&1)*32+(lane&3)*8+(4*hi+((lane&15)>>2))*64;
  const char*Kbase=shm+LDS_K; bf16x8 kf[8];
  const lds_cptr shm3=(lds_cptr)shm; const lds_cptr kp0=shm3+LDS_K+hi*1024+r32*16; const lds_cptr vp0=shm3+LDS_V+((lane>>4)&1)*32+(lane&3)*8+(4*hi+((lane&15)>>2))*64;
  DMA_K(0,0);DMA_V(0,0);DMA_K(1,SLOTB);
  bf16x8 qr[4];
  #pragma unroll
  for(int d0=0;d0<4;++d0)qr[d0]=*reinterpret_cast<const bf16x8*>(&Qw[(long)r32*QP+d0*16+hi*8]);
  float mhat=0.f,l_reg=0.f;f32x16 o[2];o[0]=f32x16{};o[1]=f32x16{};f32x16 negm=f32x16{};asm volatile("":"+v"(negm));
  #define CMASK(P0,P1,t) do{}while(0)
  bool resc=false;
  #define START(P0,P1) do{ const float rm=rowmax(P0,P1); resc=false; \
    { const float dl=rm; mhat=fadd_s(mhat,dl); \
      _Pragma("unroll") for(int r=0;r<16;++r){P0[r]=fsub_s(P0[r],dl);P1[r]=fsub_s(P1[r],dl);} \
      _Pragma("unroll") for(int r=0;r<16;++r)negm[r]=-mhat; asm volatile("":"+v"(negm)); } \
    _Pragma("unroll") for(int r=0;r<16;++r)P0[r]=__builtin_amdgcn_exp2f(P0[r]); }while(0)
  #define RESC() do{ if(resc){ asm volatile("s_waitcnt lgkmcnt(0)":::"memory"); \
      _Pragma("unroll") for(int d_=0;d_<2;++d_) _Pragma("unroll") for(int r=0;r<16;++r)o[d_][r]*=wsf[crow(r,hi)]; } }while(0)
  f32x16 pA0,pA1,pB0,pB1;
  int sl_prev=0,sl_cur=0,sl_next=SLOTB;
  #define ROT() do{sl_prev=sl_cur;sl_cur=sl_next;sl_next=(sl_next==(NSLOT-1)*SLOTB)?0:sl_next+SLOTB;}while(0)
  DMA_K(2,2*SLOTB);
  WAIT_BAR(3);
  qkt(pA0,pA1,Kbase,qr,negm,r32,hi);asm volatile("s_nop 15\n\ts_nop 7":"+v"(pA0),"+v"(pA1));CMASK(pA0,pA1,0);
  START(pA0,pA1);
  _Pragma("unroll") for(int r=0;r<16;++r)pA1[r]=__builtin_amdgcn_exp2f(pA1[r]);
  WAIT_BAR(0);
  DMA_K(3,0);DMA_V(1,SLOTB);
  ROT();
  kload8(kf,kp0+sl_cur);
  WAIT_BAR(2);
  s16x4 vlo[8],vhi[8]; u32x4 pw0,pw1,pw2,pw3;
  #define PKW(P,B) cvtpk_s(P[B],P[B+1])
  #define PAF(k) __builtin_bit_cast(bf16x8,pw##k)
  #define VFR(i) (bf16x8){vlo[i][0],vlo[i][1],vlo[i][2],vlo[i][3],vhi[i][0],vhi[i][1],vhi[i][2],vhi[i][3]}
  #define PIN(x) asm volatile("":"+v"(x))
  #define MX3(a,b,c) __builtin_fmaxf(__builtin_fmaxf((a),(b)),(c))
  #define GAPA(MF,A0,A1,A2,A3,W0,W1,PW) do{ MF; sacc+=A0; sacc+=A1; sacc+=A2; sacc+=A3; PIN(sacc); W0; W1; PIN(PW); SBAR(); }while(0)
  #define EX(v) __builtin_amdgcn_exp2f(v)
  #define GAPB(MF,X,B) do{ MF; X[B]=EX(X[B]); X[B+1]=EX(X[B+1]); X[B+2]=EX(X[B+2]); X[B+3]=EX(X[B+3]); PIN(X); SBAR(); }while(0)
  #define VRD(i) do{ vlo[i]=vtr(vp_+(((i)>>2)*4096+((i)&3)*1024)); vhi[i]=vtr(vp_+(((i)>>2)*4096+((i)&3)*1024+512)); }while(0)
  #define KRD(G,j) do{ if(G){ kload2(kf,kp0+sl_next,j); SBAR(); } }while(0)
  #define STEP(C0,C1,P0,P1,t,GK,GV,GL) do{ SBAR(); \
    const lds_cptr vp_=vp0+sl_prev; \
    VRD(0); SBAR(); float sacc=(P0[0]+P0[1]); \
    GAPA(C0=__builtin_amdgcn_mfma_f32_32x32x16_bf16(kf[0],qr[0],negm,0,0,0), P0[2],P0[3],P0[4],P0[5],     pw0[0]=PKW(P0,0), pw0[1]=PKW(P0,2), pw0); \
    VRD(4); SBAR(); GAPA(C1=__builtin_amdgcn_mfma_f32_32x32x16_bf16(kf[1],qr[0],negm,0,0,0), P0[6],P0[7],P0[8],P0[9],     pw0[2]=PKW(P0,4), pw0[3]=PKW(P0,6), pw0); \
    VRD(1); SBAR(); GAPA(C0=__builtin_amdgcn_mfma_f32_32x32x16_bf16(kf[2],qr[1],C0,0,0,0),   P0[10],P0[11],P0[12],P0[13], pw1[0]=PKW(P0,8), pw1[1]=PKW(P0,10), pw1); \
    VRD(5); SBAR(); GAPA(C1=__builtin_amdgcn_mfma_f32_32x32x16_bf16(kf[3],qr[1],C1,0,0,0),   P0[14],P0[15],P1[0],P1[1],   pw1[2]=PKW(P0,12),pw1[3]=PKW(P0,14), pw1); \
    VRD(2); SBAR(); GAPA(C0=__builtin_amdgcn_mfma_f32_32x32x16_bf16(kf[4],qr[2],C0,0,0,0),   P1[2],P1[3],P1[4],P1[5],     pw2[0]=PKW(P1,0), pw2[1]=PKW(P1,2), pw2); \
    VRD(6); SBAR(); GAPA(C1=__builtin_amdgcn_mfma_f32_32x32x16_bf16(kf[5],qr[2],C1,0,0,0),   P1[6],P1[7],P1[8],P1[9],     pw2[2]=PKW(P1,4), pw2[3]=PKW(P1,6), pw2); \
    VRD(3); SBAR(); GAPA(C0=__builtin_amdgcn_mfma_f32_32x32x16_bf16(kf[6],qr[3],C0,0,0,0),   P1[10],P1[11],P1[12],P1[13], pw3[0]=PKW(P1,8), pw3[1]=PKW(P1,10), pw3); \
    VRD(7); SBAR(); GAPA(C1=__builtin_amdgcn_mfma_f32_32x32x16_bf16(kf[7],qr[3],C1,0,0,0),   P1[14],P1[15],0.f,0.f,       pw3[2]=PKW(P1,12),pw3[3]=PKW(P1,14), pw3); \
    l_reg+=sacc; \
    if(GK){DMA_K((t)+3,sl_cur);} if(GV){DMA_V((t)+1,sl_next);} \
    CMASK(C0,C1,t); \
    { float a=MX3(C0[0],C0[1],C1[0]),b=MX3(C0[2],C0[3],C1[1]); a=MX3(a,C1[2],C1[3]); \
      _Pragma("unroll") for(int r=4;r<16;r+=4){a=MX3(a,C0[r],C0[r+1]);b=MX3(b,C0[r+2],C0[r+3]);a=MX3(a,C1[r],C1[r+1]);b=MX3(b,C1[r+2],C1[r+3]);} \
      float rm=__builtin_fmaxf(a,b); { auto rr=__builtin_amdgcn_permlane32_swap(__float_as_uint(rm),__float_as_uint(rm),false,false); rm=__builtin_fmaxf(__uint_as_float(rr[0]),__uint_as_float(rr[1])); } \
      resc=false; \
      if(__builtin_expect(__any(rm>(float)THRL),0)){ const float dl=__builtin_fmaxf(rm,0.f); mhat+=dl; \
        _Pragma("unroll") for(int r=0;r<16;++r){C0[r]-=dl;C1[r]-=dl;} \
        _Pragma("unroll") for(int r=0;r<16;++r)negm[r]=-mhat; asm volatile("":"+v"(negm)); \
        const float f=__builtin_amdgcn_exp2f(-dl); l_reg*=f; if(hi==0)wsf[r32]=f; resc=true; } } \
    SBAR(); \
    GAPB(o[0]=__builtin_amdgcn_mfma_f32_32x32x16_bf16(PAF(0),VFR(0),o[0],0,0,0), C0,0); \
    GAPB(o[1]=__builtin_amdgcn_mfma_f32_32x32x16_bf16(PAF(0),VFR(4),o[1],0,0,0), C0,4); \
    KRD(GL,0); GAPB(o[0]=__builtin_amdgcn_mfma_f32_32x32x16_bf16(PAF(1),VFR(1),o[0],0,0,0), C0,8); \
    KRD(GL,1); GAPB(o[1]=__builtin_amdgcn_mfma_f32_32x32x16_bf16(PAF(1),VFR(5),o[1],0,0,0), C0,12); \
    KRD(GL,2); GAPB(o[0]=__builtin_amdgcn_mfma_f32_32x32x16_bf16(PAF(2),VFR(2),o[0],0,0,0), C1,0); \
    KRD(GL,3); GAPB(o[1]=__builtin_amdgcn_mfma_f32_32x32x16_bf16(PAF(2),VFR(6),o[1],0,0,0), C1,4); \
    GAPB(o[0]=__builtin_amdgcn_mfma_f32_32x32x16_bf16(PAF(3),VFR(3),o[0],0,0,0), C1,8); \
    GAPB(o[1]=__builtin_amdgcn_mfma_f32_32x32x16_bf16(PAF(3),VFR(7),o[1],0,0,0), C1,12); \
    }while(0)
  int t=1;
  #undef CMASK
  #define CMASK(P0,P1,t) do{}while(0)
  for(;t+5<NT;t+=2){
    STEP(pB0,pB1,pA0,pA1,t,true,true,true);     WAIT_BAR(2); RESC(); ROT();
    STEP(pA0,pA1,pB0,pB1,t+1,true,true,true);   WAIT_BAR(2); RESC(); ROT();
  }
  #undef CMASK
  #define CMASK(P0,P1,t) do{}while(0)
  #define ENDW(tt) do{ if((tt)+3<NT){WAIT_BAR(2);} else if((tt)+2<NT){WAIT_BAR(1);} else {WAIT_BAR(0);} }while(0)
  for(;t+1<NT;t+=2){
    STEP(pB0,pB1,pA0,pA1,t,(t+3<NT),(t+1<NT),(t+1<NT));       ENDW(t);   RESC(); ROT();
    STEP(pA0,pA1,pB0,pB1,t+1,(t+4<NT),(t+2<NT),(t+2<NT));     ENDW(t+1); RESC(); ROT();
  }
  STEP(pB0,pB1,pA0,pA1,NT-1,false,false,false); RESC();
  { float sacc=pB0[0]+pB0[1]; _Pragma("unroll") for(int r=2;r<16;++r)sacc+=pB0[r]; _Pragma("unroll") for(int r=0;r<16;++r)sacc+=pB1[r]; l_reg+=sacc;
    pw0=(u32x4){PKW(pB0,0),PKW(pB0,2),PKW(pB0,4),PKW(pB0,6)};pw1=(u32x4){PKW(pB0,8),PKW(pB0,10),PKW(pB0,12),PKW(pB0,14)};pw2=(u32x4){PKW(pB1,0),PKW(pB1,2),PKW(pB1,4),PKW(pB1,6)};pw3=(u32x4){PKW(pB1,8),PKW(pB1,10),PKW(pB1,12),PKW(pB1,14)};
    SBAR(); pv(o,vb0+sl_cur,PAF(0),PAF(1),PAF(2),PAF(3)); }
  #undef PKW
  #undef PAF
  #undef VFR
  #undef PIN
  #undef MX3
  #undef GAPA
  #undef GAPB
  #undef EX
  #undef VRD
  #undef KRD
  #undef STEP
  #undef ENDW
  {auto rr=__builtin_amdgcn_permlane32_swap(__float_as_uint(l_reg),__float_as_uint(l_reg),false,false);l_reg=__uint_as_float(rr[0])+__uint_as_float(rr[1]);}
  if(hi==0)wsf[32+r32]=l_reg;asm volatile("s_waitcnt lgkmcnt(0)":::"memory");
  float rli[16];
  #pragma unroll
  for(int r=0;r<16;++r)rli[r]=__builtin_amdgcn_rcpf(wsf[32+crow(r,hi)]);
  bf16*Ow=O+(long)(wid*QBLK)*OP;
  { bf16*stg=(bf16*)(shm+LDS_OST)+wid*2048;
    #pragma unroll
    for(int r=0;r<16;++r){const int orow=crow(r,hi);
      #pragma unroll
      for(int d0=0;d0<2;++d0)stg[orow*64+d0*32+r32]=__float2bfloat16(o[d0][r]*rli[r]);}
    asm volatile("s_waitcnt lgkmcnt(0)":::"memory");
    #pragma unroll
    for(int i=0;i<4;++i){const int row=i*8+(lane>>3),ch=lane&7; const u32x4 v=*(const u32x4*)(stg+row*64+ch*8); ATTN_STORE16(Ow+(long)row*OP+ch*8,v);} }
  asm volatile("s_waitcnt lgkmcnt(0)\n\ts_barrier":::"memory");
  #undef DMA_K
  #undef DMA_V
  #undef CMASK
  #undef START
  #undef RESC
  #undef ROT
}
#undef SBAR
#undef WAIT_BAR
}
namespace ml {
constexpr int QS = 0, KS = QS + 128 * 144, VT = KS + 128 * 144, KT = VT + 64 * 272, SP = KT + 64 * 272, CB = SP + 128 * 272, GA = CB + 80 * 144, GSET = 6 * 512, END = GA + 2 * GSET;
static_assert(END <= 131072, "mlstm lds");
__device__ __forceinline__ float logsig(float x) { return fminf(x, 0.f) - __logf(1.0f + __expf(-fabsf(x))); }
#define MFMA16(a, b, c) __builtin_amdgcn_mfma_f32_16x16x32_bf16(a, b, c, 0, 0, 0)
#define ML_BAR() do { asm volatile("s_waitcnt lgkmcnt(0)" ::: "memory"); __builtin_amdgcn_s_barrier(); asm volatile("" ::: "memory"); } while (0)
#define ML_SCAN(SET, G0, G1, G2, G3) do { \
                LAS float* a_w = (LAS float*)(lds + GA + (SET) * GSET); \
                const float li0 = (G0), lf0 = logsig(G1), li1 = (G2), lf1 = logsig(G3); \
                const float ps = lf0 + lf1; float inc = ps; \
                _Pragma("unroll") for (int o = 1; o < 64; o <<= 1) { const float t = __shfl_up(inc, o); if (lane >= o) inc += t; } \
                const float b0 = (inc - ps) + lf0, b1 = b0 + lf1; \
                const float a0 = li0 - b0, a1 = li1 - b1; \
                float incm = fmaxf(a0, a1); \
                _Pragma("unroll") for (int o = 1; o < 64; o <<= 1) { const float t = __shfl_up(incm, o); if (lane >= o) incm = fmaxf(incm, t); } \
                float excm = __shfl_up(incm, 1); if (lane == 0) excm = -INFINITY; \
                const float cm0 = fmaxf(mcar, fmaxf(excm, a0)), cm1 = fmaxf(mcar, incm); \
                const float blast = __shfl(b1, 63), cmlast = __shfl(cm1, 63); \
                a_w[2 * lane] = a0; a_w[2 * lane + 1] = a1; a_w[128 + 2 * lane] = cm0; a_w[128 + 2 * lane + 1] = cm1; \
                a_w[256 + 2 * lane] = __expf(mcar - cm0); a_w[256 + 2 * lane + 1] = __expf(mcar - cm1); \
                a_w[384 + 2 * lane] = __expf(-(b0 + cm0)); a_w[384 + 2 * lane + 1] = __expf(-(b1 + cm1)); \
                a_w[512 + 2 * lane] = __expf(a0 - cmlast); a_w[512 + 2 * lane + 1] = __expf(a1 - cmlast); \
                if (lane == 0) a_w[640] = __expf(mcar - cmlast); \
                mcar = blast + cmlast; } while (0)

template <int VAR> __device__ __forceinline__ void mlstm_item(int b, int head, int dir, const bf16_t* __restrict__ MLB, const float* __restrict__ GT, bf16_t* HSd, LAS unsigned char* lds) {
    const int tid = opaque_tid(), lane = tid & 63, w = __builtin_amdgcn_readfirstlane(tid >> 6), fr = lane & 15, fq = lane >> 4;
    LAS bf16_t* Qs = (LAS bf16_t*)(lds + QS); LAS bf16_t* Ks = (LAS bf16_t*)(lds + KS); LAS bf16_t* Vt = (LAS bf16_t*)(lds + VT);
    LAS bf16_t* Kt = (LAS bf16_t*)(lds + KT); LAS bf16_t* Sp = (LAS bf16_t*)(lds + SP); LAS bf16_t* Cb = (LAS bf16_t*)(lds + CB);
    const int ntk = w & 3, mt0 = 2 * (w >> 2);
    {
        __syncthreads();
        for (int i = tid; i < 80 * 144 / 4; i += 512) ((LAS unsigned*)Cb)[i] = 0u;
        f32x4 accC[2]; accC[0] = (f32x4){0.f, 0.f, 0.f, 0.f}; accC[1] = accC[0];
        float nreg = 0.f, mcar = 0.f;
        u32x4 pq[2], pk[2], pv[2]; float pg[4];
        size_t rowbase_n;
        {
            const int ci = dir ? 1 : 0; rowbase_n = (size_t)NLAT + (size_t)b * TCTX + ci * 128;
#pragma unroll
            for (int j = 0; j < 2; ++j) { const int i = 2 * (tid & 63) + j, ch = tid >> 6; const bf16_t* src = MLB + (rowbase_n + i) * 1024 + head * 64 + ch * 8;
                pq[j] = *(const u32x4*)src; pk[j] = *(const u32x4*)(src + 256); pv[j] = *(const u32x4*)(src + 512); }
#pragma unroll
            for (int j = 0; j < 2; ++j) { const int ip = 2 * lane + j, i = dir ? 127 - ip : ip; const float* g = GT + (rowbase_n + i) * 16 + head;
                pg[2 * j] = g[8 * dir]; pg[2 * j + 1] = g[8 * dir + 4]; }
        }
        if (w == 0) ML_SCAN(0, pg[0], pg[1], pg[2], pg[3]);
        for (int cc = 0; cc < 18; ++cc) {
            const size_t rowbase = rowbase_n;
            LAS float* a_s = (LAS float*)(lds + GA + (cc & 1) * GSET); LAS float* cm_s = a_s + 128; LAS float* wi_s = a_s + 256; LAS float* emt_s = a_s + 384; LAS float* wk_s = a_s + 512; LAS float* sc_s = a_s + 640;
            ML_BAR();
            {
                const int i0 = 2 * (tid & 63), ch = tid >> 6, ipa = dir ? 127 - i0 : i0, ipb = dir ? 126 - i0 : i0 + 1, ipe = dir ? 126 - i0 : i0;
                *(LAS u32x4*)(Qs + ipa * 72 + ch * 8) = pq[0]; *(LAS u32x4*)(Qs + ipb * 72 + ch * 8) = pq[1];
                *(LAS u32x4*)(Ks + ipa * 72 + ch * 8) = pk[0]; *(LAS u32x4*)(Ks + ipb * 72 + ch * 8) = pk[1];
                const unsigned ka[4] = {pk[0].x, pk[0].y, pk[0].z, pk[0].w}, kb[4] = {pk[1].x, pk[1].y, pk[1].z, pk[1].w}, va[4] = {pv[0].x, pv[0].y, pv[0].z, pv[0].w}, vb[4] = {pv[1].x, pv[1].y, pv[1].z, pv[1].w};
#pragma unroll
                for (int e2 = 0; e2 < 4; ++e2) { if (VAR & 8) continue;
                    const unsigned kl0 = dir ? kb[e2] : ka[e2], kh0 = dir ? ka[e2] : kb[e2], vl0 = dir ? vb[e2] : va[e2], vh0 = dir ? va[e2] : vb[e2];
                    *(LAS unsigned*)(Kt + (ch * 8 + 2 * e2) * 136 + ipe) = (kl0 & 0xffffu) | (kh0 << 16);
                    *(LAS unsigned*)(Kt + (ch * 8 + 2 * e2 + 1) * 136 + ipe) = (kl0 >> 16) | (kh0 & 0xffff0000u);
                    *(LAS unsigned*)(Vt + (ch * 8 + 2 * e2) * 136 + ipe) = (vl0 & 0xffffu) | (vh0 << 16);
                    *(LAS unsigned*)(Vt + (ch * 8 + 2 * e2 + 1) * 136 + ipe) = (vl0 >> 16) | (vh0 & 0xffff0000u); }
            }
            if (cc > 0) {
#pragma unroll
                for (int i = 0; i < 2; ++i)
#pragma unroll
                    for (int j = 0; j < 4; ++j) Cb[(16 * (mt0 + i) + 4 * fq + j) * 72 + 16 * ntk + fr] = (bf16_t)f2bf_hw(accC[i][j]);
                if (w < 4 && fq == 0) Cb[64 * 72 + 16 * w + fr] = (bf16_t)f2bf_hw(nreg);
            }
            if (cc + 1 < 18) {
                const int cn = cc + 1;
                if (cn < 2) { const int ci = dir ? 1 - cn : cn; rowbase_n = (size_t)NLAT + (size_t)b * TCTX + ci * 128; }
                else { const int ci = dir ? 17 - cn : cn - 2; rowbase_n = (size_t)b * TLAT + ci * 128; }
#pragma unroll
                for (int j = 0; j < 2; ++j) { const int i = 2 * (tid & 63) + j, ch = tid >> 6; const bf16_t* src = MLB + (rowbase_n + i) * 1024 + head * 64 + ch * 8;
                    pq[j] = *(const u32x4*)src; pk[j] = *(const u32x4*)(src + 256); pv[j] = *(const u32x4*)(src + 512); }
#pragma unroll
                for (int j = 0; j < 2; ++j) { const int ip = 2 * lane + j, i = dir ? 127 - ip : ip; const float* g = GT + (rowbase_n + i) * 16 + head;
                    pg[2 * j] = g[8 * dir]; pg[2 * j + 1] = g[8 * dir + 4]; }
            }
            ML_BAR();
            if (!(VAR & 1)) {
            bf16x8 Qa[2];
            Qa[0] = *(const LAS bf16x8*)(Qs + (16 * w + fr) * 72 + 8 * fq); Qa[1] = *(const LAS bf16x8*)(Qs + (16 * w + fr) * 72 + 32 + 8 * fq);
            float cmt[4], rs[4];
#pragma unroll
            for (int j = 0; j < 4; ++j) { cmt[j] = cm_s[16 * w + 4 * fq + j]; rs[j] = 0.f; }
            for (int st = 0; st <= w; ++st) {
                const bf16x8 Kb0 = *(const LAS bf16x8*)(Ks + (16 * st + fr) * 72 + 8 * fq), Kb1 = *(const LAS bf16x8*)(Ks + (16 * st + fr) * 72 + 32 + 8 * fq);
                f32x4 S = (f32x4){0.f, 0.f, 0.f, 0.f};
                S = MFMA16(Qa[0], Kb0, S); S = MFMA16(Qa[1], Kb1, S);
                const float as = a_s[16 * st + fr];
#pragma unroll
                for (int j = 0; j < 4; ++j) { const bool ok = (st < w) || (fr <= 4 * fq + j); const float wgt = ok ? __expf(as - cmt[j]) : 0.f; const float v = S[j] * wgt;
                    rs[j] += v; Sp[(16 * w + 4 * fq + j) * 136 + 16 * st + fr] = (bf16_t)f2bf_hw(v); }
            }
            if ((w & 1) == 0) {
#pragma unroll
                for (int j = 0; j < 4; ++j) Sp[(16 * w + 4 * fq + j) * 136 + 16 * (w + 1) + fr] = (bf16_t)0;
            }
#pragma unroll
            for (int j = 0; j < 4; ++j) { rs[j] += __shfl_xor(rs[j], 1); rs[j] += __shfl_xor(rs[j], 2); rs[j] += __shfl_xor(rs[j], 4); rs[j] += __shfl_xor(rs[j], 8); }
            f32x4 hi_[4], hc[5];
#pragma unroll
            for (int nt = 0; nt < 4; ++nt) hi_[nt] = (f32x4){0.f, 0.f, 0.f, 0.f};
#pragma unroll
            for (int nt = 0; nt < 5; ++nt) hc[nt] = (f32x4){0.f, 0.f, 0.f, 0.f};
            for (int ks = 0; ks <= (w >> 1); ++ks) {
                const bf16x8 A = *(const LAS bf16x8*)(Sp + (16 * w + fr) * 136 + 32 * ks + 8 * fq);
#pragma unroll
                for (int nt = 0; nt < 4; ++nt) { const bf16x8 B = *(const LAS bf16x8*)(Vt + (16 * nt + fr) * 136 + 32 * ks + 8 * fq); hi_[nt] = MFMA16(A, B, hi_[nt]); }
            }
#pragma unroll
            for (int ks = 0; ks < 2; ++ks)
#pragma unroll
                for (int nt = 0; nt < 5; ++nt) { const bf16x8 B = *(const LAS bf16x8*)(Cb + (16 * nt + fr) * 72 + 32 * ks + 8 * fq); hc[nt] = MFMA16(Qa[ks], B, hc[nt]); }
            float hv[4][4];
#pragma unroll
            for (int j = 0; j < 4; ++j) {
                const int tl = 16 * w + 4 * fq + j;
                const float wi = wi_s[tl], em = emt_s[tl];
                const float qn = __shfl(hc[4][j], lane & 48);
                const float den = wi * qn + rs[j];
                const float inv = 1.0f / fmaxf(fabsf(den), em);
#pragma unroll
                for (int nt = 0; nt < 4; ++nt) hv[nt][j] = (wi * hc[nt][j] + hi_[nt][j]) * inv;
            }
#pragma unroll
            for (int j = 0; j < 4; ++j) { const int tl = 16 * w + 4 * fq + j; const size_t grow = rowbase + (dir ? 127 - tl : tl);
#pragma unroll
                for (int nt = 0; nt < 4; ++nt) if (!(VAR & 4)) HSd[grow * 256 + head * 64 + 16 * nt + fr] = (bf16_t)f2bf_hw(hv[nt][j]); }
            }
            if (!(VAR & 2)) {
                const float asc = sc_s[0];
                accC[0] = accC[0] * asc; accC[1] = accC[1] * asc;
                float nsum = 0.f;
#pragma unroll
                for (int ks = 0; ks < 4; ++ks) {
                    const u32x4 kb = *(const LAS u32x4*)(Kt + (16 * ntk + fr) * 136 + 32 * ks + 8 * fq);
                    const f32x4 w0 = *(const LAS f32x4*)(wk_s + 32 * ks + 8 * fq), w1 = *(const LAS f32x4*)(wk_s + 32 * ks + 8 * fq + 4);
                    const float f0 = bf2f(kb.x & 0xffffu) * w0[0], f1 = bf2f(kb.x >> 16) * w0[1], f2 = bf2f(kb.y & 0xffffu) * w0[2], f3 = bf2f(kb.y >> 16) * w0[3];
                    const float f4 = bf2f(kb.z & 0xffffu) * w1[0], f5 = bf2f(kb.z >> 16) * w1[1], f6 = bf2f(kb.w & 0xffffu) * w1[2], f7 = bf2f(kb.w >> 16) * w1[3];
                    nsum += ((f0 + f1) + (f2 + f3)) + ((f4 + f5) + (f6 + f7));
                    u32x4 pb; pb.x = pk2(f0, f1); pb.y = pk2(f2, f3); pb.z = pk2(f4, f5); pb.w = pk2(f6, f7);
                    const bf16x8 Bs = __builtin_bit_cast(bf16x8, pb);
#pragma unroll
                    for (int i = 0; i < 2; ++i) { const bf16x8 A = *(const LAS bf16x8*)(Vt + (16 * (mt0 + i) + fr) * 136 + 32 * ks + 8 * fq); accC[i] = MFMA16(A, Bs, accC[i]); }
                }
                nsum += __shfl_xor(nsum, 16); nsum += __shfl_xor(nsum, 32);
                nreg = asc * nreg + nsum;
            }
            if (w == 0 && cc + 1 < 18) ML_SCAN((cc + 1) & 1, pg[0], pg[1], pg[2], pg[3]);
        }
    }
    __syncthreads();
}
__device__ __forceinline__ void mlstm_readout_phase(bool with_ctx, const bf16_t* HS0, const bf16_t* HS1, const bf16_t* __restrict__ MLB, bf16_t* MIX, const float* __restrict__ mlw) {
    const int tid = opaque_tid(), l16 = tid & 15, sub = tid >> 4;
    const int npairs = (with_ctx ? MTOT : NLAT) * 4;
    for (int p = blockIdx.x * 32 + sub; p < npairs; p += gridDim.x * 32) {
        const size_t grow = (size_t)(p >> 2); const int head = p & 3;
        const f32x4 gw = *(const f32x4*)(mlw + head * 64 + 4 * l16);
        const size_t off = grow * 256 + head * 64 + 4 * l16;
        const unsigned long long ha = *(const unsigned long long*)(HS0 + off), hb = *(const unsigned long long*)(HS1 + off);
        const f32x4 h = (f32x4){bf2f((unsigned)ha & 0xffffu) + bf2f((unsigned)hb & 0xffffu), bf2f(((unsigned)ha) >> 16) + bf2f(((unsigned)hb) >> 16),
                                bf2f((unsigned)(ha >> 32) & 0xffffu) + bf2f((unsigned)(hb >> 32) & 0xffffu), bf2f((unsigned)(ha >> 48)) + bf2f((unsigned)(hb >> 48))};
        const unsigned long long mo = *(const unsigned long long*)(MLB + grow * 1024 + 768 + head * 64 + 4 * l16);
        float ss = (h[0] * h[0] + h[1] * h[1]) + (h[2] * h[2] + h[3] * h[3]);
        ss += __shfl_xor(ss, 1); ss += __shfl_xor(ss, 2); ss += __shfl_xor(ss, 4); ss += __shfl_xor(ss, 8);
        const float rstd = rsqrtf(ss * (1.0f / 64.0f) + EPS);
        const unsigned mlo = (unsigned)mo, mhi = (unsigned)(mo >> 32);
        const float y0 = h[0] * rstd * gw[0] * sigmoid_f(bf2f(mlo & 0xffffu)), y1 = h[1] * rstd * gw[1] * sigmoid_f(bf2f(mlo >> 16));
        const float y2 = h[2] * rstd * gw[2] * sigmoid_f(bf2f(mhi & 0xffffu)), y3 = h[3] * rstd * gw[3] * sigmoid_f(bf2f(mhi >> 16));
        *(unsigned long long*)(MIX + grow * 1024 + 512 + head * 64 + 4 * l16) = (unsigned long long)pk2(y0, y1) | ((unsigned long long)pk2(y2, y3) << 32);
    }
}
#undef MFMA16
#undef ML_BAR
#undef ML_SCAN
}

__device__ __forceinline__ void pool_item(int u, const bf16_t* __restrict__ PZ, bf16_t* MIX, LAS unsigned char* lds) {
    const int tid = opaque_tid();
    const int r0 = u * 128;
    const int seq0 = (r0 < NLAT) ? (r0 / TLAT) * TLAT : NLAT + ((r0 - NLAT) / TCTX) * TCTX;
    const int len = (r0 < NLAT) ? TLAT : TCTX;
    const int tb = r0 - seq0;
    LAS u32x4* tile = (LAS u32x4*)lds;
#pragma unroll
    for (int q = 0; q < 9; ++q) { const int e = tid + 512 * q, row = e >> 5, ch = e & 31, t = tb - 8 + row;
        u32x4 v = (u32x4){0u, 0u, 0u, 0u};
        if (t >= 0 && t < len) v = *(const u32x4*)(PZ + (size_t)(seq0 + t) * 256 + ch * 8);
        tile[e] = v; }
    __syncthreads();
    const int ch = tid & 31, run = tid >> 5, half = 1 << (ch >> 3);
    float s[8];
#pragma unroll
    for (int e = 0; e < 8; ++e) s[e] = 0.f;
#define POOL_ACC(ROW, SGN) do { const u32x4 v_ = tile[(ROW) * 32 + ch]; \
        s[0] += (SGN) * bf2f(v_.x & 0xffffu); s[1] += (SGN) * bf2f(v_.x >> 16); s[2] += (SGN) * bf2f(v_.y & 0xffffu); s[3] += (SGN) * bf2f(v_.y >> 16); \
        s[4] += (SGN) * bf2f(v_.z & 0xffffu); s[5] += (SGN) * bf2f(v_.z >> 16); s[6] += (SGN) * bf2f(v_.w & 0xffffu); s[7] += (SGN) * bf2f(v_.w >> 16); } while (0)
    const int tl0 = run * 8;
    for (int k = -half; k < half; ++k) POOL_ACC(tl0 + 8 + k, 1.0f);
#pragma unroll
    for (int i = 0; i < 8; ++i) {
        const int tl = tl0 + i, t = tb + tl;
        if (i > 0) { POOL_ACC(tl + 8 + half - 1, 1.0f); POOL_ACC(tl + 8 - half - 1, -1.0f); }
        const int lo = max(t - half, 0), hi = min(t + half, len);
        const float inv = 1.0f / (float)(hi - lo);
        const u32x4 z = tile[(tl + 8) * 32 + ch];
        u32x4 o;
        o.x = pk2(s[0] * inv - bf2f(z.x & 0xffffu), s[1] * inv - bf2f(z.x >> 16)); o.y = pk2(s[2] * inv - bf2f(z.y & 0xffffu), s[3] * inv - bf2f(z.y >> 16));
        o.z = pk2(s[4] * inv - bf2f(z.z & 0xffffu), s[5] * inv - bf2f(z.z >> 16)); o.w = pk2(s[6] * inv - bf2f(z.w & 0xffffu), s[7] * inv - bf2f(z.w >> 16));
        *(u32x4*)(MIX + (size_t)(r0 + tl) * 1024 + 768 + ch * 8) = o;
    }
#undef POOL_ACC
    __syncthreads();
}
#define XB_TMO      128
#define XB_XCNT(j)  (256  + 64 * (j))
#define XB_XSUB(j)  (1280 + 64 * (j))
#define XB_XGEN(j)  (2304 + 64 * (j))
#define XB_TOP      3328
#define XB_TOPGEN   3392
#define XCD_BAR_WORDS 3456
#define XB_SPIN_CAP (1u << 18)

__device__ __forceinline__ unsigned xb_ld(unsigned* p)              { return __hip_atomic_load(p, __ATOMIC_RELAXED, __HIP_MEMORY_SCOPE_AGENT); }
__device__ __forceinline__ unsigned xb_add(unsigned* p, unsigned v) { return __hip_atomic_fetch_add(p, v, __ATOMIC_RELAXED, __HIP_MEMORY_SCOPE_AGENT); }
__device__ __forceinline__ unsigned xb_xcc_id() { return (unsigned)__builtin_amdgcn_s_getreg((3 << 11) | 20) & 0xFu; }
#define XB_SPIN(cond, bar) do { unsigned _sp = 0; while (cond) { __builtin_amdgcn_s_sleep(1); \
    if ((++_sp & 255u) == 0u) { if (xb_ld(&(bar)[XB_TMO])) break; if (_sp > XB_SPIN_CAP) { atomicAdd(&(bar)[XB_TMO], 1u); break; } } } } while (0)

struct XcdBarrier {
    unsigned* bar; unsigned x;
    volatile LAS unsigned* st;
};

__device__ __forceinline__ XcdBarrier xcd_barrier_post(unsigned* bar, volatile LAS unsigned* st) {
    XcdBarrier b; b.bar = bar; b.x = xb_xcc_id(); b.st = st;
    if (threadIdx.x == 0) (void)xb_add(&bar[XB_XCNT(b.x)], 1u);
    return b;
}
__device__ __forceinline__ void xcd_barrier_complete(unsigned* bar, unsigned x, unsigned& nloc, unsigned& nx) {
    const unsigned G = gridDim.x * gridDim.y * gridDim.z;
    unsigned sum, cnt, mine, sp = 0u;
    for (;;) {
        sum = 0u; cnt = 0u; mine = 0u;
#pragma unroll
        for (unsigned j = 0; j < 16; ++j) { const unsigned c = xb_ld(&bar[XB_XCNT(j)]); sum += c; cnt += (c > 0u) ? 1u : 0u; mine = (j == x) ? c : mine; }
        if (sum == G) break;
        __builtin_amdgcn_s_sleep(1);
        if ((++sp & 255u) == 0u) { if (xb_ld(&bar[XB_TMO])) break; if (sp > XB_SPIN_CAP) { atomicAdd(&bar[XB_TMO], 1u); break; } }
    }
    nloc = mine > 0u ? mine : 1u; nx = cnt > 0u ? cnt : 1u;
}

__device__ __forceinline__ void xcd_barrier(const XcdBarrier& b) {
    asm volatile("s_waitcnt vmcnt(0)" ::: "memory");
    __syncthreads();
    if (threadIdx.x == 0) {
        unsigned* bar = b.bar;
        __builtin_amdgcn_s_waitcnt(0);
        unsigned nloc = b.st[0], nx = b.st[1];
        if (nloc == 0u) { xcd_barrier_complete(bar, b.x, nloc, nx); b.st[0] = nloc; b.st[1] = nx; }
        const unsigned old = xb_add(&bar[XB_XSUB(b.x)], 1u);
        const unsigned gen = old / nloc;
        if (old + 1u == (gen + 1u) * nloc) {
            __builtin_amdgcn_fence(__ATOMIC_RELEASE, "agent");
            asm volatile("s_waitcnt vmcnt(0)" ::: "memory");
            const unsigned og = xb_add(&bar[XB_TOP], 1u);
            const unsigned tg = og / nx;
            if (og + 1u == (tg + 1u) * nx) xb_add(&bar[XB_TOPGEN], 1u);
            else XB_SPIN(xb_ld(&bar[XB_TOPGEN]) == tg, bar);
            __builtin_amdgcn_fence(__ATOMIC_ACQUIRE, "agent");
            xb_add(&bar[XB_XGEN(b.x)], 1u);
            asm volatile("s_waitcnt vmcnt(0)" ::: "memory");
        } else {
            XB_SPIN(xb_ld(&bar[XB_XGEN(b.x)]) == gen, bar);
            __builtin_amdgcn_fence(__ATOMIC_ACQUIRE, "agent");
            asm volatile("s_waitcnt vmcnt(0)" ::: "memory");
        }
    }
    __syncthreads();
}
struct Args { const float* in[20]; float* out; unsigned char* ws; };
enum { I_X = 0, I_C, I_CTX, I_CCTX, I_WADA, I_BADA, I_NMIX, I_WIN, I_BG, I_QN, I_KN, I_MLN, I_PW, I_PS, I_WOUT, I_NFFN, I_WG, I_WU, I_WD, I_FN };
constexpr int LDS_BYTES = 147456;
#ifndef REP_N1
#define REP_N1 1
#endif
#ifndef REP_G1
#define REP_G1 1
#endif
#ifndef REP_MIX
#define REP_MIX 1
#endif
#ifndef REP_N2
#define REP_N2 1
#endif
#ifndef REP_G3
#define REP_G3 1
#endif
#ifndef REP_PRO
#define REP_PRO 1
#endif
#ifndef ML_DUP
#define ML_DUP 1
#endif
#ifndef AL_DUP
#define AL_DUP 1
#endif
#ifndef MIXREP_MASK
#define MIXREP_MASK 15
#endif
#ifndef ML_VAR
#define ML_VAR 0
#endif
#ifndef PRO_MASK
#define PRO_MASK 7
#endif
#ifndef REP_SYNC
#define REP_SYNC 1
#endif

__device__ __forceinline__ void tr_item(const float* colp, size_t ld, int K, bf16_t* WT, int r0, int k0, LAS float* scr, int lane) {
    float tv[32];
#pragma unroll
    for (int i = 0; i < 32; ++i) { const int kk = 2 * i + (lane >> 5); tv[i] = colp ? colp[(size_t)(k0 + kk) * ld] : 0.f; }
#pragma unroll
    for (int i = 0; i < 32; ++i) { const int kk = 2 * i + (lane >> 5); scr[kk * 33 + (lane & 31)] = tv[i]; }
    asm volatile("s_waitcnt lgkmcnt(0)" ::: "memory");
    const int c = lane & 7;
#pragma unroll
    for (int j = 0; j < 4; ++j) { const int n = (lane >> 3) + 8 * j; const LAS float* s = scr + (8 * c) * 33 + n;
        u32x4 o; o.x = pk2(s[0 * 33], s[1 * 33]); o.y = pk2(s[2 * 33], s[3 * 33]); o.z = pk2(s[4 * 33], s[5 * 33]); o.w = pk2(s[6 * 33], s[7 * 33]);
        *(u32x4*)(WT + (size_t)(r0 + n) * K + k0 + 8 * c) = o; }
    asm volatile("s_waitcnt lgkmcnt(0)" ::: "memory");
}
__device__ __forceinline__ void tr_item_pool(const float* win, const float* pw, const float* ps, bf16_t* WT, int r0, int k0, LAS float* scr, int lane) {
    const int p = (r0 - 1792) + (lane & 31), oc = 64 * ((p >> 5) & 3) + 32 * (p >> 7) + (p & 31), g = oc >> 6, o = oc & 63;
    const float scl = ps[oc];
    const float* pwc = pw + (size_t)g * 4096 + o;
    float pwr[64];
#pragma unroll
    for (int q = 0; q < 64; ++q) pwr[q] = pwc[q * 64];
    for (int i = 0; i < 8; ++i) { const int kk = 2 * i + (lane >> 5); const float* wr = win + (size_t)(k0 + kk) * INW + 1808 + 64 * g;
        f32x4 w4[16];
#pragma unroll
        for (int q = 0; q < 16; ++q) w4[q] = *(const f32x4*)(wr + 4 * q);
        float s0 = 0.f, s1 = 0.f;
#pragma unroll
        for (int q = 0; q < 16; q += 2) { s0 += (w4[q][0] * pwr[4 * q] + w4[q][1] * pwr[4 * q + 1]) + (w4[q][2] * pwr[4 * q + 2] + w4[q][3] * pwr[4 * q + 3]);
            s1 += (w4[q + 1][0] * pwr[4 * q + 4] + w4[q + 1][1] * pwr[4 * q + 5]) + (w4[q + 1][2] * pwr[4 * q + 6] + w4[q + 1][3] * pwr[4 * q + 7]); }
        scr[kk * 33 + (lane & 31)] = (s0 + s1) * scl; }
    asm volatile("s_waitcnt lgkmcnt(0)" ::: "memory");
    { const int n = lane >> 1, c = lane & 1; const LAS float* s = scr + (8 * c) * 33 + n;
        u32x4 o4; o4.x = pk2(s[0 * 33], s[1 * 33]); o4.y = pk2(s[2 * 33], s[3 * 33]); o4.z = pk2(s[4 * 33], s[5 * 33]); o4.w = pk2(s[6 * 33], s[7 * 33]);
        *(u32x4*)(WT + (size_t)(r0 + n) * 1024 + k0 + 8 * c) = o4; }
    asm volatile("s_waitcnt lgkmcnt(0)" ::: "memory");
}

__device__ __forceinline__ void prologue(const Args& a, LAS unsigned char* lds, const int pmask) {
    const int tid = threadIdx.x, lane = tid & 63, wave = tid >> 6;
    unsigned char* ws = a.ws;
    if (blockIdx.x == 0) {
        for (int e = tid; e < 1024; e += 512) { const int pos = e >> 4, f = e & 15;
            const float invf = exp2f(-(float)(2 * f) * (13.287712379549449f / 32.0f));
            float ang = (float)pos * invf; ang -= 6.283185307179586f * rintf(ang * 0.15915494309189535f);
            float* cs = (float*)(ws + WS_ROPE) + e * 2; cs[0] = __cosf(ang); cs[1] = __sinf(ang); }
    }
    LAS float* scs = (LAS float*)lds;
    LAS float* red = (LAS float*)(lds + 17 * 4096);
    for (int e = tid; e < 17 * 1024; e += 512) { const float v = (e < 16 * 1024) ? a.in[I_C][e] : a.in[I_CCTX][e - 16 * 1024]; scs[e] = silu_f(v); }
    __syncthreads();
    for (int it = blockIdx.x; it < 2 * 192; it += gridDim.x) { if (!(pmask & 1)) break;
        const int l = it / 192, c0 = (it % 192) * 32, col = tid & 31, kp = tid >> 5;
        const float* W = a.in[I_WADA] + ((size_t)l * 1024 + kp * 64) * 6144 + c0 + col;
        float acc[17];
#pragma unroll
        for (int r = 0; r < 17; ++r) acc[r] = 0.f;
#pragma unroll 16
        for (int k4 = 0; k4 < 16; ++k4) { const float w0 = W[(size_t)(4 * k4) * 6144], w1 = W[(size_t)(4 * k4 + 1) * 6144], w2 = W[(size_t)(4 * k4 + 2) * 6144], w3 = W[(size_t)(4 * k4 + 3) * 6144];
#pragma unroll
            for (int r = 0; r < 17; ++r) { const f32x4 s = *(const LAS f32x4*)(scs + r * 1024 + kp * 64 + 4 * k4); acc[r] += (s[0] * w0 + s[1] * w1) + (s[2] * w2 + s[3] * w3); } }
#pragma unroll
        for (int r = 0; r < 17; ++r) red[(kp * 17 + r) * 32 + col] = acc[r];
        __syncthreads();
        for (int e = tid; e < 17 * 32; e += 512) { const int r = e >> 5, cc = e & 31; float s = 0.f;
#pragma unroll
            for (int q = 0; q < 16; ++q) s += red[(q * 17 + r) * 32 + cc];
            ((float*)(ws + WS_MOD))[((size_t)l * 17 + r) * 6144 + c0 + cc] = s + a.in[I_BADA][(size_t)l * 6144 + c0 + cc]; }
        __syncthreads();
    }
    LAS float* scr = (LAS float*)(lds + wave * 8448);
    const int gw = blockIdx.x * 8 + wave, NGW = gridDim.x * 8;
    constexpr int IT_W1 = 64 * 16, IT_WO = 32 * 16, IT_GU = 176 * 16, IT_WD = 32 * 44, IT_L = IT_W1 + IT_WO + IT_GU + IT_WD;
#define TR_DECODE(IT, COLP, LD, KK, WTP, R0, K0) do { const int l_ = (IT) / IT_L; int r_ = (IT) % IT_L; \
        if (r_ < IT_W1) { int rg_ = r_ / 16; if (rg_ >= 56) rg_ += 8; K0 = (r_ % 16) * 64; R0 = rg_ * 32; WTP = (bf16_t*)(ws + WS_W1 + l_ * W1_BYTES); \
            const float* win_ = a.in[I_WIN] + (size_t)l_ * 1024 * INW; const int rr_ = R0 + (lane & 31), pn_ = rr_ >> 8, p_ = rr_ & 255, oc_ = 64 * ((p_ >> 5) & 3) + 32 * (p_ >> 7) + (p_ & 31), cp_ = 256 * pn_ + oc_; \
            COLP = (cp_ < 1792) ? win_ + cp_ : (cp_ >= 2048 && cp_ < 2064) ? win_ + 1792 + (cp_ - 2048) : nullptr; LD = INW; KK = 1024; } \
        else if ((r_ -= IT_W1) < IT_WO) { R0 = (r_ / 16) * 32; K0 = (r_ % 16) * 64; COLP = a.in[I_WOUT] + (size_t)l_ * 1024 * 1024 + R0 + (lane & 31); LD = 1024; KK = 1024; WTP = (bf16_t*)(ws + WS_WO + l_ * WO_BYTES); } \
        else if ((r_ -= IT_WO) < IT_GU) { R0 = (r_ / 16) * 32; K0 = (r_ % 16) * 64; const int rr_ = R0 + (lane & 31), pn_ = rr_ >> 8, p_ = rr_ & 255, hcol_ = 128 * pn_ + (p_ & 127); \
            COLP = ((p_ >> 7) ? a.in[I_WU] : a.in[I_WG]) + (size_t)l_ * 1024 * DFF + hcol_; LD = DFF; KK = 1024; WTP = (bf16_t*)(ws + WS_WGU + l_ * WGU_BYTES); } \
        else { r_ -= IT_GU; R0 = (r_ / 44) * 32; K0 = (r_ % 44) * 64; COLP = a.in[I_WD] + (size_t)l_ * DFF * 1024 + R0 + (lane & 31); LD = 1024; KK = DFF; WTP = (bf16_t*)(ws + WS_WD + l_ * WD_BYTES); } } while (0)
#define TR_LOAD(TV, COLP, LD, K0) do { _Pragma("unroll") for (int i_ = 0; i_ < 32; ++i_) { const int kk_ = 2 * i_ + (lane >> 5); TV[i_] = (COLP) ? (COLP)[(size_t)((K0) + kk_) * (LD)] : 0.f; } } while (0)
    if (pmask & 2) {
        int it = gw;
        const float* colp = nullptr; size_t ld = 0; int KK = 0, r0 = 0, k0 = 0; bf16_t* WT = nullptr;
        float tv[32];
        if (it < 2 * IT_L) { TR_DECODE(it, colp, ld, KK, WT, r0, k0); TR_LOAD(tv, colp, ld, k0); }
        while (it < 2 * IT_L) {
            const int itn = it + NGW;
            const float* colpn = nullptr; size_t ldn = 0; int KKn = 0, r0n = 0, k0n = 0; bf16_t* WTn = nullptr;
            float tn[32];
            if (itn < 2 * IT_L) { TR_DECODE(itn, colpn, ldn, KKn, WTn, r0n, k0n); TR_LOAD(tn, colpn, ldn, k0n); }
#pragma unroll
            for (int i = 0; i < 32; ++i) { const int kk = 2 * i + (lane >> 5); scr[kk * 33 + (lane & 31)] = tv[i]; }
            asm volatile("s_waitcnt lgkmcnt(0)" ::: "memory");
            { const int c = lane & 7;
#pragma unroll
                for (int j = 0; j < 4; ++j) { const int n = (lane >> 3) + 8 * j; const LAS float* s = scr + (8 * c) * 33 + n;
                    u32x4 o; o.x = pk2(s[0 * 33], s[1 * 33]); o.y = pk2(s[2 * 33], s[3 * 33]); o.z = pk2(s[4 * 33], s[5 * 33]); o.w = pk2(s[6 * 33], s[7 * 33]);
                    *(u32x4*)(WT + (size_t)(r0 + n) * KK + k0 + 8 * c) = o; } }
            asm volatile("s_waitcnt lgkmcnt(0)" ::: "memory");
            it = itn; colp = colpn; ld = ldn; KK = KKn; r0 = r0n; k0 = k0n; WT = WTn;
#pragma unroll
            for (int i = 0; i < 32; ++i) tv[i] = tn[i];
        }
    }
#undef TR_DECODE
#undef TR_LOAD
    if (pmask & 4)
    for (int it = gw; it < 1024; it += NGW) { const int l = it >> 9, rg = (it & 511) >> 6, kg = it & 63;
        tr_item_pool(a.in[I_WIN] + (size_t)l * 1024 * INW, a.in[I_PW] + (size_t)l * 4 * 4096, a.in[I_PS] + l * 256, (bf16_t*)(ws + WS_W1 + l * W1_BYTES), 1792 + rg * 32, kg * 16, scr, lane); }
}

__device__ __forceinline__ void norm_phase(const float* xl, const float* xc, const float* gw, const float* mod  , int sh_off, int sc_off, bf16_t* XN, int nrows) {
    const int tid = opaque_tid(), lane = tid & 63, gwv = blockIdx.x * 8 + (tid >> 6), NGW = gridDim.x * 8;
    const int per = (nrows + NGW - 1) / NGW;
    int cur = -1; f32x4 mul[4], add[4];
    for (int q = 0; q < per; ++q) {
        const int row = gwv * per + q; if (row >= nrows) break;
        const int mr = row < NLAT ? row / TLAT : 16;
        if (mr != cur) { cur = mr; const float* mp = mod + (size_t)mr * 6144;
#pragma unroll
            for (int j = 0; j < 4; ++j) { const f32x4 g = *(const f32x4*)(gw + 4 * lane + 256 * j), s = *(const f32x4*)(mp + sc_off + 4 * lane + 256 * j); mul[j] = g * (s + 1.0f); add[j] = *(const f32x4*)(mp + sh_off + 4 * lane + 256 * j); } }
        const float* xr = row < NLAT ? xl + (size_t)row * 1024 : xc + (size_t)(row - NLAT) * 1024;
        f32x4 v[4]; float ss = 0.f;
#pragma unroll
        for (int j = 0; j < 4; ++j) { v[j] = *(const f32x4*)(xr + 4 * lane + 256 * j); ss += (v[j][0] * v[j][0] + v[j][1] * v[j][1]) + (v[j][2] * v[j][2] + v[j][3] * v[j][3]); }
        const float rstd = rsqrtf(wave_sum(ss) * (1.0f / 1024.0f) + EPS);
        unsigned long long* o8 = (unsigned long long*)(XN + (size_t)row * 1024) + lane;
#pragma unroll
        for (int j = 0; j < 4; ++j) { const f32x4 y = v[j] * rstd * mul[j] + add[j]; o8[64 * j] = (unsigned long long)pk2(y[0], y[1]) | ((unsigned long long)pk2(y[2], y[3]) << 32); }
    }
}
__device__ __forceinline__ void ctx_gates_phase(const float* xc, const float* gw, const float* modc, const float* win, const float* bg, float* GT, LAS unsigned char* lds) {
    const int tid = opaque_tid(), lane = tid & 63, gwv = blockIdx.x * 8 + (tid >> 6), NGW = gridDim.x * 8;
    LAS float* wg = (LAS float*)lds;
    for (int e = tid; e < 4096; e += 512) { const int k = e >> 2, q4 = e & 3; *(LAS f32x4*)(wg + k * 16 + q4 * 4) = *(const f32x4*)(win + (size_t)k * INW + 1792 + q4 * 4); }
    __syncthreads();
    for (int r = gwv; r < NCTX; r += NGW) {
        asm volatile("" ::: "memory");
        const float* xr = xc + (size_t)r * 1024; float h[16]; float ss = 0.f;
#pragma unroll
        for (int q = 0; q < 16; ++q) { h[q] = xr[lane + 64 * q]; ss += h[q] * h[q]; }
        const float rstd = rsqrtf(wave_sum(ss) * (1.0f / 1024.0f) + EPS);
        f32x4 acc[4];
#pragma unroll
        for (int q = 0; q < 4; ++q) acc[q] = (f32x4){0.f, 0.f, 0.f, 0.f};
#pragma unroll
        for (int q = 0; q < 16; ++q) { const int c = lane + 64 * q; const float hv = h[q] * rstd * gw[c] * (modc[1024 + c] + 1.0f) + modc[c];
#pragma unroll
            for (int g4 = 0; g4 < 4; ++g4) acc[g4] += *(const LAS f32x4*)(wg + c * 16 + 4 * g4) * hv; }
        float out = 0.f;
#pragma unroll
        for (int q = 0; q < 4; ++q)
#pragma unroll
            for (int i = 0; i < 4; ++i) { const float v = wave_sum(acc[q][i]); if (lane == 4 * q + i) out = v; }
        if (lane < 16) GT[(size_t)(NLAT + r) * 16 + lane] = out + bg[lane];
    }
    __syncthreads();
}
__device__ __forceinline__ void norm_phase_bf(const bf16_t* xs, const float* gw, const float* mod, int sh_off, int sc_off, bf16_t* XN, int nrows, const float* part = nullptr, int nsplit = 0, const float* pgate = nullptr, const float* cbase = nullptr, bf16_t* xs_w = nullptr) {
    const int tid = opaque_tid(), lane = tid & 63, gwv = blockIdx.x * 8 + (tid >> 6), NGW = gridDim.x * 8;
    const int per = (nrows + NGW - 1) / NGW;
    int cur = -1; f32x4 mul[4], add[4];
    for (int q = 0; q < per; ++q) {
        const int row = gwv * per + q; if (row >= nrows) break;
        const int mr = row < NLAT ? row / TLAT : 16;
        if (mr != cur) { cur = mr; const float* mp = mod + (size_t)mr * 6144;
#pragma unroll
            for (int j = 0; j < 4; ++j) { const int c = 8 * lane + 512 * (j >> 1) + 4 * (j & 1); const f32x4 g = *(const f32x4*)(gw + c), s = *(const f32x4*)(mp + sc_off + c); mul[j] = g * (s + 1.0f); add[j] = *(const f32x4*)(mp + sh_off + c); } }
        const bf16_t* xr = xs + (size_t)row * 1024;
        f32x4 v[4]; float ss = 0.f;
#pragma unroll
        for (int j = 0; j < 2; ++j) { const u32x4 w = *(const u32x4*)(xr + 8 * lane + 512 * j);
            v[2 * j] = (f32x4){bf2f(w.x & 0xffffu), bf2f(w.x >> 16), bf2f(w.y & 0xffffu), bf2f(w.y >> 16)}; v[2 * j + 1] = (f32x4){bf2f(w.z & 0xffffu), bf2f(w.z >> 16), bf2f(w.w & 0xffffu), bf2f(w.w >> 16)}; }
        if (part && row >= NLAT) {
#pragma unroll
            for (int j = 0; j < 4; ++j) { const int c = 8 * lane + 512 * (j >> 1) + 4 * (j & 1); f32x4 s = (f32x4){0.f, 0.f, 0.f, 0.f};
                if (cbase) v[j] = *(const f32x4*)(cbase + (size_t)(row - NLAT) * 1024 + c);
                for (int k = 0; k < nsplit; ++k) s += *(const f32x4*)(part + ((size_t)k * NCTX + (row - NLAT)) * 1024 + c);
                v[j] += *(const f32x4*)(pgate + c) * s; }
            if (xs_w) {
#pragma unroll
                for (int j = 0; j < 2; ++j) { u32x4 o; o.x = pk2(v[2 * j][0], v[2 * j][1]); o.y = pk2(v[2 * j][2], v[2 * j][3]); o.z = pk2(v[2 * j + 1][0], v[2 * j + 1][1]); o.w = pk2(v[2 * j + 1][2], v[2 * j + 1][3]);
                    *(u32x4*)(xs_w + (size_t)row * 1024 + 8 * lane + 512 * j) = o; } } }
#pragma unroll
        for (int j = 0; j < 4; ++j) ss += (v[j][0] * v[j][0] + v[j][1] * v[j][1]) + (v[j][2] * v[j][2] + v[j][3] * v[j][3]);
        const float rstd = rsqrtf(wave_sum(ss) * (1.0f / 1024.0f) + EPS);
#pragma unroll
        for (int j = 0; j < 2; ++j) { const f32x4 y0 = v[2 * j] * rstd * mul[2 * j] + add[2 * j], y1 = v[2 * j + 1] * rstd * mul[2 * j + 1] + add[2 * j + 1];
            u32x4 o; o.x = pk2(y0[0], y0[1]); o.y = pk2(y0[2], y0[3]); o.z = pk2(y1[0], y1[1]); o.w = pk2(y1[2], y1[3]);
            *(u32x4*)(XN + (size_t)row * 1024 + 8 * lane + 512 * j) = o; }
    }
}
__device__ __forceinline__ void final_norm_phase(float* x, const float* gw) {
    const int tid = opaque_tid(), lane = tid & 63, gwv = blockIdx.x * 8 + (tid >> 6), NGW = gridDim.x * 8;
    f32x4 g[4];
#pragma unroll
    for (int j = 0; j < 4; ++j) g[j] = *(const f32x4*)(gw + 4 * lane + 256 * j);
    for (int row = gwv; row < NLAT; row += NGW) {
        float* xr = x + (size_t)row * 1024; f32x4 v[4]; float ss = 0.f;
#pragma unroll
        for (int j = 0; j < 4; ++j) { v[j] = *(const f32x4*)(xr + 4 * lane + 256 * j); ss += (v[j][0] * v[j][0] + v[j][1] * v[j][1]) + (v[j][2] * v[j][2] + v[j][3] * v[j][3]); }
        const float rstd = rsqrtf(wave_sum(ss) * (1.0f / 1024.0f) + EPS);
#pragma unroll
        for (int j = 0; j < 4; ++j) *(f32x4*)(xr + 4 * lane + 256 * j) = v[j] * rstd * g[j];
    }
}

__global__ void __launch_bounds__(512, 2) fwd_megakernel(Args a) {
    extern __shared__ __attribute__((aligned(16))) unsigned char lds_raw[];
    LAS unsigned char* lds = (LAS unsigned char*)lds_raw;
    unsigned char* ws = a.ws;
    const int tid = opaque_tid();
    float* MOD = (float*)(ws + WS_MOD);
    bf16_t* XN = (bf16_t*)(ws + WS_XN); bf16_t* QB = (bf16_t*)(ws + WS_QB); bf16_t* KB = (bf16_t*)(ws + WS_KB); bf16_t* VB = (bf16_t*)(ws + WS_VB);
    bf16_t* MLB = (bf16_t*)(ws + WS_MLB); bf16_t* PZ = (bf16_t*)(ws + WS_PZ); float* GT = (float*)(ws + WS_GT); bf16_t* HS = (bf16_t*)(ws + WS_HS); bf16_t* HS1 = (bf16_t*)(ws + WS_HS1);
    bf16_t* MIX = (bf16_t*)(ws + WS_MIX); bf16_t* HID = (bf16_t*)(ws + WS_HID); bf16_t* XS = (bf16_t*)(ws + WS_XS);
    unsigned* ctl = (unsigned*)(ws + WS_CTL);
    LAS int* item_s = (LAS int*)(lds + 131072 + 1024);
    volatile LAS unsigned* bst = (volatile LAS unsigned*)(lds + 131072 + 2048);
    if (tid < 4) bst[tid] = 0u;
    __syncthreads();
    XcdBarrier xbar = xcd_barrier_post(ctl + 4096, bst);
#define GSYNC() xcd_barrier(xbar)

    for (int rp = 0; rp < REP_PRO; ++rp) { prologue(a, lds, rp == 0 ? 7 : PRO_MASK);
    GSYNC(); }

    for (int l = 0; l < 2; ++l) {
        const float* xl_in = a.in[I_X];
        const float* xc_in = a.in[I_CTX];
        const float* modl = MOD + (size_t)l * 17 * 6144;
        for (int rp = 0; rp < REP_N1; ++rp) { if (l == 0) norm_phase(xl_in, xc_in, a.in[I_NMIX] + l * 1024, modl, 0, 1024, XN, MTOT); else norm_phase_bf(XS, a.in[I_NMIX] + l * 1024, modl, 0, 1024, XN, MTOT, (const float*)(ws + WS_MIX + 32 * MiB), 2, MOD + (size_t)16 * 6144 + 5120);
        if (l == 0) ctx_gates_phase(xc_in, a.in[I_NMIX], modl + 16 * 6144, a.in[I_WIN], a.in[I_BG], GT, lds);
        for (int rs = 0; rs < REP_SYNC; ++rs) GSYNC(); }
        for (int rp = 0; rp < REP_G1; ++rp) {
            pg8::Gemm g{XN, (const bf16_t*)(ws + WS_W1 + l * W1_BYTES), MTOT, N1, 1024}; pg8::G1Order S; S.init(gridDim.x, (int)blockIdx.x, l == 0);
            pg8::EpiIn E{QB, KB, VB, MLB, PZ, GT, a.in[I_QN] + l * 64, a.in[I_KN] + l * 64, a.in[I_BG] + l * 16, (const float*)(ws + WS_ROPE), attn_body::C2};
            pg8::gemm_phase<pg8::EpiIn, pg8::G1Order, true, true>(lds, g, S, E);
        GSYNC(); }
        for (int rp = 0; rp < REP_MIX; ++rp) {
            const int n_ml = 128 * ML_DUP, n_al = 1024 * AL_DUP, n_ac = (l == 0) ? 128 : 0, n_pool = (l == 0) ? 288 : 256, n_all = n_ml + n_al + n_ac + n_pool;
            for (;;) {
                __syncthreads();
                if (tid == 0) item_s[0] = (int)atomicAdd(ctl + 64 * (l * 4 + rp), 1u);
                __syncthreads();
                int it = item_s[0];
                if (it >= n_all) break;
                const int cmask = (rp == 0) ? 15 : MIXREP_MASK;
                if (it < n_ml) { if (!(cmask & 1)) continue; const int itm = it & 127, mb = itm >> 3, mh = (itm >> 1) & 3, md = itm & 1;
                    if (rp == 0) ml::mlstm_item<0>(mb, mh, md, MLB, GT, md ? HS1 : HS, lds); else ml::mlstm_item<ML_VAR>(mb, mh, md, MLB, GT, md ? HS1 : HS, lds);
                    continue; }
                it -= n_ml;
                if (it < n_al) { if (!(cmask & 2)) continue; const int b = (it >> 6) & 15, h = (it >> 3) & 7, qb = it & 7;
                    attn_body::attn_unit<8>((const attn_body::bf16*)(QB + ((size_t)b * TLAT + qb * 256) * 512 + h * 64), (const attn_body::bf16*)(KB + (size_t)b * TKV * 128 + (h >> 2) * 64),
                                            (const attn_body::bf16*)(VB + (size_t)b * TKV * 128 + (h >> 2) * 64), (attn_body::bf16*)(MIX + ((size_t)b * TLAT + qb * 256) * 1024 + h * 64), TKV / 64, (char*)lds_raw);
                    continue; }
                it -= n_al;
                if (it < n_ac) { if (!(cmask & 4)) continue; const int b = it >> 3, h = it & 7;
                    attn_body::attn_unit<8>((const attn_body::bf16*)(QB + ((size_t)NLAT + b * TCTX) * 512 + h * 64), (const attn_body::bf16*)(KB + ((size_t)b * TKV + TLAT) * 128 + (h >> 2) * 64),
                                            (const attn_body::bf16*)(VB + ((size_t)b * TKV + TLAT) * 128 + (h >> 2) * 64), (attn_body::bf16*)(MIX + ((size_t)NLAT + b * TCTX) * 1024 + h * 64), TCTX / 64, (char*)lds_raw);
                    continue; }
                it -= n_ac;
                if (cmask & 8) pool_item(it, PZ, MIX, lds);
            }
        GSYNC(); }
        ml::mlstm_readout_phase(l == 0, HS, HS1, MLB, MIX, a.in[I_MLN] + l * 256);
        GSYNC();
        const int Mrows = (l == 0) ? MTOT : NLAT;
        {
            pg8::Gemm g{MIX, (const bf16_t*)(ws + WS_WO + l * WO_BYTES), Mrows, 1024, 1024, 0}; pg8::StaticOrder S; S.init(Mrows, 1024, gridDim.x, (int)blockIdx.x);
            if (l == 0) { pg8::EpiRes2<false, true> E{xl_in, xc_in, XS, nullptr, modl + 2048}; pg8::gemm_phase<pg8::EpiRes2<false, true>, pg8::StaticOrder, true, true>(lds, g, S, E); }
            else { pg8::EpiRes2<true, true> E{nullptr, nullptr, XS, nullptr, modl + 2048}; pg8::gemm_phase<pg8::EpiRes2<true, true>, pg8::StaticOrder, true, true>(lds, g, S, E); }
        }
        GSYNC();
        for (int rp = 0; rp < REP_N2; ++rp) { norm_phase_bf(XS, a.in[I_NFFN] + l * 1024, modl, 3072, 4096, XN, Mrows);
        GSYNC(); }
        for (int rp = 0; rp < REP_G3; ++rp) {
            pg8::Gemm g{XN, (const bf16_t*)(ws + WS_WGU + l * WGU_BYTES), Mrows, NGU, 1024}; pg8::StaticOrder S; S.init(Mrows, NGU, gridDim.x, (int)blockIdx.x);
            pg8::EpiGU E{HID};
            pg8::gemm_phase<pg8::EpiGU, pg8::StaticOrder, true, true>(lds, g, S, E);
        GSYNC(); }
        {
            pg8::Gemm g{HID, (const bf16_t*)(ws + WS_WD + l * WD_BYTES), NLAT, 1024, DFF, 0}; pg8::StaticOrder S; S.init(NLAT, 1024, gridDim.x, (int)blockIdx.x);
            if (l == 0) { pg8::EpiRes2<true, true> E{nullptr, nullptr, XS, nullptr, modl + 5120}; pg8::gemm_phase<pg8::EpiRes2<true, true>, pg8::StaticOrder, true, true>(lds, g, S, E);
                for (int kc = 0; kc < 2; ++kc) { pg8::Gemm gt{HID + kc * (DFF / 2), (const bf16_t*)(ws + WS_WD) + kc * (DFF / 2), MTOT, 1024, DFF / 2, DFF}; pg8::TailOrder T{(int)blockIdx.x, 64 * kc};
                    pg8::EpiPart EP{(float*)(ws + WS_MIX + 32 * MiB) + (size_t)kc * NCTX * 1024};
                    pg8::gemm_phase<pg8::EpiPart, pg8::TailOrder, true, true>(lds, gt, T, EP); } }
            else { pg8::EpiRes2<true, false> E{nullptr, nullptr, XS, a.out, modl + 5120}; pg8::gemm_phase<pg8::EpiRes2<true, false>, pg8::StaticOrder, true, true>(lds, g, S, E); }
        }
        GSYNC();
    }
    final_norm_phase(a.out, a.in[I_FN]);
}

extern "C" void kernel_launch(void* const* d_in, const int* in_sizes, int n_in, void* d_out, int out_size, void* d_ws, size_t ws_size, hipStream_t stream) {
    static int grid_blocks = 0;
    if (grid_blocks == 0) {
        if (n_in != 20 || ws_size < WS_END) { fprintf(stderr, "kernel_launch: unexpected n_in %d / ws_size %zu\n", n_in, ws_size); grid_blocks = -1; return; }
        int dev = 0, cus = 0, per_cu = 0;
        hipGetDevice(&dev);
        hipDeviceGetAttribute(&cus, hipDeviceAttributeMultiprocessorCount, dev);
        if (hipFuncSetAttribute((const void*)fwd_megakernel, hipFuncAttributeMaxDynamicSharedMemorySize, LDS_BYTES) != hipSuccess) { fprintf(stderr, "kernel_launch: hipFuncSetAttribute failed\n"); grid_blocks = -1; return; }
        if (hipOccupancyMaxActiveBlocksPerMultiprocessor(&per_cu, (const void*)fwd_megakernel, 512, LDS_BYTES) != hipSuccess || per_cu < 1) { fprintf(stderr, "kernel_launch: occupancy query failed (%d)\n", per_cu); grid_blocks = -1; return; }
        grid_blocks = cus * per_cu;
    }
    if (grid_blocks < 0) return;
    hipMemsetAsync((char*)d_ws + WS_CTL, 0, 65536, stream);
    Args a{};
    for (int i = 0; i < 20; ++i) a.in[i] = (const float*)d_in[i];
    a.out = (float*)d_out; a.ws = (unsigned char*)d_ws;
    void* args[] = {&a};
    hipError_t e = hipLaunchCooperativeKernel((const void*)fwd_megakernel, dim3(grid_blocks), dim3(512), args, LDS_BYTES, stream);
    if (e != hipSuccess) fprintf(stderr, "cooperative launch failed: %s (grid %d)\n", hipGetErrorString(e), grid_blocks);
}
```

```cpp
#include <hip/hip_runtime.h>
#include <hip/hip_cooperative_groups.h>
#include <hip/hip_bf16.h>
#include <cstdio>
#include <cstdint>
#include <cmath>
namespace cg = cooperative_groups;

constexpr int DMODEL = 1024, NBATCH = 16, TLAT = 2048, TCTX = 256, NLAT = NBATCH * TLAT, NCTX = NBATCH * TCTX, MTOT = NLAT + NCTX;
constexpr int N1 = 2304, DFF = 2816, NGU = 2 * DFF, TKV = TLAT + TCTX, INW = 2064;
constexpr float EPS = 1e-6f;
constexpr size_t MiB = 1u << 20;
constexpr size_t WS_CTL = 0, WS_MOD = 1 * MiB, WS_ROPE = 2 * MiB, WS_W1 = 4 * MiB, WS_WO = 13 * MiB, WS_WGU = 17 * MiB, WS_WD = 39 * MiB,
                 WS_XC = 50 * MiB, WS_XN = 66 * MiB, WS_QB = 138 * MiB, WS_KB = 174 * MiB, WS_VB = 183 * MiB, WS_MLB = 192 * MiB, WS_PZ = 264 * MiB,
                 WS_GT = 282 * MiB, WS_HS = 285 * MiB, WS_MIX = 321 * MiB, WS_HID = 138 * MiB, WS_HS1 = 393 * MiB, WS_XS = 429 * MiB, WS_END = 501 * MiB;
constexpr size_t W1_BYTES = (size_t)N1 * 1024 * 2, WO_BYTES = (size_t)1024 * 1024 * 2, WGU_BYTES = (size_t)NGU * 1024 * 2, WD_BYTES = (size_t)1024 * DFF * 2;

#define LAS __attribute__((address_space(3)))
typedef unsigned short bf16_t;
typedef float f32x4 __attribute__((ext_vector_type(4)));
typedef unsigned u32x4 __attribute__((ext_vector_type(4)));
typedef short bf16x8 __attribute__((ext_vector_type(8)));

__device__ __forceinline__ unsigned f2bf(float f) { unsigned u = __builtin_bit_cast(unsigned, f); return (u + 0x7fffu + ((u >> 16) & 1u)) >> 16; }
typedef float f32x2_hw __attribute__((ext_vector_type(2))); typedef __bf16 bf16x2_hw __attribute__((ext_vector_type(2)));
__device__ __forceinline__ unsigned pk2(float lo, float hi) { f32x2_hw v = {lo, hi}; bf16x2_hw b = __builtin_convertvector(v, bf16x2_hw); return __builtin_bit_cast(unsigned, b); }
__device__ __forceinline__ unsigned f2bf_hw(float f) { return pk2(f, 0.f) & 0xffffu; }
__device__ __forceinline__ float bf2f(unsigned v) { return __builtin_bit_cast(float, v << 16); }
__device__ __forceinline__ float silu_f(float x) { return x * __builtin_amdgcn_rcpf(1.0f + __expf(-x)); }
__device__ __forceinline__ float sigmoid_f(float x) { return __builtin_amdgcn_rcpf(1.0f + __expf(-x)); }
__device__ __forceinline__ float wave_sum(float v) {
#pragma unroll
    for (int o = 1; o < 64; o <<= 1) v += __shfl_xor(v, o);
    return v;
}
__device__ __forceinline__ int opaque_tid() { int t = threadIdx.x; asm volatile("" : "+v"(t)); return t; }
namespace pg8 {
#define PG8_LAS __attribute__((address_space(3)))
typedef unsigned short bf16_t;
typedef short bf16x8 __attribute__((ext_vector_type(8)));
typedef float f32x4 __attribute__((ext_vector_type(4)));
typedef unsigned u32x4 __attribute__((ext_vector_type(4)));
constexpr int BM = 256, BK = 64, HALF = 128, HTB = HALF * BK * 2  , STAGE_BYTES = 8 * HTB, NXCD = 8, WGM = 8;

__host__ __device__ __forceinline__ int lds_byte(int r, int c) { const int st = (r >> 4) * 2 + (c >> 5), rr = r & 15, cc = c & 31, ob = rr * 64 + cc * 2; return st * 1024 + (ob ^ (((ob >> 9) & 1) << 5)); }
__host__ __device__ __forceinline__ void stage_rc(int b, int& R, int& C) { const int st = b / 1024, sb = b % 1024, swz = sb ^ (((sb >> 9) & 1) << 5); R = (st >> 1) * 16 + swz / 64; C = (st & 1) * 32 + (swz % 64) / 2; }
__host__ __device__ __forceinline__ int perm32(int rho) { const int n = rho >> 4, i = rho & 15; return 8 * (i >> 2) + 4 * n + (i & 3); }

struct Unit { int pm, pn; };
struct Gemm { const bf16_t* A; const bf16_t* Bt; int M, N, K; int ld; };

struct StaticOrder {
    int nM, nN, nwg, G, c;
    __host__ __device__ void init(int M, int N, int G_, int c_) { nM = M / BM; nN = N / BM; nwg = nM * nN; G = G_; c = c_; }
    __host__ __device__ bool next(int i, Unit& u) const {
        const long L = (long)i * G + c; if (L >= nwg) return false;
        int wgid = (int)L; { const int q = nwg / NXCD, r = nwg % NXCD, xcd = wgid % NXCD, off = wgid / NXCD; wgid = (xcd < r ? xcd * (q + 1) : r * (q + 1) + (xcd - r) * q) + off; }
        const int nig = WGM * nN, gid = wgid / nig, fm = gid * WGM, gsz = (nM - fm) < WGM ? (nM - fm) : WGM;
        u.pm = fm + ((wgid % nig) % gsz); u.pn = (wgid % nig) / gsz; return true;
    }
    __device__ __forceinline__ void a_ready(const Unit&) const {}
    __device__ __forceinline__ void done(const Unit&) const {}
};

__device__ __forceinline__ unsigned cvt_pk_bf16(float lo, float hi) { unsigned r; asm volatile("v_cvt_pk_bf16_f32 %0, %1, %2" : "=v"(r) : "v"(lo), "v"(hi)); return r; }
typedef float f32x2 __attribute__((ext_vector_type(2)));
struct G1Order {
    StaticOrder so; int G, c, next_n, npn; int pl0, pl1, pl2, pl3, pl4, pl5, pl6, pl7;
    __device__ void init(int G_, int c_, bool layer0) { so.init(NLAT, N1, G_, c_); G = G_; c = c_;
        if (layer0) { npn = 8; pl0 = 0; pl1 = 1; pl2 = 2; pl3 = 3; pl4 = 4; pl5 = 5; pl6 = 6; pl7 = 7; }
        else { npn = 5; pl0 = 2; pl1 = 3; pl2 = 4; pl3 = 5; pl4 = 8; pl5 = 0; pl6 = 0; pl7 = 0; }
        next_n = 16 * npn; }
    __device__ bool next(int i, Unit& u) const {
        const int L = i * G + c;
        if (L < so.nwg) return so.next(i, u);
        const int e = L - so.nwg; if (e >= next_n) return false;
        const int d = (npn == 8) ? (e >> 3) : ((e * 52429) >> 18); const int q = e - d * npn; u.pm = 128 + d;
        u.pn = (q == 0) ? pl0 : (q == 1) ? pl1 : (q == 2) ? pl2 : (q == 3) ? pl3 : (q == 4) ? pl4 : (q == 5) ? pl5 : (q == 6) ? pl6 : pl7; return true; }
    __device__ __forceinline__ void a_ready(const Unit&) const {}
    __device__ __forceinline__ void done(const Unit&) const {}
};
struct EpiIn {
    static constexpr bool PERM = true, AFTER_DRAIN = false;
    bf16_t *QB, *KB, *VB, *MLB, *PZ; float* GT;
    const float *qn, *kn, *bg; const float* CS;
    float c2;
    __device__ __forceinline__ void operator()(const f32x4 (&acc)[2][2][4][2], const Unit& u, int wr, int wc, int fr, int fq) const {
        const int pn = u.pn, pm = u.pm;
        const bool lat = pm < 128;
        const int rt0 = wr * 64 + fr;
        const size_t grow0 = (size_t)pm * 256 + rt0;
        const size_t kv0 = lat ? ((size_t)(pm >> 3) * TKV + (size_t)(pm & 7) * 256 + rt0) : ((size_t)(pm - 128) * TKV + TLAT + rt0);
        if (pn < 2 || (pn == 2 && wc < 2)) {
            const bool isq = pn < 2;
            const float* nw = isq ? qn : kn;
            f32x4 wv[2][2];
#pragma unroll
            for (int bj = 0; bj < 2; ++bj)
#pragma unroll
                for (int n = 0; n < 2; ++n) wv[bj][n] = *(const f32x4*)(nw + 32 * bj + 8 * fq + 4 * n);
            const float sgn = (fq < 2) ? -1.f : 1.f;
            const float osc = isq ? c2 : 1.f;
#pragma unroll
            for (int ai = 0; ai < 2; ++ai)
#pragma unroll
                for (int m = 0; m < 4; ++m) {
                    float ss = 0.f;
#pragma unroll
                    for (int bj = 0; bj < 2; ++bj)
#pragma unroll
                        for (int n = 0; n < 2; ++n) { const f32x4 v = acc[ai][bj][m][n]; ss += (v[0] * v[0] + v[1] * v[1]) + (v[2] * v[2] + v[3] * v[3]); }
                    ss += __shfl_xor(ss, 16); ss += __shfl_xor(ss, 32);
                    const float rstd = rsqrtf(ss * (1.0f / 64.0f) + EPS);
                    const int roff = ai * 128 + m * 16;
#pragma unroll
                    for (int bj = 0; bj < 2; ++bj) {
                        f32x4 y[2];
#pragma unroll
                        for (int n = 0; n < 2; ++n) y[n] = acc[ai][bj][m][n] * rstd * wv[bj][n];
                        if (lat) {
                            const int pos = (bj == 0) ? ((pm & 7) * 4 + 2 * ai + wr) : (m * 16 + fr);
                            const float* cs = CS + (size_t)pos * 32 + 16 * (fq & 1);
#pragma unroll
                            for (int n = 0; n < 2; ++n) {
                                const f32x4 t0 = *(const f32x4*)(cs + 8 * n), t1 = *(const f32x4*)(cs + 8 * n + 4);
                                f32x4 p;
                                p[0] = __shfl_xor(y[n][0], 32); p[1] = __shfl_xor(y[n][1], 32); p[2] = __shfl_xor(y[n][2], 32); p[3] = __shfl_xor(y[n][3], 32);
                                f32x4 o;
                                o[0] = y[n][0] * t0[0] + sgn * p[0] * t0[1];
                                o[1] = y[n][1] * t0[2] + sgn * p[1] * t0[3];
                                o[2] = y[n][2] * t1[0] + sgn * p[2] * t1[1];
                                o[3] = y[n][3] * t1[2] + sgn * p[3] * t1[3];
                                y[n] = o;
                            }
                        }
                        u32x4 w;
                        w.x = cvt_pk_bf16(y[0][0] * osc, y[0][1] * osc); w.y = cvt_pk_bf16(y[0][2] * osc, y[0][3] * osc);
                        w.z = cvt_pk_bf16(y[1][0] * osc, y[1][1] * osc); w.w = cvt_pk_bf16(y[1][2] * osc, y[1][3] * osc);
                        bf16_t* dst = isq ? (QB + (grow0 + roff) * 512 + (4 * pn + wc) * 64 + 32 * bj + 8 * fq)
                                          : (KB + (kv0 + roff) * 128 + wc * 64 + 32 * bj + 8 * fq);
                        *(u32x4*)dst = w;
                    }
                    asm volatile("" ::: "memory");
                }
        } else if (pn <= 7) {
            bf16_t* base; size_t ld; size_t r0; int cb; float sc = 1.f;
            if (pn == 2) { base = VB; ld = 128; r0 = kv0; cb = (wc - 2) * 64; }
            else if (pn == 7) { base = PZ; ld = 256; r0 = grow0; cb = wc * 64; }
            else { base = MLB; ld = 1024; r0 = grow0; cb = (pn - 3) * 256 + wc * 64; if (pn == 4) sc = 0.125f; }
#pragma unroll
            for (int ai = 0; ai < 2; ++ai)
#pragma unroll
                for (int m = 0; m < 4; ++m)
#pragma unroll
                    for (int bj = 0; bj < 2; ++bj) {
                        const f32x4 v0 = acc[ai][bj][m][0] * sc, v1 = acc[ai][bj][m][1] * sc;
                        u32x4 w; w.x = cvt_pk_bf16(v0[0], v0[1]); w.y = cvt_pk_bf16(v0[2], v0[3]); w.z = cvt_pk_bf16(v1[0], v1[1]); w.w = cvt_pk_bf16(v1[2], v1[3]);
                        *(u32x4*)(base + (r0 + ai * 128 + m * 16) * ld + cb + 32 * bj + 8 * fq) = w;
                    }
        } else {
            if (wc == 0 && fq < 2) {
                const f32x4 b0 = *(const f32x4*)(bg + 8 * fq), b1 = *(const f32x4*)(bg + 8 * fq + 4);
#pragma unroll
                for (int ai = 0; ai < 2; ++ai)
#pragma unroll
                    for (int m = 0; m < 4; ++m) {
                        float* g = GT + (grow0 + ai * 128 + m * 16) * 16 + 8 * fq;
                        *(f32x4*)g = acc[ai][0][m][0] + b0; *(f32x4*)(g + 4) = acc[ai][0][m][1] + b1;
                    }
            }
        }
    }
};
struct EpiRes {
    static constexpr bool PERM = false, AFTER_DRAIN = false;
    const float *base_l, *base_c; float *out_l, *out_c; const float* gate;
    __device__ __forceinline__ void operator()(const f32x4 (&acc)[2][2][4][2], const Unit& u, int wr, int wc, int fr, int fq) const {
        const int pn = u.pn, pm = u.pm; const bool lat = pm < 128;
        const float* gv = gate + (size_t)(lat ? (pm >> 3) : 16) * 6144;
        const float* bp = lat ? base_l + (size_t)pm * 256 * 1024 : base_c + (size_t)(pm - 128) * 256 * 1024;
        float* op = lat ? out_l + (size_t)pm * 256 * 1024 : out_c + (size_t)(pm - 128) * 256 * 1024;
        const int col0 = pn * BM + wc * 32 + 4 * fq;
        f32x4 g4[2][2];
#pragma unroll
        for (int bj = 0; bj < 2; ++bj)
#pragma unroll
            for (int n = 0; n < 2; ++n) g4[bj][n] = *(const f32x4*)(gv + col0 + bj * HALF + n * 16);
#pragma unroll
        for (int ai = 0; ai < 2; ++ai)
#pragma unroll
            for (int m = 0; m < 4; ++m) { const size_t off = (size_t)(ai * HALF + wr * 64 + m * 16 + fr) * 1024 + col0;
#pragma unroll
                for (int bj = 0; bj < 2; ++bj)
#pragma unroll
                    for (int n = 0; n < 2; ++n) { const f32x4 x = *(const f32x4*)(bp + off + bj * HALF + n * 16); *(f32x4*)(op + off + bj * HALF + n * 16) = x + g4[bj][n] * acc[ai][bj][m][n]; }
                if (m & 1) asm volatile("" ::: "memory"); }
    }
};
struct EpiGU {
    static constexpr bool PERM = true, AFTER_DRAIN = false;
    bf16_t* H;
    __device__ __forceinline__ void operator()(const f32x4 (&acc)[2][2][4][2], const Unit& u, int wr, int wc, int fr, int fq) const {
        const size_t row0 = (size_t)u.pm * BM + wr * 64 + fr; const int col0 = u.pn * 128 + wc * 32 + 8 * fq;
#pragma unroll
        for (int ai = 0; ai < 2; ++ai)
#pragma unroll
            for (int m = 0; m < 4; ++m) {
                f32x4 v[2];
#pragma unroll
                for (int n = 0; n < 2; ++n) { const f32x4 g = acc[ai][0][m][n], up = acc[ai][1][m][n];
                    v[n][0] = g[0] * __builtin_amdgcn_rcpf(1.0f + __expf(-g[0])) * up[0]; v[n][1] = g[1] * __builtin_amdgcn_rcpf(1.0f + __expf(-g[1])) * up[1];
                    v[n][2] = g[2] * __builtin_amdgcn_rcpf(1.0f + __expf(-g[2])) * up[2]; v[n][3] = g[3] * __builtin_amdgcn_rcpf(1.0f + __expf(-g[3])) * up[3]; }
                u32x4 w; w.x = cvt_pk_bf16(v[0][0], v[0][1]); w.y = cvt_pk_bf16(v[0][2], v[0][3]); w.z = cvt_pk_bf16(v[1][0], v[1][1]); w.w = cvt_pk_bf16(v[1][2], v[1][3]);
                *(u32x4*)(H + (row0 + ai * HALF + m * 16) * DFF + col0) = w;
            }
    }
};
template <bool IN_BF16, bool OUT_BF16> struct EpiRes2 {
    static constexpr bool PERM = true, AFTER_DRAIN = false;
    const float *bl, *bc; bf16_t* xs; float* ol; const float* gate;
    __device__ __forceinline__ void operator()(const f32x4 (&acc)[2][2][4][2], const Unit& u, int wr, int wc, int fr, int fq) const {
        const int pn = u.pn, pm = u.pm; const bool lat = pm < 128;
        const float* gv = gate + (size_t)(lat ? (pm >> 3) : 16) * 6144;
        const int col0 = pn * BM + wc * 32 + 8 * fq;
        const size_t row0 = (size_t)pm * BM + wr * 64 + fr;
        const float* bf = lat ? bl + row0 * 1024 : bc + (row0 - NLAT) * 1024;
        f32x4 g4[2][2];
#pragma unroll
        for (int bj = 0; bj < 2; ++bj)
#pragma unroll
            for (int n = 0; n < 2; ++n) g4[bj][n] = *(const f32x4*)(gv + col0 + bj * HALF + 4 * n);
#pragma unroll
        for (int ai = 0; ai < 2; ++ai)
#pragma unroll
            for (int m = 0; m < 4; ++m) { const size_t ro = (size_t)(ai * HALF + m * 16) * 1024;
#pragma unroll
                for (int bj = 0; bj < 2; ++bj) { const int c = col0 + bj * HALF;
                    f32x4 x0, x1;
                    if (IN_BF16) { const u32x4 v = *(const u32x4*)(xs + row0 * 1024 + ro + c);
                        x0 = (f32x4){__builtin_bit_cast(float, v.x << 16), __builtin_bit_cast(float, v.x & 0xffff0000u), __builtin_bit_cast(float, v.y << 16), __builtin_bit_cast(float, v.y & 0xffff0000u)};
                        x1 = (f32x4){__builtin_bit_cast(float, v.z << 16), __builtin_bit_cast(float, v.z & 0xffff0000u), __builtin_bit_cast(float, v.w << 16), __builtin_bit_cast(float, v.w & 0xffff0000u)}; }
                    else { x0 = *(const f32x4*)(bf + ro + c); x1 = *(const f32x4*)(bf + ro + c + 4); }
                    x0 = x0 + g4[bj][0] * acc[ai][bj][m][0]; x1 = x1 + g4[bj][1] * acc[ai][bj][m][1];
                    if (OUT_BF16) { u32x4 w; w.x = cvt_pk_bf16(x0[0], x0[1]); w.y = cvt_pk_bf16(x0[2], x0[3]); w.z = cvt_pk_bf16(x1[0], x1[1]); w.w = cvt_pk_bf16(x1[2], x1[3]);
                        *(u32x4*)(xs + row0 * 1024 + ro + c) = w; }
                    else { *(f32x4*)(ol + row0 * 1024 + ro + c) = x0; *(f32x4*)(ol + row0 * 1024 + ro + c + 4) = x1; } }
                if (IN_BF16 ? (m == 3) : (m & 1)) asm volatile("" ::: "memory"); }
    }
};
struct TailOrder {
    int c, c0;
    __device__ bool next(int i, Unit& u) const { const int e = c - c0; if (i != 0 || e < 0 || e >= 64) return false; u.pn = e & 3; u.pm = 128 + (e >> 2); return true; }
    __device__ __forceinline__ void a_ready(const Unit&) const {}
    __device__ __forceinline__ void done(const Unit&) const {}
};
struct EpiPart {
    static constexpr bool PERM = true, AFTER_DRAIN = false;
    float* P;
    __device__ __forceinline__ void operator()(const f32x4 (&acc)[2][2][4][2], const Unit& u, int wr, int wc, int fr, int fq) const {
        float* op = P + ((size_t)(u.pm - 128) * BM + wr * 64 + fr) * 1024 + u.pn * BM + wc * 32 + 8 * fq;
#pragma unroll
        for (int ai = 0; ai < 2; ++ai)
#pragma unroll
            for (int m = 0; m < 4; ++m)
#pragma unroll
                for (int bj = 0; bj < 2; ++bj) { float* o = op + (size_t)(ai * HALF + m * 16) * 1024 + bj * HALF; *(f32x4*)o = acc[ai][bj][m][0]; *(f32x4*)(o + 4) = acc[ai][bj][m][1]; }
    }
};
template <class Epi, class Sched, bool ALIGN_EPI = false, bool SP2 = false>
__device__ __forceinline__ void gemm_phase(PG8_LAS unsigned char* lds, const Gemm g, const Sched& S, const Epi& E) {
    const int tid = opaque_tid(), wid = __builtin_amdgcn_readfirstlane(tid >> 6), lane = tid & 63, wr = wid >> 2, wc = wid & 3, fr = lane & 15, fq = lane >> 4;
    const int K = g.ld ? g.ld : g.K, nt = g.K / BK;
    unsigned voffA[2], voffB[2];
#pragma unroll
    for (int i = 0; i < 2; ++i) { int R, C; stage_rc(tid * 16 + i * 8192, R, C); const int Rb = Epi::PERM ? ((R & ~31) + perm32(R & 31)) : R;
        voffA[i] = (unsigned)(R * K + C) * 2u; voffB[i] = (unsigned)(Rb * K + C) * 2u; }
    const size_t kstep = (size_t)(BK * 2);
    const size_t hstep = (size_t)HALF * K * 2;
    const size_t tstep = 2 * hstep;
    const unsigned ldsw = (unsigned)wid * 1024u;
    const int aoff = lds_byte(wr * 64 + fr, fq * 8), boff = lds_byte(wc * 32 + fr, fq * 8);
#define PG8_SA(b, h) (((b) * 2 + (h)) * HTB)
#define PG8_SB(b, h) ((4 + (b) * 2 + (h)) * HTB)
#define PG8_STAGE(bufoff, gbase, voff) do { _Pragma("unroll") for (int _i = 0; _i < 2; ++_i) \
        __builtin_amdgcn_global_load_lds((const unsigned*)((const char*)(gbase) + (voff)[_i]), (PG8_LAS unsigned*)(lds + (bufoff) + ldsw + _i * 8192), 16, 0, 0); } while (0)
#define PG8_LDA(dst, b, h) do { _Pragma("unroll") for (int m = 0; m < 4; ++m) _Pragma("unroll") for (int k = 0; k < 2; ++k) dst[m][k] = *(const PG8_LAS bf16x8*)(lds + PG8_SA(b, h) + aoff + m * 2048 + k * 1024); } while (0)
#define PG8_LDB(dst, b, h) do { _Pragma("unroll") for (int n = 0; n < 2; ++n) _Pragma("unroll") for (int k = 0; k < 2; ++k) dst[n][k] = *(const PG8_LAS bf16x8*)(lds + PG8_SB(b, h) + boff + n * 2048 + k * 1024); } while (0)
#define PG8_MMA(ai, bj, At, Bt) do { __builtin_amdgcn_s_setprio(1); _Pragma("unroll") for (int m = 0; m < 4; ++m) _Pragma("unroll") for (int n = 0; n < 2; ++n) _Pragma("unroll") for (int k = 0; k < 2; ++k) \
        acc[ai][bj][m][n] = __builtin_amdgcn_mfma_f32_16x16x32_bf16(Bt[n][k], At[m][k], acc[ai][bj][m][n], 0, 0, 0); __builtin_amdgcn_s_setprio(0); } while (0)
#define PG8_WAIT_V(n) asm volatile("s_waitcnt vmcnt(" #n ")" ::: "memory")
#define PG8_WAIT_L(n) asm volatile("s_waitcnt lgkmcnt(" #n ")" ::: "memory")
#define PG8_BAR __builtin_amdgcn_s_barrier()
#define PG8_SCHED __builtin_amdgcn_sched_barrier(0)
    Unit cur, nxt; int ui = 0;
    if (!S.next(0, cur)) return;
    f32x4 acc[2][2][4][2];
#pragma unroll
    for (int a = 0; a < 2; ++a)
#pragma unroll
        for (int b = 0; b < 2; ++b)
#pragma unroll
            for (int m = 0; m < 4; ++m)
#pragma unroll
                for (int n = 0; n < 2; ++n) acc[a][b][m][n] = (f32x4){0.f, 0.f, 0.f, 0.f};
    bf16x8 At[4][2], B0[2][2], B1[2][2];
    const char* cA = (const char*)g.A + (size_t)cur.pm * tstep; const char* cB = (const char*)g.Bt + (size_t)cur.pn * tstep;
    S.a_ready(cur);
    if constexpr (SP2) {
        PG8_STAGE(PG8_SB(0, 0), cB, voffB); PG8_STAGE(PG8_SB(0, 1), cB + hstep, voffB); PG8_STAGE(PG8_SA(0, 0), cA, voffA); PG8_STAGE(PG8_SA(0, 1), cA + hstep, voffA);
        if (wr == 1) PG8_BAR;
        PG8_WAIT_V(2); PG8_BAR;
        PG8_STAGE(PG8_SB(1, 0), cB + kstep, voffB); PG8_STAGE(PG8_SA(1, 0), cA + kstep, voffA); PG8_STAGE(PG8_SB(1, 1), cB + hstep + kstep, voffB);
        PG8_WAIT_V(6); PG8_BAR;
    } else {
        PG8_STAGE(PG8_SB(0, 0), cB, voffB); PG8_STAGE(PG8_SA(0, 0), cA, voffA); PG8_STAGE(PG8_SB(0, 1), cB + hstep, voffB); PG8_STAGE(PG8_SA(0, 1), cA + hstep, voffA);
        if (wr == 1) PG8_BAR;
        PG8_WAIT_V(4); PG8_BAR;
        PG8_STAGE(PG8_SB(1, 0), cB + kstep, voffB); PG8_STAGE(PG8_SA(1, 0), cA + kstep, voffA); PG8_STAGE(PG8_SB(1, 1), cB + hstep + kstep, voffB);
        PG8_WAIT_V(6); PG8_BAR;
    }
    for (;;) {
        const bool has_next = S.next(ui + 1, nxt);
        const char* nA = has_next ? (const char*)g.A + (size_t)nxt.pm * tstep : cA; const char* nB = has_next ? (const char*)g.Bt + (size_t)nxt.pn * tstep : cB;
        for (int t = 0; t < nt; t += 2) {
            const bool last = (t == nt - 2);
            const char* a1 = cA + (size_t)(t + 1) * kstep;
            const char* a2 = last ? nA : cA + (size_t)(t + 2) * kstep; const char* b2 = last ? nB : cB + (size_t)(t + 2) * kstep;
            const char* a3 = a2 + kstep; const char* b3 = b2 + kstep;
            if (last && has_next) S.a_ready(nxt);
            if constexpr (SP2) {
            PG8_LDB(B0, 0, 0); PG8_LDB(B1, 0, 1); PG8_SCHED; PG8_LDA(At, 0, 0); PG8_STAGE(PG8_SA(1, 1), a1 + hstep, voffA);
            PG8_WAIT_V(8); PG8_WAIT_L(0); PG8_BAR; PG8_MMA(0, 0, At, B0); PG8_MMA(0, 1, At, B1); PG8_BAR; PG8_SCHED;
            PG8_LDA(At, 0, 1); PG8_STAGE(PG8_SB(0, 0), b2, voffB); PG8_STAGE(PG8_SB(0, 1), b2 + hstep, voffB); PG8_STAGE(PG8_SA(0, 0), a2, voffA);
            PG8_WAIT_V(8); PG8_WAIT_L(0); PG8_BAR; PG8_MMA(1, 0, At, B0); PG8_MMA(1, 1, At, B1); PG8_BAR; PG8_SCHED;
            PG8_LDB(B0, 1, 0); PG8_LDB(B1, 1, 1); PG8_SCHED; PG8_LDA(At, 1, 0); PG8_STAGE(PG8_SA(0, 1), a2 + hstep, voffA);
            PG8_WAIT_V(8); PG8_WAIT_L(0); PG8_BAR; PG8_MMA(0, 0, At, B0); PG8_MMA(0, 1, At, B1); PG8_BAR; PG8_SCHED;
            PG8_LDA(At, 1, 1); PG8_STAGE(PG8_SB(1, 0), b3, voffB); PG8_STAGE(PG8_SB(1, 1), b3 + hstep, voffB); PG8_STAGE(PG8_SA(1, 0), a3, voffA);
            PG8_WAIT_V(8); PG8_WAIT_L(0); PG8_BAR; PG8_MMA(1, 0, At, B0); PG8_MMA(1, 1, At, B1); PG8_BAR; PG8_SCHED;
            } else {
            PG8_LDB(B0, 0, 0); PG8_SCHED; PG8_LDA(At, 0, 0); PG8_STAGE(PG8_SA(1, 1), a1 + hstep, voffA);
            PG8_WAIT_L(8); PG8_BAR; PG8_WAIT_L(0); PG8_MMA(0, 0, At, B0); PG8_BAR; PG8_SCHED;
            PG8_LDB(B1, 0, 1); PG8_STAGE(PG8_SB(0, 0), b2, voffB);
            PG8_BAR; PG8_WAIT_L(0); PG8_MMA(0, 1, At, B1); PG8_BAR;
            PG8_LDA(At, 0, 1); PG8_STAGE(PG8_SA(0, 0), a2, voffA);
            PG8_BAR; PG8_WAIT_L(0); PG8_MMA(1, 0, At, B0); PG8_BAR; PG8_SCHED;
            PG8_STAGE(PG8_SB(0, 1), b2 + hstep, voffB);
            PG8_WAIT_V(6); PG8_BAR; PG8_MMA(1, 1, At, B1); PG8_BAR;
            PG8_LDB(B0, 1, 0); PG8_SCHED; PG8_LDA(At, 1, 0); PG8_STAGE(PG8_SA(0, 1), a2 + hstep, voffA);
            PG8_WAIT_L(8); PG8_BAR; PG8_WAIT_L(0); PG8_MMA(0, 0, At, B0); PG8_BAR; PG8_SCHED;
            PG8_LDB(B1, 1, 1); PG8_STAGE(PG8_SB(1, 0), b3, voffB);
            PG8_BAR; PG8_WAIT_L(0); PG8_MMA(0, 1, At, B1); PG8_BAR;
            PG8_LDA(At, 1, 1); PG8_STAGE(PG8_SA(1, 0), a3, voffA);
            PG8_BAR; PG8_WAIT_L(0); PG8_MMA(1, 0, At, B0); PG8_BAR; PG8_SCHED;
            PG8_STAGE(PG8_SB(1, 1), b3 + hstep, voffB);
            PG8_WAIT_V(6); PG8_BAR; PG8_MMA(1, 1, At, B1); PG8_BAR;
            }
        }
        if constexpr (ALIGN_EPI) { if (wr == 0) PG8_BAR; }
        if constexpr (!Epi::AFTER_DRAIN) { E(acc, cur, wr, wc, fr, fq); S.done(cur); }
        if (!has_next) break;
#pragma unroll
        for (int a = 0; a < 2; ++a)
#pragma unroll
            for (int b = 0; b < 2; ++b)
#pragma unroll
                for (int m = 0; m < 4; ++m)
#pragma unroll
                    for (int n = 0; n < 2; ++n) acc[a][b][m][n] = (f32x4){0.f, 0.f, 0.f, 0.f};
        cur = nxt; cA = nA; cB = nB; ++ui;
        if constexpr (ALIGN_EPI) { if (wr == 1) PG8_BAR; }
    }
    PG8_WAIT_V(0);
    if constexpr (!ALIGN_EPI) { if (wr == 0) PG8_BAR; }
    PG8_BAR;
    if constexpr (Epi::AFTER_DRAIN) { E.fused(acc, cur, wr, wc, fr, fq, lds, wid, lane); S.done(cur); }
#undef PG8_SA
#undef PG8_SB
#undef PG8_STAGE
#undef PG8_LDA
#undef PG8_LDB
#undef PG8_MMA
#undef PG8_WAIT_V
#undef PG8_WAIT_L
#undef PG8_BAR
#undef PG8_SCHED
}
}

namespace attn_body {
using bf16=__hip_bfloat16;
using bf16x8=__attribute__((ext_vector_type(8)))short;
using s16x4=__attribute__((ext_vector_type(4)))short;
using f32x16=__attribute__((ext_vector_type(16)))float;
using u32x4=__attribute__((ext_vector_type(4)))unsigned;
constexpr int D=64,QP=512,KP=128,OP=1024;
constexpr int NW=8,QBLK=32,QB=QBLK*NW,KVBLK=64;
__device__ __forceinline__ int crow(int r,int hi){return (r&3)+8*(r>>2)+4*hi;}
#define SBAR() __builtin_amdgcn_sched_barrier(0)
constexpr int NSLOT=3, SLOTB=8192;
constexpr int LDS_K=0, LDS_V=NSLOT*SLOTB, LDS_WS=2*NSLOT*SLOTB, LDS_OST=LDS_WS+NW*64*4, LDS_BYTES=LDS_OST+NW*4096;
constexpr float C2=0.125f*1.4426950408889634f;
__device__ __forceinline__ void glds16(const void*gsrc,unsigned lds_dst){unsigned keep;
  asm volatile("s_mov_b32 %0, m0\n\ts_mov_b32 m0, %2\n\ts_nop 0\n\tglobal_load_lds_dwordx4 %1, off\n\ts_mov_b32 m0, %0":"=&s"(keep):"v"(gsrc),"s"(lds_dst):"memory");}
__device__ __forceinline__ float max3f(float a,float b,float c){float r;asm("v_max3_f32 %0, %1, %2, %3":"=v"(r):"v"(a),"v"(b),"v"(c));return r;}
__device__ __forceinline__ float max2f(float a,float b){float r;asm("v_max_f32_e32 %0, %1, %2":"=v"(r):"v"(a),"v"(b));return r;}
__device__ __forceinline__ float fadd_s(float a,float b){float r;asm("v_add_f32_e32 %0, %1, %2":"=v"(r):"v"(a),"v"(b));return r;}
__device__ __forceinline__ float fsub_s(float a,float b){float r;asm("v_sub_f32_e32 %0, %1, %2":"=v"(r):"v"(a),"v"(b));return r;}
typedef float f32x2_t __attribute__((ext_vector_type(2))); typedef __bf16 bf16x2_t __attribute__((ext_vector_type(2)));
__device__ __forceinline__ unsigned cvtpk_s(float lo,float hi){f32x2_t v={lo,hi};bf16x2_t b=__builtin_convertvector(v,bf16x2_t);return __builtin_bit_cast(unsigned,b);}
#define WAIT_BAR(N) asm volatile("s_waitcnt vmcnt(" #N ") lgkmcnt(0)\n\ts_barrier":::"memory")

__device__ __forceinline__ void qkt(f32x16&p0,f32x16&p1,const char*Kslot,const bf16x8*qr,const f32x16&negm,int r32,int hi){
  const char*kb=Kslot+hi*1024+r32*16;
  #pragma unroll
  for(int d0=0;d0<4;++d0){
    const bf16x8 b0=*reinterpret_cast<const bf16x8*>(kb+d0*2048);
    const bf16x8 b1=*reinterpret_cast<const bf16x8*>(kb+d0*2048+512);
    if(d0==0){p0=__builtin_amdgcn_mfma_f32_32x32x16_bf16(b0,qr[0],negm,0,0,0);p1=__builtin_amdgcn_mfma_f32_32x32x16_bf16(b1,qr[0],negm,0,0,0);}
    else{p0=__builtin_amdgcn_mfma_f32_32x32x16_bf16(b0,qr[d0],p0,0,0,0);p1=__builtin_amdgcn_mfma_f32_32x32x16_bf16(b1,qr[d0],p1,0,0,0);}}
}
typedef __attribute__((address_space(3))) const char* lds_cptr;
typedef short v4i16_t __attribute__((ext_vector_type(4)));
__device__ __forceinline__ void kload8(bf16x8*kf,lds_cptr kp){
  kf[0]=*(const __attribute__((address_space(3))) bf16x8*)(kp);      kf[1]=*(const __attribute__((address_space(3))) bf16x8*)(kp+512);
  kf[2]=*(const __attribute__((address_space(3))) bf16x8*)(kp+2048); kf[3]=*(const __attribute__((address_space(3))) bf16x8*)(kp+2560);
  kf[4]=*(const __attribute__((address_space(3))) bf16x8*)(kp+4096); kf[5]=*(const __attribute__((address_space(3))) bf16x8*)(kp+4608);
  kf[6]=*(const __attribute__((address_space(3))) bf16x8*)(kp+6144); kf[7]=*(const __attribute__((address_space(3))) bf16x8*)(kp+6656);
}
__device__ __forceinline__ void kload2(bf16x8*kf,lds_cptr kp,int j){ kf[2*j]=*(const __attribute__((address_space(3))) bf16x8*)(kp+j*2048); kf[2*j+1]=*(const __attribute__((address_space(3))) bf16x8*)(kp+j*2048+512); }
__device__ __forceinline__ s16x4 vtr(lds_cptr p){ return __builtin_bit_cast(s16x4,__builtin_amdgcn_ds_read_tr16_b64_v4i16((__attribute__((address_space(3))) v4i16_t*)p)); }
__device__ __forceinline__ float rowmax(const f32x16&p0,const f32x16&p1){
  float a=max3f(p0[0],p0[1],p1[0]),b=max3f(p0[2],p0[3],p1[1]);a=max3f(a,p1[2],p1[3]);
  #pragma unroll
  for(int r=4;r<16;r+=4){a=max3f(a,p0[r],p0[r+1]);b=max3f(b,p0[r+2],p0[r+3]);a=max3f(a,p1[r],p1[r+1]);b=max3f(b,p1[r+2],p1[r+3]);}
  const float m=max2f(a,b);
  auto rr=__builtin_amdgcn_permlane32_swap(__float_as_uint(m),__float_as_uint(m),false,false);
  return max2f(__uint_as_float(rr[0]),__uint_as_float(rr[1]));
}
__device__ __forceinline__ void pv(f32x16*o,int vb,bf16x8 pa0,bf16x8 pa1,bf16x8 pa2,bf16x8 pa3){
  #pragma unroll
  for(int d0=0;d0<2;++d0){s16x4 lo[4],hi[4];
    #pragma unroll
    for(int ks=0;ks<4;++ks){
      asm volatile("ds_read_b64_tr_b16 %0,%1 offset:%c2":"=&v"(lo[ks]):"v"(vb),"i"(d0*4096+ks*1024):"memory");
      asm volatile("ds_read_b64_tr_b16 %0,%1 offset:%c2":"=&v"(hi[ks]):"v"(vb),"i"(d0*4096+ks*1024+512):"memory");}
    asm volatile("s_waitcnt lgkmcnt(0)":::"memory");SBAR();
    #define PK(k) (bf16x8){lo[k][0],lo[k][1],lo[k][2],lo[k][3],hi[k][0],hi[k][1],hi[k][2],hi[k][3]}
    o[d0]=__builtin_amdgcn_mfma_f32_32x32x16_bf16(pa0,PK(0),o[d0],0,0,0);
    o[d0]=__builtin_amdgcn_mfma_f32_32x32x16_bf16(pa1,PK(1),o[d0],0,0,0);
    o[d0]=__builtin_amdgcn_mfma_f32_32x32x16_bf16(pa2,PK(2),o[d0],0,0,0);
    o[d0]=__builtin_amdgcn_mfma_f32_32x32x16_bf16(pa3,PK(3),o[d0],0,0,0);
    #undef PK
  }
}

#ifndef ATTN_STORE16
#define ATTN_STORE16(p,v) (*(u32x4*)(p)=(v))
#endif
template<int THRL> __device__ __forceinline__ void attn_unit(const bf16*Q,const bf16*__restrict__ K,const bf16*__restrict__ V,bf16*O,const int NT,char*shm){
  const int tid=opaque_tid(),lane=tid&63,r32=lane&31,hi=lane>>5; const int wid=__builtin_amdgcn_readfirstlane(tid>>6);
  const bf16*Qw=Q+(long)(wid*QBLK)*QP;
  const bf16*Kh=K,*Vh=V;
  const unsigned lds0=(unsigned)(uintptr_t)shm;
  float*wsf=(float*)(shm+LDS_WS)+wid*64;
  const bf16*ksrc=Kh+(long)lane*KP+wid*8;
  const bf16*vsrc=Vh+(long)(16*(wid&3)+(lane>>2))*KP+(wid>>2)*32+(lane&3)*8;
  const unsigned kdst=lds0+LDS_K+wid*1024, vdst=lds0+LDS_V+wid*1024;
  #define DMA_K(t,slot) glds16(ksrc+(long)(t)*KVBLK*KP,(unsigned)__builtin_amdgcn_readfirstlane(kdst+(slot)))
  #define DMA_V(t,slot) glds16(vsrc+(long)(t)*KVBLK*KP,(unsigned)__builtin_amdgcn_readfirstlane(vdst+(slot)))
  const int vb0=(int)(lds0+LDS_V)+((lane>>4)&1)*32+(lane&3)*8+(4*hi+((lane&15)>>2))*64;
  const char*Kbase=shm+LDS_K; bf16x8 kf[8];
  const lds_cptr shm3=(lds_cptr)shm; const lds_cptr kp0=shm3+LDS_K+hi*1024+r32*16; const lds_cptr vp0=shm3+LDS_V+((lane>>4)&1)*32+(lane&3)*8+(4*hi+((lane&15)>>2))*64;
  DMA_K(0,0);DMA_V(0,0);DMA_K(1,SLOTB);
  bf16x8 qr[4];
  #pragma unroll
  for(int d0=0;d0<4;++d0)qr[d0]=*reinterpret_cast<const bf16x8*>(&Qw[(long)r32*QP+d0*16+hi*8]);
  float mhat=0.f,l_reg=0.f;f32x16 o[2];o[0]=f32x16{};o[1]=f32x16{};f32x16 negm=f32x16{};asm volatile("":"+v"(negm));
  #define CMASK(P0,P1,t) do{}while(0)
  bool resc=false;
  #define START(P0,P1) do{ const float rm=rowmax(P0,P1); resc=false; \
    { const float dl=rm; mhat=fadd_s(mhat,dl); \
      _Pragma("unroll") for(int r=0;r<16;++r){P0[r]=fsub_s(P0[r],dl);P1[r]=fsub_s(P1[r],dl);} \
      _Pragma("unroll") for(int r=0;r<16;++r)negm[r]=-mhat; asm volatile("":"+v"(negm)); } \
    _Pragma("unroll") for(int r=0;r<16;++r)P0[r]=__builtin_amdgcn_exp2f(P0[r]); }while(0)
  #define RESC() do{ if(resc){ asm volatile("s_waitcnt lgkmcnt(0)":::"memory"); \
      _Pragma("unroll") for(int d_=0;d_<2;++d_) _Pragma("unroll") for(int r=0;r<16;++r)o[d_][r]*=wsf[crow(r,hi)]; } }while(0)
  f32x16 pA0,pA1,pB0,pB1;
  int sl_prev=0,sl_cur=0,sl_next=SLOTB;
  #define ROT() do{sl_prev=sl_cur;sl_cur=sl_next;sl_next=(sl_next==(NSLOT-1)*SLOTB)?0:sl_next+SLOTB;}while(0)
  DMA_K(2,2*SLOTB);
  WAIT_BAR(3);
  qkt(pA0,pA1,Kbase,qr,negm,r32,hi);asm volatile("s_nop 15\n\ts_nop 7":"+v"(pA0),"+v"(pA1));CMASK(pA0,pA1,0);
  START(pA0,pA1);
  _Pragma("unroll") for(int r=0;r<16;++r)pA1[r]=__builtin_amdgcn_exp2f(pA1[r]);
  WAIT_BAR(0);
  DMA_K(3,0);DMA_V(1,SLOTB);
  ROT();
  kload8(kf,kp0+sl_cur);
  WAIT_BAR(2);
  s16x4 vlo[8],vhi[8]; u32x4 pw0,pw1,pw2,pw3;
  #define PKW(P,B) cvtpk_s(P[B],P[B+1])
  #define PAF(k) __builtin_bit_cast(bf16x8,pw##k)
  #define VFR(i) (bf16x8){vlo[i][0],vlo[i][1],vlo[i][2],vlo[i][3],vhi[i][0],vhi[i][1],vhi[i][2],vhi[i][3]}
  #define PIN(x) asm volatile("":"+v"(x))
  #define MX3(a,b,c) __builtin_fmaxf(__builtin_fmaxf((a),(b)),(c))
  #define GAPA(MF,A0,A1,A2,A3,W0,W1,PW) do{ MF; sacc+=A0; sacc+=A1; sacc+=A2; sacc+=A3; PIN(sacc); W0; W1; PIN(PW); SBAR(); }while(0)
  #define EX(v) __builtin_amdgcn_exp2f(v)
  #define GAPB(MF,X,B) do{ MF; X[B]=EX(X[B]); X[B+1]=EX(X[B+1]); X[B+2]=EX(X[B+2]); X[B+3]=EX(X[B+3]); PIN(X); SBAR(); }while(0)
  #define VRD(i) do{ vlo[i]=vtr(vp_+(((i)>>2)*4096+((i)&3)*1024)); vhi[i]=vtr(vp_+(((i)>>2)*4096+((i)&3)*1024+512)); }while(0)
  #define KRD(G,j) do{ if(G){ kload2(kf,kp0+sl_next,j); SBAR(); } }while(0)
  #define STEP(C0,C1,P0,P1,t,GK,GV,GL) do{ SBAR(); \
    const lds_cptr vp_=vp0+sl_prev; \
    VRD(0); SBAR(); float sacc=(P0[0]+P0[1]); \
    GAPA(C0=__builtin_amdgcn_mfma_f32_32x32x16_bf16(kf[0],qr[0],negm,0,0,0), P0[2],P0[3],P0[4],P0[5],     pw0[0]=PKW(P0,0), pw0[1]=PKW(P0,2), pw0); \
    VRD(4); SBAR(); GAPA(C1=__builtin_amdgcn_mfma_f32_32x32x16_bf16(kf[1],qr[0],negm,0,0,0), P0[6],P0[7],P0[8],P0[9],     pw0[2]=PKW(P0,4), pw0[3]=PKW(P0,6), pw0); \
    VRD(1); SBAR(); GAPA(C0=__builtin_amdgcn_mfma_f32_32x32x16_bf16(kf[2],qr[1],C0,0,0,0),   P0[10],P0[11],P0[12],P0[13], pw1[0]=PKW(P0,8), pw1[1]=PKW(P0,10), pw1); \
    VRD(5); SBAR(); GAPA(C1=__builtin_amdgcn_mfma_f32_32x32x16_bf16(kf[3],qr[1],C1,0,0,0),   P0[14],P0[15],P1[0],P1[1],   pw1[2]=PKW(P0,12),pw1[3]=PKW(P0,14), pw1); \
    VRD(2); SBAR(); GAPA(C0=__builtin_amdgcn_mfma_f32_32x32x16_bf16(kf[4],qr[2],C0,0,0,0),   P1[2],P1[3],P1[4],P1[5],     pw2[0]=PKW(P1,0), pw2[1]=PKW(P1,2), pw2); \
    VRD(6); SBAR(); GAPA(C1=__builtin_amdgcn_mfma_f32_32x32x16_bf16(kf[5],qr[2],C1,0,0,0),   P1[6],P1[7],P1[8],P1[9],     pw2[2]=PKW(P1,4), pw2[3]=PKW(P1,6), pw2); \
    VRD(3); SBAR(); GAPA(C0=__builtin_amdgcn_mfma_f32_32x32x16_bf16(kf[6],qr[3],C0,0,0,0),   P1[10],P1[11],P1[12],P1[13], pw3[0]=PKW(P1,8), pw3[1]=PKW(P1,10), pw3); \
    VRD(7); SBAR(); GAPA(C1=__builtin_amdgcn_mfma_f32_32x32x16_bf16(kf[7],qr[3],C1,0,0,0),   P1[14],P1[15],0.f,0.f,       pw3[2]=PKW(P1,12),pw3[3]=PKW(P1,14), pw3); \
    l_reg+=sacc; \
    if(GK){DMA_K((t)+3,sl_cur);} if(GV){DMA_V((t)+1,sl_next);} \
    CMASK(C0,C1,t); \
    { float a=MX3(C0[0],C0[1],C1[0]),b=MX3(C0[2],C0[3],C1[1]); a=MX3(a,C1[2],C1[3]); \
      _Pragma("unroll") for(int r=4;r<16;r+=4){a=MX3(a,C0[r],C0[r+1]);b=MX3(b,C0[r+2],C0[r+3]);a=MX3(a,C1[r],C1[r+1]);b=MX3(b,C1[r+2],C1[r+3]);} \
      float rm=__builtin_fmaxf(a,b); { auto rr=__builtin_amdgcn_permlane32_swap(__float_as_uint(rm),__float_as_uint(rm),false,false); rm=__builtin_fmaxf(__uint_as_float(rr[0]),__uint_as_float(rr[1])); } \
      resc=false; \
      if(__builtin_expect(__any(rm>(float)THRL),0)){ const float dl=__builtin_fmaxf(rm,0.f); mhat+=dl; \
        _Pragma("unroll") for(int r=0;r<16;++r){C0[r]-=dl;C1[r]-=dl;} \
        _Pragma("unroll") for(int r=0;r<16;++r)negm[r]=-mhat; asm volatile("":"+v"(negm)); \
        const float f=__builtin_amdgcn_exp2f(-dl); l_reg*=f; if(hi==0)wsf[r32]=f; resc=true; } } \
    SBAR(); \
    GAPB(o[0]=__builtin_amdgcn_mfma_f32_32x32x16_bf16(PAF(0),VFR(0),o[0],0,0,0), C0,0); \
    GAPB(o[1]=__builtin_amdgcn_mfma_f32_32x32x16_bf16(PAF(0),VFR(4),o[1],0,0,0), C0,4); \
    KRD(GL,0); GAPB(o[0]=__builtin_amdgcn_mfma_f32_32x32x16_bf16(PAF(1),VFR(1),o[0],0,0,0), C0,8); \
    KRD(GL,1); GAPB(o[1]=__builtin_amdgcn_mfma_f32_32x32x16_bf16(PAF(1),VFR(5),o[1],0,0,0), C0,12); \
    KRD(GL,2); GAPB(o[0]=__builtin_amdgcn_mfma_f32_32x32x16_bf16(PAF(2),VFR(2),o[0],0,0,0), C1,0); \
    KRD(GL,3); GAPB(o[1]=__builtin_amdgcn_mfma_f32_32x32x16_bf16(PAF(2),VFR(6),o[1],0,0,0), C1,4); \
    GAPB(o[0]=__builtin_amdgcn_mfma_f32_32x32x16_bf16(PAF(3),VFR(3),o[0],0,0,0), C1,8); \
    GAPB(o[1]=__builtin_amdgcn_mfma_f32_32x32x16_bf16(PAF(3),VFR(7),o[1],0,0,0), C1,12); \
    }while(0)
  int t=1;
  #undef CMASK
  #define CMASK(P0,P1,t) do{}while(0)
  for(;t+5<NT;t+=2){
    STEP(pB0,pB1,pA0,pA1,t,true,true,true);     WAIT_BAR(2); RESC(); ROT();
    STEP(pA0,pA1,pB0,pB1,t+1,true,true,true);   WAIT_BAR(2); RESC(); ROT();
  }
  #undef CMASK
  #define CMASK(P0,P1,t) do{}while(0)
  #define ENDW(tt) do{ if((tt)+3<NT){WAIT_BAR(2);} else if((tt)+2<NT){WAIT_BAR(1);} else {WAIT_BAR(0);} }while(0)
  for(;t+1<NT;t+=2){
    STEP(pB0,pB1,pA0,pA1,t,(t+3<NT),(t+1<NT),(t+1<NT));       ENDW(t);   RESC(); ROT();
    STEP(pA0,pA1,pB0,pB1,t+1,(t+4<NT),(t+2<NT),(t+2<NT));     ENDW(t+1); RESC(); ROT();
  }
  STEP(pB0,pB1,pA0,pA1,NT-1,false,false,false); RESC();
  { float sacc=pB0[0]+pB0[1]; _Pragma("unroll") for(int r=2;r<16;++r)sacc+=pB0[r]; _Pragma("unroll") for(int r=0;r<16;++r)sacc+=pB1[r]; l_reg+=sacc;
    pw0=(u32x4){PKW(pB0,0),PKW(pB0,2),PKW(pB0,4),PKW(pB0,6)};pw1=(u32x4){PKW(pB0,8),PKW(pB0,10),PKW(pB0,12),PKW(pB0,14)};pw2=(u32x4){PKW(pB1,0),PKW(pB1,2),PKW(pB1,4),PKW(pB1,6)};pw3=(u32x4){PKW(pB1,8),PKW(pB1,10),PKW(pB1,12),PKW(pB1,14)};
    SBAR(); pv(o,vb0+sl_cur,PAF(0),PAF(1),PAF(2),PAF(3)); }
  #undef PKW
  #undef PAF
  #undef VFR
  #undef PIN
  #undef MX3
  #undef GAPA
  #undef GAPB
  #undef EX
  #undef VRD
  #undef KRD
  #undef STEP
  #undef ENDW
  {auto rr=__builtin_amdgcn_permlane32_swap(__float_as_uint(l_reg),__float_as_uint(l_reg),false,false);l_reg=__uint_as_float(rr[0])+__uint_as_float(rr[1]);}
  if(hi==0)wsf[32+r32]=l_reg;asm volatile("s_waitcnt lgkmcnt(0)":::"memory");
  float rli[16];
  #pragma unroll
  for(int r=0;r<16;++r)rli[r]=__builtin_amdgcn_rcpf(wsf[32+crow(r,hi)]);
  bf16*Ow=O+(long)(wid*QBLK)*OP;
  { bf16*stg=(bf16*)(shm+LDS_OST)+wid*2048;
    #pragma unroll
    for(int r=0;r<16;++r){const int orow=crow(r,hi);
      #pragma unroll
      for(int d0=0;d0<2;++d0)stg[orow*64+d0*32+r32]=__float2bfloat16(o[d0][r]*rli[r]);}
    asm volatile("s_waitcnt lgkmcnt(0)":::"memory");
    #pragma unroll
    for(int i=0;i<4;++i){const int row=i*8+(lane>>3),ch=lane&7; const u32x4 v=*(const u32x4*)(stg+row*64+ch*8); ATTN_STORE16(Ow+(long)row*OP+ch*8,v);} }
  asm volatile("s_waitcnt lgkmcnt(0)\n\ts_barrier":::"memory");
  #undef DMA_K
  #undef DMA_V
  #undef CMASK
  #undef START
  #undef RESC
  #undef ROT
}
#undef SBAR
#undef WAIT_BAR
}
namespace ml {
constexpr int QS = 0, KS = QS + 128 * 144, VT = KS + 128 * 144, KT = VT + 80 * 272, SP = KT + 64 * 272, CB = SP + 128 * 272, GA = CB + 80 * 144, GSET = 6 * 512, END = GA + 2 * GSET;
static_assert(END <= 131072, "mlstm lds");
__device__ __forceinline__ float logsig(float x) { return fminf(x, 0.f) - __logf(1.0f + __expf(-fabsf(x))); }
#define MFMA16(a, b, c) __builtin_amdgcn_mfma_f32_16x16x32_bf16(a, b, c, 0, 0, 0)
#define ML_BAR() do { asm volatile("s_waitcnt lgkmcnt(0)" ::: "memory"); __builtin_amdgcn_s_barrier(); asm volatile("" ::: "memory"); } while (0)
#define ML_SCAN(SET, G0, G1, G2, G3) do { \
                LAS float* a_w = (LAS float*)(lds + GA + (SET) * GSET); \
                const float li0 = (G0), lf0 = logsig(G1), li1 = (G2), lf1 = logsig(G3); \
                const float ps = lf0 + lf1; float inc = ps; \
                _Pragma("unroll") for (int o = 1; o < 64; o <<= 1) { const float t = __shfl_up(inc, o); if (lane >= o) inc += t; } \
                const float b0 = (inc - ps) + lf0, b1 = b0 + lf1; \
                const float a0 = li0 - b0, a1 = li1 - b1; \
                float incm = fmaxf(a0, a1); \
                _Pragma("unroll") for (int o = 1; o < 64; o <<= 1) { const float t = __shfl_up(incm, o); if (lane >= o) incm = fmaxf(incm, t); } \
                float excm = __shfl_up(incm, 1); if (lane == 0) excm = -INFINITY; \
                const float cm0 = fmaxf(mcar, fmaxf(excm, a0)), cm1 = fmaxf(mcar, incm); \
                const float blast = __shfl(b1, 63), cmlast = __shfl(cm1, 63); \
                a_w[2 * lane] = a0; a_w[2 * lane + 1] = a1; a_w[128 + 2 * lane] = cm0; a_w[128 + 2 * lane + 1] = cm1; \
                a_w[256 + 2 * lane] = __expf(mcar - cm0); a_w[256 + 2 * lane + 1] = __expf(mcar - cm1); \
                a_w[384 + 2 * lane] = __expf(-(b0 + cm0)); a_w[384 + 2 * lane + 1] = __expf(-(b1 + cm1)); \
                a_w[512 + 2 * lane] = __expf(a0 - cmlast); a_w[512 + 2 * lane + 1] = __expf(a1 - cmlast); \
                if (lane == 0) a_w[640] = __expf(mcar - cmlast); \
                mcar = blast + cmlast; } while (0)

template <int VAR> __device__ __forceinline__ void mlstm_item(int b, int head, int dir, const bf16_t* __restrict__ MLB, const float* __restrict__ GT, bf16_t* HSd, LAS unsigned char* lds) {
    const int tid = opaque_tid(), lane = tid & 63, w = __builtin_amdgcn_readfirstlane(tid >> 6), fr = lane & 15, fq = lane >> 4;
    LAS bf16_t* Qs = (LAS bf16_t*)(lds + QS); LAS bf16_t* Ks = (LAS bf16_t*)(lds + KS); LAS bf16_t* Vt = (LAS bf16_t*)(lds + VT);
    LAS bf16_t* Kt = (LAS bf16_t*)(lds + KT); LAS bf16_t* Sp = (LAS bf16_t*)(lds + SP); LAS bf16_t* Cb = (LAS bf16_t*)(lds + CB);
    const int ntk = w & 3, mt0 = 2 * (w >> 2);
    {
        __syncthreads();
        for (int i = tid; i < 80 * 144 / 4; i += 512) ((LAS unsigned*)Cb)[i] = 0u;
        for (int i = tid; i < 16 * 136 / 2; i += 512) ((LAS unsigned*)(Vt + 64 * 136))[i] = (i < 68) ? 0x3f803f80u : 0u;
        f32x4 accN = (f32x4){0.f, 0.f, 0.f, 0.f};
        f32x4 accC[2]; accC[0] = (f32x4){0.f, 0.f, 0.f, 0.f}; accC[1] = accC[0];
        float mcar = 0.f;
        u32x4 pq[2], pk[2], pv[2];
        size_t rowbase_n;
        {
            const int ci = dir ? 1 : 0; rowbase_n = (size_t)NLAT + (size_t)b * TCTX + ci * 128;
#pragma unroll
            for (int j = 0; j < 2; ++j) { const int i = 2 * (tid & 63) + j, ch = tid >> 6; const bf16_t* src = MLB + (rowbase_n + i) * 1024 + head * 64 + ch * 8;
                pq[j] = *(const u32x4*)src; pk[j] = *(const u32x4*)(src + 256); pv[j] = *(const u32x4*)(src + 512); }
        }
        if (w == 0) { const float* ga_ = GT + (rowbase_n + (dir ? 127 - 2 * lane : 2 * lane)) * 16 + head + 8 * dir; const float* gb_ = GT + (rowbase_n + (dir ? 126 - 2 * lane : 2 * lane + 1)) * 16 + head + 8 * dir; const float g0_ = ga_[0], g1_ = ga_[4], g2_ = gb_[0], g3_ = gb_[4]; ML_SCAN(0, g0_, g1_, g2_, g3_); }
        for (int cc = 0; cc < 18; ++cc) {
            const size_t rowbase = rowbase_n;
            LAS float* a_s = (LAS float*)(lds + GA + (cc & 1) * GSET); LAS float* cm_s = a_s + 128; LAS float* wi_s = a_s + 256; LAS float* emt_s = a_s + 384; LAS float* wk_s = a_s + 512; LAS float* sc_s = a_s + 640;
            ML_BAR();
            {
                const int i0 = 2 * (tid & 63), ch = tid >> 6, ipa = dir ? 127 - i0 : i0, ipb = dir ? 126 - i0 : i0 + 1, ipe = dir ? 126 - i0 : i0;
                *(LAS u32x4*)(Qs + ipa * 72 + ch * 8) = pq[0]; *(LAS u32x4*)(Qs + ipb * 72 + ch * 8) = pq[1];
                *(LAS u32x4*)(Ks + ipa * 72 + ch * 8) = pk[0]; *(LAS u32x4*)(Ks + ipb * 72 + ch * 8) = pk[1];
                const unsigned ka[4] = {pk[0].x, pk[0].y, pk[0].z, pk[0].w}, kb[4] = {pk[1].x, pk[1].y, pk[1].z, pk[1].w}, va[4] = {pv[0].x, pv[0].y, pv[0].z, pv[0].w}, vb[4] = {pv[1].x, pv[1].y, pv[1].z, pv[1].w};
                const float wkl = wk_s[ipe], wkh = wk_s[ipe + 1];
#pragma unroll
                for (int e2 = 0; e2 < 4; ++e2) { if (VAR & 8) continue;
                    const unsigned kl0 = dir ? kb[e2] : ka[e2], kh0 = dir ? ka[e2] : kb[e2], vl0 = dir ? vb[e2] : va[e2], vh0 = dir ? va[e2] : vb[e2];
                    *(LAS unsigned*)(Kt + (ch * 8 + 2 * e2) * 136 + ipe) = pk2(bf2f(kl0 & 0xffffu) * wkl, bf2f(kh0 & 0xffffu) * wkh);
                    *(LAS unsigned*)(Kt + (ch * 8 + 2 * e2 + 1) * 136 + ipe) = pk2(bf2f(kl0 >> 16) * wkl, bf2f(kh0 >> 16) * wkh);
                    *(LAS unsigned*)(Vt + (ch * 8 + 2 * e2) * 136 + ipe) = (vl0 & 0xffffu) | (vh0 << 16);
                    *(LAS unsigned*)(Vt + (ch * 8 + 2 * e2 + 1) * 136 + ipe) = (vl0 >> 16) | (vh0 & 0xffff0000u); }
            }
            if (cc > 0) {
#pragma unroll
                for (int i = 0; i < 2; ++i)
#pragma unroll
                    for (int j = 0; j < 4; ++j) Cb[(16 * (mt0 + i) + 4 * fq + j) * 72 + 16 * ntk + fr] = (bf16_t)f2bf_hw(accC[i][j]);
                if (w < 4 && fq == 0) Cb[64 * 72 + 16 * w + fr] = (bf16_t)f2bf_hw(accN[0]);
            }
            if (cc + 1 < 18) {
                const int cn = cc + 1;
                if (cn < 2) { const int ci = dir ? 1 - cn : cn; rowbase_n = (size_t)NLAT + (size_t)b * TCTX + ci * 128; }
                else { const int ci = dir ? 17 - cn : cn - 2; rowbase_n = (size_t)b * TLAT + ci * 128; }
#pragma unroll
                for (int j = 0; j < 2; ++j) { const int i = 2 * (tid & 63) + j, ch = tid >> 6; const bf16_t* src = MLB + (rowbase_n + i) * 1024 + head * 64 + ch * 8;
                    pq[j] = *(const u32x4*)src; pk[j] = *(const u32x4*)(src + 256); pv[j] = *(const u32x4*)(src + 512); }
            }
            ML_BAR();
            if (!(VAR & 1)) {
            bf16x8 Qa[2];
            Qa[0] = *(const LAS bf16x8*)(Qs + (16 * w + fr) * 72 + 8 * fq); Qa[1] = *(const LAS bf16x8*)(Qs + (16 * w + fr) * 72 + 32 + 8 * fq);
            float cmt[4], rs[4];
#pragma unroll
            for (int j = 0; j < 4; ++j) { cmt[j] = cm_s[16 * w + 4 * fq + j]; rs[j] = 0.f; }
            for (int st = 0; st <= w; ++st) {
                const bf16x8 Kb0 = *(const LAS bf16x8*)(Ks + (16 * st + fr) * 72 + 8 * fq), Kb1 = *(const LAS bf16x8*)(Ks + (16 * st + fr) * 72 + 32 + 8 * fq);
                f32x4 S = (f32x4){0.f, 0.f, 0.f, 0.f};
                S = MFMA16(Qa[0], Kb0, S); S = MFMA16(Qa[1], Kb1, S);
                const float as = a_s[16 * st + fr];
#pragma unroll
                for (int j = 0; j < 4; ++j) { const bool ok = (st < w) || (fr <= 4 * fq + j); const float wgt = ok ? __expf(as - cmt[j]) : 0.f; const float v = S[j] * wgt;
                    rs[j] += v; Sp[(16 * w + 4 * fq + j) * 136 + 16 * st + fr] = (bf16_t)f2bf_hw(v); }
            }
            if ((w & 1) == 0) {
#pragma unroll
                for (int j = 0; j < 4; ++j) Sp[(16 * w + 4 * fq + j) * 136 + 16 * (w + 1) + fr] = (bf16_t)0;
            }
#pragma unroll
            for (int j = 0; j < 4; ++j) { rs[j] += __shfl_xor(rs[j], 1); rs[j] += __shfl_xor(rs[j], 2); rs[j] += __shfl_xor(rs[j], 4); rs[j] += __shfl_xor(rs[j], 8); }
            f32x4 hi_[4], hc[5];
#pragma unroll
            for (int nt = 0; nt < 4; ++nt) hi_[nt] = (f32x4){0.f, 0.f, 0.f, 0.f};
#pragma unroll
            for (int nt = 0; nt < 5; ++nt) hc[nt] = (f32x4){0.f, 0.f, 0.f, 0.f};
            for (int ks = 0; ks <= (w >> 1); ++ks) {
                const bf16x8 A = *(const LAS bf16x8*)(Sp + (16 * w + fr) * 136 + 32 * ks + 8 * fq);
#pragma unroll
                for (int nt = 0; nt < 4; ++nt) { const bf16x8 B = *(const LAS bf16x8*)(Vt + (16 * nt + fr) * 136 + 32 * ks + 8 * fq); hi_[nt] = MFMA16(A, B, hi_[nt]); }
            }
#pragma unroll
            for (int ks = 0; ks < 2; ++ks)
#pragma unroll
                for (int nt = 0; nt < 5; ++nt) { const bf16x8 B = *(const LAS bf16x8*)(Cb + (16 * nt + fr) * 72 + 32 * ks + 8 * fq); hc[nt] = MFMA16(Qa[ks], B, hc[nt]); }
            float hv[4][4];
#pragma unroll
            for (int j = 0; j < 4; ++j) {
                const int tl = 16 * w + 4 * fq + j;
                const float wi = wi_s[tl], em = emt_s[tl];
                const float qn = __shfl(hc[4][j], lane & 48);
                const float den = wi * qn + rs[j];
                const float inv = 1.0f / fmaxf(fabsf(den), em);
#pragma unroll
                for (int nt = 0; nt < 4; ++nt) hv[nt][j] = (wi * hc[nt][j] + hi_[nt][j]) * inv;
            }
#pragma unroll
            for (int j = 0; j < 4; ++j) { const int tl = 16 * w + 4 * fq + j; const size_t grow = rowbase + (dir ? 127 - tl : tl);
#pragma unroll
                for (int nt = 0; nt < 4; ++nt) if (!(VAR & 4)) HSd[grow * 256 + head * 64 + 16 * nt + fr] = (bf16_t)f2bf_hw(hv[nt][j]); }
            }
            if (!(VAR & 2)) {
                const float asc = sc_s[0];
                accC[0] = accC[0] * asc; accC[1] = accC[1] * asc; accN = accN * asc;
#pragma unroll
                for (int ks = 0; ks < 4; ++ks) {
                    const bf16x8 Bs = *(const LAS bf16x8*)(Kt + (16 * ntk + fr) * 136 + 32 * ks + 8 * fq);
#pragma unroll
                    for (int i = 0; i < 2; ++i) { const bf16x8 A = *(const LAS bf16x8*)(Vt + (16 * (mt0 + i) + fr) * 136 + 32 * ks + 8 * fq); accC[i] = MFMA16(A, Bs, accC[i]); }
                    if (w < 4) { const bf16x8 A1 = *(const LAS bf16x8*)(Vt + (64 + fr) * 136 + 32 * ks + 8 * fq); accN = MFMA16(A1, Bs, accN); }
                }
            }
            if (w == 0 && cc + 1 < 18) { const float* ga_ = GT + (rowbase_n + (dir ? 127 - 2 * lane : 2 * lane)) * 16 + head + 8 * dir; const float* gb_ = GT + (rowbase_n + (dir ? 126 - 2 * lane : 2 * lane + 1)) * 16 + head + 8 * dir; const float g0_ = ga_[0], g1_ = ga_[4], g2_ = gb_[0], g3_ = gb_[4]; ML_SCAN((cc + 1) & 1, g0_, g1_, g2_, g3_); }
        }
    }
    __syncthreads();
}
__device__ __forceinline__ void mlstm_readout_phase(bool with_ctx, const bf16_t* HS0, const bf16_t* HS1, const bf16_t* __restrict__ MLB, bf16_t* MIX, const float* __restrict__ mlw) {
    const int tid = opaque_tid(), l16 = tid & 15, sub = tid >> 4;
    const int npairs = (with_ctx ? MTOT : NLAT) * 4;
    for (int p = blockIdx.x * 32 + sub; p < npairs; p += gridDim.x * 32) {
        const size_t grow = (size_t)(p >> 2); const int head = p & 3;
        const f32x4 gw = *(const f32x4*)(mlw + head * 64 + 4 * l16);
        const size_t off = grow * 256 + head * 64 + 4 * l16;
        const unsigned long long ha = *(const unsigned long long*)(HS0 + off), hb = *(const unsigned long long*)(HS1 + off);
        const f32x4 h = (f32x4){bf2f((unsigned)ha & 0xffffu) + bf2f((unsigned)hb & 0xffffu), bf2f(((unsigned)ha) >> 16) + bf2f(((unsigned)hb) >> 16),
                                bf2f((unsigned)(ha >> 32) & 0xffffu) + bf2f((unsigned)(hb >> 32) & 0xffffu), bf2f((unsigned)(ha >> 48)) + bf2f((unsigned)(hb >> 48))};
        const unsigned long long mo = *(const unsigned long long*)(MLB + grow * 1024 + 768 + head * 64 + 4 * l16);
        float ss = (h[0] * h[0] + h[1] * h[1]) + (h[2] * h[2] + h[3] * h[3]);
        ss += __shfl_xor(ss, 1); ss += __shfl_xor(ss, 2); ss += __shfl_xor(ss, 4); ss += __shfl_xor(ss, 8);
        const float rstd = rsqrtf(ss * (1.0f / 64.0f) + EPS);
        const unsigned mlo = (unsigned)mo, mhi = (unsigned)(mo >> 32);
        const float y0 = h[0] * rstd * gw[0] * sigmoid_f(bf2f(mlo & 0xffffu)), y1 = h[1] * rstd * gw[1] * sigmoid_f(bf2f(mlo >> 16));
        const float y2 = h[2] * rstd * gw[2] * sigmoid_f(bf2f(mhi & 0xffffu)), y3 = h[3] * rstd * gw[3] * sigmoid_f(bf2f(mhi >> 16));
        *(unsigned long long*)(MIX + grow * 1024 + 512 + head * 64 + 4 * l16) = (unsigned long long)pk2(y0, y1) | ((unsigned long long)pk2(y2, y3) << 32);
    }
}
#undef MFMA16
#undef ML_BAR
#undef ML_SCAN
}

__device__ __forceinline__ void pool_item(int u, const bf16_t* __restrict__ PZ, bf16_t* MIX, LAS unsigned char* lds) {
    const int tid = opaque_tid();
    const int r0 = u * 128;
    const int seq0 = (r0 < NLAT) ? (r0 / TLAT) * TLAT : NLAT + ((r0 - NLAT) / TCTX) * TCTX;
    const int len = (r0 < NLAT) ? TLAT : TCTX;
    const int tb = r0 - seq0;
    LAS u32x4* tile = (LAS u32x4*)lds;
#pragma unroll
    for (int q = 0; q < 9; ++q) { const int e = tid + 512 * q, row = e >> 5, ch = e & 31, t = tb - 8 + row;
        u32x4 v = (u32x4){0u, 0u, 0u, 0u};
        if (t >= 0 && t < len) v = *(const u32x4*)(PZ + (size_t)(seq0 + t) * 256 + ch * 8);
        tile[e] = v; }
    __syncthreads();
    const int ch = tid & 31, run = tid >> 5, half = 1 << (ch >> 3);
    float s[8];
#pragma unroll
    for (int e = 0; e < 8; ++e) s[e] = 0.f;
#define POOL_ACC(ROW, SGN) do { const u32x4 v_ = tile[(ROW) * 32 + ch]; \
        s[0] += (SGN) * bf2f(v_.x & 0xffffu); s[1] += (SGN) * bf2f(v_.x >> 16); s[2] += (SGN) * bf2f(v_.y & 0xffffu); s[3] += (SGN) * bf2f(v_.y >> 16); \
        s[4] += (SGN) * bf2f(v_.z & 0xffffu); s[5] += (SGN) * bf2f(v_.z >> 16); s[6] += (SGN) * bf2f(v_.w & 0xffffu); s[7] += (SGN) * bf2f(v_.w >> 16); } while (0)
    const int tl0 = run * 8;
    for (int k = -half; k < half; ++k) POOL_ACC(tl0 + 8 + k, 1.0f);
#pragma unroll
    for (int i = 0; i < 8; ++i) {
        const int tl = tl0 + i, t = tb + tl;
        if (i > 0) { POOL_ACC(tl + 8 + half - 1, 1.0f); POOL_ACC(tl + 8 - half - 1, -1.0f); }
        const int lo = max(t - half, 0), hi = min(t + half, len);
        const float inv = 1.0f / (float)(hi - lo);
        const u32x4 z = tile[(tl + 8) * 32 + ch];
        u32x4 o;
        o.x = pk2(s[0] * inv - bf2f(z.x & 0xffffu), s[1] * inv - bf2f(z.x >> 16)); o.y = pk2(s[2] * inv - bf2f(z.y & 0xffffu), s[3] * inv - bf2f(z.y >> 16));
        o.z = pk2(s[4] * inv - bf2f(z.z & 0xffffu), s[5] * inv - bf2f(z.z >> 16)); o.w = pk2(s[6] * inv - bf2f(z.w & 0xffffu), s[7] * inv - bf2f(z.w >> 16));
        *(u32x4*)(MIX + (size_t)(r0 + tl) * 1024 + 768 + ch * 8) = o;
    }
#undef POOL_ACC
    __syncthreads();
}
#define XB_TMO      128
#define XB_XCNT(j)  (256  + 64 * (j))
#define XB_XSUB(j)  (1280 + 64 * (j))
#define XB_XGEN(j)  (2304 + 64 * (j))
#define XB_TOP      3328
#define XB_TOPGEN   3392
#define XCD_BAR_WORDS 3456
#define XB_SPIN_CAP (1u << 18)

__device__ __forceinline__ unsigned xb_ld(unsigned* p)              { return __hip_atomic_load(p, __ATOMIC_RELAXED, __HIP_MEMORY_SCOPE_AGENT); }
__device__ __forceinline__ unsigned xb_add(unsigned* p, unsigned v) { return __hip_atomic_fetch_add(p, v, __ATOMIC_RELAXED, __HIP_MEMORY_SCOPE_AGENT); }
__device__ __forceinline__ unsigned xb_xcc_id() { return (unsigned)__builtin_amdgcn_s_getreg((3 << 11) | 20) & 0xFu; }
#define XB_SPIN(cond, bar) do { unsigned _sp = 0; while (cond) { __builtin_amdgcn_s_sleep(1); \
    if ((++_sp & 255u) == 0u) { if (xb_ld(&(bar)[XB_TMO])) break; if (_sp > XB_SPIN_CAP) { atomicAdd(&(bar)[XB_TMO], 1u); break; } } } } while (0)

struct XcdBarrier {
    unsigned* bar; unsigned x;
    volatile LAS unsigned* st;
};

__device__ __forceinline__ XcdBarrier xcd_barrier_post(unsigned* bar, volatile LAS unsigned* st) {
    XcdBarrier b; b.bar = bar; b.x = xb_xcc_id(); b.st = st;
    if (threadIdx.x == 0) (void)xb_add(&bar[XB_XCNT(b.x)], 1u);
    return b;
}
__device__ __forceinline__ void xcd_barrier_complete(unsigned* bar, unsigned x, unsigned& nloc, unsigned& nx) {
    const unsigned G = gridDim.x * gridDim.y * gridDim.z;
    unsigned sum, cnt, mine, sp = 0u;
    for (;;) {
        sum = 0u; cnt = 0u; mine = 0u;
#pragma unroll
        for (unsigned j = 0; j < 16; ++j) { const unsigned c = xb_ld(&bar[XB_XCNT(j)]); sum += c; cnt += (c > 0u) ? 1u : 0u; mine = (j == x) ? c : mine; }
        if (sum == G) break;
        __builtin_amdgcn_s_sleep(1);
        if ((++sp & 255u) == 0u) { if (xb_ld(&bar[XB_TMO])) break; if (sp > XB_SPIN_CAP) { atomicAdd(&bar[XB_TMO], 1u); break; } }
    }
    nloc = mine > 0u ? mine : 1u; nx = cnt > 0u ? cnt : 1u;
}

__device__ __forceinline__ void xcd_barrier(const XcdBarrier& b) {
    asm volatile("s_waitcnt vmcnt(0)" ::: "memory");
    __syncthreads();
    if (threadIdx.x == 0) {
        unsigned* bar = b.bar;
        __builtin_amdgcn_s_waitcnt(0);
        unsigned nloc = b.st[0], nx = b.st[1];
        if (nloc == 0u) { xcd_barrier_complete(bar, b.x, nloc, nx); b.st[0] = nloc; b.st[1] = nx; }
        const unsigned old = xb_add(&bar[XB_XSUB(b.x)], 1u);
        const unsigned gen = old / nloc;
        if (old + 1u == (gen + 1u) * nloc) {
            __builtin_amdgcn_fence(__ATOMIC_RELEASE, "agent");
            asm volatile("s_waitcnt vmcnt(0)" ::: "memory");
            const unsigned og = xb_add(&bar[XB_TOP], 1u);
            const unsigned tg = og / nx;
            if (og + 1u == (tg + 1u) * nx) xb_add(&bar[XB_TOPGEN], 1u);
            else XB_SPIN(xb_ld(&bar[XB_TOPGEN]) == tg, bar);
            __builtin_amdgcn_fence(__ATOMIC_ACQUIRE, "agent");
            xb_add(&bar[XB_XGEN(b.x)], 1u);
            asm volatile("s_waitcnt vmcnt(0)" ::: "memory");
        } else {
            XB_SPIN(xb_ld(&bar[XB_XGEN(b.x)]) == gen, bar);
            __builtin_amdgcn_fence(__ATOMIC_ACQUIRE, "agent");
            asm volatile("s_waitcnt vmcnt(0)" ::: "memory");
        }
    }
    __syncthreads();
}
struct Args { const float* in[20]; float* out; unsigned char* ws; };
enum { I_X = 0, I_C, I_CTX, I_CCTX, I_WADA, I_BADA, I_NMIX, I_WIN, I_BG, I_QN, I_KN, I_MLN, I_PW, I_PS, I_WOUT, I_NFFN, I_WG, I_WU, I_WD, I_FN };
constexpr int LDS_BYTES = 147456;
#ifndef REP_N1
#define REP_N1 1
#endif
#ifndef REP_G1
#define REP_G1 1
#endif
#ifndef REP_MIX
#define REP_MIX 1
#endif
#ifndef REP_N2
#define REP_N2 1
#endif
#ifndef REP_G3
#define REP_G3 1
#endif
#ifndef REP_PRO
#define REP_PRO 1
#endif
#ifndef ML_DUP
#define ML_DUP 1
#endif
#ifndef AL_DUP
#define AL_DUP 1
#endif
#ifndef MIXREP_MASK
#define MIXREP_MASK 15
#endif
#ifndef ML_VAR
#define ML_VAR 0
#endif
#ifndef PRO_MASK
#define PRO_MASK 7
#endif
#ifndef REP_SYNC
#define REP_SYNC 1
#endif

__device__ __forceinline__ void tr_item(const float* colp, size_t ld, int K, bf16_t* WT, int r0, int k0, LAS float* scr, int lane) {
    float tv[32];
#pragma unroll
    for (int i = 0; i < 32; ++i) { const int kk = 2 * i + (lane >> 5); tv[i] = colp ? colp[(size_t)(k0 + kk) * ld] : 0.f; }
#pragma unroll
    for (int i = 0; i < 32; ++i) { const int kk = 2 * i + (lane >> 5); scr[kk * 33 + (lane & 31)] = tv[i]; }
    asm volatile("s_waitcnt lgkmcnt(0)" ::: "memory");
    const int c = lane & 7;
#pragma unroll
    for (int j = 0; j < 4; ++j) { const int n = (lane >> 3) + 8 * j; const LAS float* s = scr + (8 * c) * 33 + n;
        u32x4 o; o.x = pk2(s[0 * 33], s[1 * 33]); o.y = pk2(s[2 * 33], s[3 * 33]); o.z = pk2(s[4 * 33], s[5 * 33]); o.w = pk2(s[6 * 33], s[7 * 33]);
        *(u32x4*)(WT + (size_t)(r0 + n) * K + k0 + 8 * c) = o; }
    asm volatile("s_waitcnt lgkmcnt(0)" ::: "memory");
}
__device__ __forceinline__ void tr_item_pool(const float* win, const float* pw, const float* ps, bf16_t* WT, int r0, int k0, LAS float* scr, int lane) {
    const int p = (r0 - 1792) + (lane & 31), oc = 64 * ((p >> 5) & 3) + 32 * (p >> 7) + (p & 31), g = oc >> 6, o = oc & 63;
    const float scl = ps[oc];
    const float* pwc = pw + (size_t)g * 4096 + o;
    float pwr[64];
#pragma unroll
    for (int q = 0; q < 64; ++q) pwr[q] = pwc[q * 64];
    for (int i = 0; i < 8; ++i) { const int kk = 2 * i + (lane >> 5); const float* wr = win + (size_t)(k0 + kk) * INW + 1808 + 64 * g;
        f32x4 w4[16];
#pragma unroll
        for (int q = 0; q < 16; ++q) w4[q] = *(const f32x4*)(wr + 4 * q);
        float s0 = 0.f, s1 = 0.f;
#pragma unroll
        for (int q = 0; q < 16; q += 2) { s0 += (w4[q][0] * pwr[4 * q] + w4[q][1] * pwr[4 * q + 1]) + (w4[q][2] * pwr[4 * q + 2] + w4[q][3] * pwr[4 * q + 3]);
            s1 += (w4[q + 1][0] * pwr[4 * q + 4] + w4[q + 1][1] * pwr[4 * q + 5]) + (w4[q + 1][2] * pwr[4 * q + 6] + w4[q + 1][3] * pwr[4 * q + 7]); }
        scr[kk * 33 + (lane & 31)] = (s0 + s1) * scl; }
    asm volatile("s_waitcnt lgkmcnt(0)" ::: "memory");
    { const int n = lane >> 1, c = lane & 1; const LAS float* s = scr + (8 * c) * 33 + n;
        u32x4 o4; o4.x = pk2(s[0 * 33], s[1 * 33]); o4.y = pk2(s[2 * 33], s[3 * 33]); o4.z = pk2(s[4 * 33], s[5 * 33]); o4.w = pk2(s[6 * 33], s[7 * 33]);
        *(u32x4*)(WT + (size_t)(r0 + n) * 1024 + k0 + 8 * c) = o4; }
    asm volatile("s_waitcnt lgkmcnt(0)" ::: "memory");
}

__device__ __forceinline__ void prologue(const Args& a, LAS unsigned char* lds, const int pmask) {
    const int tid = threadIdx.x, lane = tid & 63, wave = tid >> 6;
    unsigned char* ws = a.ws;
    if (blockIdx.x == 0) {
        for (int e = tid; e < 1024; e += 512) { const int pos = e >> 4, f = e & 15;
            const float invf = exp2f(-(float)(2 * f) * (13.287712379549449f / 32.0f));
            float ang = (float)pos * invf; ang -= 6.283185307179586f * rintf(ang * 0.15915494309189535f);
            float* cs = (float*)(ws + WS_ROPE) + e * 2; cs[0] = __cosf(ang); cs[1] = __sinf(ang); }
    }
    LAS float* scs = (LAS float*)lds;
    LAS float* red = (LAS float*)(lds + 17 * 4096);
    for (int e = tid; e < 17 * 1024; e += 512) { const float v = (e < 16 * 1024) ? a.in[I_C][e] : a.in[I_CCTX][e - 16 * 1024]; scs[e] = silu_f(v); }
    __syncthreads();
    for (int it = blockIdx.x; it < 2 * 192; it += gridDim.x) { if (!(pmask & 1)) break;
        const int l = it / 192, c0 = (it % 192) * 32, col = tid & 31, kp = tid >> 5;
        const float* W = a.in[I_WADA] + ((size_t)l * 1024 + kp * 64) * 6144 + c0 + col;
        float acc[17];
#pragma unroll
        for (int r = 0; r < 17; ++r) acc[r] = 0.f;
#pragma unroll 16
        for (int k4 = 0; k4 < 16; ++k4) { const float w0 = W[(size_t)(4 * k4) * 6144], w1 = W[(size_t)(4 * k4 + 1) * 6144], w2 = W[(size_t)(4 * k4 + 2) * 6144], w3 = W[(size_t)(4 * k4 + 3) * 6144];
#pragma unroll
            for (int r = 0; r < 17; ++r) { const f32x4 s = *(const LAS f32x4*)(scs + r * 1024 + kp * 64 + 4 * k4); acc[r] += (s[0] * w0 + s[1] * w1) + (s[2] * w2 + s[3] * w3); } }
#pragma unroll
        for (int r = 0; r < 17; ++r) red[(kp * 17 + r) * 32 + col] = acc[r];
        __syncthreads();
        for (int e = tid; e < 17 * 32; e += 512) { const int r = e >> 5, cc = e & 31; float s = 0.f;
#pragma unroll
            for (int q = 0; q < 16; ++q) s += red[(q * 17 + r) * 32 + cc];
            ((float*)(ws + WS_MOD))[((size_t)l * 17 + r) * 6144 + c0 + cc] = s + a.in[I_BADA][(size_t)l * 6144 + c0 + cc]; }
        __syncthreads();
    }
    LAS float* scr = (LAS float*)(lds + wave * 8448);
    const int gw = blockIdx.x * 8 + wave, NGW = gridDim.x * 8;
    constexpr int IT_W1 = 64 * 16, IT_WO = 32 * 16, IT_GU = 176 * 16, IT_WD = 32 * 44, IT_L = IT_W1 + IT_WO + IT_GU + IT_WD;
#define TR_DECODE(IT, COLP, LD, KK, WTP, R0, K0) do { const int l_ = (IT) / IT_L; int r_ = (IT) % IT_L; \
        if (r_ < IT_W1) { int rg_ = r_ / 16; if (rg_ >= 56) rg_ += 8; K0 = (r_ % 16) * 64; R0 = rg_ * 32; WTP = (bf16_t*)(ws + WS_W1 + l_ * W1_BYTES); \
            const float* win_ = a.in[I_WIN] + (size_t)l_ * 1024 * INW; const int rr_ = R0 + (lane & 31), pn_ = rr_ >> 8, p_ = rr_ & 255, oc_ = 64 * ((p_ >> 5) & 3) + 32 * (p_ >> 7) + (p_ & 31), cp_ = 256 * pn_ + oc_; \
            COLP = (cp_ < 1792) ? win_ + cp_ : (cp_ >= 2048 && cp_ < 2064) ? win_ + 1792 + (cp_ - 2048) : nullptr; LD = INW; KK = 1024; } \
        else if ((r_ -= IT_W1) < IT_WO) { R0 = (r_ / 16) * 32; K0 = (r_ % 16) * 64; COLP = a.in[I_WOUT] + (size_t)l_ * 1024 * 1024 + R0 + (lane & 31); LD = 1024; KK = 1024; WTP = (bf16_t*)(ws + WS_WO + l_ * WO_BYTES); } \
        else if ((r_ -= IT_WO) < IT_GU) { R0 = (r_ / 16) * 32; K0 = (r_ % 16) * 64; const int rr_ = R0 + (lane & 31), pn_ = rr_ >> 8, p_ = rr_ & 255, hcol_ = 128 * pn_ + (p_ & 127); \
            COLP = ((p_ >> 7) ? a.in[I_WU] : a.in[I_WG]) + (size_t)l_ * 1024 * DFF + hcol_; LD = DFF; KK = 1024; WTP = (bf16_t*)(ws + WS_WGU + l_ * WGU_BYTES); } \
        else { r_ -= IT_GU; R0 = (r_ / 44) * 32; K0 = (r_ % 44) * 64; COLP = a.in[I_WD] + (size_t)l_ * DFF * 1024 + R0 + (lane & 31); LD = 1024; KK = DFF; WTP = (bf16_t*)(ws + WS_WD + l_ * WD_BYTES); } } while (0)
#define TR_LOAD(TV, COLP, LD, K0) do { _Pragma("unroll") for (int i_ = 0; i_ < 32; ++i_) { const int kk_ = 2 * i_ + (lane >> 5); TV[i_] = (COLP) ? (COLP)[(size_t)((K0) + kk_) * (LD)] : 0.f; } } while (0)
    if (pmask & 2) {
        int it = gw;
        const float* colp = nullptr; size_t ld = 0; int KK = 0, r0 = 0, k0 = 0; bf16_t* WT = nullptr;
        float tv[32];
        if (it < 2 * IT_L) { TR_DECODE(it, colp, ld, KK, WT, r0, k0); TR_LOAD(tv, colp, ld, k0); }
        while (it < 2 * IT_L) {
            const int itn = it + NGW;
            const float* colpn = nullptr; size_t ldn = 0; int KKn = 0, r0n = 0, k0n = 0; bf16_t* WTn = nullptr;
            float tn[32];
            if (itn < 2 * IT_L) { TR_DECODE(itn, colpn, ldn, KKn, WTn, r0n, k0n); TR_LOAD(tn, colpn, ldn, k0n); }
#pragma unroll
            for (int i = 0; i < 32; ++i) { const int kk = 2 * i + (lane >> 5); scr[kk * 33 + (lane & 31)] = tv[i]; }
            asm volatile("s_waitcnt lgkmcnt(0)" ::: "memory");
            { const int c = lane & 7;
#pragma unroll
                for (int j = 0; j < 4; ++j) { const int n = (lane >> 3) + 8 * j; const LAS float* s = scr + (8 * c) * 33 + n;
                    u32x4 o; o.x = pk2(s[0 * 33], s[1 * 33]); o.y = pk2(s[2 * 33], s[3 * 33]); o.z = pk2(s[4 * 33], s[5 * 33]); o.w = pk2(s[6 * 33], s[7 * 33]);
                    *(u32x4*)(WT + (size_t)(r0 + n) * KK + k0 + 8 * c) = o; } }
            asm volatile("s_waitcnt lgkmcnt(0)" ::: "memory");
            it = itn; colp = colpn; ld = ldn; KK = KKn; r0 = r0n; k0 = k0n; WT = WTn;
#pragma unroll
            for (int i = 0; i < 32; ++i) tv[i] = tn[i];
        }
    }
#undef TR_DECODE
#undef TR_LOAD
    if (pmask & 4)
    for (int it = gw; it < 1024; it += NGW) { const int l = it >> 9, rg = (it & 511) >> 6, kg = it & 63;
        tr_item_pool(a.in[I_WIN] + (size_t)l * 1024 * INW, a.in[I_PW] + (size_t)l * 4 * 4096, a.in[I_PS] + l * 256, (bf16_t*)(ws + WS_W1 + l * W1_BYTES), 1792 + rg * 32, kg * 16, scr, lane); }
}

__device__ __forceinline__ void norm_phase(const float* xl, const float* xc, const float* gw, const float* mod  , int sh_off, int sc_off, bf16_t* XN, int nrows) {
    const int tid = opaque_tid(), lane = tid & 63, gwv = blockIdx.x * 8 + (tid >> 6), NGW = gridDim.x * 8;
    const int per = (nrows + NGW - 1) / NGW;
    int cur = -1; f32x4 mul[4], add[4];
    for (int q = 0; q < per; ++q) {
        const int row = gwv * per + q; if (row >= nrows) break;
        const int mr = row < NLAT ? row / TLAT : 16;
        if (mr != cur) { cur = mr; const float* mp = mod + (size_t)mr * 6144;
#pragma unroll
            for (int j = 0; j < 4; ++j) { const f32x4 g = *(const f32x4*)(gw + 4 * lane + 256 * j), s = *(const f32x4*)(mp + sc_off + 4 * lane + 256 * j); mul[j] = g * (s + 1.0f); add[j] = *(const f32x4*)(mp + sh_off + 4 * lane + 256 * j); } }
        const float* xr = row < NLAT ? xl + (size_t)row * 1024 : xc + (size_t)(row - NLAT) * 1024;
        f32x4 v[4]; float ss = 0.f;
#pragma unroll
        for (int j = 0; j < 4; ++j) { v[j] = *(const f32x4*)(xr + 4 * lane + 256 * j); ss += (v[j][0] * v[j][0] + v[j][1] * v[j][1]) + (v[j][2] * v[j][2] + v[j][3] * v[j][3]); }
        const float rstd = rsqrtf(wave_sum(ss) * (1.0f / 1024.0f) + EPS);
        unsigned long long* o8 = (unsigned long long*)(XN + (size_t)row * 1024) + lane;
#pragma unroll
        for (int j = 0; j < 4; ++j) { const f32x4 y = v[j] * rstd * mul[j] + add[j]; o8[64 * j] = (unsigned long long)pk2(y[0], y[1]) | ((unsigned long long)pk2(y[2], y[3]) << 32); }
    }
}
__device__ __forceinline__ void ctx_gates_phase(const float* xc, const float* gw, const float* modc, const float* win, const float* bg, float* GT, LAS unsigned char* lds) {
    const int tid = opaque_tid(), lane = tid & 63, gwv = blockIdx.x * 8 + (tid >> 6), NGW = gridDim.x * 8;
    LAS float* wg = (LAS float*)lds;
    for (int e = tid; e < 4096; e += 512) { const int k = e >> 2, q4 = e & 3; *(LAS f32x4*)(wg + k * 16 + q4 * 4) = *(const f32x4*)(win + (size_t)k * INW + 1792 + q4 * 4); }
    __syncthreads();
    for (int r = gwv; r < NCTX; r += NGW) {
        asm volatile("" ::: "memory");
        const float* xr = xc + (size_t)r * 1024; float h[16]; float ss = 0.f;
#pragma unroll
        for (int q = 0; q < 16; ++q) { h[q] = xr[lane + 64 * q]; ss += h[q] * h[q]; }
        const float rstd = rsqrtf(wave_sum(ss) * (1.0f / 1024.0f) + EPS);
        f32x4 acc[4];
#pragma unroll
        for (int q = 0; q < 4; ++q) acc[q] = (f32x4){0.f, 0.f, 0.f, 0.f};
#pragma unroll
        for (int q = 0; q < 16; ++q) { const int c = lane + 64 * q; const float hv = h[q] * rstd * gw[c] * (modc[1024 + c] + 1.0f) + modc[c];
#pragma unroll
            for (int g4 = 0; g4 < 4; ++g4) acc[g4] += *(const LAS f32x4*)(wg + c * 16 + 4 * g4) * hv; }
        float out = 0.f;
#pragma unroll
        for (int q = 0; q < 4; ++q)
#pragma unroll
            for (int i = 0; i < 4; ++i) { const float v = wave_sum(acc[q][i]); if (lane == 4 * q + i) out = v; }
        if (lane < 16) GT[(size_t)(NLAT + r) * 16 + lane] = out + bg[lane];
    }
    __syncthreads();
}
__device__ __forceinline__ void norm_phase_bf(const bf16_t* xs, const float* gw, const float* mod, int sh_off, int sc_off, bf16_t* XN, int nrows, const float* part = nullptr, int nsplit = 0, const float* pgate = nullptr, const float* cbase = nullptr, bf16_t* xs_w = nullptr) {
    const int tid = opaque_tid(), lane = tid & 63, gwv = blockIdx.x * 8 + (tid >> 6), NGW = gridDim.x * 8;
    const int per = (nrows + NGW - 1) / NGW;
    int cur = -1; f32x4 mul[4], add[4];
    for (int q = 0; q < per; ++q) {
        const int row = gwv * per + q; if (row >= nrows) break;
        const int mr = row < NLAT ? row / TLAT : 16;
        if (mr != cur) { cur = mr; const float* mp = mod + (size_t)mr * 6144;
#pragma unroll
            for (int j = 0; j < 4; ++j) { const int c = 8 * lane + 512 * (j >> 1) + 4 * (j & 1); const f32x4 g = *(const f32x4*)(gw + c), s = *(const f32x4*)(mp + sc_off + c); mul[j] = g * (s + 1.0f); add[j] = *(const f32x4*)(mp + sh_off + c); } }
        const bf16_t* xr = xs + (size_t)row * 1024;
        f32x4 v[4]; float ss = 0.f;
#pragma unroll
        for (int j = 0; j < 2; ++j) { const u32x4 w = *(const u32x4*)(xr + 8 * lane + 512 * j);
            v[2 * j] = (f32x4){bf2f(w.x & 0xffffu), bf2f(w.x >> 16), bf2f(w.y & 0xffffu), bf2f(w.y >> 16)}; v[2 * j + 1] = (f32x4){bf2f(w.z & 0xffffu), bf2f(w.z >> 16), bf2f(w.w & 0xffffu), bf2f(w.w >> 16)}; }
        if (part && row >= NLAT) {
#pragma unroll
            for (int j = 0; j < 4; ++j) { const int c = 8 * lane + 512 * (j >> 1) + 4 * (j & 1); f32x4 s = (f32x4){0.f, 0.f, 0.f, 0.f};
                if (cbase) v[j] = *(const f32x4*)(cbase + (size_t)(row - NLAT) * 1024 + c);
                for (int k = 0; k < nsplit; ++k) s += *(const f32x4*)(part + ((size_t)k * NCTX + (row - NLAT)) * 1024 + c);
                v[j] += *(const f32x4*)(pgate + c) * s; }
            if (xs_w) {
#pragma unroll
                for (int j = 0; j < 2; ++j) { u32x4 o; o.x = pk2(v[2 * j][0], v[2 * j][1]); o.y = pk2(v[2 * j][2], v[2 * j][3]); o.z = pk2(v[2 * j + 1][0], v[2 * j + 1][1]); o.w = pk2(v[2 * j + 1][2], v[2 * j + 1][3]);
                    *(u32x4*)(xs_w + (size_t)row * 1024 + 8 * lane + 512 * j) = o; } } }
#pragma unroll
        for (int j = 0; j < 4; ++j) ss += (v[j][0] * v[j][0] + v[j][1] * v[j][1]) + (v[j][2] * v[j][2] + v[j][3] * v[j][3]);
        const float rstd = rsqrtf(wave_sum(ss) * (1.0f / 1024.0f) + EPS);
#pragma unroll
        for (int j = 0; j < 2; ++j) { const f32x4 y0 = v[2 * j] * rstd * mul[2 * j] + add[2 * j], y1 = v[2 * j + 1] * rstd * mul[2 * j + 1] + add[2 * j + 1];
            u32x4 o; o.x = pk2(y0[0], y0[1]); o.y = pk2(y0[2], y0[3]); o.z = pk2(y1[0], y1[1]); o.w = pk2(y1[2], y1[3]);
            *(u32x4*)(XN + (size_t)row * 1024 + 8 * lane + 512 * j) = o; }
    }
}
__device__ __forceinline__ void final_norm_phase(float* x, const float* gw) {
    const int tid = opaque_tid(), lane = tid & 63, gwv = blockIdx.x * 8 + (tid >> 6), NGW = gridDim.x * 8;
    f32x4 g[4];
#pragma unroll
    for (int j = 0; j < 4; ++j) g[j] = *(const f32x4*)(gw + 4 * lane + 256 * j);
    for (int row = gwv; row < NLAT; row += NGW) {
        float* xr = x + (size_t)row * 1024; f32x4 v[4]; float ss = 0.f;
#pragma unroll
        for (int j = 0; j < 4; ++j) { v[j] = *(const f32x4*)(xr + 4 * lane + 256 * j); ss += (v[j][0] * v[j][0] + v[j][1] * v[j][1]) + (v[j][2] * v[j][2] + v[j][3] * v[j][3]); }
        const float rstd = rsqrtf(wave_sum(ss) * (1.0f / 1024.0f) + EPS);
#pragma unroll
        for (int j = 0; j < 4; ++j) *(f32x4*)(xr + 4 * lane + 256 * j) = v[j] * rstd * g[j];
    }
}

__global__ void __launch_bounds__(512, 2) fwd_megakernel(Args a) {
    extern __shared__ __attribute__((aligned(16))) unsigned char lds_raw[];
    LAS unsigned char* lds = (LAS unsigned char*)lds_raw;
    unsigned char* ws = a.ws;
    const int tid = threadIdx.x;
    float* MOD = (float*)(ws + WS_MOD);
    bf16_t* XN = (bf16_t*)(ws + WS_XN); bf16_t* QB = (bf16_t*)(ws + WS_QB); bf16_t* KB = (bf16_t*)(ws + WS_KB); bf16_t* VB = (bf16_t*)(ws + WS_VB);
    bf16_t* MLB = (bf16_t*)(ws + WS_MLB); bf16_t* PZ = (bf16_t*)(ws + WS_PZ); float* GT = (float*)(ws + WS_GT); bf16_t* HS = (bf16_t*)(ws + WS_HS); bf16_t* HS1 = (bf16_t*)(ws + WS_HS1);
    bf16_t* MIX = (bf16_t*)(ws + WS_MIX); bf16_t* HID = (bf16_t*)(ws + WS_HID); bf16_t* XS = (bf16_t*)(ws + WS_XS);
    unsigned* ctl = (unsigned*)(ws + WS_CTL);
    LAS int* item_s = (LAS int*)(lds + 131072 + 1024);
    volatile LAS unsigned* bst = (volatile LAS unsigned*)(lds + 131072 + 2048);
    if (tid < 4) bst[tid] = 0u;
    __syncthreads();
    XcdBarrier xbar = xcd_barrier_post(ctl + 4096, bst);
#define GSYNC() xcd_barrier(xbar)

    for (int rp = 0; rp < REP_PRO; ++rp) { prologue(a, lds, rp == 0 ? 7 : PRO_MASK);
    GSYNC(); }

    for (int l = 0; l < 2; ++l) {
        const float* xl_in = a.in[I_X];
        const float* xc_in = a.in[I_CTX];
        const float* modl = MOD + (size_t)l * 17 * 6144;
        for (int rp = 0; rp < REP_N1; ++rp) { if (l == 0) norm_phase(xl_in, xc_in, a.in[I_NMIX] + l * 1024, modl, 0, 1024, XN, MTOT); else norm_phase_bf(XS, a.in[I_NMIX] + l * 1024, modl, 0, 1024, XN, MTOT, (const float*)(ws + WS_MIX + 32 * MiB), 2, MOD + (size_t)16 * 6144 + 5120);
        if (l == 0) ctx_gates_phase(xc_in, a.in[I_NMIX], modl + 16 * 6144, a.in[I_WIN], a.in[I_BG], GT, lds);
        for (int rs = 0; rs < REP_SYNC; ++rs) GSYNC(); }
        for (int rp = 0; rp < REP_G1; ++rp) {
            pg8::Gemm g{XN, (const bf16_t*)(ws + WS_W1 + l * W1_BYTES), MTOT, N1, 1024}; pg8::G1Order S; S.init(gridDim.x, (int)blockIdx.x, l == 0);
            pg8::EpiIn E{QB, KB, VB, MLB, PZ, GT, a.in[I_QN] + l * 64, a.in[I_KN] + l * 64, a.in[I_BG] + l * 16, (const float*)(ws + WS_ROPE), attn_body::C2};
            pg8::gemm_phase<pg8::EpiIn, pg8::G1Order, true, true>(lds, g, S, E);
        GSYNC(); }
        for (int rp = 0; rp < REP_MIX; ++rp) {
            const int n_ml = 128 * ML_DUP, n_al = 1024 * AL_DUP, n_ac = (l == 0) ? 128 : 0, n_pool = (l == 0) ? 288 : 256, n_all = n_ml + n_al + n_ac + n_pool;
            for (;;) {
                __syncthreads();
                if (tid == 0) item_s[0] = (int)atomicAdd(ctl + 64 * (l * 4 + rp), 1u);
                __syncthreads();
                int it = item_s[0];
                if (it >= n_all) break;
                const int cmask = (rp == 0) ? 15 : MIXREP_MASK;
                if (it < n_ml) { if (!(cmask & 1)) continue; const int itm = it & 127, mb = itm >> 3, mh = (itm >> 1) & 3, md = itm & 1;
                    if (rp == 0) ml::mlstm_item<0>(mb, mh, md, MLB, GT, md ? HS1 : HS, lds); else ml::mlstm_item<ML_VAR>(mb, mh, md, MLB, GT, md ? HS1 : HS, lds);
                    continue; }
                it -= n_ml;
                if (it < n_al) { if (!(cmask & 2)) continue; const int b = (it >> 6) & 15, h = (it >> 3) & 7, qb = it & 7;
                    attn_body::attn_unit<8>((const attn_body::bf16*)(QB + ((size_t)b * TLAT + qb * 256) * 512 + h * 64), (const attn_body::bf16*)(KB + (size_t)b * TKV * 128 + (h >> 2) * 64),
                                            (const attn_body::bf16*)(VB + (size_t)b * TKV * 128 + (h >> 2) * 64), (attn_body::bf16*)(MIX + ((size_t)b * TLAT + qb * 256) * 1024 + h * 64), TKV / 64, (char*)lds_raw);
                    continue; }
                it -= n_al;
                if (it < n_ac) { if (!(cmask & 4)) continue; const int b = it >> 3, h = it & 7;
                    attn_body::attn_unit<8>((const attn_body::bf16*)(QB + ((size_t)NLAT + b * TCTX) * 512 + h * 64), (const attn_body::bf16*)(KB + ((size_t)b * TKV + TLAT) * 128 + (h >> 2) * 64),
                                            (const attn_body::bf16*)(VB + ((size_t)b * TKV + TLAT) * 128 + (h >> 2) * 64), (attn_body::bf16*)(MIX + ((size_t)NLAT + b * TCTX) * 1024 + h * 64), TCTX / 64, (char*)lds_raw);
                    continue; }
                it -= n_ac;
                if (cmask & 8) pool_item(it, PZ, MIX, lds);
            }
        GSYNC(); }
        ml::mlstm_readout_phase(l == 0, HS, HS1, MLB, MIX, a.in[I_MLN] + l * 256);
        GSYNC();
        const int Mrows = (l == 0) ? MTOT : NLAT;
        {
            pg8::Gemm g{MIX, (const bf16_t*)(ws + WS_WO + l * WO_BYTES), Mrows, 1024, 1024, 0}; pg8::StaticOrder S; S.init(Mrows, 1024, gridDim.x, (int)blockIdx.x);
            if (l == 0) { pg8::EpiRes2<false, true> E{xl_in, xc_in, XS, nullptr, modl + 2048}; pg8::gemm_phase<pg8::EpiRes2<false, true>, pg8::StaticOrder, true, true>(lds, g, S, E); }
            else { pg8::EpiRes2<true, true> E{nullptr, nullptr, XS, nullptr, modl + 2048}; pg8::gemm_phase<pg8::EpiRes2<true, true>, pg8::StaticOrder, true, true>(lds, g, S, E); }
        }
        GSYNC();
        for (int rp = 0; rp < REP_N2; ++rp) { norm_phase_bf(XS, a.in[I_NFFN] + l * 1024, modl, 3072, 4096, XN, Mrows);
        GSYNC(); }
        for (int rp = 0; rp < REP_G3; ++rp) {
            pg8::Gemm g{XN, (const bf16_t*)(ws + WS_WGU + l * WGU_BYTES), Mrows, NGU, 1024}; pg8::StaticOrder S; S.init(Mrows, NGU, gridDim.x, (int)blockIdx.x);
            pg8::EpiGU E{HID};
            pg8::gemm_phase<pg8::EpiGU, pg8::StaticOrder, true, true>(lds, g, S, E);
        GSYNC(); }
        {
            pg8::Gemm g{HID, (const bf16_t*)(ws + WS_WD + l * WD_BYTES), NLAT, 1024, DFF, 0}; pg8::StaticOrder S; S.init(NLAT, 1024, gridDim.x, (int)blockIdx.x);
            if (l == 0) { pg8::EpiRes2<true, true> E{nullptr, nullptr, XS, nullptr, modl + 5120}; pg8::gemm_phase<pg8::EpiRes2<true, true>, pg8::StaticOrder, true, true>(lds, g, S, E);
                for (int kc = 0; kc < 2; ++kc) { pg8::Gemm gt{HID + kc * (DFF / 2), (const bf16_t*)(ws + WS_WD) + kc * (DFF / 2), MTOT, 1024, DFF / 2, DFF}; pg8::TailOrder T{(int)blockIdx.x, 64 * kc};
                    pg8::EpiPart EP{(float*)(ws + WS_MIX + 32 * MiB) + (size_t)kc * NCTX * 1024};
                    pg8::gemm_phase<pg8::EpiPart, pg8::TailOrder, true, true>(lds, gt, T, EP); } }
            else { pg8::EpiRes2<true, false> E{nullptr, nullptr, XS, a.out, modl + 5120}; pg8::gemm_phase<pg8::EpiRes2<true, false>, pg8::StaticOrder, true, true>(lds, g, S, E); }
        }
        GSYNC();
    }
    final_norm_phase(a.out, a.in[I_FN]);
}

extern "C" void kernel_launch(void* const* d_in, const int* in_sizes, int n_in, void* d_out, int out_size, void* d_ws, size_t ws_size, hipStream_t stream) {
    static int grid_blocks = 0;
    if (grid_blocks == 0) {
        if (n_in != 20 || ws_size < WS_END) { fprintf(stderr, "kernel_launch: unexpected n_in %d / ws_size %zu\n", n_in, ws_size); grid_blocks = -1; return; }
        int dev = 0, cus = 0, per_cu = 0;
        hipGetDevice(&dev);
        hipDeviceGetAttribute(&cus, hipDeviceAttributeMultiprocessorCount, dev);
        if (hipFuncSetAttribute((const void*)fwd_megakernel, hipFuncAttributeMaxDynamicSharedMemorySize, LDS_BYTES) != hipSuccess) { fprintf(stderr, "kernel_launch: hipFuncSetAttribute failed\n"); grid_blocks = -1; return; }
        if (hipOccupancyMaxActiveBlocksPerMultiprocessor(&per_cu, (const void*)fwd_megakernel, 512, LDS_BYTES) != hipSuccess || per_cu < 1) { fprintf(stderr, "kernel_launch: occupancy query failed (%d)\n", per_cu); grid_blocks = -1; return; }
        grid_blocks = cus * per_cu;
    }
    if (grid_blocks < 0) return;
    hipMemsetAsync((char*)d_ws + WS_CTL, 0, 65536, stream);
    Args a{};
    for (int i = 0; i < 20; ++i) a.in[i] = (const float*)d_in[i];
    a.out = (float*)d_out; a.ws = (unsigned char*)d_ws;
    void* args[] = {&a};
    hipError_t e = hipLaunchCooperativeKernel((const void*)fwd_megakernel, dim3(grid_blocks), dim3(512), args, LDS_BYTES, stream);
    if (e != hipSuccess) fprintf(stderr, "cooperative launch failed: %s (grid %d)\n", hipGetErrorString(e), grid_blocks);
}
```

```cpp
#include <hip/hip_runtime.h>
#include <hip/hip_cooperative_groups.h>
#include <hip/hip_bf16.h>
#include <cstdio>
#include <cstdint>
#include <cmath>
namespace cg = cooperative_groups;

constexpr int DMODEL = 1024, NBATCH = 16, TLAT = 2048, TCTX = 256, NLAT = NBATCH * TLAT, NCTX = NBATCH * TCTX, MTOT = NLAT + NCTX;
constexpr int N1 = 2304, DFF = 2816, NGU = 2 * DFF, TKV = TLAT + TCTX, INW = 2064;
constexpr float EPS = 1e-6f;
constexpr size_t MiB = 1u << 20;
constexpr size_t WS_CTL = 0, WS_MOD = 1 * MiB, WS_ROPE = 2 * MiB, WS_W1 = 4 * MiB, WS_WO = 13 * MiB, WS_WGU = 17 * MiB, WS_WD = 39 * MiB,
                 WS_XC = 50 * MiB, WS_XN = 66 * MiB, WS_QB = 138 * MiB, WS_KB = 174 * MiB, WS_VB = 183 * MiB, WS_MLB = 192 * MiB, WS_PZ = 264 * MiB,
                 WS_GT = 282 * MiB, WS_HS = 285 * MiB, WS_MIX = 321 * MiB, WS_HID = 138 * MiB, WS_HS1 = 393 * MiB, WS_XS = 429 * MiB, WS_END = 501 * MiB;
constexpr size_t W1_BYTES = (size_t)N1 * 1024 * 2, WO_BYTES = (size_t)1024 * 1024 * 2, WGU_BYTES = (size_t)NGU * 1024 * 2, WD_BYTES = (size_t)1024 * DFF * 2;

#define LAS __attribute__((address_space(3)))
typedef unsigned short bf16_t;
typedef float f32x4 __attribute__((ext_vector_type(4)));
typedef unsigned u32x4 __attribute__((ext_vector_type(4)));
typedef short bf16x8 __attribute__((ext_vector_type(8)));

__device__ __forceinline__ unsigned f2bf(float f) { unsigned u = __builtin_bit_cast(unsigned, f); return (u + 0x7fffu + ((u >> 16) & 1u)) >> 16; }
typedef float f32x2_hw __attribute__((ext_vector_type(2))); typedef __bf16 bf16x2_hw __attribute__((ext_vector_type(2)));
__device__ __forceinline__ unsigned pk2(float lo, float hi) { f32x2_hw v = {lo, hi}; bf16x2_hw b = __builtin_convertvector(v, bf16x2_hw); return __builtin_bit_cast(unsigned, b); }
__device__ __forceinline__ unsigned f2bf_hw(float f) { return pk2(f, 0.f) & 0xffffu; }
__device__ __forceinline__ float bf2f(unsigned v) { return __builtin_bit_cast(float, v << 16); }
__device__ __forceinline__ float silu_f(float x) { return x * __builtin_amdgcn_rcpf(1.0f + __expf(-x)); }
__device__ __forceinline__ float sigmoid_f(float x) { return __builtin_amdgcn_rcpf(1.0f + __expf(-x)); }
__device__ __forceinline__ float wave_sum(float v) {
#pragma unroll
    for (int o = 1; o < 64; o <<= 1) v += __shfl_xor(v, o);
    return v;
}
__device__ __forceinline__ int opaque_tid() { int t = threadIdx.x; asm volatile("" : "+v"(t)); return t; }
namespace pg8 {
#define PG8_LAS __attribute__((address_space(3)))
typedef unsigned short bf16_t;
typedef short bf16x8 __attribute__((ext_vector_type(8)));
typedef float f32x4 __attribute__((ext_vector_type(4)));
typedef unsigned u32x4 __attribute__((ext_vector_type(4)));
constexpr int BM = 256, BK = 64, HALF = 128, HTB = HALF * BK * 2  , STAGE_BYTES = 8 * HTB, NXCD = 8, WGM = 8;

__host__ __device__ __forceinline__ int lds_byte(int r, int c) { const int st = (r >> 4) * 2 + (c >> 5), rr = r & 15, cc = c & 31, ob = rr * 64 + cc * 2; return st * 1024 + (ob ^ (((ob >> 9) & 1) << 5)); }
__host__ __device__ __forceinline__ void stage_rc(int b, int& R, int& C) { const int st = b / 1024, sb = b % 1024, swz = sb ^ (((sb >> 9) & 1) << 5); R = (st >> 1) * 16 + swz / 64; C = (st & 1) * 32 + (swz % 64) / 2; }
__host__ __device__ __forceinline__ int perm32(int rho) { const int n = rho >> 4, i = rho & 15; return 8 * (i >> 2) + 4 * n + (i & 3); }

struct Unit { int pm, pn; };
struct Gemm { const bf16_t* A; const bf16_t* Bt; int M, N, K; int ld; };

struct StaticOrder {
    int nM, nN, nwg, G, c;
    __host__ __device__ void init(int M, int N, int G_, int c_) { nM = M / BM; nN = N / BM; nwg = nM * nN; G = G_; c = c_; }
    __host__ __device__ bool next(int i, Unit& u) const {
        const long L = (long)i * G + c; if (L >= nwg) return false;
        int wgid = (int)L; { const int q = nwg / NXCD, r = nwg % NXCD, xcd = wgid % NXCD, off = wgid / NXCD; wgid = (xcd < r ? xcd * (q + 1) : r * (q + 1) + (xcd - r) * q) + off; }
        const int nig = WGM * nN, gid = wgid / nig, fm = gid * WGM, gsz = (nM - fm) < WGM ? (nM - fm) : WGM;
        u.pm = fm + ((wgid % nig) % gsz); u.pn = (wgid % nig) / gsz; return true;
    }
    __device__ __forceinline__ void a_ready(const Unit&) const {}
    __device__ __forceinline__ void done(const Unit&) const {}
};

__device__ __forceinline__ unsigned cvt_pk_bf16(float lo, float hi) { unsigned r; asm volatile("v_cvt_pk_bf16_f32 %0, %1, %2" : "=v"(r) : "v"(lo), "v"(hi)); return r; }
typedef float f32x2 __attribute__((ext_vector_type(2)));
struct G1Order {
    StaticOrder so; int G, c, next_n, npn; int pl0, pl1, pl2, pl3, pl4, pl5, pl6, pl7;
    __device__ void init(int G_, int c_, bool layer0) { so.init(NLAT, N1, G_, c_); G = G_; c = c_;
        if (layer0) { npn = 8; pl0 = 0; pl1 = 1; pl2 = 2; pl3 = 3; pl4 = 4; pl5 = 5; pl6 = 6; pl7 = 7; }
        else { npn = 5; pl0 = 2; pl1 = 3; pl2 = 4; pl3 = 5; pl4 = 8; pl5 = 0; pl6 = 0; pl7 = 0; }
        next_n = 16 * npn; }
    __device__ bool next(int i, Unit& u) const {
        const int L = i * G + c;
        if (L < so.nwg) return so.next(i, u);
        const int e = L - so.nwg; if (e >= next_n) return false;
        const int d = (npn == 8) ? (e >> 3) : ((e * 52429) >> 18); const int q = e - d * npn; u.pm = 128 + d;
        u.pn = (q == 0) ? pl0 : (q == 1) ? pl1 : (q == 2) ? pl2 : (q == 3) ? pl3 : (q == 4) ? pl4 : (q == 5) ? pl5 : (q == 6) ? pl6 : pl7; return true; }
    __device__ __forceinline__ void a_ready(const Unit&) const {}
    __device__ __forceinline__ void done(const Unit&) const {}
};
struct EpiIn {
    static constexpr bool PERM = true, AFTER_DRAIN = false;
    bf16_t *QB, *KB, *VB, *MLB, *PZ; float* GT;
    const float *qn, *kn, *bg; const float* CS;
    float c2;
    __device__ __forceinline__ void operator()(const f32x4 (&acc)[2][2][4][2], const Unit& u, int wr, int wc, int fr, int fq) const {
        const int pn = u.pn, pm = u.pm;
        const bool lat = pm < 128;
        const int rt0 = wr * 64 + fr;
        const size_t grow0 = (size_t)pm * 256 + rt0;
        const size_t kv0 = lat ? ((size_t)(pm >> 3) * TKV + (size_t)(pm & 7) * 256 + rt0) : ((size_t)(pm - 128) * TKV + TLAT + rt0);
        if (pn < 2 || (pn == 2 && wc < 2)) {
            const bool isq = pn < 2;
            const float* nw = isq ? qn : kn;
            f32x4 wv[2][2];
#pragma unroll
            for (int bj = 0; bj < 2; ++bj)
#pragma unroll
                for (int n = 0; n < 2; ++n) wv[bj][n] = *(const f32x4*)(nw + 32 * bj + 8 * fq + 4 * n);
            const float sgn = (fq < 2) ? -1.f : 1.f;
            const float osc = isq ? c2 : 1.f;
#pragma unroll
            for (int ai = 0; ai < 2; ++ai)
#pragma unroll
                for (int m = 0; m < 4; ++m) {
                    float ss = 0.f;
#pragma unroll
                    for (int bj = 0; bj < 2; ++bj)
#pragma unroll
                        for (int n = 0; n < 2; ++n) { const f32x4 v = acc[ai][bj][m][n]; ss += (v[0] * v[0] + v[1] * v[1]) + (v[2] * v[2] + v[3] * v[3]); }
                    ss += __shfl_xor(ss, 16); ss += __shfl_xor(ss, 32);
                    const float rstd = rsqrtf(ss * (1.0f / 64.0f) + EPS);
                    const int roff = ai * 128 + m * 16;
#pragma unroll
                    for (int bj = 0; bj < 2; ++bj) {
                        f32x4 y[2];
#pragma unroll
                        for (int n = 0; n < 2; ++n) y[n] = acc[ai][bj][m][n] * rstd * wv[bj][n];
                        if (lat) {
                            const int pos = (bj == 0) ? ((pm & 7) * 4 + 2 * ai + wr) : (m * 16 + fr);
                            const float* cs = CS + (size_t)pos * 32 + 16 * (fq & 1);
#pragma unroll
                            for (int n = 0; n < 2; ++n) {
                                const f32x4 t0 = *(const f32x4*)(cs + 8 * n), t1 = *(const f32x4*)(cs + 8 * n + 4);
                                f32x4 p;
                                p[0] = __shfl_xor(y[n][0], 32); p[1] = __shfl_xor(y[n][1], 32); p[2] = __shfl_xor(y[n][2], 32); p[3] = __shfl_xor(y[n][3], 32);
                                f32x4 o;
                                o[0] = y[n][0] * t0[0] + sgn * p[0] * t0[1];
                                o[1] = y[n][1] * t0[2] + sgn * p[1] * t0[3];
                                o[2] = y[n][2] * t1[0] + sgn * p[2] * t1[1];
                                o[3] = y[n][3] * t1[2] + sgn * p[3] * t1[3];
                                y[n] = o;
                            }
                        }
                        u32x4 w;
                        w.x = cvt_pk_bf16(y[0][0] * osc, y[0][1] * osc); w.y = cvt_pk_bf16(y[0][2] * osc, y[0][3] * osc);
                        w.z = cvt_pk_bf16(y[1][0] * osc, y[1][1] * osc); w.w = cvt_pk_bf16(y[1][2] * osc, y[1][3] * osc);
                        bf16_t* dst = isq ? (QB + (grow0 + roff) * 512 + (4 * pn + wc) * 64 + 32 * bj + 8 * fq)
                                          : (KB + (kv0 + roff) * 128 + wc * 64 + 32 * bj + 8 * fq);
                        *(u32x4*)dst = w;
                    }
                    asm volatile("" ::: "memory");
                }
        } else if (pn <= 7) {
            bf16_t* base; size_t ld; size_t r0; int cb; float sc = 1.f;
            if (pn == 2) { base = VB; ld = 128; r0 = kv0; cb = (wc - 2) * 64; }
            else if (pn == 7) { base = PZ; ld = 256; r0 = grow0; cb = wc * 64; }
            else { base = MLB; ld = 1024; r0 = grow0; cb = (pn - 3) * 256 + wc * 64; if (pn == 4) sc = 0.125f; }
#pragma unroll
            for (int ai = 0; ai < 2; ++ai)
#pragma unroll
                for (int m = 0; m < 4; ++m)
#pragma unroll
                    for (int bj = 0; bj < 2; ++bj) {
                        const f32x4 v0 = acc[ai][bj][m][0] * sc, v1 = acc[ai][bj][m][1] * sc;
                        u32x4 w; w.x = cvt_pk_bf16(v0[0], v0[1]); w.y = cvt_pk_bf16(v0[2], v0[3]); w.z = cvt_pk_bf16(v1[0], v1[1]); w.w = cvt_pk_bf16(v1[2], v1[3]);
                        *(u32x4*)(base + (r0 + ai * 128 + m * 16) * ld + cb + 32 * bj + 8 * fq) = w;
                    }
        } else {
            if (wc == 0 && fq < 2) {
                const f32x4 b0 = *(const f32x4*)(bg + 8 * fq), b1 = *(const f32x4*)(bg + 8 * fq + 4);
#pragma unroll
                for (int ai = 0; ai < 2; ++ai)
#pragma unroll
                    for (int m = 0; m < 4; ++m) {
                        float* g = GT + (grow0 + ai * 128 + m * 16) * 16 + 8 * fq;
                        *(f32x4*)g = acc[ai][0][m][0] + b0; *(f32x4*)(g + 4) = acc[ai][0][m][1] + b1;
                    }
            }
        }
    }
};
struct EpiRes {
    static constexpr bool PERM = false, AFTER_DRAIN = false;
    const float *base_l, *base_c; float *out_l, *out_c; const float* gate;
    __device__ __forceinline__ void operator()(const f32x4 (&acc)[2][2][4][2], const Unit& u, int wr, int wc, int fr, int fq) const {
        const int pn = u.pn, pm = u.pm; const bool lat = pm < 128;
        const float* gv = gate + (size_t)(lat ? (pm >> 3) : 16) * 6144;
        const float* bp = lat ? base_l + (size_t)pm * 256 * 1024 : base_c + (size_t)(pm - 128) * 256 * 1024;
        float* op = lat ? out_l + (size_t)pm * 256 * 1024 : out_c + (size_t)(pm - 128) * 256 * 1024;
        const int col0 = pn * BM + wc * 32 + 4 * fq;
        f32x4 g4[2][2];
#pragma unroll
        for (int bj = 0; bj < 2; ++bj)
#pragma unroll
            for (int n = 0; n < 2; ++n) g4[bj][n] = *(const f32x4*)(gv + col0 + bj * HALF + n * 16);
#pragma unroll
        for (int ai = 0; ai < 2; ++ai)
#pragma unroll
            for (int m = 0; m < 4; ++m) { const size_t off = (size_t)(ai * HALF + wr * 64 + m * 16 + fr) * 1024 + col0;
#pragma unroll
                for (int bj = 0; bj < 2; ++bj)
#pragma unroll
                    for (int n = 0; n < 2; ++n) { const f32x4 x = *(const f32x4*)(bp + off + bj * HALF + n * 16); *(f32x4*)(op + off + bj * HALF + n * 16) = x + g4[bj][n] * acc[ai][bj][m][n]; }
                if (m & 1) asm volatile("" ::: "memory"); }
    }
};
struct EpiGU {
    static constexpr bool PERM = true, AFTER_DRAIN = false;
    bf16_t* H;
    __device__ __forceinline__ void operator()(const f32x4 (&acc)[2][2][4][2], const Unit& u, int wr, int wc, int fr, int fq) const {
        const size_t row0 = (size_t)u.pm * BM + wr * 64 + fr; const int col0 = u.pn * 128 + wc * 32 + 8 * fq;
#pragma unroll
        for (int ai = 0; ai < 2; ++ai)
#pragma unroll
            for (int m = 0; m < 4; ++m) {
                f32x4 v[2];
#pragma unroll
                for (int n = 0; n < 2; ++n) { const f32x4 g = acc[ai][0][m][n], up = acc[ai][1][m][n];
                    v[n][0] = g[0] * __builtin_amdgcn_rcpf(1.0f + __expf(-g[0])) * up[0]; v[n][1] = g[1] * __builtin_amdgcn_rcpf(1.0f + __expf(-g[1])) * up[1];
                    v[n][2] = g[2] * __builtin_amdgcn_rcpf(1.0f + __expf(-g[2])) * up[2]; v[n][3] = g[3] * __builtin_amdgcn_rcpf(1.0f + __expf(-g[3])) * up[3]; }
                u32x4 w; w.x = cvt_pk_bf16(v[0][0], v[0][1]); w.y = cvt_pk_bf16(v[0][2], v[0][3]); w.z = cvt_pk_bf16(v[1][0], v[1][1]); w.w = cvt_pk_bf16(v[1][2], v[1][3]);
                *(u32x4*)(H + (row0 + ai * HALF + m * 16) * DFF + col0) = w;
            }
    }
};
template <bool IN_BF16, bool OUT_BF16> struct EpiRes2 {
    static constexpr bool PERM = true, AFTER_DRAIN = false;
    const float *bl, *bc; bf16_t* xs; float* ol; const float* gate;
    __device__ __forceinline__ void operator()(const f32x4 (&acc)[2][2][4][2], const Unit& u, int wr, int wc, int fr, int fq) const {
        const int pn = u.pn, pm = u.pm; const bool lat = pm < 128;
        const float* gv = gate + (size_t)(lat ? (pm >> 3) : 16) * 6144;
        const int col0 = pn * BM + wc * 32 + 8 * fq;
        const size_t row0 = (size_t)pm * BM + wr * 64 + fr;
        const float* bf = lat ? bl + row0 * 1024 : bc + (row0 - NLAT) * 1024;
        f32x4 g4[2][2];
#pragma unroll
        for (int bj = 0; bj < 2; ++bj)
#pragma unroll
            for (int n = 0; n < 2; ++n) g4[bj][n] = *(const f32x4*)(gv + col0 + bj * HALF + 4 * n);
#pragma unroll
        for (int ai = 0; ai < 2; ++ai)
#pragma unroll
            for (int m = 0; m < 4; ++m) { const size_t ro = (size_t)(ai * HALF + m * 16) * 1024;
#pragma unroll
                for (int bj = 0; bj < 2; ++bj) { const int c = col0 + bj * HALF;
                    f32x4 x0, x1;
                    if (IN_BF16) { const u32x4 v = *(const u32x4*)(xs + row0 * 1024 + ro + c);
                        x0 = (f32x4){__builtin_bit_cast(float, v.x << 16), __builtin_bit_cast(float, v.x & 0xffff0000u), __builtin_bit_cast(float, v.y << 16), __builtin_bit_cast(float, v.y & 0xffff0000u)};
                        x1 = (f32x4){__builtin_bit_cast(float, v.z << 16), __builtin_bit_cast(float, v.z & 0xffff0000u), __builtin_bit_cast(float, v.w << 16), __builtin_bit_cast(float, v.w & 0xffff0000u)}; }
                    else { x0 = *(const f32x4*)(bf + ro + c); x1 = *(const f32x4*)(bf + ro + c + 4); }
                    x0 = x0 + g4[bj][0] * acc[ai][bj][m][0]; x1 = x1 + g4[bj][1] * acc[ai][bj][m][1];
                    if (OUT_BF16) { u32x4 w; w.x = cvt_pk_bf16(x0[0], x0[1]); w.y = cvt_pk_bf16(x0[2], x0[3]); w.z = cvt_pk_bf16(x1[0], x1[1]); w.w = cvt_pk_bf16(x1[2], x1[3]);
                        *(u32x4*)(xs + row0 * 1024 + ro + c) = w; }
                    else { *(f32x4*)(ol + row0 * 1024 + ro + c) = x0; *(f32x4*)(ol + row0 * 1024 + ro + c + 4) = x1; } }
                if (IN_BF16 ? (m == 3) : (m & 1)) asm volatile("" ::: "memory"); }
    }
};
struct TailOrder {
    int c, c0;
    __device__ bool next(int i, Unit& u) const { const int e = c - c0; if (i != 0 || e < 0 || e >= 64) return false; u.pn = e & 3; u.pm = 128 + (e >> 2); return true; }
    __device__ __forceinline__ void a_ready(const Unit&) const {}
    __device__ __forceinline__ void done(const Unit&) const {}
};
struct EpiPart {
    static constexpr bool PERM = true, AFTER_DRAIN = false;
    float* P;
    __device__ __forceinline__ void operator()(const f32x4 (&acc)[2][2][4][2], const Unit& u, int wr, int wc, int fr, int fq) const {
        float* op = P + ((size_t)(u.pm - 128) * BM + wr * 64 + fr) * 1024 + u.pn * BM + wc * 32 + 8 * fq;
#pragma unroll
        for (int ai = 0; ai < 2; ++ai)
#pragma unroll
            for (int m = 0; m < 4; ++m)
#pragma unroll
                for (int bj = 0; bj < 2; ++bj) { float* o = op + (size_t)(ai * HALF + m * 16) * 1024 + bj * HALF; *(f32x4*)o = acc[ai][bj][m][0]; *(f32x4*)(o + 4) = acc[ai][bj][m][1]; }
    }
};
template <class Epi, class Sched, bool ALIGN_EPI = false, bool SP2 = false>
__device__ __forceinline__ void gemm_phase(PG8_LAS unsigned char* lds, const Gemm g, const Sched& S, const Epi& E) {
    const int tid = opaque_tid(), wid = __builtin_amdgcn_readfirstlane(tid >> 6), lane = tid & 63, wr = wid >> 2, wc = wid & 3, fr = lane & 15, fq = lane >> 4;
    const int K = g.ld ? g.ld : g.K, nt = g.K / BK;
    unsigned voffA[2], voffB[2];
#pragma unroll
    for (int i = 0; i < 2; ++i) { int R, C; stage_rc(tid * 16 + i * 8192, R, C); const int Rb = Epi::PERM ? ((R & ~31) + perm32(R & 31)) : R;
        voffA[i] = (unsigned)(R * K + C) * 2u; voffB[i] = (unsigned)(Rb * K + C) * 2u; }
    const size_t kstep = (size_t)(BK * 2);
    const size_t hstep = (size_t)HALF * K * 2;
    const size_t tstep = 2 * hstep;
    const unsigned ldsw = (unsigned)wid * 1024u;
    const int aoff = lds_byte(wr * 64 + fr, fq * 8), boff = lds_byte(wc * 32 + fr, fq * 8);
#define PG8_SA(b, h) (((b) * 2 + (h)) * HTB)
#define PG8_SB(b, h) ((4 + (b) * 2 + (h)) * HTB)
#define PG8_STAGE(bufoff, gbase, voff) do { _Pragma("unroll") for (int _i = 0; _i < 2; ++_i) \
        __builtin_amdgcn_global_load_lds((const unsigned*)((const char*)(gbase) + (voff)[_i]), (PG8_LAS unsigned*)(lds + (bufoff) + ldsw + _i * 8192), 16, 0, 0); } while (0)
#define PG8_LDA(dst, b, h) do { _Pragma("unroll") for (int m = 0; m < 4; ++m) _Pragma("unroll") for (int k = 0; k < 2; ++k) dst[m][k] = *(const PG8_LAS bf16x8*)(lds + PG8_SA(b, h) + aoff + m * 2048 + k * 1024); } while (0)
#define PG8_LDB(dst, b, h) do { _Pragma("unroll") for (int n = 0; n < 2; ++n) _Pragma("unroll") for (int k = 0; k < 2; ++k) dst[n][k] = *(const PG8_LAS bf16x8*)(lds + PG8_SB(b, h) + boff + n * 2048 + k * 1024); } while (0)
#define PG8_MMA(ai, bj, At, Bt) do { __builtin_amdgcn_s_setprio(1); _Pragma("unroll") for (int m = 0; m < 4; ++m) _Pragma("unroll") for (int n = 0; n < 2; ++n) _Pragma("unroll") for (int k = 0; k < 2; ++k) \
        acc[ai][bj][m][n] = __builtin_amdgcn_mfma_f32_16x16x32_bf16(Bt[n][k], At[m][k], acc[ai][bj][m][n], 0, 0, 0); __builtin_amdgcn_s_setprio(0); } while (0)
#define PG8_WAIT_V(n) asm volatile("s_waitcnt vmcnt(" #n ")" ::: "memory")
#define PG8_WAIT_L(n) asm volatile("s_waitcnt lgkmcnt(" #n ")" ::: "memory")
#define PG8_BAR __builtin_amdgcn_s_barrier()
#define PG8_SCHED __builtin_amdgcn_sched_barrier(0)
    Unit cur, nxt; int ui = 0;
    if (!S.next(0, cur)) return;
    f32x4 acc[2][2][4][2];
#pragma unroll
    for (int a = 0; a < 2; ++a)
#pragma unroll
        for (int b = 0; b < 2; ++b)
#pragma unroll
            for (int m = 0; m < 4; ++m)
#pragma unroll
                for (int n = 0; n < 2; ++n) acc[a][b][m][n] = (f32x4){0.f, 0.f, 0.f, 0.f};
    bf16x8 At[4][2], B0[2][2], B1[2][2];
    const char* cA = (const char*)g.A + (size_t)cur.pm * tstep; const char* cB = (const char*)g.Bt + (size_t)cur.pn * tstep;
    S.a_ready(cur);
    if constexpr (SP2) {
        PG8_STAGE(PG8_SB(0, 0), cB, voffB); PG8_STAGE(PG8_SB(0, 1), cB + hstep, voffB); PG8_STAGE(PG8_SA(0, 0), cA, voffA); PG8_STAGE(PG8_SA(0, 1), cA + hstep, voffA);
        if (wr == 1) PG8_BAR;
        PG8_WAIT_V(2); PG8_BAR;
        PG8_STAGE(PG8_SB(1, 0), cB + kstep, voffB); PG8_STAGE(PG8_SA(1, 0), cA + kstep, voffA); PG8_STAGE(PG8_SB(1, 1), cB + hstep + kstep, voffB);
        PG8_WAIT_V(6); PG8_BAR;
    } else {
        PG8_STAGE(PG8_SB(0, 0), cB, voffB); PG8_STAGE(PG8_SA(0, 0), cA, voffA); PG8_STAGE(PG8_SB(0, 1), cB + hstep, voffB); PG8_STAGE(PG8_SA(0, 1), cA + hstep, voffA);
        if (wr == 1) PG8_BAR;
        PG8_WAIT_V(4); PG8_BAR;
        PG8_STAGE(PG8_SB(1, 0), cB + kstep, voffB); PG8_STAGE(PG8_SA(1, 0), cA + kstep, voffA); PG8_STAGE(PG8_SB(1, 1), cB + hstep + kstep, voffB);
        PG8_WAIT_V(6); PG8_BAR;
    }
    for (;;) {
        const bool has_next = S.next(ui + 1, nxt);
        const char* nA = has_next ? (const char*)g.A + (size_t)nxt.pm * tstep : cA; const char* nB = has_next ? (const char*)g.Bt + (size_t)nxt.pn * tstep : cB;
        for (int t = 0; t < nt; t += 2) {
            const bool last = (t == nt - 2);
            const char* a1 = cA + (size_t)(t + 1) * kstep;
            const char* a2 = last ? nA : cA + (size_t)(t + 2) * kstep; const char* b2 = last ? nB : cB + (size_t)(t + 2) * kstep;
            const char* a3 = a2 + kstep; const char* b3 = b2 + kstep;
            if (last && has_next) S.a_ready(nxt);
            if constexpr (SP2) {
            PG8_LDB(B0, 0, 0); PG8_LDB(B1, 0, 1); PG8_SCHED; PG8_LDA(At, 0, 0); PG8_STAGE(PG8_SA(1, 1), a1 + hstep, voffA);
            PG8_WAIT_V(8); PG8_WAIT_L(0); PG8_BAR; PG8_MMA(0, 0, At, B0); PG8_MMA(0, 1, At, B1); PG8_BAR; PG8_SCHED;
            PG8_LDA(At, 0, 1); PG8_STAGE(PG8_SB(0, 0), b2, voffB); PG8_STAGE(PG8_SB(0, 1), b2 + hstep, voffB); PG8_STAGE(PG8_SA(0, 0), a2, voffA);
            PG8_WAIT_V(8); PG8_WAIT_L(0); PG8_BAR; PG8_MMA(1, 0, At, B0); PG8_MMA(1, 1, At, B1); PG8_BAR; PG8_SCHED;
            PG8_LDB(B0, 1, 0); PG8_LDB(B1, 1, 1); PG8_SCHED; PG8_LDA(At, 1, 0); PG8_STAGE(PG8_SA(0, 1), a2 + hstep, voffA);
            PG8_WAIT_V(8); PG8_WAIT_L(0); PG8_BAR; PG8_MMA(0, 0, At, B0); PG8_MMA(0, 1, At, B1); PG8_BAR; PG8_SCHED;
            PG8_LDA(At, 1, 1); PG8_STAGE(PG8_SB(1, 0), b3, voffB); PG8_STAGE(PG8_SB(1, 1), b3 + hstep, voffB); PG8_STAGE(PG8_SA(1, 0), a3, voffA);
            PG8_WAIT_V(8); PG8_WAIT_L(0); PG8_BAR; PG8_MMA(1, 0, At, B0); PG8_MMA(1, 1, At, B1); PG8_BAR; PG8_SCHED;
            } else {
            PG8_LDB(B0, 0, 0); PG8_SCHED; PG8_LDA(At, 0, 0); PG8_STAGE(PG8_SA(1, 1), a1 + hstep, voffA);
            PG8_WAIT_L(8); PG8_BAR; PG8_WAIT_L(0); PG8_MMA(0, 0, At, B0); PG8_BAR; PG8_SCHED;
            PG8_LDB(B1, 0, 1); PG8_STAGE(PG8_SB(0, 0), b2, voffB);
            PG8_BAR; PG8_WAIT_L(0); PG8_MMA(0, 1, At, B1); PG8_BAR;
            PG8_LDA(At, 0, 1); PG8_STAGE(PG8_SA(0, 0), a2, voffA);
            PG8_BAR; PG8_WAIT_L(0); PG8_MMA(1, 0, At, B0); PG8_BAR; PG8_SCHED;
            PG8_STAGE(PG8_SB(0, 1), b2 + hstep, voffB);
            PG8_WAIT_V(6); PG8_BAR; PG8_MMA(1, 1, At, B1); PG8_BAR;
            PG8_LDB(B0, 1, 0); PG8_SCHED; PG8_LDA(At, 1, 0); PG8_STAGE(PG8_SA(0, 1), a2 + hstep, voffA);
            PG8_WAIT_L(8); PG8_BAR; PG8_WAIT_L(0); PG8_MMA(0, 0, At, B0); PG8_BAR; PG8_SCHED;
            PG8_LDB(B1, 1, 1); PG8_STAGE(PG8_SB(1, 0), b3, voffB);
            PG8_BAR; PG8_WAIT_L(0); PG8_MMA(0, 1, At, B1); PG8_BAR;
            PG8_LDA(At, 1, 1); PG8_STAGE(PG8_SA(1, 0), a3, voffA);
            PG8_BAR; PG8_WAIT_L(0); PG8_MMA(1, 0, At, B0); PG8_BAR; PG8_SCHED;
            PG8_STAGE(PG8_SB(1, 1), b3 + hstep, voffB);
            PG8_WAIT_V(6); PG8_BAR; PG8_MMA(1, 1, At, B1); PG8_BAR;
            }
        }
        if constexpr (ALIGN_EPI) { if (wr == 0) PG8_BAR; }
        if constexpr (!Epi::AFTER_DRAIN) { E(acc, cur, wr, wc, fr, fq); S.done(cur); }
        if (!has_next) break;
#pragma unroll
        for (int a = 0; a < 2; ++a)
#pragma unroll
            for (int b = 0; b < 2; ++b)
#pragma unroll
                for (int m = 0; m < 4; ++m)
#pragma unroll
                    for (int n = 0; n < 2; ++n) acc[a][b][m][n] = (f32x4){0.f, 0.f, 0.f, 0.f};
        cur = nxt; cA = nA; cB = nB; ++ui;
        if constexpr (ALIGN_EPI) { if (wr == 1) PG8_BAR; }
    }
    PG8_WAIT_V(0);
    if constexpr (!ALIGN_EPI) { if (wr == 0) PG8_BAR; }
    PG8_BAR;
    if constexpr (Epi::AFTER_DRAIN) { E.fused(acc, cur, wr, wc, fr, fq, lds, wid, lane); S.done(cur); }
#undef PG8_SA
#undef PG8_SB
#undef PG8_STAGE
#undef PG8_LDA
#undef PG8_LDB
#undef PG8_MMA
#undef PG8_WAIT_V
#undef PG8_WAIT_L
#undef PG8_BAR
#undef PG8_SCHED
}
}

namespace attn_body {
using bf16=__hip_bfloat16;
using bf16x8=__attribute__((ext_vector_type(8)))short;
using s16x4=__attribute__((ext_vector_type(4)))short;
using f32x16=__attribute__((ext_vector_type(16)))float;
using u32x4=__attribute__((ext_vector_type(4)))unsigned;
constexpr int D=64,QP=512,KP=128,OP=1024;
constexpr int NW=8,QBLK=32,QB=QBLK*NW,KVBLK=64;
__device__ __forceinline__ int crow(int r,int hi){return (r&3)+8*(r>>2)+4*hi;}
#define SBAR() __builtin_amdgcn_sched_barrier(0)
constexpr int NSLOT=3, SLOTB=8192;
constexpr int LDS_K=0, LDS_V=NSLOT*SLOTB, LDS_WS=2*NSLOT*SLOTB, LDS_OST=LDS_WS+NW*64*4, LDS_BYTES=LDS_OST+NW*4096;
constexpr float C2=0.125f*1.4426950408889634f;
__device__ __forceinline__ void glds16(const void*gsrc,unsigned lds_dst){unsigned keep;
  asm volatile("s_mov_b32 %0, m0\n\ts_mov_b32 m0, %2\n\ts_nop 0\n\tglobal_load_lds_dwordx4 %1, off\n\ts_mov_b32 m0, %0":"=&s"(keep):"v"(gsrc),"s"(lds_dst):"memory");}
__device__ __forceinline__ float max3f(float a,float b,float c){float r;asm("v_max3_f32 %0, %1, %2, %3":"=v"(r):"v"(a),"v"(b),"v"(c));return r;}
__device__ __forceinline__ float max2f(float a,float b){float r;asm("v_max_f32_e32 %0, %1, %2":"=v"(r):"v"(a),"v"(b));return r;}
__device__ __forceinline__ float fadd_s(float a,float b){float r;asm("v_add_f32_e32 %0, %1, %2":"=v"(r):"v"(a),"v"(b));return r;}
__device__ __forceinline__ float fsub_s(float a,float b){float r;asm("v_sub_f32_e32 %0, %1, %2":"=v"(r):"v"(a),"v"(b));return r;}
typedef float f32x2_t __attribute__((ext_vector_type(2))); typedef __bf16 bf16x2_t __attribute__((ext_vector_type(2)));
__device__ __forceinline__ unsigned cvtpk_s(float lo,float hi){f32x2_t v={lo,hi};bf16x2_t b=__builtin_convertvector(v,bf16x2_t);return __builtin_bit_cast(unsigned,b);}
#define WAIT_BAR(N) asm volatile("s_waitcnt vmcnt(" #N ") lgkmcnt(0)\n\ts_barrier":::"memory")

__device__ __forceinline__ void qkt(f32x16&p0,f32x16&p1,const char*Kslot,const bf16x8*qr,const f32x16&negm,int r32,int hi){
  const char*kb=Kslot+hi*1024+r32*16;
  #pragma unroll
  for(int d0=0;d0<4;++d0){
    const bf16x8 b0=*reinterpret_cast<const bf16x8*>(kb+d0*2048);
    const bf16x8 b1=*reinterpret_cast<const bf16x8*>(kb+d0*2048+512);
    if(d0==0){p0=__builtin_amdgcn_mfma_f32_32x32x16_bf16(b0,qr[0],negm,0,0,0);p1=__builtin_amdgcn_mfma_f32_32x32x16_bf16(b1,qr[0],negm,0,0,0);}
    else{p0=__builtin_amdgcn_mfma_f32_32x32x16_bf16(b0,qr[d0],p0,0,0,0);p1=__builtin_amdgcn_mfma_f32_32x32x16_bf16(b1,qr[d0],p1,0,0,0);}}
}
typedef __attribute__((address_space(3))) const char* lds_cptr;
typedef short v4i16_t __attribute__((ext_vector_type(4)));
__device__ __forceinline__ void kload8(bf16x8*kf,lds_cptr kp){
  kf[0]=*(const __attribute__((address_space(3))) bf16x8*)(kp);      kf[1]=*(const __attribute__((address_space(3))) bf16x8*)(kp+512);
  kf[2]=*(const __attribute__((address_space(3))) bf16x8*)(kp+2048); kf[3]=*(const __attribute__((address_space(3))) bf16x8*)(kp+2560);
  kf[4]=*(const __attribute__((address_space(3))) bf16x8*)(kp+4096); kf[5]=*(const __attribute__((address_space(3))) bf16x8*)(kp+4608);
  kf[6]=*(const __attribute__((address_space(3))) bf16x8*)(kp+6144); kf[7]=*(const __attribute__((address_space(3))) bf16x8*)(kp+6656);
}
__device__ __forceinline__ void kload2(bf16x8*kf,lds_cptr kp,int j){ kf[2*j]=*(const __attribute__((address_space(3))) bf16x8*)(kp+j*2048); kf[2*j+1]=*(const __attribute__((address_space(3))) bf16x8*)(kp+j*2048+512); }
__device__ __forceinline__ s16x4 vtr(lds_cptr p){ return __builtin_bit_cast(s16x4,__builtin_amdgcn_ds_read_tr16_b64_v4i16((__attribute__((address_space(3))) v4i16_t*)p)); }
__device__ __forceinline__ float rowmax(const f32x16&p0,const f32x16&p1){
  float a=max3f(p0[0],p0[1],p1[0]),b=max3f(p0[2],p0[3],p1[1]);a=max3f(a,p1[2],p1[3]);
  #pragma unroll
  for(int r=4;r<16;r+=4){a=max3f(a,p0[r],p0[r+1]);b=max3f(b,p0[r+2],p0[r+3]);a=max3f(a,p1[r],p1[r+1]);b=max3f(b,p1[r+2],p1[r+3]);}
  const float m=max2f(a,b);
  auto rr=__builtin_amdgcn_permlane32_swap(__float_as_uint(m),__float_as_uint(m),false,false);
  return max2f(__uint_as_float(rr[0]),__uint_as_float(rr[1]));
}
__device__ __forceinline__ void pv(f32x16*o,int vb,bf16x8 pa0,bf16x8 pa1,bf16x8 pa2,bf16x8 pa3){
  #pragma unroll
  for(int d0=0;d0<2;++d0){s16x4 lo[4],hi[4];
    #pragma unroll
    for(int ks=0;ks<4;++ks){
      asm volatile("ds_read_b64_tr_b16 %0,%1 offset:%c2":"=&v"(lo[ks]):"v"(vb),"i"(d0*4096+ks*1024):"memory");
      asm volatile("ds_read_b64_tr_b16 %0,%1 offset:%c2":"=&v"(hi[ks]):"v"(vb),"i"(d0*4096+ks*1024+512):"memory");}
    asm volatile("s_waitcnt lgkmcnt(0)":::"memory");SBAR();
    #define PK(k) (bf16x8){lo[k][0],lo[k][1],lo[k][2],lo[k][3],hi[k][0],hi[k][1],hi[k][2],hi[k][3]}
    o[d0]=__builtin_amdgcn_mfma_f32_32x32x16_bf16(pa0,PK(0),o[d0],0,0,0);
    o[d0]=__builtin_amdgcn_mfma_f32_32x32x16_bf16(pa1,PK(1),o[d0],0,0,0);
    o[d0]=__builtin_amdgcn_mfma_f32_32x32x16_bf16(pa2,PK(2),o[d0],0,0,0);
    o[d0]=__builtin_amdgcn_mfma_f32_32x32x16_bf16(pa3,PK(3),o[d0],0,0,0);
    #undef PK
  }
}

#ifndef ATTN_STORE16
#define ATTN_STORE16(p,v) (*(u32x4*)(p)=(v))
#endif
template<int THRL> __device__ __forceinline__ void attn_unit(const bf16*Q,const bf16*__restrict__ K,const bf16*__restrict__ V,bf16*O,const int NT,char*shm){
  const int tid=opaque_tid(),lane=tid&63,r32=lane&31,hi=lane>>5; const int wid=__builtin_amdgcn_readfirstlane(tid>>6);
  const bf16*Qw=Q+(long)(wid*QBLK)*QP;
  const bf16*Kh=K,*Vh=V;
  const unsigned lds0=(unsigned)(uintptr_t)shm;
  float*wsf=(float*)(shm+LDS_WS)+wid*64;
  const bf16*ksrc=Kh+(long)lane*KP+wid*8;
  const bf16*vsrc=Vh+(long)(16*(wid&3)+(lane>>2))*KP+(wid>>2)*32+(lane&3)*8;
  const unsigned kdst=lds0+LDS_K+wid*1024, vdst=lds0+LDS_V+wid*1024;
  #define DMA_K(t,slot) glds16(ksrc+(long)(t)*KVBLK*KP,(unsigned)__builtin_amdgcn_readfirstlane(kdst+(slot)))
  #define DMA_V(t,slot) glds16(vsrc+(long)(t)*KVBLK*KP,(unsigned)__builtin_amdgcn_readfirstlane(vdst+(slot)))
  const int vb0=(int)(lds0+LDS_V)+((lane>>4)&1)*32+(lane&3)*8+(4*hi+((lane&15)>>2))*64;
  const char*Kbase=shm+LDS_K; bf16x8 kf[8];
  const lds_cptr shm3=(lds_cptr)shm; const lds_cptr kp0=shm3+LDS_K+hi*1024+r32*16; const lds_cptr vp0=shm3+LDS_V+((lane>>4)&1)*32+(lane&3)*8+(4*hi+((lane&15)>>2))*64;
  DMA_K(0,0);DMA_V(0,0);DMA_K(1,SLOTB);
  bf16x8 qr[4];
  #pragma unroll
  for(int d0=0;d0<4;++d0)qr[d0]=*reinterpret_cast<const bf16x8*>(&Qw[(long)r32*QP+d0*16+hi*8]);
  float mhat=0.f,l_reg=0.f;f32x16 o[2];o[0]=f32x16{};o[1]=f32x16{};f32x16 negm=f32x16{};asm volatile("":"+v"(negm));
  #define CMASK(P0,P1,t) do{}while(0)
  bool resc=false;
  #define START(P0,P1) do{ const float rm=rowmax(P0,P1); resc=false; \
    { const float dl=rm; mhat=fadd_s(mhat,dl); \
      _Pragma("unroll") for(int r=0;r<16;++r){P0[r]=fsub_s(P0[r],dl);P1[r]=fsub_s(P1[r],dl);} \
      _Pragma("unroll") for(int r=0;r<16;++r)negm[r]=-mhat; asm volatile("":"+v"(negm)); } \
    _Pragma("unroll") for(int r=0;r<16;++r)P0[r]=__builtin_amdgcn_exp2f(P0[r]); }while(0)
  #define RESC() do{ if(resc){ asm volatile("s_waitcnt lgkmcnt(0)":::"memory"); \
      _Pragma("unroll") for(int d_=0;d_<2;++d_) _Pragma("unroll") for(int r=0;r<16;++r)o[d_][r]*=wsf[crow(r,hi)]; } }while(0)
  f32x16 pA0,pA1,pB0,pB1;
  int sl_prev=0,sl_cur=0,sl_next=SLOTB;
  #define ROT() do{sl_prev=sl_cur;sl_cur=sl_next;sl_next=(sl_next==(NSLOT-1)*SLOTB)?0:sl_next+SLOTB;}while(0)
  DMA_K(2,2*SLOTB);
  WAIT_BAR(3);
  qkt(pA0,pA1,Kbase,qr,negm,r32,hi);asm volatile("s_nop 15\n\ts_nop 7":"+v"(pA0),"+v"(pA1));CMASK(pA0,pA1,0);
  START(pA0,pA1);
  _Pragma("unroll") for(int r=0;r<16;++r)pA1[r]=__builtin_amdgcn_exp2f(pA1[r]);
  WAIT_BAR(0);
  DMA_K(3,0);DMA_V(1,SLOTB);
  ROT();
  kload8(kf,kp0+sl_cur);
  WAIT_BAR(2);
  s16x4 vlo[8],vhi[8]; u32x4 pw0,pw1,pw2,pw3;
  #define PKW(P,B) cvtpk_s(P[B],P[B+1])
  #define PAF(k) __builtin_bit_cast(bf16x8,pw##k)
  #define VFR(i) (bf16x8){vlo[i][0],vlo[i][1],vlo[i][2],vlo[i][3],vhi[i][0],vhi[i][1],vhi[i][2],vhi[i][3]}
  #define PIN(x) asm volatile("":"+v"(x))
  #define MX3(a,b,c) __builtin_fmaxf(__builtin_fmaxf((a),(b)),(c))
  #define GAPA(MF,A0,A1,A2,A3,W0,W1,PW) do{ MF; sacc+=A0; sacc+=A1; sacc+=A2; sacc+=A3; PIN(sacc); W0; W1; PIN(PW); SBAR(); }while(0)
  #define EX(v) __builtin_amdgcn_exp2f(v)
  #define GAPB(MF,X,B) do{ MF; X[B]=EX(X[B]); X[B+1]=EX(X[B+1]); X[B+2]=EX(X[B+2]); X[B+3]=EX(X[B+3]); PIN(X); SBAR(); }while(0)
  #define VRD(i) do{ vlo[i]=vtr(vp_+(((i)>>2)*4096+((i)&3)*1024)); vhi[i]=vtr(vp_+(((i)>>2)*4096+((i)&3)*1024+512)); }while(0)
  #define KRD(G,j) do{ if(G){ kload2(kf,kp0+sl_next,j); SBAR(); } }while(0)
  #define STEP(C0,C1,P0,P1,t,GK,GV,GL) do{ SBAR(); \
    const lds_cptr vp_=vp0+sl_prev; \
    VRD(0); SBAR(); float sacc=(P0[0]+P0[1]); \
    GAPA(C0=__builtin_amdgcn_mfma_f32_32x32x16_bf16(kf[0],qr[0],negm,0,0,0), P0[2],P0[3],P0[4],P0[5],     pw0[0]=PKW(P0,0), pw0[1]=PKW(P0,2), pw0); \
    VRD(4); SBAR(); GAPA(C1=__builtin_amdgcn_mfma_f32_32x32x16_bf16(kf[1],qr[0],negm,0,0,0), P0[6],P0[7],P0[8],P0[9],     pw0[2]=PKW(P0,4), pw0[3]=PKW(P0,6), pw0); \
    VRD(1); SBAR(); GAPA(C0=__builtin_amdgcn_mfma_f32_32x32x16_bf16(kf[2],qr[1],C0,0,0,0),   P0[10],P0[11],P0[12],P0[13], pw1[0]=PKW(P0,8), pw1[1]=PKW(P0,10), pw1); \
    VRD(5); SBAR(); GAPA(C1=__builtin_amdgcn_mfma_f32_32x32x16_bf16(kf[3],qr[1],C1,0,0,0),   P0[14],P0[15],P1[0],P1[1],   pw1[2]=PKW(P0,12),pw1[3]=PKW(P0,14), pw1); \
    VRD(2); SBAR(); GAPA(C0=__builtin_amdgcn_mfma_f32_32x32x16_bf16(kf[4],qr[2],C0,0,0,0),   P1[2],P1[3],P1[4],P1[5],     pw2[0]=PKW(P1,0), pw2[1]=PKW(P1,2), pw2); \
    VRD(6); SBAR(); GAPA(C1=__builtin_amdgcn_mfma_f32_32x32x16_bf16(kf[5],qr[2],C1,0,0,0),   P1[6],P1[7],P1[8],P1[9],     pw2[2]=PKW(P1,4), pw2[3]=PKW(P1,6), pw2); \
    VRD(3); SBAR(); GAPA(C0=__builtin_amdgcn_mfma_f32_32x32x16_bf16(kf[6],qr[3],C0,0,0,0),   P1[10],P1[11],P1[12],P1[13], pw3[0]=PKW(P1,8), pw3[1]=PKW(P1,10), pw3); \
    VRD(7); SBAR(); GAPA(C1=__builtin_amdgcn_mfma_f32_32x32x16_bf16(kf[7],qr[3],C1,0,0,0),   P1[14],P1[15],0.f,0.f,       pw3[2]=PKW(P1,12),pw3[3]=PKW(P1,14), pw3); \
    l_reg+=sacc; \
    if(GK){DMA_K((t)+3,sl_cur);} if(GV){DMA_V((t)+1,sl_next);} \
    CMASK(C0,C1,t); \
    { float a=MX3(C0[0],C0[1],C1[0]),b=MX3(C0[2],C0[3],C1[1]); a=MX3(a,C1[2],C1[3]); \
      _Pragma("unroll") for(int r=4;r<16;r+=4){a=MX3(a,C0[r],C0[r+1]);b=MX3(b,C0[r+2],C0[r+3]);a=MX3(a,C1[r],C1[r+1]);b=MX3(b,C1[r+2],C1[r+3]);} \
      float rm=__builtin_fmaxf(a,b); { auto rr=__builtin_amdgcn_permlane32_swap(__float_as_uint(rm),__float_as_uint(rm),false,false); rm=__builtin_fmaxf(__uint_as_float(rr[0]),__uint_as_float(rr[1])); } \
      resc=false; \
      if(__builtin_expect(__any(rm>(float)THRL),0)){ const float dl=__builtin_fmaxf(rm,0.f); mhat+=dl; \
        _Pragma("unroll") for(int r=0;r<16;++r){C0[r]-=dl;C1[r]-=dl;} \
        _Pragma("unroll") for(int r=0;r<16;++r)negm[r]=-mhat; asm volatile("":"+v"(negm)); \
        const float f=__builtin_amdgcn_exp2f(-dl); l_reg*=f; if(hi==0)wsf[r32]=f; resc=true; } } \
    SBAR(); \
    GAPB(o[0]=__builtin_amdgcn_mfma_f32_32x32x16_bf16(PAF(0),VFR(0),o[0],0,0,0), C0,0); \
    GAPB(o[1]=__builtin_amdgcn_mfma_f32_32x32x16_bf16(PAF(0),VFR(4),o[1],0,0,0), C0,4); \
    KRD(GL,0); GAPB(o[0]=__builtin_amdgcn_mfma_f32_32x32x16_bf16(PAF(1),VFR(1),o[0],0,0,0), C0,8); \
    KRD(GL,1); GAPB(o[1]=__builtin_amdgcn_mfma_f32_32x32x16_bf16(PAF(1),VFR(5),o[1],0,0,0), C0,12); \
    KRD(GL,2); GAPB(o[0]=__builtin_amdgcn_mfma_f32_32x32x16_bf16(PAF(2),VFR(2),o[0],0,0,0), C1,0); \
    KRD(GL,3); GAPB(o[1]=__builtin_amdgcn_mfma_f32_32x32x16_bf16(PAF(2),VFR(6),o[1],0,0,0), C1,4); \
    GAPB(o[0]=__builtin_amdgcn_mfma_f32_32x32x16_bf16(PAF(3),VFR(3),o[0],0,0,0), C1,8); \
    GAPB(o[1]=__builtin_amdgcn_mfma_f32_32x32x16_bf16(PAF(3),VFR(7),o[1],0,0,0), C1,12); \
    }while(0)
  int t=1;
  #undef CMASK
  #define CMASK(P0,P1,t) do{}while(0)
  for(;t+5<NT;t+=2){
    STEP(pB0,pB1,pA0,pA1,t,true,true,true);     WAIT_BAR(2); RESC(); ROT();
    STEP(pA0,pA1,pB0,pB1,t+1,true,true,true);   WAIT_BAR(2); RESC(); ROT();
  }
  #undef CMASK
  #define CMASK(P0,P1,t) do{}while(0)
  #define ENDW(tt) do{ if((tt)+3<NT){WAIT_BAR(2);} else if((tt)+2<NT){WAIT_BAR(1);} else {WAIT_BAR(0);} }while(0)
  for(;t+1<NT;t+=2){
    STEP(pB0,pB1,pA0,pA1,t,(t+3<NT),(t+1<NT),(t+1<NT));       ENDW(t);   RESC(); ROT();
    STEP(pA0,pA1,pB0,pB1,t+1,(t+4<NT),(t+2<NT),(t+2<NT));     ENDW(t+1); RESC(); ROT();
  }
  STEP(pB0,pB1,pA0,pA1,NT-1,false,false,false); RESC();
  { float sacc=pB0[0]+pB0[1]; _Pragma("unroll") for(int r=2;r<16;++r)sacc+=pB0[r]; _Pragma("unroll") for(int r=0;r<16;++r)sacc+=pB1[r]; l_reg+=sacc;
    pw0=(u32x4){PKW(pB0,0),PKW(pB0,2),PKW(pB0,4),PKW(pB0,6)};pw1=(u32x4){PKW(pB0,8),PKW(pB0,10),PKW(pB0,12),PKW(pB0,14)};pw2=(u32x4){PKW(pB1,0),PKW(pB1,2),PKW(pB1,4),PKW(pB1,6)};pw3=(u32x4){PKW(pB1,8),PKW(pB1,10),PKW(pB1,12),PKW(pB1,14)};
    SBAR(); pv(o,vb0+sl_cur,PAF(0),PAF(1),PAF(2),PAF(3)); }
  #undef PKW
  #undef PAF
  #undef VFR
  #undef PIN
  #undef MX3
  #undef GAPA
  #undef GAPB
  #undef EX
  #undef VRD
  #undef KRD
  #undef STEP
  #undef ENDW
  {auto rr=__builtin_amdgcn_permlane32_swap(__float_as_uint(l_reg),__float_as_uint(l_reg),false,false);l_reg=__uint_as_float(rr[0])+__uint_as_float(rr[1]);}
  if(hi==0)wsf[32+r32]=l_reg;asm volatile("s_waitcnt lgkmcnt(0)":::"memory");
  float rli[16];
  #pragma unroll
  for(int r=0;r<16;++r)rli[r]=__builtin_amdgcn_rcpf(wsf[32+crow(r,hi)]);
  bf16*Ow=O+(long)(wid*QBLK)*OP;
  { bf16*stg=(bf16*)(shm+LDS_OST)+wid*2048;
    #pragma unroll
    for(int r=0;r<16;++r){const int orow=crow(r,hi);
      #pragma unroll
      for(int d0=0;d0<2;++d0)stg[orow*64+d0*32+r32]=__float2bfloat16(o[d0][r]*rli[r]);}
    asm volatile("s_waitcnt lgkmcnt(0)":::"memory");
    #pragma unroll
    for(int i=0;i<4;++i){const int row=i*8+(lane>>3),ch=lane&7; const u32x4 v=*(const u32x4*)(stg+row*64+ch*8); ATTN_STORE16(Ow+(long)row*OP+ch*8,v);} }
  asm volatile("s_waitcnt lgkmcnt(0)\n\ts_barrier":::"memory");
  #undef DMA_K
  #undef DMA_V
  #undef CMASK
  #undef START
  #undef RESC
  #undef ROT
}
#undef SBAR
#undef WAIT_BAR
}
namespace ml {
constexpr int QS = 0, KS = QS + 128 * 144, VT = KS + 128 * 144, KT = VT + 80 * 272, SP = KT + 64 * 272, CB = SP + 128 * 272, GA = CB + 80 * 144, GSET = 6 * 512, END = GA + 2 * GSET;
static_assert(END <= 131072, "mlstm lds");
__device__ __forceinline__ float logsig(float x) { return fminf(x, 0.f) - __logf(1.0f + __expf(-fabsf(x))); }
#define MFMA16(a, b, c) __builtin_amdgcn_mfma_f32_16x16x32_bf16(a, b, c, 0, 0, 0)
#define ML_BAR() do { asm volatile("s_waitcnt lgkmcnt(0)" ::: "memory"); __builtin_amdgcn_s_barrier(); asm volatile("" ::: "memory"); } while (0)
#define ML_SCAN(SET, G0, G1, G2, G3) do { \
                LAS float* a_w = (LAS float*)(lds + GA + (SET) * GSET); \
                const float li0 = (G0), lf0 = logsig(G1), li1 = (G2), lf1 = logsig(G3); \
                const float ps = lf0 + lf1; float inc = ps; \
                _Pragma("unroll") for (int o = 1; o < 64; o <<= 1) { const float t = __shfl_up(inc, o); if (lane >= o) inc += t; } \
                const float b0 = (inc - ps) + lf0, b1 = b0 + lf1; \
                const float a0 = li0 - b0, a1 = li1 - b1; \
                float incm = fmaxf(a0, a1); \
                _Pragma("unroll") for (int o = 1; o < 64; o <<= 1) { const float t = __shfl_up(incm, o); if (lane >= o) incm = fmaxf(incm, t); } \
                float excm = __shfl_up(incm, 1); if (lane == 0) excm = -INFINITY; \
                const float cm0 = fmaxf(mcar, fmaxf(excm, a0)), cm1 = fmaxf(mcar, incm); \
                const float blast = __shfl(b1, 63), cmlast = __shfl(cm1, 63); \
                a_w[2 * lane] = a0; a_w[2 * lane + 1] = a1; a_w[128 + 2 * lane] = cm0; a_w[128 + 2 * lane + 1] = cm1; \
                a_w[256 + 2 * lane] = __expf(mcar - cm0); a_w[256 + 2 * lane + 1] = __expf(mcar - cm1); \
                a_w[384 + 2 * lane] = __expf(-(b0 + cm0)); a_w[384 + 2 * lane + 1] = __expf(-(b1 + cm1)); \
                a_w[512 + 2 * lane] = __expf(a0 - cmlast); a_w[512 + 2 * lane + 1] = __expf(a1 - cmlast); \
                if (lane == 0) a_w[640] = __expf(mcar - cmlast); \
                mcar = blast + cmlast; } while (0)

template <int VAR> __device__ __forceinline__ void mlstm_item(int b, int head, int dir, const bf16_t* __restrict__ MLB, const float* __restrict__ GT, bf16_t* HSd, LAS unsigned char* lds) {
    const int tid = opaque_tid(), lane = tid & 63, w = __builtin_amdgcn_readfirstlane(tid >> 6), fr = lane & 15, fq = lane >> 4;
    LAS bf16_t* Qs = (LAS bf16_t*)(lds + QS); LAS bf16_t* Ks = (LAS bf16_t*)(lds + KS); LAS bf16_t* Vt = (LAS bf16_t*)(lds + VT);
    LAS bf16_t* Kt = (LAS bf16_t*)(lds + KT); LAS bf16_t* Sp = (LAS bf16_t*)(lds + SP); LAS bf16_t* Cb = (LAS bf16_t*)(lds + CB);
    const int ntk = w & 3, mt0 = 2 * (w >> 2);
    {
        __syncthreads();
        for (int i = tid; i < 80 * 144 / 4; i += 512) ((LAS unsigned*)Cb)[i] = 0u;
        for (int i = tid; i < 16 * 136 / 2; i += 512) ((LAS unsigned*)(Vt + 64 * 136))[i] = (i < 68) ? 0x3f803f80u : 0u;
        f32x4 accN = (f32x4){0.f, 0.f, 0.f, 0.f};
        f32x4 accC[2]; accC[0] = (f32x4){0.f, 0.f, 0.f, 0.f}; accC[1] = accC[0];
        float mcar = 0.f;
        u32x4 pq[2], pk[2], pv[2];
        size_t rowbase_n;
        {
            const int ci = dir ? 1 : 0; rowbase_n = (size_t)NLAT + (size_t)b * TCTX + ci * 128;
#pragma unroll
            for (int j = 0; j < 2; ++j) { const int i = 2 * (tid & 63) + j, ch = tid >> 6; const bf16_t* src = MLB + (rowbase_n + i) * 1024 + head * 64 + ch * 8;
                pq[j] = *(const u32x4*)src; pk[j] = *(const u32x4*)(src + 256); pv[j] = *(const u32x4*)(src + 512); }
        }
        if (w == 0) { const float* ga_ = GT + (rowbase_n + (dir ? 127 - 2 * lane : 2 * lane)) * 16 + head + 8 * dir; const float* gb_ = GT + (rowbase_n + (dir ? 126 - 2 * lane : 2 * lane + 1)) * 16 + head + 8 * dir; const float g0_ = ga_[0], g1_ = ga_[4], g2_ = gb_[0], g3_ = gb_[4]; ML_SCAN(0, g0_, g1_, g2_, g3_); }
        for (int cc = 0; cc < 18; ++cc) {
            const size_t rowbase = rowbase_n;
            LAS float* a_s = (LAS float*)(lds + GA + (cc & 1) * GSET); LAS float* cm_s = a_s + 128; LAS float* wi_s = a_s + 256; LAS float* emt_s = a_s + 384; LAS float* wk_s = a_s + 512; LAS float* sc_s = a_s + 640;
            ML_BAR();
            {
                const int i0 = 2 * (tid & 63), ch = tid >> 6, ipa = dir ? 127 - i0 : i0, ipb = dir ? 126 - i0 : i0 + 1, ipe = dir ? 126 - i0 : i0;
                *(LAS u32x4*)(Qs + ipa * 72 + ch * 8) = pq[0]; *(LAS u32x4*)(Qs + ipb * 72 + ch * 8) = pq[1];
                *(LAS u32x4*)(Ks + ipa * 72 + ch * 8) = pk[0]; *(LAS u32x4*)(Ks + ipb * 72 + ch * 8) = pk[1];
                const unsigned ka[4] = {pk[0].x, pk[0].y, pk[0].z, pk[0].w}, kb[4] = {pk[1].x, pk[1].y, pk[1].z, pk[1].w}, va[4] = {pv[0].x, pv[0].y, pv[0].z, pv[0].w}, vb[4] = {pv[1].x, pv[1].y, pv[1].z, pv[1].w};
                const float wkl = wk_s[ipe], wkh = wk_s[ipe + 1];
#pragma unroll
                for (int e2 = 0; e2 < 4; ++e2) { if (VAR & 8) continue;
                    const unsigned kl0 = dir ? kb[e2] : ka[e2], kh0 = dir ? ka[e2] : kb[e2], vl0 = dir ? vb[e2] : va[e2], vh0 = dir ? va[e2] : vb[e2];
                    *(LAS unsigned*)(Kt + (ch * 8 + 2 * e2) * 136 + ipe) = pk2(bf2f(kl0 & 0xffffu) * wkl, bf2f(kh0 & 0xffffu) * wkh);
                    *(LAS unsigned*)(Kt + (ch * 8 + 2 * e2 + 1) * 136 + ipe) = pk2(bf2f(kl0 >> 16) * wkl, bf2f(kh0 >> 16) * wkh);
                    *(LAS unsigned*)(Vt + (ch * 8 + 2 * e2) * 136 + ipe) = (vl0 & 0xffffu) | (vh0 << 16);
                    *(LAS unsigned*)(Vt + (ch * 8 + 2 * e2 + 1) * 136 + ipe) = (vl0 >> 16) | (vh0 & 0xffff0000u); }
            }
            if (cc > 0) {
#pragma unroll
                for (int i = 0; i < 2; ++i)
#pragma unroll
                    for (int j = 0; j < 4; ++j) Cb[(16 * (mt0 + i) + 4 * fq + j) * 72 + 16 * ntk + fr] = (bf16_t)f2bf_hw(accC[i][j]);
                if (w < 4 && fq == 0) Cb[64 * 72 + 16 * w + fr] = (bf16_t)f2bf_hw(accN[0]);
            }
            if (cc + 1 < 18) {
                const int cn = cc + 1;
                if (cn < 2) { const int ci = dir ? 1 - cn : cn; rowbase_n = (size_t)NLAT + (size_t)b * TCTX + ci * 128; }
                else { const int ci = dir ? 17 - cn : cn - 2; rowbase_n = (size_t)b * TLAT + ci * 128; }
#pragma unroll
                for (int j = 0; j < 2; ++j) { const int i = 2 * (tid & 63) + j, ch = tid >> 6; const bf16_t* src = MLB + (rowbase_n + i) * 1024 + head * 64 + ch * 8;
                    pq[j] = *(const u32x4*)src; pk[j] = *(const u32x4*)(src + 256); pv[j] = *(const u32x4*)(src + 512); }
            }
            ML_BAR();
            if (!(VAR & 1)) {
            bf16x8 Qa[2];
            Qa[0] = *(const LAS bf16x8*)(Qs + (16 * w + fr) * 72 + 8 * fq); Qa[1] = *(const LAS bf16x8*)(Qs + (16 * w + fr) * 72 + 32 + 8 * fq);
            float cmt[4], rs[4];
#pragma unroll
            for (int j = 0; j < 4; ++j) { cmt[j] = cm_s[16 * w + 4 * fq + j]; rs[j] = 0.f; }
            for (int st = 0; st <= w; ++st) {
                const bf16x8 Kb0 = *(const LAS bf16x8*)(Ks + (16 * st + fr) * 72 + 8 * fq), Kb1 = *(const LAS bf16x8*)(Ks + (16 * st + fr) * 72 + 32 + 8 * fq);
                f32x4 S = (f32x4){0.f, 0.f, 0.f, 0.f};
                S = MFMA16(Qa[0], Kb0, S); S = MFMA16(Qa[1], Kb1, S);
                const float as = a_s[16 * st + fr];
#pragma unroll
                for (int j = 0; j < 4; ++j) { const bool ok = (st < w) || (fr <= 4 * fq + j); const float wgt = ok ? __expf(as - cmt[j]) : 0.f; const float v = S[j] * wgt;
                    rs[j] += v; Sp[(16 * w + 4 * fq + j) * 136 + 16 * st + fr] = (bf16_t)f2bf_hw(v); }
            }
            if ((w & 1) == 0) {
#pragma unroll
                for (int j = 0; j < 4; ++j) Sp[(16 * w + 4 * fq + j) * 136 + 16 * (w + 1) + fr] = (bf16_t)0;
            }
#pragma unroll
            for (int j = 0; j < 4; ++j) { rs[j] += __shfl_xor(rs[j], 1); rs[j] += __shfl_xor(rs[j], 2); rs[j] += __shfl_xor(rs[j], 4); rs[j] += __shfl_xor(rs[j], 8); }
            f32x4 hi_[4], hc[5];
#pragma unroll
            for (int nt = 0; nt < 4; ++nt) hi_[nt] = (f32x4){0.f, 0.f, 0.f, 0.f};
#pragma unroll
            for (int nt = 0; nt < 5; ++nt) hc[nt] = (f32x4){0.f, 0.f, 0.f, 0.f};
            for (int ks = 0; ks <= (w >> 1); ++ks) {
                const bf16x8 A = *(const LAS bf16x8*)(Sp + (16 * w + fr) * 136 + 32 * ks + 8 * fq);
#pragma unroll
                for (int nt = 0; nt < 4; ++nt) { const bf16x8 B = *(const LAS bf16x8*)(Vt + (16 * nt + fr) * 136 + 32 * ks + 8 * fq); hi_[nt] = MFMA16(A, B, hi_[nt]); }
            }
#pragma unroll
            for (int ks = 0; ks < 2; ++ks)
#pragma unroll
                for (int nt = 0; nt < 5; ++nt) { const bf16x8 B = *(const LAS bf16x8*)(Cb + (16 * nt + fr) * 72 + 32 * ks + 8 * fq); hc[nt] = MFMA16(Qa[ks], B, hc[nt]); }
            float hv[4][4];
#pragma unroll
            for (int j = 0; j < 4; ++j) {
                const int tl = 16 * w + 4 * fq + j;
                const float wi = wi_s[tl], em = emt_s[tl];
                const float qn = __shfl(hc[4][j], lane & 48);
                const float den = wi * qn + rs[j];
                const float inv = 1.0f / fmaxf(fabsf(den), em);
#pragma unroll
                for (int nt = 0; nt < 4; ++nt) hv[nt][j] = (wi * hc[nt][j] + hi_[nt][j]) * inv;
            }
            if (!(VAR & 4)) {
                LAS bf16_t* T = Sp + (16 * w) * 136;
#pragma unroll
                for (int j = 0; j < 4; ++j)
#pragma unroll
                    for (int nt = 0; nt < 4; ++nt) T[(4 * fq + j) * 136 + 16 * nt + fr] = (bf16_t)f2bf_hw(hv[nt][j]);
                asm volatile("s_waitcnt lgkmcnt(0)" ::: "memory");
#pragma unroll
                for (int q = 0; q < 2; ++q) { const int r = (lane >> 3) + 8 * q, c8 = lane & 7, tl = 16 * w + r; const size_t grow = rowbase + (dir ? 127 - tl : tl);
                    const u32x4 v = *(const LAS u32x4*)(T + r * 136 + c8 * 8);
                    *(u32x4*)(HSd + grow * 256 + head * 64 + c8 * 8) = v; }
            }
            }
            if (!(VAR & 2)) {
                const float asc = sc_s[0];
                accC[0] = accC[0] * asc; accC[1] = accC[1] * asc; accN = accN * asc;
#pragma unroll
                for (int ks = 0; ks < 4; ++ks) {
                    const bf16x8 Bs = *(const LAS bf16x8*)(Kt + (16 * ntk + fr) * 136 + 32 * ks + 8 * fq);
#pragma unroll
                    for (int i = 0; i < 2; ++i) { const bf16x8 A = *(const LAS bf16x8*)(Vt + (16 * (mt0 + i) + fr) * 136 + 32 * ks + 8 * fq); accC[i] = MFMA16(A, Bs, accC[i]); }
                    if (w < 4) { const bf16x8 A1 = *(const LAS bf16x8*)(Vt + (64 + fr) * 136 + 32 * ks + 8 * fq); accN = MFMA16(A1, Bs, accN); }
                }
            }
            if (w == 0 && cc + 1 < 18) { const float* ga_ = GT + (rowbase_n + (dir ? 127 - 2 * lane : 2 * lane)) * 16 + head + 8 * dir; const float* gb_ = GT + (rowbase_n + (dir ? 126 - 2 * lane : 2 * lane + 1)) * 16 + head + 8 * dir; const float g0_ = ga_[0], g1_ = ga_[4], g2_ = gb_[0], g3_ = gb_[4]; ML_SCAN((cc + 1) & 1, g0_, g1_, g2_, g3_); }
        }
    }
    __syncthreads();
}
__device__ __forceinline__ void mlstm_readout_phase(bool with_ctx, const bf16_t* HS0, const bf16_t* HS1, const bf16_t* __restrict__ MLB, bf16_t* MIX, const float* __restrict__ mlw) {
    const int tid = opaque_tid(), l16 = tid & 15, sub = tid >> 4;
    const int npairs = (with_ctx ? MTOT : NLAT) * 4;
    for (int p = blockIdx.x * 32 + sub; p < npairs; p += gridDim.x * 32) {
        const size_t grow = (size_t)(p >> 2); const int head = p & 3;
        const f32x4 gw = *(const f32x4*)(mlw + head * 64 + 4 * l16);
        const size_t off = grow * 256 + head * 64 + 4 * l16;
        const unsigned long long ha = *(const unsigned long long*)(HS0 + off), hb = *(const unsigned long long*)(HS1 + off);
        const f32x4 h = (f32x4){bf2f((unsigned)ha & 0xffffu) + bf2f((unsigned)hb & 0xffffu), bf2f(((unsigned)ha) >> 16) + bf2f(((unsigned)hb) >> 16),
                                bf2f((unsigned)(ha >> 32) & 0xffffu) + bf2f((unsigned)(hb >> 32) & 0xffffu), bf2f((unsigned)(ha >> 48)) + bf2f((unsigned)(hb >> 48))};
        const unsigned long long mo = *(const unsigned long long*)(MLB + grow * 1024 + 768 + head * 64 + 4 * l16);
        float ss = (h[0] * h[0] + h[1] * h[1]) + (h[2] * h[2] + h[3] * h[3]);
        ss += __shfl_xor(ss, 1); ss += __shfl_xor(ss, 2); ss += __shfl_xor(ss, 4); ss += __shfl_xor(ss, 8);
        const float rstd = rsqrtf(ss * (1.0f / 64.0f) + EPS);
        const unsigned mlo = (unsigned)mo, mhi = (unsigned)(mo >> 32);
        const float y0 = h[0] * rstd * gw[0] * sigmoid_f(bf2f(mlo & 0xffffu)), y1 = h[1] * rstd * gw[1] * sigmoid_f(bf2f(mlo >> 16));
        const float y2 = h[2] * rstd * gw[2] * sigmoid_f(bf2f(mhi & 0xffffu)), y3 = h[3] * rstd * gw[3] * sigmoid_f(bf2f(mhi >> 16));
        *(unsigned long long*)(MIX + grow * 1024 + 512 + head * 64 + 4 * l16) = (unsigned long long)pk2(y0, y1) | ((unsigned long long)pk2(y2, y3) << 32);
    }
}
#undef MFMA16
#undef ML_BAR
#undef ML_SCAN
}

__device__ __forceinline__ void pool_item(int u, const bf16_t* __restrict__ PZ, bf16_t* MIX, LAS unsigned char* lds) {
    const int tid = opaque_tid();
    const int r0 = u * 128;
    const int seq0 = (r0 < NLAT) ? (r0 / TLAT) * TLAT : NLAT + ((r0 - NLAT) / TCTX) * TCTX;
    const int len = (r0 < NLAT) ? TLAT : TCTX;
    const int tb = r0 - seq0;
    LAS u32x4* tile = (LAS u32x4*)lds;
#pragma unroll
    for (int q = 0; q < 9; ++q) { const int e = tid + 512 * q, row = e >> 5, ch = e & 31, t = tb - 8 + row;
        u32x4 v = (u32x4){0u, 0u, 0u, 0u};
        if (t >= 0 && t < len) v = *(const u32x4*)(PZ + (size_t)(seq0 + t) * 256 + ch * 8);
        tile[e] = v; }
    __syncthreads();
    const int ch = tid & 31, run = tid >> 5, half = 1 << (ch >> 3);
    float s[8];
#pragma unroll
    for (int e = 0; e < 8; ++e) s[e] = 0.f;
#define POOL_ACC(ROW, SGN) do { const u32x4 v_ = tile[(ROW) * 32 + ch]; \
        s[0] += (SGN) * bf2f(v_.x & 0xffffu); s[1] += (SGN) * bf2f(v_.x >> 16); s[2] += (SGN) * bf2f(v_.y & 0xffffu); s[3] += (SGN) * bf2f(v_.y >> 16); \
        s[4] += (SGN) * bf2f(v_.z & 0xffffu); s[5] += (SGN) * bf2f(v_.z >> 16); s[6] += (SGN) * bf2f(v_.w & 0xffffu); s[7] += (SGN) * bf2f(v_.w >> 16); } while (0)
    const int tl0 = run * 8;
    for (int k = -half; k < half; ++k) POOL_ACC(tl0 + 8 + k, 1.0f);
#pragma unroll
    for (int i = 0; i < 8; ++i) {
        const int tl = tl0 + i, t = tb + tl;
        if (i > 0) { POOL_ACC(tl + 8 + half - 1, 1.0f); POOL_ACC(tl + 8 - half - 1, -1.0f); }
        const int lo = max(t - half, 0), hi = min(t + half, len);
        const float inv = 1.0f / (float)(hi - lo);
        const u32x4 z = tile[(tl + 8) * 32 + ch];
        u32x4 o;
        o.x = pk2(s[0] * inv - bf2f(z.x & 0xffffu), s[1] * inv - bf2f(z.x >> 16)); o.y = pk2(s[2] * inv - bf2f(z.y & 0xffffu), s[3] * inv - bf2f(z.y >> 16));
        o.z = pk2(s[4] * inv - bf2f(z.z & 0xffffu), s[5] * inv - bf2f(z.z >> 16)); o.w = pk2(s[6] * inv - bf2f(z.w & 0xffffu), s[7] * inv - bf2f(z.w >> 16));
        *(u32x4*)(MIX + (size_t)(r0 + tl) * 1024 + 768 + ch * 8) = o;
    }
#undef POOL_ACC
    __syncthreads();
}
#define XB_TMO      128
#define XB_XCNT(j)  (256  + 64 * (j))
#define XB_XSUB(j)  (1280 + 64 * (j))
#define XB_XGEN(j)  (2304 + 64 * (j))
#define XB_TOP      3328
#define XB_TOPGEN   3392
#define XCD_BAR_WORDS 3456
#define XB_SPIN_CAP (1u << 18)

__device__ __forceinline__ unsigned xb_ld(unsigned* p)              { return __hip_atomic_load(p, __ATOMIC_RELAXED, __HIP_MEMORY_SCOPE_AGENT); }
__device__ __forceinline__ unsigned xb_add(unsigned* p, unsigned v) { return __hip_atomic_fetch_add(p, v, __ATOMIC_RELAXED, __HIP_MEMORY_SCOPE_AGENT); }
__device__ __forceinline__ unsigned xb_xcc_id() { return (unsigned)__builtin_amdgcn_s_getreg((3 << 11) | 20) & 0xFu; }
#define XB_SPIN(cond, bar) do { unsigned _sp = 0; while (cond) { __builtin_amdgcn_s_sleep(1); \
    if ((++_sp & 255u) == 0u) { if (xb_ld(&(bar)[XB_TMO])) break; if (_sp > XB_SPIN_CAP) { atomicAdd(&(bar)[XB_TMO], 1u); break; } } } } while (0)

struct XcdBarrier {
    unsigned* bar; unsigned x;
    volatile LAS unsigned* st;
};

__device__ __forceinline__ XcdBarrier xcd_barrier_post(unsigned* bar, volatile LAS unsigned* st) {
    XcdBarrier b; b.bar = bar; b.x = xb_xcc_id(); b.st = st;
    if (threadIdx.x == 0) (void)xb_add(&bar[XB_XCNT(b.x)], 1u);
    return b;
}
__device__ __forceinline__ void xcd_barrier_complete(unsigned* bar, unsigned x, unsigned& nloc, unsigned& nx) {
    const unsigned G = gridDim.x * gridDim.y * gridDim.z;
    unsigned sum, cnt, mine, sp = 0u;
    for (;;) {
        sum = 0u; cnt = 0u; mine = 0u;
#pragma unroll
        for (unsigned j = 0; j < 16; ++j) { const unsigned c = xb_ld(&bar[XB_XCNT(j)]); sum += c; cnt += (c > 0u) ? 1u : 0u; mine = (j == x) ? c : mine; }
        if (sum == G) break;
        __builtin_amdgcn_s_sleep(1);
        if ((++sp & 255u) == 0u) { if (xb_ld(&bar[XB_TMO])) break; if (sp > XB_SPIN_CAP) { atomicAdd(&bar[XB_TMO], 1u); break; } }
    }
    nloc = mine > 0u ? mine : 1u; nx = cnt > 0u ? cnt : 1u;
}

__device__ __forceinline__ void xcd_barrier(const XcdBarrier& b) {
    asm volatile("s_waitcnt vmcnt(0)" ::: "memory");
    __syncthreads();
    if (threadIdx.x == 0) {
        unsigned* bar = b.bar;
        __builtin_amdgcn_s_waitcnt(0);
        unsigned nloc = b.st[0], nx = b.st[1];
        if (nloc == 0u) { xcd_barrier_complete(bar, b.x, nloc, nx); b.st[0] = nloc; b.st[1] = nx; }
        const unsigned old = xb_add(&bar[XB_XSUB(b.x)], 1u);
        const unsigned gen = old / nloc;
        if (old + 1u == (gen + 1u) * nloc) {
            __builtin_amdgcn_fence(__ATOMIC_RELEASE, "agent");
            asm volatile("s_waitcnt vmcnt(0)" ::: "memory");
            const unsigned og = xb_add(&bar[XB_TOP], 1u);
            const unsigned tg = og / nx;
            if (og + 1u == (tg + 1u) * nx) xb_add(&bar[XB_TOPGEN], 1u);
            else XB_SPIN(xb_ld(&bar[XB_TOPGEN]) == tg, bar);
            __builtin_amdgcn_fence(__ATOMIC_ACQUIRE, "agent");
            xb_add(&bar[XB_XGEN(b.x)], 1u);
            asm volatile("s_waitcnt vmcnt(0)" ::: "memory");
        } else {
            XB_SPIN(xb_ld(&bar[XB_XGEN(b.x)]) == gen, bar);
            __builtin_amdgcn_fence(__ATOMIC_ACQUIRE, "agent");
            asm volatile("s_waitcnt vmcnt(0)" ::: "memory");
        }
    }
    __syncthreads();
}
struct Args { const float* in[20]; float* out; unsigned char* ws; };
enum { I_X = 0, I_C, I_CTX, I_CCTX, I_WADA, I_BADA, I_NMIX, I_WIN, I_BG, I_QN, I_KN, I_MLN, I_PW, I_PS, I_WOUT, I_NFFN, I_WG, I_WU, I_WD, I_FN };
constexpr int LDS_BYTES = 147456;
#ifndef REP_N1
#define REP_N1 1
#endif
#ifndef REP_G1
#define REP_G1 1
#endif
#ifndef REP_MIX
#define REP_MIX 1
#endif
#ifndef REP_N2
#define REP_N2 1
#endif
#ifndef REP_G3
#define REP_G3 1
#endif
#ifndef REP_PRO
#define REP_PRO 1
#endif
#ifndef ML_DUP
#define ML_DUP 1
#endif
#ifndef AL_DUP
#define AL_DUP 1
#endif
#ifndef MIXREP_MASK
#define MIXREP_MASK 15
#endif
#ifndef ML_VAR
#define ML_VAR 0
#endif
#ifndef PRO_MASK
#define PRO_MASK 7
#endif
#ifndef REP_SYNC
#define REP_SYNC 1
#endif

__device__ __forceinline__ void tr_item(const float* colp, size_t ld, int K, bf16_t* WT, int r0, int k0, LAS float* scr, int lane) {
    float tv[32];
#pragma unroll
    for (int i = 0; i < 32; ++i) { const int kk = 2 * i + (lane >> 5); tv[i] = colp ? colp[(size_t)(k0 + kk) * ld] : 0.f; }
#pragma unroll
    for (int i = 0; i < 32; ++i) { const int kk = 2 * i + (lane >> 5); scr[kk * 33 + (lane & 31)] = tv[i]; }
    asm volatile("s_waitcnt lgkmcnt(0)" ::: "memory");
    const int c = lane & 7;
#pragma unroll
    for (int j = 0; j < 4; ++j) { const int n = (lane >> 3) + 8 * j; const LAS float* s = scr + (8 * c) * 33 + n;
        u32x4 o; o.x = pk2(s[0 * 33], s[1 * 33]); o.y = pk2(s[2 * 33], s[3 * 33]); o.z = pk2(s[4 * 33], s[5 * 33]); o.w = pk2(s[6 * 33], s[7 * 33]);
        *(u32x4*)(WT + (size_t)(r0 + n) * K + k0 + 8 * c) = o; }
    asm volatile("s_waitcnt lgkmcnt(0)" ::: "memory");
}
__device__ __forceinline__ void tr_item_pool(const float* win, const float* pw, const float* ps, bf16_t* WT, int r0, int k0, LAS float* scr, int lane) {
    const int p = (r0 - 1792) + (lane & 31), oc = 64 * ((p >> 5) & 3) + 32 * (p >> 7) + (p & 31), g = oc >> 6, o = oc & 63;
    const float scl = ps[oc];
    const float* pwc = pw + (size_t)g * 4096 + o;
    float pwr[64];
#pragma unroll
    for (int q = 0; q < 64; ++q) pwr[q] = pwc[q * 64];
    for (int i = 0; i < 8; ++i) { const int kk = 2 * i + (lane >> 5); const float* wr = win + (size_t)(k0 + kk) * INW + 1808 + 64 * g;
        f32x4 w4[16];
#pragma unroll
        for (int q = 0; q < 16; ++q) w4[q] = *(const f32x4*)(wr + 4 * q);
        float s0 = 0.f, s1 = 0.f;
#pragma unroll
        for (int q = 0; q < 16; q += 2) { s0 += (w4[q][0] * pwr[4 * q] + w4[q][1] * pwr[4 * q + 1]) + (w4[q][2] * pwr[4 * q + 2] + w4[q][3] * pwr[4 * q + 3]);
            s1 += (w4[q + 1][0] * pwr[4 * q + 4] + w4[q + 1][1] * pwr[4 * q + 5]) + (w4[q + 1][2] * pwr[4 * q + 6] + w4[q + 1][3] * pwr[4 * q + 7]); }
        scr[kk * 33 + (lane & 31)] = (s0 + s1) * scl; }
    asm volatile("s_waitcnt lgkmcnt(0)" ::: "memory");
    { const int n = lane >> 1, c = lane & 1; const LAS float* s = scr + (8 * c) * 33 + n;
        u32x4 o4; o4.x = pk2(s[0 * 33], s[1 * 33]); o4.y = pk2(s[2 * 33], s[3 * 33]); o4.z = pk2(s[4 * 33], s[5 * 33]); o4.w = pk2(s[6 * 33], s[7 * 33]);
        *(u32x4*)(WT + (size_t)(r0 + n) * 1024 + k0 + 8 * c) = o4; }
    asm volatile("s_waitcnt lgkmcnt(0)" ::: "memory");
}

__device__ __forceinline__ void prologue(const Args& a, LAS unsigned char* lds, const int pmask) {
    const int tid = threadIdx.x, lane = tid & 63, wave = tid >> 6;
    unsigned char* ws = a.ws;
    if (blockIdx.x == 0) {
        for (int e = tid; e < 1024; e += 512) { const int pos = e >> 4, f = e & 15;
            const float invf = exp2f(-(float)(2 * f) * (13.287712379549449f / 32.0f));
            float ang = (float)pos * invf; ang -= 6.283185307179586f * rintf(ang * 0.15915494309189535f);
            float* cs = (float*)(ws + WS_ROPE) + e * 2; cs[0] = __cosf(ang); cs[1] = __sinf(ang); }
    }
    LAS float* scs = (LAS float*)lds;
    LAS float* red = (LAS float*)(lds + 17 * 4096);
    for (int e = tid; e < 17 * 1024; e += 512) { const float v = (e < 16 * 1024) ? a.in[I_C][e] : a.in[I_CCTX][e - 16 * 1024]; scs[e] = silu_f(v); }
    __syncthreads();
    for (int it = blockIdx.x; it < 2 * 192; it += gridDim.x) { if (!(pmask & 1)) break;
        const int l = it / 192, c0 = (it % 192) * 32, col = tid & 31, kp = tid >> 5;
        const float* W = a.in[I_WADA] + ((size_t)l * 1024 + kp * 64) * 6144 + c0 + col;
        float acc[17];
#pragma unroll
        for (int r = 0; r < 17; ++r) acc[r] = 0.f;
#pragma unroll 16
        for (int k4 = 0; k4 < 16; ++k4) { const float w0 = W[(size_t)(4 * k4) * 6144], w1 = W[(size_t)(4 * k4 + 1) * 6144], w2 = W[(size_t)(4 * k4 + 2) * 6144], w3 = W[(size_t)(4 * k4 + 3) * 6144];
#pragma unroll
            for (int r = 0; r < 17; ++r) { const f32x4 s = *(const LAS f32x4*)(scs + r * 1024 + kp * 64 + 4 * k4); acc[r] += (s[0] * w0 + s[1] * w1) + (s[2] * w2 + s[3] * w3); } }
#pragma unroll
        for (int r = 0; r < 17; ++r) red[(kp * 17 + r) * 32 + col] = acc[r];
        __syncthreads();
        for (int e = tid; e < 17 * 32; e += 512) { const int r = e >> 5, cc = e & 31; float s = 0.f;
#pragma unroll
            for (int q = 0; q < 16; ++q) s += red[(q * 17 + r) * 32 + cc];
            ((float*)(ws + WS_MOD))[((size_t)l * 17 + r) * 6144 + c0 + cc] = s + a.in[I_BADA][(size_t)l * 6144 + c0 + cc]; }
        __syncthreads();
    }
    LAS float* scr = (LAS float*)(lds + wave * 8448);
    const int gw = blockIdx.x * 8 + wave, NGW = gridDim.x * 8;
    constexpr int IT_W1 = 64 * 16, IT_WO = 32 * 16, IT_GU = 176 * 16, IT_WD = 32 * 44, IT_L = IT_W1 + IT_WO + IT_GU + IT_WD;
#define TR_DECODE(IT, COLP, LD, KK, WTP, R0, K0) do { const int l_ = (IT) / IT_L; int r_ = (IT) % IT_L; \
        if (r_ < IT_W1) { int rg_ = r_ / 16; if (rg_ >= 56) rg_ += 8; K0 = (r_ % 16) * 64; R0 = rg_ * 32; WTP = (bf16_t*)(ws + WS_W1 + l_ * W1_BYTES); \
            const float* win_ = a.in[I_WIN] + (size_t)l_ * 1024 * INW; const int rr_ = R0 + (lane & 31), pn_ = rr_ >> 8, p_ = rr_ & 255, oc_ = 64 * ((p_ >> 5) & 3) + 32 * (p_ >> 7) + (p_ & 31), cp_ = 256 * pn_ + oc_; \
            COLP = (cp_ < 1792) ? win_ + cp_ : (cp_ >= 2048 && cp_ < 2064) ? win_ + 1792 + (cp_ - 2048) : nullptr; LD = INW; KK = 1024; } \
        else if ((r_ -= IT_W1) < IT_WO) { R0 = (r_ / 16) * 32; K0 = (r_ % 16) * 64; COLP = a.in[I_WOUT] + (size_t)l_ * 1024 * 1024 + R0 + (lane & 31); LD = 1024; KK = 1024; WTP = (bf16_t*)(ws + WS_WO + l_ * WO_BYTES); } \
        else if ((r_ -= IT_WO) < IT_GU) { R0 = (r_ / 16) * 32; K0 = (r_ % 16) * 64; const int rr_ = R0 + (lane & 31), pn_ = rr_ >> 8, p_ = rr_ & 255, hcol_ = 128 * pn_ + (p_ & 127); \
            COLP = ((p_ >> 7) ? a.in[I_WU] : a.in[I_WG]) + (size_t)l_ * 1024 * DFF + hcol_; LD = DFF; KK = 1024; WTP = (bf16_t*)(ws + WS_WGU + l_ * WGU_BYTES); } \
        else { r_ -= IT_GU; R0 = (r_ / 44) * 32; K0 = (r_ % 44) * 64; COLP = a.in[I_WD] + (size_t)l_ * DFF * 1024 + R0 + (lane & 31); LD = 1024; KK = DFF; WTP = (bf16_t*)(ws + WS_WD + l_ * WD_BYTES); } } while (0)
#define TR_LOAD(TV, COLP, LD, K0) do { _Pragma("unroll") for (int i_ = 0; i_ < 32; ++i_) { const int kk_ = 2 * i_ + (lane >> 5); TV[i_] = (COLP) ? (COLP)[(size_t)((K0) + kk_) * (LD)] : 0.f; } } while (0)
    if (pmask & 2) {
        int it = gw;
        const float* colp = nullptr; size_t ld = 0; int KK = 0, r0 = 0, k0 = 0; bf16_t* WT = nullptr;
        float tv[32];
        if (it < 2 * IT_L) { TR_DECODE(it, colp, ld, KK, WT, r0, k0); TR_LOAD(tv, colp, ld, k0); }
        while (it < 2 * IT_L) {
            const int itn = it + NGW;
            const float* colpn = nullptr; size_t ldn = 0; int KKn = 0, r0n = 0, k0n = 0; bf16_t* WTn = nullptr;
            float tn[32];
            if (itn < 2 * IT_L) { TR_DECODE(itn, colpn, ldn, KKn, WTn, r0n, k0n); TR_LOAD(tn, colpn, ldn, k0n); }
#pragma unroll
            for (int i = 0; i < 32; ++i) { const int kk = 2 * i + (lane >> 5); scr[kk * 33 + (lane & 31)] = tv[i]; }
            asm volatile("s_waitcnt lgkmcnt(0)" ::: "memory");
            { const int c = lane & 7;
#pragma unroll
                for (int j = 0; j < 4; ++j) { const int n = (lane >> 3) + 8 * j; const LAS float* s = scr + (8 * c) * 33 + n;
                    u32x4 o; o.x = pk2(s[0 * 33], s[1 * 33]); o.y = pk2(s[2 * 33], s[3 * 33]); o.z = pk2(s[4 * 33], s[5 * 33]); o.w = pk2(s[6 * 33], s[7 * 33]);
                    *(u32x4*)(WT + (size_t)(r0 + n) * KK + k0 + 8 * c) = o; } }
            asm volatile("s_waitcnt lgkmcnt(0)" ::: "memory");
            it = itn; colp = colpn; ld = ldn; KK = KKn; r0 = r0n; k0 = k0n; WT = WTn;
#pragma unroll
            for (int i = 0; i < 32; ++i) tv[i] = tn[i];
        }
    }
#undef TR_DECODE
#undef TR_LOAD
    if (pmask & 4)
    for (int it = gw; it < 1024; it += NGW) { const int l = it >> 9, rg = (it & 511) >> 6, kg = it & 63;
        tr_item_pool(a.in[I_WIN] + (size_t)l * 1024 * INW, a.in[I_PW] + (size_t)l * 4 * 4096, a.in[I_PS] + l * 256, (bf16_t*)(ws + WS_W1 + l * W1_BYTES), 1792 + rg * 32, kg * 16, scr, lane); }
}

__device__ __forceinline__ void norm_phase(const float* xl, const float* xc, const float* gw, const float* mod  , int sh_off, int sc_off, bf16_t* XN, int nrows) {
    const int tid = opaque_tid(), lane = tid & 63, gwv = blockIdx.x * 8 + (tid >> 6), NGW = gridDim.x * 8;
    const int per = (nrows + NGW - 1) / NGW;
    int cur = -1; f32x4 mul[4], add[4];
    for (int q = 0; q < per; ++q) {
        const int row = gwv * per + q; if (row >= nrows) break;
        const int mr = row < NLAT ? row / TLAT : 16;
        if (mr != cur) { cur = mr; const float* mp = mod + (size_t)mr * 6144;
#pragma unroll
            for (int j = 0; j < 4; ++j) { const f32x4 g = *(const f32x4*)(gw + 4 * lane + 256 * j), s = *(const f32x4*)(mp + sc_off + 4 * lane + 256 * j); mul[j] = g * (s + 1.0f); add[j] = *(const f32x4*)(mp + sh_off + 4 * lane + 256 * j); } }
        const float* xr = row < NLAT ? xl + (size_t)row * 1024 : xc + (size_t)(row - NLAT) * 1024;
        f32x4 v[4]; float ss = 0.f;
#pragma unroll
        for (int j = 0; j < 4; ++j) { v[j] = *(const f32x4*)(xr + 4 * lane + 256 * j); ss += (v[j][0] * v[j][0] + v[j][1] * v[j][1]) + (v[j][2] * v[j][2] + v[j][3] * v[j][3]); }
        const float rstd = rsqrtf(wave_sum(ss) * (1.0f / 1024.0f) + EPS);
        unsigned long long* o8 = (unsigned long long*)(XN + (size_t)row * 1024) + lane;
#pragma unroll
        for (int j = 0; j < 4; ++j) { const f32x4 y = v[j] * rstd * mul[j] + add[j]; o8[64 * j] = (unsigned long long)pk2(y[0], y[1]) | ((unsigned long long)pk2(y[2], y[3]) << 32); }
    }
}
__device__ __forceinline__ void ctx_gates_phase(const float* xc, const float* gw, const float* modc, const float* win, const float* bg, float* GT, LAS unsigned char* lds) {
    const int tid = opaque_tid(), lane = tid & 63, gwv = blockIdx.x * 8 + (tid >> 6), NGW = gridDim.x * 8;
    LAS float* wg = (LAS float*)lds;
    for (int e = tid; e < 4096; e += 512) { const int k = e >> 2, q4 = e & 3; *(LAS f32x4*)(wg + k * 16 + q4 * 4) = *(const f32x4*)(win + (size_t)k * INW + 1792 + q4 * 4); }
    __syncthreads();
    for (int r = gwv; r < NCTX; r += NGW) {
        asm volatile("" ::: "memory");
        const float* xr = xc + (size_t)r * 1024; float h[16]; float ss = 0.f;
#pragma unroll
        for (int q = 0; q < 16; ++q) { h[q] = xr[lane + 64 * q]; ss += h[q] * h[q]; }
        const float rstd = rsqrtf(wave_sum(ss) * (1.0f / 1024.0f) + EPS);
        f32x4 acc[4];
#pragma unroll
        for (int q = 0; q < 4; ++q) acc[q] = (f32x4){0.f, 0.f, 0.f, 0.f};
#pragma unroll
        for (int q = 0; q < 16; ++q) { const int c = lane + 64 * q; const float hv = h[q] * rstd * gw[c] * (modc[1024 + c] + 1.0f) + modc[c];
#pragma unroll
            for (int g4 = 0; g4 < 4; ++g4) acc[g4] += *(const LAS f32x4*)(wg + c * 16 + 4 * g4) * hv; }
        float out = 0.f;
#pragma unroll
        for (int q = 0; q < 4; ++q)
#pragma unroll
            for (int i = 0; i < 4; ++i) { const float v = wave_sum(acc[q][i]); if (lane == 4 * q + i) out = v; }
        if (lane < 16) GT[(size_t)(NLAT + r) * 16 + lane] = out + bg[lane];
    }
    __syncthreads();
}
__device__ __forceinline__ void norm_phase_bf(const bf16_t* xs, const float* gw, const float* mod, int sh_off, int sc_off, bf16_t* XN, int nrows, const float* part = nullptr, int nsplit = 0, const float* pgate = nullptr, const float* cbase = nullptr, bf16_t* xs_w = nullptr) {
    const int tid = opaque_tid(), lane = tid & 63, gwv = blockIdx.x * 8 + (tid >> 6), NGW = gridDim.x * 8;
    const int per = (nrows + NGW - 1) / NGW;
    int cur = -1; f32x4 mul[4], add[4];
    for (int q = 0; q < per; ++q) {
        const int row = gwv * per + q; if (row >= nrows) break;
        const int mr = row < NLAT ? row / TLAT : 16;
        if (mr != cur) { cur = mr; const float* mp = mod + (size_t)mr * 6144;
#pragma unroll
            for (int j = 0; j < 4; ++j) { const int c = 8 * lane + 512 * (j >> 1) + 4 * (j & 1); const f32x4 g = *(const f32x4*)(gw + c), s = *(const f32x4*)(mp + sc_off + c); mul[j] = g * (s + 1.0f); add[j] = *(const f32x4*)(mp + sh_off + c); } }
        const bf16_t* xr = xs + (size_t)row * 1024;
        f32x4 v[4]; float ss = 0.f;
#pragma unroll
        for (int j = 0; j < 2; ++j) { const u32x4 w = *(const u32x4*)(xr + 8 * lane + 512 * j);
            v[2 * j] = (f32x4){bf2f(w.x & 0xffffu), bf2f(w.x >> 16), bf2f(w.y & 0xffffu), bf2f(w.y >> 16)}; v[2 * j + 1] = (f32x4){bf2f(w.z & 0xffffu), bf2f(w.z >> 16), bf2f(w.w & 0xffffu), bf2f(w.w >> 16)}; }
        if (part && row >= NLAT) {
#pragma unroll
            for (int j = 0; j < 4; ++j) { const int c = 8 * lane + 512 * (j >> 1) + 4 * (j & 1); f32x4 s = (f32x4){0.f, 0.f, 0.f, 0.f};
                if (cbase) v[j] = *(const f32x4*)(cbase + (size_t)(row - NLAT) * 1024 + c);
                for (int k = 0; k < nsplit; ++k) s += *(const f32x4*)(part + ((size_t)k * NCTX + (row - NLAT)) * 1024 + c);
                v[j] += *(const f32x4*)(pgate + c) * s; }
            if (xs_w) {
#pragma unroll
                for (int j = 0; j < 2; ++j) { u32x4 o; o.x = pk2(v[2 * j][0], v[2 * j][1]); o.y = pk2(v[2 * j][2], v[2 * j][3]); o.z = pk2(v[2 * j + 1][0], v[2 * j + 1][1]); o.w = pk2(v[2 * j + 1][2], v[2 * j + 1][3]);
                    *(u32x4*)(xs_w + (size_t)row * 1024 + 8 * lane + 512 * j) = o; } } }
#pragma unroll
        for (int j = 0; j < 4; ++j) ss += (v[j][0] * v[j][0] + v[j][1] * v[j][1]) + (v[j][2] * v[j][2] + v[j][3] * v[j][3]);
        const float rstd = rsqrtf(wave_sum(ss) * (1.0f / 1024.0f) + EPS);
#pragma unroll
        for (int j = 0; j < 2; ++j) { const f32x4 y0 = v[2 * j] * rstd * mul[2 * j] + add[2 * j], y1 = v[2 * j + 1] * rstd * mul[2 * j + 1] + add[2 * j + 1];
            u32x4 o; o.x = pk2(y0[0], y0[1]); o.y = pk2(y0[2], y0[3]); o.z = pk2(y1[0], y1[1]); o.w = pk2(y1[2], y1[3]);
            *(u32x4*)(XN + (size_t)row * 1024 + 8 * lane + 512 * j) = o; }
    }
}
__device__ __forceinline__ void final_norm_phase(float* x, const float* gw) {
    const int tid = opaque_tid(), lane = tid & 63, gwv = blockIdx.x * 8 + (tid >> 6), NGW = gridDim.x * 8;
    f32x4 g[4];
#pragma unroll
    for (int j = 0; j < 4; ++j) g[j] = *(const f32x4*)(gw + 4 * lane + 256 * j);
    for (int row = gwv; row < NLAT; row += NGW) {
        float* xr = x + (size_t)row * 1024; f32x4 v[4]; float ss = 0.f;
#pragma unroll
        for (int j = 0; j < 4; ++j) { v[j] = *(const f32x4*)(xr + 4 * lane + 256 * j); ss += (v[j][0] * v[j][0] + v[j][1] * v[j][1]) + (v[j][2] * v[j][2] + v[j][3] * v[j][3]); }
        const float rstd = rsqrtf(wave_sum(ss) * (1.0f / 1024.0f) + EPS);
#pragma unroll
        for (int j = 0; j < 4; ++j) *(f32x4*)(xr + 4 * lane + 256 * j) = v[j] * rstd * g[j];
    }
}

__global__ void __launch_bounds__(512, 2) fwd_megakernel(Args a) {
    extern __shared__ __attribute__((aligned(16))) unsigned char lds_raw[];
    LAS unsigned char* lds = (LAS unsigned char*)lds_raw;
    unsigned char* ws = a.ws;
    const int tid = threadIdx.x;
    float* MOD = (float*)(ws + WS_MOD);
    bf16_t* XN = (bf16_t*)(ws + WS_XN); bf16_t* QB = (bf16_t*)(ws + WS_QB); bf16_t* KB = (bf16_t*)(ws + WS_KB); bf16_t* VB = (bf16_t*)(ws + WS_VB);
    bf16_t* MLB = (bf16_t*)(ws + WS_MLB); bf16_t* PZ = (bf16_t*)(ws + WS_PZ); float* GT = (float*)(ws + WS_GT); bf16_t* HS = (bf16_t*)(ws + WS_HS); bf16_t* HS1 = (bf16_t*)(ws + WS_HS1);
    bf16_t* MIX = (bf16_t*)(ws + WS_MIX); bf16_t* HID = (bf16_t*)(ws + WS_HID); bf16_t* XS = (bf16_t*)(ws + WS_XS);
    unsigned* ctl = (unsigned*)(ws + WS_CTL);
    LAS int* item_s = (LAS int*)(lds + 131072 + 1024);
    volatile LAS unsigned* bst = (volatile LAS unsigned*)(lds + 131072 + 2048);
    if (tid < 4) bst[tid] = 0u;
    __syncthreads();
    XcdBarrier xbar = xcd_barrier_post(ctl + 4096, bst);
#define GSYNC() xcd_barrier(xbar)

    for (int rp = 0; rp < REP_PRO; ++rp) { prologue(a, lds, rp == 0 ? 7 : PRO_MASK);
    GSYNC(); }

    for (int l = 0; l < 2; ++l) {
        const float* xl_in = a.in[I_X];
        const float* xc_in = a.in[I_CTX];
        const float* modl = MOD + (size_t)l * 17 * 6144;
        for (int rp = 0; rp < REP_N1; ++rp) { if (l == 0) norm_phase(xl_in, xc_in, a.in[I_NMIX] + l * 1024, modl, 0, 1024, XN, MTOT); else norm_phase_bf(XS, a.in[I_NMIX] + l * 1024, modl, 0, 1024, XN, MTOT, (const float*)(ws + WS_MIX + 32 * MiB), 2, MOD + (size_t)16 * 6144 + 5120);
        if (l == 0) ctx_gates_phase(xc_in, a.in[I_NMIX], modl + 16 * 6144, a.in[I_WIN], a.in[I_BG], GT, lds);
        for (int rs = 0; rs < REP_SYNC; ++rs) GSYNC(); }
        for (int rp = 0; rp < REP_G1; ++rp) {
            pg8::Gemm g{XN, (const bf16_t*)(ws + WS_W1 + l * W1_BYTES), MTOT, N1, 1024}; pg8::G1Order S; S.init(gridDim.x, (int)blockIdx.x, l == 0);
            pg8::EpiIn E{QB, KB, VB, MLB, PZ, GT, a.in[I_QN] + l * 64, a.in[I_KN] + l * 64, a.in[I_BG] + l * 16, (const float*)(ws + WS_ROPE), attn_body::C2};
            pg8::gemm_phase<pg8::EpiIn, pg8::G1Order, true, true>(lds, g, S, E);
        GSYNC(); }
        for (int rp = 0; rp < REP_MIX; ++rp) {
            const int n_ml = 128 * ML_DUP, n_al = 1024 * AL_DUP, n_ac = (l == 0) ? 128 : 0, n_pool = (l == 0) ? 288 : 256, n_all = n_ml + n_al + n_ac + n_pool;
            for (;;) {
                __syncthreads();
                if (tid == 0) item_s[0] = (int)atomicAdd(ctl + 64 * (l * 4 + rp), 1u);
                __syncthreads();
                int it = item_s[0];
                if (it >= n_all) break;
                const int cmask = (rp == 0) ? 15 : MIXREP_MASK;
                if (it < n_ml) { if (!(cmask & 1)) continue; const int itm = it & 127, mb = itm >> 3, mh = (itm >> 1) & 3, md = itm & 1;
                    if (rp == 0) ml::mlstm_item<0>(mb, mh, md, MLB, GT, md ? HS1 : HS, lds); else ml::mlstm_item<ML_VAR>(mb, mh, md, MLB, GT, md ? HS1 : HS, lds);
                    continue; }
                it -= n_ml;
                if (it < n_al) { if (!(cmask & 2)) continue; const int b = (it >> 6) & 15, h = (it >> 3) & 7, qb = it & 7;
                    attn_body::attn_unit<8>((const attn_body::bf16*)(QB + ((size_t)b * TLAT + qb * 256) * 512 + h * 64), (const attn_body::bf16*)(KB + (size_t)b * TKV * 128 + (h >> 2) * 64),
                                            (const attn_body::bf16*)(VB + (size_t)b * TKV * 128 + (h >> 2) * 64), (attn_body::bf16*)(MIX + ((size_t)b * TLAT + qb * 256) * 1024 + h * 64), TKV / 64, (char*)lds_raw);
                    continue; }
                it -= n_al;
                if (it < n_ac) { if (!(cmask & 4)) continue; const int b = it >> 3, h = it & 7;
                    attn_body::attn_unit<8>((const attn_body::bf16*)(QB + ((size_t)NLAT + b * TCTX) * 512 + h * 64), (const attn_body::bf16*)(KB + ((size_t)b * TKV + TLAT) * 128 + (h >> 2) * 64),
                                            (const attn_body::bf16*)(VB + ((size_t)b * TKV + TLAT) * 128 + (h >> 2) * 64), (attn_body::bf16*)(MIX + ((size_t)NLAT + b * TCTX) * 1024 + h * 64), TCTX / 64, (char*)lds_raw);
                    continue; }
                it -= n_ac;
                if (cmask & 8) pool_item(it, PZ, MIX, lds);
            }
        GSYNC(); }
        ml::mlstm_readout_phase(l == 0, HS, HS1, MLB, MIX, a.in[I_MLN] + l * 256);
        GSYNC();
        const int Mrows = (l == 0) ? MTOT : NLAT;
        {
            pg8::Gemm g{MIX, (const bf16_t*)(ws + WS_WO + l * WO_BYTES), Mrows, 1024, 1024, 0}; pg8::StaticOrder S; S.init(Mrows, 1024, gridDim.x, (int)blockIdx.x);
            if (l == 0) { pg8::EpiRes2<false, true> E{xl_in, xc_in, XS, nullptr, modl + 2048}; pg8::gemm_phase<pg8::EpiRes2<false, true>, pg8::StaticOrder, true, true>(lds, g, S, E); }
            else { pg8::EpiRes2<true, true> E{nullptr, nullptr, XS, nullptr, modl + 2048}; pg8::gemm_phase<pg8::EpiRes2<true, true>, pg8::StaticOrder, true, true>(lds, g, S, E); }
        }
        GSYNC();
        for (int rp = 0; rp < REP_N2; ++rp) { norm_phase_bf(XS, a.in[I_NFFN] + l * 1024, modl, 3072, 4096, XN, Mrows);
        GSYNC(); }
        for (int rp = 0; rp < REP_G3; ++rp) {
            pg8::Gemm g{XN, (const bf16_t*)(ws + WS_WGU + l * WGU_BYTES), Mrows, NGU, 1024}; pg8::StaticOrder S; S.init(Mrows, NGU, gridDim.x, (int)blockIdx.x);
            pg8::EpiGU E{HID};
            pg8::gemm_phase<pg8::EpiGU, pg8::StaticOrder, true, true>(lds, g, S, E);
        GSYNC(); }
        {
            pg8::Gemm g{HID, (const bf16_t*)(ws + WS_WD + l * WD_BYTES), NLAT, 1024, DFF, 0}; pg8::StaticOrder S; S.init(NLAT, 1024, gridDim.x, (int)blockIdx.x);
            if (l == 0) { pg8::EpiRes2<true, true> E{nullptr, nullptr, XS, nullptr, modl + 5120}; pg8::gemm_phase<pg8::EpiRes2<true, true>, pg8::StaticOrder, true, true>(lds, g, S, E);
                for (int kc = 0; kc < 2; ++kc) { pg8::Gemm gt{HID + kc * (DFF / 2), (const bf16_t*)(ws + WS_WD) + kc * (DFF / 2), MTOT, 1024, DFF / 2, DFF}; pg8::TailOrder T{(int)blockIdx.x, 64 * kc};
                    pg8::EpiPart EP{(float*)(ws + WS_MIX + 32 * MiB) + (size_t)kc * NCTX * 1024};
                    pg8::gemm_phase<pg8::EpiPart, pg8::TailOrder, true, true>(lds, gt, T, EP); } }
            else { pg8::EpiRes2<true, false> E{nullptr, nullptr, XS, a.out, modl + 5120}; pg8::gemm_phase<pg8::EpiRes2<true, false>, pg8::StaticOrder, true, true>(lds, g, S, E); }
        }
        GSYNC();
    }
    final_norm_phase(a.out, a.in[I_FN]);
}

extern "C" void kernel_launch(void* const* d_in, const int* in_sizes, int n_in, void* d_out, int out_size, void* d_ws, size_t ws_size, hipStream_t stream) {
    static int grid_blocks = 0;
    if (grid_blocks == 0) {
        if (n_in != 20 || ws_size < WS_END) { fprintf(stderr, "kernel_launch: unexpected n_in %d / ws_size %zu\n", n_in, ws_size); grid_blocks = -1; return; }
        int dev = 0, cus = 0, per_cu = 0;
        hipGetDevice(&dev);
        hipDeviceGetAttribute(&cus, hipDeviceAttributeMultiprocessorCount, dev);
        if (hipFuncSetAttribute((const void*)fwd_megakernel, hipFuncAttributeMaxDynamicSharedMemorySize, LDS_BYTES) != hipSuccess) { fprintf(stderr, "kernel_launch: hipFuncSetAttribute failed\n"); grid_blocks = -1; return; }
        if (hipOccupancyMaxActiveBlocksPerMultiprocessor(&per_cu, (const void*)fwd_megakernel, 512, LDS_BYTES) != hipSuccess || per_cu < 1) { fprintf(stderr, "kernel_launch: occupancy query failed (%d)\n", per_cu); grid_blocks = -1; return; }
        grid_blocks = cus * per_cu;
    }
    if (grid_blocks < 0) return;
    hipMemsetAsync((char*)d_ws + WS_CTL, 0, 65536, stream);
    Args a{};
    for (int i = 0; i < 20; ++i) a.in[i] = (const float*)d_in[i];
    a.out = (float*)d_out; a.ws = (unsigned char*)d_ws;
    void* args[] = {&a};
    hipError_t e = hipLaunchCooperativeKernel((const void*)fwd_megakernel, dim3(grid_blocks), dim3(512), args, LDS_BYTES, stream);
    if (e != hipSuccess) fprintf(stderr, "cooperative launch failed: %s (grid %d)\n", hipGetErrorString(e), grid_blocks);
}
```

```cpp
#include <hip/hip_runtime.h>
#include <hip/hip_cooperative_groups.h>
#include <hip/hip_bf16.h>
#include <cstdio>
#include <cstdint>
#include <cmath>
namespace cg = cooperative_groups;

constexpr int DMODEL = 1024, NBATCH = 16, TLAT = 2048, TCTX = 256, NLAT = NBATCH * TLAT, NCTX = NBATCH * TCTX, MTOT = NLAT + NCTX;
constexpr int N1 = 2304, DFF = 2816, NGU = 2 * DFF, TKV = TLAT + TCTX, INW = 2064;
constexpr float EPS = 1e-6f;
constexpr size_t MiB = 1u << 20;
constexpr size_t WS_CTL = 0, WS_MOD = 1 * MiB, WS_ROPE = 2 * MiB, WS_W1 = 4 * MiB, WS_WO = 13 * MiB, WS_WGU = 17 * MiB, WS_WD = 39 * MiB,
                 WS_XC = 50 * MiB, WS_XN = 66 * MiB, WS_QB = 138 * MiB, WS_KB = 174 * MiB, WS_VB = 183 * MiB, WS_MLB = 192 * MiB, WS_PZ = 264 * MiB,
                 WS_GT = 282 * MiB, WS_HS = 285 * MiB, WS_MIX = 321 * MiB, WS_HID = 138 * MiB, WS_HS1 = 393 * MiB, WS_XS = 429 * MiB, WS_END = 501 * MiB;
constexpr size_t W1_BYTES = (size_t)N1 * 1024 * 2, WO_BYTES = (size_t)1024 * 1024 * 2, WGU_BYTES = (size_t)NGU * 1024 * 2, WD_BYTES = (size_t)1024 * DFF * 2;

#define LAS __attribute__((address_space(3)))
typedef unsigned short bf16_t;
typedef float f32x4 __attribute__((ext_vector_type(4)));
typedef unsigned u32x4 __attribute__((ext_vector_type(4)));
typedef short bf16x8 __attribute__((ext_vector_type(8)));

__device__ __forceinline__ unsigned f2bf(float f) { unsigned u = __builtin_bit_cast(unsigned, f); return (u + 0x7fffu + ((u >> 16) & 1u)) >> 16; }
typedef float f32x2_hw __attribute__((ext_vector_type(2))); typedef __bf16 bf16x2_hw __attribute__((ext_vector_type(2)));
__device__ __forceinline__ unsigned pk2(float lo, float hi) { f32x2_hw v = {lo, hi}; bf16x2_hw b = __builtin_convertvector(v, bf16x2_hw); return __builtin_bit_cast(unsigned, b); }
__device__ __forceinline__ unsigned f2bf_hw(float f) { return pk2(f, 0.f) & 0xffffu; }
__device__ __forceinline__ float bf2f(unsigned v) { return __builtin_bit_cast(float, v << 16); }
__device__ __forceinline__ float silu_f(float x) { return x * __builtin_amdgcn_rcpf(1.0f + __expf(-x)); }
__device__ __forceinline__ float sigmoid_f(float x) { return __builtin_amdgcn_rcpf(1.0f + __expf(-x)); }
__device__ __forceinline__ float wave_sum(float v) {
#pragma unroll
    for (int o = 1; o < 64; o <<= 1) v += __shfl_xor(v, o);
    return v;
}
__device__ __forceinline__ int opaque_tid() { int t = threadIdx.x; asm volatile("" : "+v"(t)); return t; }
namespace pg8 {
#define PG8_LAS __attribute__((address_space(3)))
typedef unsigned short bf16_t;
typedef short bf16x8 __attribute__((ext_vector_type(8)));
typedef float f32x4 __attribute__((ext_vector_type(4)));
typedef unsigned u32x4 __attribute__((ext_vector_type(4)));
constexpr int BM = 256, BK = 64, HALF = 128, HTB = HALF * BK * 2  , STAGE_BYTES = 8 * HTB, NXCD = 8, WGM = 8;

__host__ __device__ __forceinline__ int lds_byte(int r, int c) { const int st = (r >> 4) * 2 + (c >> 5), rr = r & 15, cc = c & 31, ob = rr * 64 + cc * 2; return st * 1024 + (ob ^ (((ob >> 9) & 1) << 5)); }
__host__ __device__ __forceinline__ void stage_rc(int b, int& R, int& C) { const int st = b / 1024, sb = b % 1024, swz = sb ^ (((sb >> 9) & 1) << 5); R = (st >> 1) * 16 + swz / 64; C = (st & 1) * 32 + (swz % 64) / 2; }
__host__ __device__ __forceinline__ int perm32(int rho) { const int n = rho >> 4, i = rho & 15; return 8 * (i >> 2) + 4 * n + (i & 3); }

struct Unit { int pm, pn; };
struct Gemm { const bf16_t* A; const bf16_t* Bt; int M, N, K; int ld; };

struct StaticOrder {
    int nM, nN, nwg, G, c;
    __host__ __device__ void init(int M, int N, int G_, int c_) { nM = M / BM; nN = N / BM; nwg = nM * nN; G = G_; c = c_; }
    __host__ __device__ bool next(int i, Unit& u) const {
        const long L = (long)i * G + c; if (L >= nwg) return false;
        int wgid = (int)L; { const int q = nwg / NXCD, r = nwg % NXCD, xcd = wgid % NXCD, off = wgid / NXCD; wgid = (xcd < r ? xcd * (q + 1) : r * (q + 1) + (xcd - r) * q) + off; }
        const int nig = WGM * nN, gid = wgid / nig, fm = gid * WGM, gsz = (nM - fm) < WGM ? (nM - fm) : WGM;
        u.pm = fm + ((wgid % nig) % gsz); u.pn = (wgid % nig) / gsz; return true;
    }
    __device__ __forceinline__ void a_ready(const Unit&) const {}
    __device__ __forceinline__ void done(const Unit&) const {}
};

__device__ __forceinline__ unsigned cvt_pk_bf16(float lo, float hi) { unsigned r; asm volatile("v_cvt_pk_bf16_f32 %0, %1, %2" : "=v"(r) : "v"(lo), "v"(hi)); return r; }
typedef float f32x2 __attribute__((ext_vector_type(2)));
struct G1Order {
    StaticOrder so; int G, c, next_n, npn; int pl0, pl1, pl2, pl3, pl4, pl5, pl6, pl7;
    __device__ void init(int G_, int c_, bool layer0) { so.init(NLAT, N1, G_, c_); G = G_; c = c_;
        if (layer0) { npn = 8; pl0 = 0; pl1 = 1; pl2 = 2; pl3 = 3; pl4 = 4; pl5 = 5; pl6 = 6; pl7 = 7; }
        else { npn = 5; pl0 = 2; pl1 = 3; pl2 = 4; pl3 = 5; pl4 = 8; pl5 = 0; pl6 = 0; pl7 = 0; }
        next_n = 16 * npn; }
    __device__ bool next(int i, Unit& u) const {
        const int L = i * G + c;
        if (L < so.nwg) return so.next(i, u);
        const int e = L - so.nwg; if (e >= next_n) return false;
        const int d = (npn == 8) ? (e >> 3) : ((e * 52429) >> 18); const int q = e - d * npn; u.pm = 128 + d;
        u.pn = (q == 0) ? pl0 : (q == 1) ? pl1 : (q == 2) ? pl2 : (q == 3) ? pl3 : (q == 4) ? pl4 : (q == 5) ? pl5 : (q == 6) ? pl6 : pl7; return true; }
    __device__ __forceinline__ void a_ready(const Unit&) const {}
    __device__ __forceinline__ void done(const Unit&) const {}
};
struct EpiIn {
    static constexpr bool PERM = true, AFTER_DRAIN = false;
    bf16_t *QB, *KB, *VB, *MLB, *PZ; float* GT;
    const float *qn, *kn, *bg; const float* CS;
    float c2;
    __device__ __forceinline__ void operator()(const f32x4 (&acc)[2][2][4][2], const Unit& u, int wr, int wc, int fr, int fq) const {
        const int pn = u.pn, pm = u.pm;
        const bool lat = pm < 128;
        const int rt0 = wr * 64 + fr;
        const size_t grow0 = (size_t)pm * 256 + rt0;
        const size_t kv0 = lat ? ((size_t)(pm >> 3) * TKV + (size_t)(pm & 7) * 256 + rt0) : ((size_t)(pm - 128) * TKV + TLAT + rt0);
        if (pn < 2 || (pn == 2 && wc < 2)) {
            const bool isq = pn < 2;
            const float* nw = isq ? qn : kn;
            f32x4 wv[2][2];
#pragma unroll
            for (int bj = 0; bj < 2; ++bj)
#pragma unroll
                for (int n = 0; n < 2; ++n) wv[bj][n] = *(const f32x4*)(nw + 32 * bj + 8 * fq + 4 * n);
            const float sgn = (fq < 2) ? -1.f : 1.f;
            const float osc = isq ? c2 : 1.f;
#pragma unroll
            for (int ai = 0; ai < 2; ++ai)
#pragma unroll
                for (int m = 0; m < 4; ++m) {
                    float ss = 0.f;
#pragma unroll
                    for (int bj = 0; bj < 2; ++bj)
#pragma unroll
                        for (int n = 0; n < 2; ++n) { const f32x4 v = acc[ai][bj][m][n]; ss += (v[0] * v[0] + v[1] * v[1]) + (v[2] * v[2] + v[3] * v[3]); }
                    ss += __shfl_xor(ss, 16); ss += __shfl_xor(ss, 32);
                    const float rstd = rsqrtf(ss * (1.0f / 64.0f) + EPS);
                    const int roff = ai * 128 + m * 16;
#pragma unroll
                    for (int bj = 0; bj < 2; ++bj) {
                        f32x4 y[2];
#pragma unroll
                        for (int n = 0; n < 2; ++n) y[n] = acc[ai][bj][m][n] * rstd * wv[bj][n];
                        if (lat) {
                            const int pos = (bj == 0) ? ((pm & 7) * 4 + 2 * ai + wr) : (m * 16 + fr);
                            const float* cs = CS + (size_t)pos * 32 + 16 * (fq & 1);
#pragma unroll
                            for (int n = 0; n < 2; ++n) {
                                const f32x4 t0 = *(const f32x4*)(cs + 8 * n), t1 = *(const f32x4*)(cs + 8 * n + 4);
                                f32x4 p;
                                p[0] = __shfl_xor(y[n][0], 32); p[1] = __shfl_xor(y[n][1], 32); p[2] = __shfl_xor(y[n][2], 32); p[3] = __shfl_xor(y[n][3], 32);
                                f32x4 o;
                                o[0] = y[n][0] * t0[0] + sgn * p[0] * t0[1];
                                o[1] = y[n][1] * t0[2] + sgn * p[1] * t0[3];
                                o[2] = y[n][2] * t1[0] + sgn * p[2] * t1[1];
                                o[3] = y[n][3] * t1[2] + sgn * p[3] * t1[3];
                                y[n] = o;
                            }
                        }
                        u32x4 w;
                        w.x = cvt_pk_bf16(y[0][0] * osc, y[0][1] * osc); w.y = cvt_pk_bf16(y[0][2] * osc, y[0][3] * osc);
                        w.z = cvt_pk_bf16(y[1][0] * osc, y[1][1] * osc); w.w = cvt_pk_bf16(y[1][2] * osc, y[1][3] * osc);
                        bf16_t* dst = isq ? (QB + (grow0 + roff) * 512 + (4 * pn + wc) * 64 + 32 * bj + 8 * fq)
                                          : (KB + (kv0 + roff) * 128 + wc * 64 + 32 * bj + 8 * fq);
                        *(u32x4*)dst = w;
                    }
                    asm volatile("" ::: "memory");
                }
        } else if (pn <= 7) {
            bf16_t* base; size_t ld; size_t r0; int cb; float sc = 1.f;
            if (pn == 2) { base = VB; ld = 128; r0 = kv0; cb = (wc - 2) * 64; }
            else if (pn == 7) { base = PZ; ld = 256; r0 = grow0; cb = wc * 64; }
            else { base = MLB; ld = 1024; r0 = grow0; cb = (pn - 3) * 256 + wc * 64; if (pn == 4) sc = 0.125f; }
#pragma unroll
            for (int ai = 0; ai < 2; ++ai)
#pragma unroll
                for (int m = 0; m < 4; ++m)
#pragma unroll
                    for (int bj = 0; bj < 2; ++bj) {
                        const f32x4 v0 = acc[ai][bj][m][0] * sc, v1 = acc[ai][bj][m][1] * sc;
                        u32x4 w; w.x = cvt_pk_bf16(v0[0], v0[1]); w.y = cvt_pk_bf16(v0[2], v0[3]); w.z = cvt_pk_bf16(v1[0], v1[1]); w.w = cvt_pk_bf16(v1[2], v1[3]);
                        *(u32x4*)(base + (r0 + ai * 128 + m * 16) * ld + cb + 32 * bj + 8 * fq) = w;
                    }
        } else {
            if (wc == 0 && fq < 2) {
                const f32x4 b0 = *(const f32x4*)(bg + 8 * fq), b1 = *(const f32x4*)(bg + 8 * fq + 4);
#pragma unroll
                for (int ai = 0; ai < 2; ++ai)
#pragma unroll
                    for (int m = 0; m < 4; ++m) {
                        float* g = GT + (grow0 + ai * 128 + m * 16) * 16 + 8 * fq;
                        *(f32x4*)g = acc[ai][0][m][0] + b0; *(f32x4*)(g + 4) = acc[ai][0][m][1] + b1;
                    }
            }
        }
    }
};
struct EpiRes {
    static constexpr bool PERM = false, AFTER_DRAIN = false;
    const float *base_l, *base_c; float *out_l, *out_c; const float* gate;
    __device__ __forceinline__ void operator()(const f32x4 (&acc)[2][2][4][2], const Unit& u, int wr, int wc, int fr, int fq) const {
        const int pn = u.pn, pm = u.pm; const bool lat = pm < 128;
        const float* gv = gate + (size_t)(lat ? (pm >> 3) : 16) * 6144;
        const float* bp = lat ? base_l + (size_t)pm * 256 * 1024 : base_c + (size_t)(pm - 128) * 256 * 1024;
        float* op = lat ? out_l + (size_t)pm * 256 * 1024 : out_c + (size_t)(pm - 128) * 256 * 1024;
        const int col0 = pn * BM + wc * 32 + 4 * fq;
        f32x4 g4[2][2];
#pragma unroll
        for (int bj = 0; bj < 2; ++bj)
#pragma unroll
            for (int n = 0; n < 2; ++n) g4[bj][n] = *(const f32x4*)(gv + col0 + bj * HALF + n * 16);
#pragma unroll
        for (int ai = 0; ai < 2; ++ai)
#pragma unroll
            for (int m = 0; m < 4; ++m) { const size_t off = (size_t)(ai * HALF + wr * 64 + m * 16 + fr) * 1024 + col0;
#pragma unroll
                for (int bj = 0; bj < 2; ++bj)
#pragma unroll
                    for (int n = 0; n < 2; ++n) { const f32x4 x = *(const f32x4*)(bp + off + bj * HALF + n * 16); *(f32x4*)(op + off + bj * HALF + n * 16) = x + g4[bj][n] * acc[ai][bj][m][n]; }
                if (m & 1) asm volatile("" ::: "memory"); }
    }
};
struct EpiGU {
    static constexpr bool PERM = true, AFTER_DRAIN = false;
    bf16_t* H;
    __device__ __forceinline__ void operator()(const f32x4 (&acc)[2][2][4][2], const Unit& u, int wr, int wc, int fr, int fq) const {
        const size_t row0 = (size_t)u.pm * BM + wr * 64 + fr; const int col0 = u.pn * 128 + wc * 32 + 8 * fq;
#pragma unroll
        for (int ai = 0; ai < 2; ++ai)
#pragma unroll
            for (int m = 0; m < 4; ++m) {
                f32x4 v[2];
#pragma unroll
                for (int n = 0; n < 2; ++n) { const f32x4 g = acc[ai][0][m][n], up = acc[ai][1][m][n];
                    v[n][0] = g[0] * __builtin_amdgcn_rcpf(1.0f + __expf(-g[0])) * up[0]; v[n][1] = g[1] * __builtin_amdgcn_rcpf(1.0f + __expf(-g[1])) * up[1];
                    v[n][2] = g[2] * __builtin_amdgcn_rcpf(1.0f + __expf(-g[2])) * up[2]; v[n][3] = g[3] * __builtin_amdgcn_rcpf(1.0f + __expf(-g[3])) * up[3]; }
                u32x4 w; w.x = cvt_pk_bf16(v[0][0], v[0][1]); w.y = cvt_pk_bf16(v[0][2], v[0][3]); w.z = cvt_pk_bf16(v[1][0], v[1][1]); w.w = cvt_pk_bf16(v[1][2], v[1][3]);
                __builtin_nontemporal_store(w, (u32x4*)(H + (row0 + ai * HALF + m * 16) * DFF + col0));
            }
    }
};
template <bool IN_BF16, bool OUT_BF16> struct EpiRes2 {
    static constexpr bool PERM = true, AFTER_DRAIN = false;
    const float *bl, *bc; bf16_t* xs; float* ol; const float* gate;
    __device__ __forceinline__ void operator()(const f32x4 (&acc)[2][2][4][2], const Unit& u, int wr, int wc, int fr, int fq) const {
        const int pn = u.pn, pm = u.pm; const bool lat = pm < 128;
        const float* gv = gate + (size_t)(lat ? (pm >> 3) : 16) * 6144;
        const int col0 = pn * BM + wc * 32 + 8 * fq;
        const size_t row0 = (size_t)pm * BM + wr * 64 + fr;
        const float* bf = lat ? bl + row0 * 1024 : bc + (row0 - NLAT) * 1024;
        f32x4 g4[2][2];
#pragma unroll
        for (int bj = 0; bj < 2; ++bj)
#pragma unroll
            for (int n = 0; n < 2; ++n) g4[bj][n] = *(const f32x4*)(gv + col0 + bj * HALF + 4 * n);
#pragma unroll
        for (int ai = 0; ai < 2; ++ai)
#pragma unroll
            for (int m = 0; m < 4; ++m) { const size_t ro = (size_t)(ai * HALF + m * 16) * 1024;
#pragma unroll
                for (int bj = 0; bj < 2; ++bj) { const int c = col0 + bj * HALF;
                    f32x4 x0, x1;
                    if (IN_BF16) { const u32x4 v = *(const u32x4*)(xs + row0 * 1024 + ro + c);
                        x0 = (f32x4){__builtin_bit_cast(float, v.x << 16), __builtin_bit_cast(float, v.x & 0xffff0000u), __builtin_bit_cast(float, v.y << 16), __builtin_bit_cast(float, v.y & 0xffff0000u)};
                        x1 = (f32x4){__builtin_bit_cast(float, v.z << 16), __builtin_bit_cast(float, v.z & 0xffff0000u), __builtin_bit_cast(float, v.w << 16), __builtin_bit_cast(float, v.w & 0xffff0000u)}; }
                    else { x0 = *(const f32x4*)(bf + ro + c); x1 = *(const f32x4*)(bf + ro + c + 4); }
                    x0 = x0 + g4[bj][0] * acc[ai][bj][m][0]; x1 = x1 + g4[bj][1] * acc[ai][bj][m][1];
                    if (OUT_BF16) { u32x4 w; w.x = cvt_pk_bf16(x0[0], x0[1]); w.y = cvt_pk_bf16(x0[2], x0[3]); w.z = cvt_pk_bf16(x1[0], x1[1]); w.w = cvt_pk_bf16(x1[2], x1[3]);
                        *(u32x4*)(xs + row0 * 1024 + ro + c) = w; }
                    else { *(f32x4*)(ol + row0 * 1024 + ro + c) = x0; *(f32x4*)(ol + row0 * 1024 + ro + c + 4) = x1; } }
                if (IN_BF16 ? (m == 3) : (m & 1)) asm volatile("" ::: "memory"); }
    }
};
struct TailOrder {
    int c, c0;
    __device__ bool next(int i, Unit& u) const { const int e = c - c0; if (i != 0 || e < 0 || e >= 64) return false; u.pn = e & 3; u.pm = 128 + (e >> 2); return true; }
    __device__ __forceinline__ void a_ready(const Unit&) const {}
    __device__ __forceinline__ void done(const Unit&) const {}
};
struct EpiPart {
    static constexpr bool PERM = true, AFTER_DRAIN = false;
    float* P;
    __device__ __forceinline__ void operator()(const f32x4 (&acc)[2][2][4][2], const Unit& u, int wr, int wc, int fr, int fq) const {
        float* op = P + ((size_t)(u.pm - 128) * BM + wr * 64 + fr) * 1024 + u.pn * BM + wc * 32 + 8 * fq;
#pragma unroll
        for (int ai = 0; ai < 2; ++ai)
#pragma unroll
            for (int m = 0; m < 4; ++m)
#pragma unroll
                for (int bj = 0; bj < 2; ++bj) { float* o = op + (size_t)(ai * HALF + m * 16) * 1024 + bj * HALF; *(f32x4*)o = acc[ai][bj][m][0]; *(f32x4*)(o + 4) = acc[ai][bj][m][1]; }
    }
};
template <class Epi, class Sched, bool ALIGN_EPI = false, bool SP2 = false>
__device__ __forceinline__ void gemm_phase(PG8_LAS unsigned char* lds, const Gemm g, const Sched& S, const Epi& E) {
    const int tid = opaque_tid(), wid = __builtin_amdgcn_readfirstlane(tid >> 6), lane = tid & 63, wr = wid >> 2, wc = wid & 3, fr = lane & 15, fq = lane >> 4;
    const int K = g.ld ? g.ld : g.K, nt = g.K / BK;
    unsigned voffA[2], voffB[2];
#pragma unroll
    for (int i = 0; i < 2; ++i) { int R, C; stage_rc(tid * 16 + i * 8192, R, C); const int Rb = Epi::PERM ? ((R & ~31) + perm32(R & 31)) : R;
        voffA[i] = (unsigned)(R * K + C) * 2u; voffB[i] = (unsigned)(Rb * K + C) * 2u; }
    const size_t kstep = (size_t)(BK * 2);
    const size_t hstep = (size_t)HALF * K * 2;
    const size_t tstep = 2 * hstep;
    const unsigned ldsw = (unsigned)wid * 1024u;
    const int aoff = lds_byte(wr * 64 + fr, fq * 8), boff = lds_byte(wc * 32 + fr, fq * 8);
#define PG8_SA(b, h) (((b) * 2 + (h)) * HTB)
#define PG8_SB(b, h) ((4 + (b) * 2 + (h)) * HTB)
#define PG8_STAGE(bufoff, gbase, voff) do { _Pragma("unroll") for (int _i = 0; _i < 2; ++_i) \
        __builtin_amdgcn_global_load_lds((const unsigned*)((const char*)(gbase) + (voff)[_i]), (PG8_LAS unsigned*)(lds + (bufoff) + ldsw + _i * 8192), 16, 0, 0); } while (0)
#define PG8_LDA(dst, b, h) do { _Pragma("unroll") for (int m = 0; m < 4; ++m) _Pragma("unroll") for (int k = 0; k < 2; ++k) dst[m][k] = *(const PG8_LAS bf16x8*)(lds + PG8_SA(b, h) + aoff + m * 2048 + k * 1024); } while (0)
#define PG8_LDB(dst, b, h) do { _Pragma("unroll") for (int n = 0; n < 2; ++n) _Pragma("unroll") for (int k = 0; k < 2; ++k) dst[n][k] = *(const PG8_LAS bf16x8*)(lds + PG8_SB(b, h) + boff + n * 2048 + k * 1024); } while (0)
#define PG8_MMA(ai, bj, At, Bt) do { __builtin_amdgcn_s_setprio(1); _Pragma("unroll") for (int m = 0; m < 4; ++m) _Pragma("unroll") for (int n = 0; n < 2; ++n) _Pragma("unroll") for (int k = 0; k < 2; ++k) \
        acc[ai][bj][m][n] = __builtin_amdgcn_mfma_f32_16x16x32_bf16(Bt[n][k], At[m][k], acc[ai][bj][m][n], 0, 0, 0); __builtin_amdgcn_s_setprio(0); } while (0)
#define PG8_WAIT_V(n) asm volatile("s_waitcnt vmcnt(" #n ")" ::: "memory")
#define PG8_WAIT_L(n) asm volatile("s_waitcnt lgkmcnt(" #n ")" ::: "memory")
#define PG8_BAR __builtin_amdgcn_s_barrier()
#define PG8_SCHED __builtin_amdgcn_sched_barrier(0)
    Unit cur, nxt; int ui = 0;
    if (!S.next(0, cur)) return;
    f32x4 acc[2][2][4][2];
#pragma unroll
    for (int a = 0; a < 2; ++a)
#pragma unroll
        for (int b = 0; b < 2; ++b)
#pragma unroll
            for (int m = 0; m < 4; ++m)
#pragma unroll
                for (int n = 0; n < 2; ++n) acc[a][b][m][n] = (f32x4){0.f, 0.f, 0.f, 0.f};
    bf16x8 At[4][2], B0[2][2], B1[2][2];
    const char* cA = (const char*)g.A + (size_t)cur.pm * tstep; const char* cB = (const char*)g.Bt + (size_t)cur.pn * tstep;
    S.a_ready(cur);
    if constexpr (SP2) {
        PG8_STAGE(PG8_SB(0, 0), cB, voffB); PG8_STAGE(PG8_SB(0, 1), cB + hstep, voffB); PG8_STAGE(PG8_SA(0, 0), cA, voffA); PG8_STAGE(PG8_SA(0, 1), cA + hstep, voffA);
        if (wr == 1) PG8_BAR;
        PG8_WAIT_V(2); PG8_BAR;
        PG8_STAGE(PG8_SB(1, 0), cB + kstep, voffB); PG8_STAGE(PG8_SA(1, 0), cA + kstep, voffA); PG8_STAGE(PG8_SB(1, 1), cB + hstep + kstep, voffB);
        PG8_WAIT_V(6); PG8_BAR;
    } else {
        PG8_STAGE(PG8_SB(0, 0), cB, voffB); PG8_STAGE(PG8_SA(0, 0), cA, voffA); PG8_STAGE(PG8_SB(0, 1), cB + hstep, voffB); PG8_STAGE(PG8_SA(0, 1), cA + hstep, voffA);
        if (wr == 1) PG8_BAR;
        PG8_WAIT_V(4); PG8_BAR;
        PG8_STAGE(PG8_SB(1, 0), cB + kstep, voffB); PG8_STAGE(PG8_SA(1, 0), cA + kstep, voffA); PG8_STAGE(PG8_SB(1, 1), cB + hstep + kstep, voffB);
        PG8_WAIT_V(6); PG8_BAR;
    }
    for (;;) {
        const bool has_next = S.next(ui + 1, nxt);
        const char* nA = has_next ? (const char*)g.A + (size_t)nxt.pm * tstep : cA; const char* nB = has_next ? (const char*)g.Bt + (size_t)nxt.pn * tstep : cB;
        for (int t = 0; t < nt; t += 2) {
            const bool last = (t == nt - 2);
            const char* a1 = cA + (size_t)(t + 1) * kstep;
            const char* a2 = last ? nA : cA + (size_t)(t + 2) * kstep; const char* b2 = last ? nB : cB + (size_t)(t + 2) * kstep;
            const char* a3 = a2 + kstep; const char* b3 = b2 + kstep;
            if (last && has_next) S.a_ready(nxt);
            if constexpr (SP2) {
            PG8_LDB(B0, 0, 0); PG8_LDB(B1, 0, 1); PG8_SCHED; PG8_LDA(At, 0, 0); PG8_STAGE(PG8_SA(1, 1), a1 + hstep, voffA);
            PG8_WAIT_V(8); PG8_WAIT_L(0); PG8_BAR; PG8_MMA(0, 0, At, B0); PG8_MMA(0, 1, At, B1); PG8_BAR; PG8_SCHED;
            PG8_LDA(At, 0, 1); PG8_STAGE(PG8_SB(0, 0), b2, voffB); PG8_STAGE(PG8_SB(0, 1), b2 + hstep, voffB); PG8_STAGE(PG8_SA(0, 0), a2, voffA);
            PG8_WAIT_V(8); PG8_WAIT_L(0); PG8_BAR; PG8_MMA(1, 0, At, B0); PG8_MMA(1, 1, At, B1); PG8_BAR; PG8_SCHED;
            PG8_LDB(B0, 1, 0); PG8_LDB(B1, 1, 1); PG8_SCHED; PG8_LDA(At, 1, 0); PG8_STAGE(PG8_SA(0, 1), a2 + hstep, voffA);
            PG8_WAIT_V(8); PG8_WAIT_L(0); PG8_BAR; PG8_MMA(0, 0, At, B0); PG8_MMA(0, 1, At, B1); PG8_BAR; PG8_SCHED;
            PG8_LDA(At, 1, 1); PG8_STAGE(PG8_SB(1, 0), b3, voffB); PG8_STAGE(PG8_SB(1, 1), b3 + hstep, voffB); PG8_STAGE(PG8_SA(1, 0), a3, voffA);
            PG8_WAIT_V(8); PG8_WAIT_L(0); PG8_BAR; PG8_MMA(1, 0, At, B0); PG8_MMA(1, 1, At, B1); PG8_BAR; PG8_SCHED;
            } else {
            PG8_LDB(B0, 0, 0); PG8_SCHED; PG8_LDA(At, 0, 0); PG8_STAGE(PG8_SA(1, 1), a1 + hstep, voffA);
            PG8_WAIT_L(8); PG8_BAR; PG8_WAIT_L(0); PG8_MMA(0, 0, At, B0); PG8_BAR; PG8_SCHED;
            PG8_LDB(B1, 0, 1); PG8_STAGE(PG8_SB(0, 0), b2, voffB);
            PG8_BAR; PG8_WAIT_L(0); PG8_MMA(0, 1, At, B1); PG8_BAR;
            PG8_LDA(At, 0, 1); PG8_STAGE(PG8_SA(0, 0), a2, voffA);
            PG8_BAR; PG8_WAIT_L(0); PG8_MMA(1, 0, At, B0); PG8_BAR; PG8_SCHED;
            PG8_STAGE(PG8_SB(0, 1), b2 + hstep, voffB);
            PG8_WAIT_V(6); PG8_BAR; PG8_MMA(1, 1, At, B1); PG8_BAR;
            PG8_LDB(B0, 1, 0); PG8_SCHED; PG8_LDA(At, 1, 0); PG8_STAGE(PG8_SA(0, 1), a2 + hstep, voffA);
            PG8_WAIT_L(8); PG8_BAR; PG8_WAIT_L(0); PG8_MMA(0, 0, At, B0); PG8_BAR; PG8_SCHED;
            PG8_LDB(B1, 1, 1); PG8_STAGE(PG8_SB(1, 0), b3, voffB);
            PG8_BAR; PG8_WAIT_L(0); PG8_MMA(0, 1, At, B1); PG8_BAR;
            PG8_LDA(At, 1, 1); PG8_STAGE(PG8_SA(1, 0), a3, voffA);
            PG8_BAR; PG8_WAIT_L(0); PG8_MMA(1, 0, At, B0); PG8_BAR; PG8_SCHED;
            PG8_STAGE(PG8_SB(1, 1), b3 + hstep, voffB);
            PG8_WAIT_V(6); PG8_BAR; PG8_MMA(1, 1, At, B1); PG8_BAR;
            }
        }
        if constexpr (ALIGN_EPI) { if (wr == 0) PG8_BAR; }
        if constexpr (!Epi::AFTER_DRAIN) { E(acc, cur, wr, wc, fr, fq); S.done(cur); }
        if (!has_next) break;
#pragma unroll
        for (int a = 0; a < 2; ++a)
#pragma unroll
            for (int b = 0; b < 2; ++b)
#pragma unroll
                for (int m = 0; m < 4; ++m)
#pragma unroll
                    for (int n = 0; n < 2; ++n) acc[a][b][m][n] = (f32x4){0.f, 0.f, 0.f, 0.f};
        cur = nxt; cA = nA; cB = nB; ++ui;
        if constexpr (ALIGN_EPI) { if (wr == 1) PG8_BAR; }
    }
    PG8_WAIT_V(0);
    if constexpr (!ALIGN_EPI) { if (wr == 0) PG8_BAR; }
    PG8_BAR;
    if constexpr (Epi::AFTER_DRAIN) { E.fused(acc, cur, wr, wc, fr, fq, lds, wid, lane); S.done(cur); }
#undef PG8_SA
#undef PG8_SB
#undef PG8_STAGE
#undef PG8_LDA
#undef PG8_LDB
#undef PG8_MMA
#undef PG8_WAIT_V
#undef PG8_WAIT_L
#undef PG8_BAR
#undef PG8_SCHED
}
}

namespace attn_body {
using bf16=__hip_bfloat16;
using bf16x8=__attribute__((ext_vector_type(8)))short;
using s16x4=__attribute__((ext_vector_type(4)))short;
using f32x16=__attribute__((ext_vector_type(16)))float;
using u32x4=__attribute__((ext_vector_type(4)))unsigned;
constexpr int D=64,QP=512,KP=128,OP=1024;
constexpr int NW=8,QBLK=32,QB=QBLK*NW,KVBLK=64;
__device__ __forceinline__ int crow(int r,int hi){return (r&3)+8*(r>>2)+4*hi;}
#define SBAR() __builtin_amdgcn_sched_barrier(0)
constexpr int NSLOT=3, SLOTB=8192;
constexpr int LDS_K=0, LDS_V=NSLOT*SLOTB, LDS_WS=2*NSLOT*SLOTB, LDS_OST=LDS_WS+NW*64*4, LDS_BYTES=LDS_OST+NW*4096;
constexpr float C2=0.125f*1.4426950408889634f;
__device__ __forceinline__ void glds16(const void*gsrc,unsigned lds_dst){unsigned keep;
  asm volatile("s_mov_b32 %0, m0\n\ts_mov_b32 m0, %2\n\ts_nop 0\n\tglobal_load_lds_dwordx4 %1, off\n\ts_mov_b32 m0, %0":"=&s"(keep):"v"(gsrc),"s"(lds_dst):"memory");}
__device__ __forceinline__ float max3f(float a,float b,float c){float r;asm("v_max3_f32 %0, %1, %2, %3":"=v"(r):"v"(a),"v"(b),"v"(c));return r;}
__device__ __forceinline__ float max2f(float a,float b){float r;asm("v_max_f32_e32 %0, %1, %2":"=v"(r):"v"(a),"v"(b));return r;}
__device__ __forceinline__ float fadd_s(float a,float b){float r;asm("v_add_f32_e32 %0, %1, %2":"=v"(r):"v"(a),"v"(b));return r;}
__device__ __forceinline__ float fsub_s(float a,float b){float r;asm("v_sub_f32_e32 %0, %1, %2":"=v"(r):"v"(a),"v"(b));return r;}
typedef float f32x2_t __attribute__((ext_vector_type(2))); typedef __bf16 bf16x2_t __attribute__((ext_vector_type(2)));
__device__ __forceinline__ unsigned cvtpk_s(float lo,float hi){f32x2_t v={lo,hi};bf16x2_t b=__builtin_convertvector(v,bf16x2_t);return __builtin_bit_cast(unsigned,b);}
#define WAIT_BAR(N) asm volatile("s_waitcnt vmcnt(" #N ") lgkmcnt(0)\n\ts_barrier":::"memory")

__device__ __forceinline__ void qkt(f32x16&p0,f32x16&p1,const char*Kslot,const bf16x8*qr,const f32x16&negm,int r32,int hi){
  const char*kb=Kslot+hi*1024+r32*16;
  #pragma unroll
  for(int d0=0;d0<4;++d0){
    const bf16x8 b0=*reinterpret_cast<const bf16x8*>(kb+d0*2048);
    const bf16x8 b1=*reinterpret_cast<const bf16x8*>(kb+d0*2048+512);
    if(d0==0){p0=__builtin_amdgcn_mfma_f32_32x32x16_bf16(b0,qr[0],negm,0,0,0);p1=__builtin_amdgcn_mfma_f32_32x32x16_bf16(b1,qr[0],negm,0,0,0);}
    else{p0=__builtin_amdgcn_mfma_f32_32x32x16_bf16(b0,qr[d0],p0,0,0,0);p1=__builtin_amdgcn_mfma_f32_32x32x16_bf16(b1,qr[d0],p1,0,0,0);}}
}
typedef __attribute__((address_space(3))) const char* lds_cptr;
typedef short v4i16_t __attribute__((ext_vector_type(4)));
__device__ __forceinline__ void kload8(bf16x8*kf,lds_cptr kp){
  kf[0]=*(const __attribute__((address_space(3))) bf16x8*)(kp);      kf[1]=*(const __attribute__((address_space(3))) bf16x8*)(kp+512);
  kf[2]=*(const __attribute__((address_space(3))) bf16x8*)(kp+2048); kf[3]=*(const __attribute__((address_space(3))) bf16x8*)(kp+2560);
  kf[4]=*(const __attribute__((address_space(3))) bf16x8*)(kp+4096); kf[5]=*(const __attribute__((address_space(3))) bf16x8*)(kp+4608);
  kf[6]=*(const __attribute__((address_space(3))) bf16x8*)(kp+6144); kf[7]=*(const __attribute__((address_space(3))) bf16x8*)(kp+6656);
}
__device__ __forceinline__ void kload2(bf16x8*kf,lds_cptr kp,int j){ kf[2*j]=*(const __attribute__((address_space(3))) bf16x8*)(kp+j*2048); kf[2*j+1]=*(const __attribute__((address_space(3))) bf16x8*)(kp+j*2048+512); }
__device__ __forceinline__ s16x4 vtr(lds_cptr p){ return __builtin_bit_cast(s16x4,__builtin_amdgcn_ds_read_tr16_b64_v4i16((__attribute__((address_space(3))) v4i16_t*)p)); }
__device__ __forceinline__ float rowmax(const f32x16&p0,const f32x16&p1){
  float a=max3f(p0[0],p0[1],p1[0]),b=max3f(p0[2],p0[3],p1[1]);a=max3f(a,p1[2],p1[3]);
  #pragma unroll
  for(int r=4;r<16;r+=4){a=max3f(a,p0[r],p0[r+1]);b=max3f(b,p0[r+2],p0[r+3]);a=max3f(a,p1[r],p1[r+1]);b=max3f(b,p1[r+2],p1[r+3]);}
  const float m=max2f(a,b);
  auto rr=__builtin_amdgcn_permlane32_swap(__float_as_uint(m),__float_as_uint(m),false,false);
  return max2f(__uint_as_float(rr[0]),__uint_as_float(rr[1]));
}
__device__ __forceinline__ void pv(f32x16*o,int vb,bf16x8 pa0,bf16x8 pa1,bf16x8 pa2,bf16x8 pa3){
  #pragma unroll
  for(int d0=0;d0<2;++d0){s16x4 lo[4],hi[4];
    #pragma unroll
    for(int ks=0;ks<4;++ks){
      asm volatile("ds_read_b64_tr_b16 %0,%1 offset:%c2":"=&v"(lo[ks]):"v"(vb),"i"(d0*4096+ks*1024):"memory");
      asm volatile("ds_read_b64_tr_b16 %0,%1 offset:%c2":"=&v"(hi[ks]):"v"(vb),"i"(d0*4096+ks*1024+512):"memory");}
    asm volatile("s_waitcnt lgkmcnt(0)":::"memory");SBAR();
    #define PK(k) (bf16x8){lo[k][0],lo[k][1],lo[k][2],lo[k][3],hi[k][0],hi[k][1],hi[k][2],hi[k][3]}
    o[d0]=__builtin_amdgcn_mfma_f32_32x32x16_bf16(pa0,PK(0),o[d0],0,0,0);
    o[d0]=__builtin_amdgcn_mfma_f32_32x32x16_bf16(pa1,PK(1),o[d0],0,0,0);
    o[d0]=__builtin_amdgcn_mfma_f32_32x32x16_bf16(pa2,PK(2),o[d0],0,0,0);
    o[d0]=__builtin_amdgcn_mfma_f32_32x32x16_bf16(pa3,PK(3),o[d0],0,0,0);
    #undef PK
  }
}

#ifndef ATTN_STORE16
#define ATTN_STORE16(p,v) (*(u32x4*)(p)=(v))
#endif
template<int THRL> __device__ __forceinline__ void attn_unit(const bf16*Q,const bf16*__restrict__ K,const bf16*__restrict__ V,bf16*O,const int NT,char*shm){
  const int tid=opaque_tid(),lane=tid&63,r32=lane&31,hi=lane>>5; const int wid=__builtin_amdgcn_readfirstlane(tid>>6);
  const bf16*Qw=Q+(long)(wid*QBLK)*QP;
  const bf16*Kh=K,*Vh=V;
  const unsigned lds0=(unsigned)(uintptr_t)shm;
  float*wsf=(float*)(shm+LDS_WS)+wid*64;
  const bf16*ksrc=Kh+(long)lane*KP+wid*8;
  const bf16*vsrc=Vh+(long)(16*(wid&3)+(lane>>2))*KP+(wid>>2)*32+(lane&3)*8;
  const unsigned kdst=lds0+LDS_K+wid*1024, vdst=lds0+LDS_V+wid*1024;
  #define DMA_K(t,slot) glds16(ksrc+(long)(t)*KVBLK*KP,(unsigned)__builtin_amdgcn_readfirstlane(kdst+(slot)))
  #define DMA_V(t,slot) glds16(vsrc+(long)(t)*KVBLK*KP,(unsigned)__builtin_amdgcn_readfirstlane(vdst+(slot)))
  const int vb0=(int)(lds0+LDS_V)+((lane>>4)&1)*32+(lane&3)*8+(4*hi+((lane&15)>>2))*64;
  const char*Kbase=shm+LDS_K; bf16x8 kf[8];
  const lds_cptr shm3=(lds_cptr)shm; const lds_cptr kp0=shm3+LDS_K+hi*1024+r32*16; const lds_cptr vp0=shm3+LDS_V+((lane>>4)&1)*32+(lane&3)*8+(4*hi+((lane&15)>>2))*64;
  DMA_K(0,0);DMA_V(0,0);DMA_K(1,SLOTB);
  bf16x8 qr[4];
  #pragma unroll
  for(int d0=0;d0<4;++d0)qr[d0]=*reinterpret_cast<const bf16x8*>(&Qw[(long)r32*QP+d0*16+hi*8]);
  float mhat=0.f,l_reg=0.f;f32x16 o[2];o[0]=f32x16{};o[1]=f32x16{};f32x16 negm=f32x16{};asm volatile("":"+v"(negm));
  #define CMASK(P0,P1,t) do{}while(0)
  bool resc=false;
  #define START(P0,P1) do{ const float rm=rowmax(P0,P1); resc=false; \
    { const float dl=rm; mhat=fadd_s(mhat,dl); \
      _Pragma("unroll") for(int r=0;r<16;++r){P0[r]=fsub_s(P0[r],dl);P1[r]=fsub_s(P1[r],dl);} \
      _Pragma("unroll") for(int r=0;r<16;++r)negm[r]=-mhat; asm volatile("":"+v"(negm)); } \
    _Pragma("unroll") for(int r=0;r<16;++r)P0[r]=__builtin_amdgcn_exp2f(P0[r]); }while(0)
  #define RESC() do{ if(resc){ asm volatile("s_waitcnt lgkmcnt(0)":::"memory"); \
      _Pragma("unroll") for(int d_=0;d_<2;++d_) _Pragma("unroll") for(int r=0;r<16;++r)o[d_][r]*=wsf[crow(r,hi)]; } }while(0)
  f32x16 pA0,pA1,pB0,pB1;
  int sl_prev=0,sl_cur=0,sl_next=SLOTB;
  #define ROT() do{sl_prev=sl_cur;sl_cur=sl_next;sl_next=(sl_next==(NSLOT-1)*SLOTB)?0:sl_next+SLOTB;}while(0)
  DMA_K(2,2*SLOTB);
  WAIT_BAR(3);
  qkt(pA0,pA1,Kbase,qr,negm,r32,hi);asm volatile("s_nop 15\n\ts_nop 7":"+v"(pA0),"+v"(pA1));CMASK(pA0,pA1,0);
  START(pA0,pA1);
  _Pragma("unroll") for(int r=0;r<16;++r)pA1[r]=__builtin_amdgcn_exp2f(pA1[r]);
  WAIT_BAR(0);
  DMA_K(3,0);DMA_V(1,SLOTB);
  ROT();
  kload8(kf,kp0+sl_cur);
  WAIT_BAR(2);
  s16x4 vlo[8],vhi[8]; u32x4 pw0,pw1,pw2,pw3;
  #define PKW(P,B) cvtpk_s(P[B],P[B+1])
  #define PAF(k) __builtin_bit_cast(bf16x8,pw##k)
  #define VFR(i) (bf16x8){vlo[i][0],vlo[i][1],vlo[i][2],vlo[i][3],vhi[i][0],vhi[i][1],vhi[i][2],vhi[i][3]}
  #define PIN(x) asm volatile("":"+v"(x))
  #define MX3(a,b,c) __builtin_fmaxf(__builtin_fmaxf((a),(b)),(c))
  #define GAPA(MF,A0,A1,A2,A3,W0,W1,PW) do{ MF; sacc+=A0; sacc+=A1; sacc+=A2; sacc+=A3; PIN(sacc); W0; W1; PIN(PW); SBAR(); }while(0)
  #define EX(v) __builtin_amdgcn_exp2f(v)
  #define GAPB(MF,X,B) do{ MF; X[B]=EX(X[B]); X[B+1]=EX(X[B+1]); X[B+2]=EX(X[B+2]); X[B+3]=EX(X[B+3]); PIN(X); SBAR(); }while(0)
  #define VRD(i) do{ vlo[i]=vtr(vp_+(((i)>>2)*4096+((i)&3)*1024)); vhi[i]=vtr(vp_+(((i)>>2)*4096+((i)&3)*1024+512)); }while(0)
  #define KRD(G,j) do{ if(G){ kload2(kf,kp0+sl_next,j); SBAR(); } }while(0)
  #define STEP(C0,C1,P0,P1,t,GK,GV,GL) do{ SBAR(); \
    const lds_cptr vp_=vp0+sl_prev; \
    VRD(0); SBAR(); float sacc=(P0[0]+P0[1]); \
    GAPA(C0=__builtin_amdgcn_mfma_f32_32x32x16_bf16(kf[0],qr[0],negm,0,0,0), P0[2],P0[3],P0[4],P0[5],     pw0[0]=PKW(P0,0), pw0[1]=PKW(P0,2), pw0); \
    VRD(4); SBAR(); GAPA(C1=__builtin_amdgcn_mfma_f32_32x32x16_bf16(kf[1],qr[0],negm,0,0,0), P0[6],P0[7],P0[8],P0[9],     pw0[2]=PKW(P0,4), pw0[3]=PKW(P0,6), pw0); \
    VRD(1); SBAR(); GAPA(C0=__builtin_amdgcn_mfma_f32_32x32x16_bf16(kf[2],qr[1],C0,0,0,0),   P0[10],P0[11],P0[12],P0[13], pw1[0]=PKW(P0,8), pw1[1]=PKW(P0,10), pw1); \
    VRD(5); SBAR(); GAPA(C1=__builtin_amdgcn_mfma_f32_32x32x16_bf16(kf[3],qr[1],C1,0,0,0),   P0[14],P0[15],P1[0],P1[1],   pw1[2]=PKW(P0,12),pw1[3]=PKW(P0,14), pw1); \
    VRD(2); SBAR(); GAPA(C0=__builtin_amdgcn_mfma_f32_32x32x16_bf16(kf[4],qr[2],C0,0,0,0),   P1[2],P1[3],P1[4],P1[5],     pw2[0]=PKW(P1,0), pw2[1]=PKW(P1,2), pw2); \
    VRD(6); SBAR(); GAPA(C1=__builtin_amdgcn_mfma_f32_32x32x16_bf16(kf[5],qr[2],C1,0,0,0),   P1[6],P1[7],P1[8],P1[9],     pw2[2]=PKW(P1,4), pw2[3]=PKW(P1,6), pw2); \
    VRD(3); SBAR(); GAPA(C0=__builtin_amdgcn_mfma_f32_32x32x16_bf16(kf[6],qr[3],C0,0,0,0),   P1[10],P1[11],P1[12],P1[13], pw3[0]=PKW(P1,8), pw3[1]=PKW(P1,10), pw3); \
    VRD(7); SBAR(); GAPA(C1=__builtin_amdgcn_mfma_f32_32x32x16_bf16(kf[7],qr[3],C1,0,0,0),   P1[14],P1[15],0.f,0.f,       pw3[2]=PKW(P1,12),pw3[3]=PKW(P1,14), pw3); \
    l_reg+=sacc; \
    if(GK){DMA_K((t)+3,sl_cur);} if(GV){DMA_V((t)+1,sl_next);} \
    CMASK(C0,C1,t); \
    { float a=MX3(C0[0],C0[1],C1[0]),b=MX3(C0[2],C0[3],C1[1]); a=MX3(a,C1[2],C1[3]); \
      _Pragma("unroll") for(int r=4;r<16;r+=4){a=MX3(a,C0[r],C0[r+1]);b=MX3(b,C0[r+2],C0[r+3]);a=MX3(a,C1[r],C1[r+1]);b=MX3(b,C1[r+2],C1[r+3]);} \
      float rm=__builtin_fmaxf(a,b); { auto rr=__builtin_amdgcn_permlane32_swap(__float_as_uint(rm),__float_as_uint(rm),false,false); rm=__builtin_fmaxf(__uint_as_float(rr[0]),__uint_as_float(rr[1])); } \
      resc=false; \
      if(__builtin_expect(__any(rm>(float)THRL),0)){ const float dl=__builtin_fmaxf(rm,0.f); mhat+=dl; \
        _Pragma("unroll") for(int r=0;r<16;++r){C0[r]-=dl;C1[r]-=dl;} \
        _Pragma("unroll") for(int r=0;r<16;++r)negm[r]=-mhat; asm volatile("":"+v"(negm)); \
        const float f=__builtin_amdgcn_exp2f(-dl); l_reg*=f; if(hi==0)wsf[r32]=f; resc=true; } } \
    SBAR(); \
    GAPB(o[0]=__builtin_amdgcn_mfma_f32_32x32x16_bf16(PAF(0),VFR(0),o[0],0,0,0), C0,0); \
    GAPB(o[1]=__builtin_amdgcn_mfma_f32_32x32x16_bf16(PAF(0),VFR(4),o[1],0,0,0), C0,4); \
    KRD(GL,0); GAPB(o[0]=__builtin_amdgcn_mfma_f32_32x32x16_bf16(PAF(1),VFR(1),o[0],0,0,0), C0,8); \
    KRD(GL,1); GAPB(o[1]=__builtin_amdgcn_mfma_f32_32x32x16_bf16(PAF(1),VFR(5),o[1],0,0,0), C0,12); \
    KRD(GL,2); GAPB(o[0]=__builtin_amdgcn_mfma_f32_32x32x16_bf16(PAF(2),VFR(2),o[0],0,0,0), C1,0); \
    KRD(GL,3); GAPB(o[1]=__builtin_amdgcn_mfma_f32_32x32x16_bf16(PAF(2),VFR(6),o[1],0,0,0), C1,4); \
    GAPB(o[0]=__builtin_amdgcn_mfma_f32_32x32x16_bf16(PAF(3),VFR(3),o[0],0,0,0), C1,8); \
    GAPB(o[1]=__builtin_amdgcn_mfma_f32_32x32x16_bf16(PAF(3),VFR(7),o[1],0,0,0), C1,12); \
    }while(0)
  int t=1;
  #undef CMASK
  #define CMASK(P0,P1,t) do{}while(0)
  for(;t+5<NT;t+=2){
    STEP(pB0,pB1,pA0,pA1,t,true,true,true);     WAIT_BAR(2); RESC(); ROT();
    STEP(pA0,pA1,pB0,pB1,t+1,true,true,true);   WAIT_BAR(2); RESC(); ROT();
  }
  #undef CMASK
  #define CMASK(P0,P1,t) do{}while(0)
  #define ENDW(tt) do{ if((tt)+3<NT){WAIT_BAR(2);} else if((tt)+2<NT){WAIT_BAR(1);} else {WAIT_BAR(0);} }while(0)
  for(;t+1<NT;t+=2){
    STEP(pB0,pB1,pA0,pA1,t,(t+3<NT),(t+1<NT),(t+1<NT));       ENDW(t);   RESC(); ROT();
    STEP(pA0,pA1,pB0,pB1,t+1,(t+4<NT),(t+2<NT),(t+2<NT));     ENDW(t+1); RESC(); ROT();
  }
  STEP(pB0,pB1,pA0,pA1,NT-1,false,false,false); RESC();
  { float sacc=pB0[0]+pB0[1]; _Pragma("unroll") for(int r=2;r<16;++r)sacc+=pB0[r]; _Pragma("unroll") for(int r=0;r<16;++r)sacc+=pB1[r]; l_reg+=sacc;
    pw0=(u32x4){PKW(pB0,0),PKW(pB0,2),PKW(pB0,4),PKW(pB0,6)};pw1=(u32x4){PKW(pB0,8),PKW(pB0,10),PKW(pB0,12),PKW(pB0,14)};pw2=(u32x4){PKW(pB1,0),PKW(pB1,2),PKW(pB1,4),PKW(pB1,6)};pw3=(u32x4){PKW(pB1,8),PKW(pB1,10),PKW(pB1,12),PKW(pB1,14)};
    SBAR(); pv(o,vb0+sl_cur,PAF(0),PAF(1),PAF(2),PAF(3)); }
  #undef PKW
  #undef PAF
  #undef VFR
  #undef PIN
  #undef MX3
  #undef GAPA
  #undef GAPB
  #undef EX
  #undef VRD
  #undef KRD
  #undef STEP
  #undef ENDW
  {auto rr=__builtin_amdgcn_permlane32_swap(__float_as_uint(l_reg),__float_as_uint(l_reg),false,false);l_reg=__uint_as_float(rr[0])+__uint_as_float(rr[1]);}
  if(hi==0)wsf[32+r32]=l_reg;asm volatile("s_waitcnt lgkmcnt(0)":::"memory");
  float rli[16];
  #pragma unroll
  for(int r=0;r<16;++r)rli[r]=__builtin_amdgcn_rcpf(wsf[32+crow(r,hi)]);
  bf16*Ow=O+(long)(wid*QBLK)*OP;
  { bf16*stg=(bf16*)(shm+LDS_OST)+wid*2048;
    #pragma unroll
    for(int r=0;r<16;++r){const int orow=crow(r,hi);
      #pragma unroll
      for(int d0=0;d0<2;++d0)stg[orow*64+d0*32+r32]=__float2bfloat16(o[d0][r]*rli[r]);}
    asm volatile("s_waitcnt lgkmcnt(0)":::"memory");
    #pragma unroll
    for(int i=0;i<4;++i){const int row=i*8+(lane>>3),ch=lane&7; const u32x4 v=*(const u32x4*)(stg+row*64+ch*8); ATTN_STORE16(Ow+(long)row*OP+ch*8,v);} }
  asm volatile("s_waitcnt lgkmcnt(0)\n\ts_barrier":::"memory");
  #undef DMA_K
  #undef DMA_V
  #undef CMASK
  #undef START
  #undef RESC
  #undef ROT
}
#undef SBAR
#undef WAIT_BAR
}
namespace ml {
constexpr int QS = 0, KS = QS + 128 * 144, VT = KS + 128 * 144, KT = VT + 80 * 272, SP = KT + 64 * 272, CB = SP + 128 * 272, GA = CB + 80 * 144, GSET = 6 * 512, END = GA + 2 * GSET;
static_assert(END <= 131072, "mlstm lds");
__device__ __forceinline__ float logsig(float x) { return fminf(x, 0.f) - __logf(1.0f + __expf(-fabsf(x))); }
#define MFMA16(a, b, c) __builtin_amdgcn_mfma_f32_16x16x32_bf16(a, b, c, 0, 0, 0)
#define ML_BAR() do { asm volatile("s_waitcnt lgkmcnt(0)" ::: "memory"); __builtin_amdgcn_s_barrier(); asm volatile("" ::: "memory"); } while (0)
#define ML_SCAN(SET, G0, G1, G2, G3) do { \
                LAS float* a_w = (LAS float*)(lds + GA + (SET) * GSET); \
                const float li0 = (G0), lf0 = logsig(G1), li1 = (G2), lf1 = logsig(G3); \
                const float ps = lf0 + lf1; float inc = ps; \
                _Pragma("unroll") for (int o = 1; o < 64; o <<= 1) { const float t = __shfl_up(inc, o); if (lane >= o) inc += t; } \
                const float b0 = (inc - ps) + lf0, b1 = b0 + lf1; \
                const float a0 = li0 - b0, a1 = li1 - b1; \
                float incm = fmaxf(a0, a1); \
                _Pragma("unroll") for (int o = 1; o < 64; o <<= 1) { const float t = __shfl_up(incm, o); if (lane >= o) incm = fmaxf(incm, t); } \
                float excm = __shfl_up(incm, 1); if (lane == 0) excm = -INFINITY; \
                const float cm0 = fmaxf(mcar, fmaxf(excm, a0)), cm1 = fmaxf(mcar, incm); \
                const float blast = __shfl(b1, 63), cmlast = __shfl(cm1, 63); \
                a_w[2 * lane] = a0; a_w[2 * lane + 1] = a1; a_w[128 + 2 * lane] = cm0; a_w[128 + 2 * lane + 1] = cm1; \
                a_w[256 + 2 * lane] = __expf(mcar - cm0); a_w[256 + 2 * lane + 1] = __expf(mcar - cm1); \
                a_w[384 + 2 * lane] = __expf(-(b0 + cm0)); a_w[384 + 2 * lane + 1] = __expf(-(b1 + cm1)); \
                a_w[512 + 2 * lane] = __expf(a0 - cmlast); a_w[512 + 2 * lane + 1] = __expf(a1 - cmlast); \
                if (lane == 0) a_w[640] = __expf(mcar - cmlast); \
                mcar = blast + cmlast; } while (0)

template <int VAR> __device__ __forceinline__ void mlstm_item(int b, int head, int dir, const bf16_t* __restrict__ MLB, const float* __restrict__ GT, bf16_t* HSd, LAS unsigned char* lds) {
    const int tid = opaque_tid(), lane = tid & 63, w = __builtin_amdgcn_readfirstlane(tid >> 6), fr = lane & 15, fq = lane >> 4;
    LAS bf16_t* Qs = (LAS bf16_t*)(lds + QS); LAS bf16_t* Ks = (LAS bf16_t*)(lds + KS); LAS bf16_t* Vt = (LAS bf16_t*)(lds + VT);
    LAS bf16_t* Kt = (LAS bf16_t*)(lds + KT); LAS bf16_t* Sp = (LAS bf16_t*)(lds + SP); LAS bf16_t* Cb = (LAS bf16_t*)(lds + CB);
    const int ntk = w & 3, mt0 = 2 * (w >> 2);
    {
        __syncthreads();
        for (int i = tid; i < 80 * 144 / 4; i += 512) ((LAS unsigned*)Cb)[i] = 0u;
        for (int i = tid; i < 16 * 136 / 2; i += 512) ((LAS unsigned*)(Vt + 64 * 136))[i] = (i < 68) ? 0x3f803f80u : 0u;
        f32x4 accN = (f32x4){0.f, 0.f, 0.f, 0.f};
        f32x4 accC[2]; accC[0] = (f32x4){0.f, 0.f, 0.f, 0.f}; accC[1] = accC[0];
        float mcar = 0.f;
        u32x4 pq[2], pk[2], pv[2];
        size_t rowbase_n;
        {
            const int ci = dir ? 1 : 0; rowbase_n = (size_t)NLAT + (size_t)b * TCTX + ci * 128;
#pragma unroll
            for (int j = 0; j < 2; ++j) { const int i = 2 * (tid & 63) + j, ch = tid >> 6; const bf16_t* src = MLB + (rowbase_n + i) * 1024 + head * 64 + ch * 8;
                pq[j] = *(const u32x4*)src; pk[j] = *(const u32x4*)(src + 256); pv[j] = *(const u32x4*)(src + 512); }
        }
        if (w == 0) { const float* ga_ = GT + (rowbase_n + (dir ? 127 - 2 * lane : 2 * lane)) * 16 + head + 8 * dir; const float* gb_ = GT + (rowbase_n + (dir ? 126 - 2 * lane : 2 * lane + 1)) * 16 + head + 8 * dir; const float g0_ = ga_[0], g1_ = ga_[4], g2_ = gb_[0], g3_ = gb_[4]; ML_SCAN(0, g0_, g1_, g2_, g3_); }
        for (int cc = 0; cc < 18; ++cc) {
            const size_t rowbase = rowbase_n;
            LAS float* a_s = (LAS float*)(lds + GA + (cc & 1) * GSET); LAS float* cm_s = a_s + 128; LAS float* wi_s = a_s + 256; LAS float* emt_s = a_s + 384; LAS float* wk_s = a_s + 512; LAS float* sc_s = a_s + 640;
            ML_BAR();
            {
                const int i0 = 2 * (tid & 63), ch = tid >> 6, ipa = dir ? 127 - i0 : i0, ipb = dir ? 126 - i0 : i0 + 1, ipe = dir ? 126 - i0 : i0;
                *(LAS u32x4*)(Qs + ipa * 72 + ch * 8) = pq[0]; *(LAS u32x4*)(Qs + ipb * 72 + ch * 8) = pq[1];
                *(LAS u32x4*)(Ks + ipa * 72 + ch * 8) = pk[0]; *(LAS u32x4*)(Ks + ipb * 72 + ch * 8) = pk[1];
                const unsigned ka[4] = {pk[0].x, pk[0].y, pk[0].z, pk[0].w}, kb[4] = {pk[1].x, pk[1].y, pk[1].z, pk[1].w}, va[4] = {pv[0].x, pv[0].y, pv[0].z, pv[0].w}, vb[4] = {pv[1].x, pv[1].y, pv[1].z, pv[1].w};
                const float wkl = wk_s[ipe], wkh = wk_s[ipe + 1];
#pragma unroll
                for (int e2 = 0; e2 < 4; ++e2) { if (VAR & 8) continue;
                    const unsigned kl0 = dir ? kb[e2] : ka[e2], kh0 = dir ? ka[e2] : kb[e2], vl0 = dir ? vb[e2] : va[e2], vh0 = dir ? va[e2] : vb[e2];
                    *(LAS unsigned*)(Kt + (ch * 8 + 2 * e2) * 136 + ipe) = pk2(bf2f(kl0 & 0xffffu) * wkl, bf2f(kh0 & 0xffffu) * wkh);
                    *(LAS unsigned*)(Kt + (ch * 8 + 2 * e2 + 1) * 136 + ipe) = pk2(bf2f(kl0 >> 16) * wkl, bf2f(kh0 >> 16) * wkh);
                    *(LAS unsigned*)(Vt + (ch * 8 + 2 * e2) * 136 + ipe) = (vl0 & 0xffffu) | (vh0 << 16);
                    *(LAS unsigned*)(Vt + (ch * 8 + 2 * e2 + 1) * 136 + ipe) = (vl0 >> 16) | (vh0 & 0xffff0000u); }
            }
            if (cc > 0) {
#pragma unroll
                for (int i = 0; i < 2; ++i)
#pragma unroll
                    for (int j = 0; j < 4; ++j) Cb[(16 * (mt0 + i) + 4 * fq + j) * 72 + 16 * ntk + fr] = (bf16_t)f2bf_hw(accC[i][j]);
                if (w < 4 && fq == 0) Cb[64 * 72 + 16 * w + fr] = (bf16_t)f2bf_hw(accN[0]);
            }
            if (cc + 1 < 18) {
                const int cn = cc + 1;
                if (cn < 2) { const int ci = dir ? 1 - cn : cn; rowbase_n = (size_t)NLAT + (size_t)b * TCTX + ci * 128; }
                else { const int ci = dir ? 17 - cn : cn - 2; rowbase_n = (size_t)b * TLAT + ci * 128; }
#pragma unroll
                for (int j = 0; j < 2; ++j) { const int i = 2 * (tid & 63) + j, ch = tid >> 6; const bf16_t* src = MLB + (rowbase_n + i) * 1024 + head * 64 + ch * 8;
                    pq[j] = *(const u32x4*)src; pk[j] = *(const u32x4*)(src + 256); pv[j] = *(const u32x4*)(src + 512); }
            }
            ML_BAR();
            if (!(VAR & 1)) {
            bf16x8 Qa[2];
            Qa[0] = *(const LAS bf16x8*)(Qs + (16 * w + fr) * 72 + 8 * fq); Qa[1] = *(const LAS bf16x8*)(Qs + (16 * w + fr) * 72 + 32 + 8 * fq);
            float cmt[4], rs[4];
#pragma unroll
            for (int j = 0; j < 4; ++j) { cmt[j] = cm_s[16 * w + 4 * fq + j]; rs[j] = 0.f; }
            for (int st = 0; st <= w; ++st) {
                const bf16x8 Kb0 = *(const LAS bf16x8*)(Ks + (16 * st + fr) * 72 + 8 * fq), Kb1 = *(const LAS bf16x8*)(Ks + (16 * st + fr) * 72 + 32 + 8 * fq);
                f32x4 S = (f32x4){0.f, 0.f, 0.f, 0.f};
                S = MFMA16(Qa[0], Kb0, S); S = MFMA16(Qa[1], Kb1, S);
                const float as = a_s[16 * st + fr];
#pragma unroll
                for (int j = 0; j < 4; ++j) { const bool ok = (st < w) || (fr <= 4 * fq + j); const float wgt = ok ? __expf(as - cmt[j]) : 0.f; const float v = S[j] * wgt;
                    rs[j] += v; Sp[(16 * w + 4 * fq + j) * 136 + 16 * st + fr] = (bf16_t)f2bf_hw(v); }
            }
            if ((w & 1) == 0) {
#pragma unroll
                for (int j = 0; j < 4; ++j) Sp[(16 * w + 4 * fq + j) * 136 + 16 * (w + 1) + fr] = (bf16_t)0;
            }
#pragma unroll
            for (int j = 0; j < 4; ++j) { rs[j] += __shfl_xor(rs[j], 1); rs[j] += __shfl_xor(rs[j], 2); rs[j] += __shfl_xor(rs[j], 4); rs[j] += __shfl_xor(rs[j], 8); }
            f32x4 hi_[4], hc[5];
#pragma unroll
            for (int nt = 0; nt < 4; ++nt) hi_[nt] = (f32x4){0.f, 0.f, 0.f, 0.f};
#pragma unroll
            for (int nt = 0; nt < 5; ++nt) hc[nt] = (f32x4){0.f, 0.f, 0.f, 0.f};
            for (int ks = 0; ks <= (w >> 1); ++ks) {
                const bf16x8 A = *(const LAS bf16x8*)(Sp + (16 * w + fr) * 136 + 32 * ks + 8 * fq);
#pragma unroll
                for (int nt = 0; nt < 4; ++nt) { const bf16x8 B = *(const LAS bf16x8*)(Vt + (16 * nt + fr) * 136 + 32 * ks + 8 * fq); hi_[nt] = MFMA16(A, B, hi_[nt]); }
            }
#pragma unroll
            for (int ks = 0; ks < 2; ++ks)
#pragma unroll
                for (int nt = 0; nt < 5; ++nt) { const bf16x8 B = *(const LAS bf16x8*)(Cb + (16 * nt + fr) * 72 + 32 * ks + 8 * fq); hc[nt] = MFMA16(Qa[ks], B, hc[nt]); }
            float hv[4][4];
#pragma unroll
            for (int j = 0; j < 4; ++j) {
                const int tl = 16 * w + 4 * fq + j;
                const float wi = wi_s[tl], em = emt_s[tl];
                const float qn = __shfl(hc[4][j], lane & 48);
                const float den = wi * qn + rs[j];
                const float inv = 1.0f / fmaxf(fabsf(den), em);
#pragma unroll
                for (int nt = 0; nt < 4; ++nt) hv[nt][j] = (wi * hc[nt][j] + hi_[nt][j]) * inv;
            }
            if (!(VAR & 4)) {
                LAS bf16_t* T = Sp + (16 * w) * 136;
#pragma unroll
                for (int j = 0; j < 4; ++j)
#pragma unroll
                    for (int nt = 0; nt < 4; ++nt) T[(4 * fq + j) * 136 + 16 * nt + fr] = (bf16_t)f2bf_hw(hv[nt][j]);
                asm volatile("s_waitcnt lgkmcnt(0)" ::: "memory");
#pragma unroll
                for (int q = 0; q < 2; ++q) { const int r = (lane >> 3) + 8 * q, c8 = lane & 7, tl = 16 * w + r; const size_t grow = rowbase + (dir ? 127 - tl : tl);
                    const u32x4 v = *(const LAS u32x4*)(T + r * 136 + c8 * 8);
                    *(u32x4*)(HSd + grow * 256 + head * 64 + c8 * 8) = v; }
            }
            }
            if (!(VAR & 2)) {
                const float asc = sc_s[0];
                accC[0] = accC[0] * asc; accC[1] = accC[1] * asc; accN = accN * asc;
#pragma unroll
                for (int ks = 0; ks < 4; ++ks) {
                    const bf16x8 Bs = *(const LAS bf16x8*)(Kt + (16 * ntk + fr) * 136 + 32 * ks + 8 * fq);
#pragma unroll
                    for (int i = 0; i < 2; ++i) { const bf16x8 A = *(const LAS bf16x8*)(Vt + (16 * (mt0 + i) + fr) * 136 + 32 * ks + 8 * fq); accC[i] = MFMA16(A, Bs, accC[i]); }
                    if (w < 4) { const bf16x8 A1 = *(const LAS bf16x8*)(Vt + (64 + fr) * 136 + 32 * ks + 8 * fq); accN = MFMA16(A1, Bs, accN); }
                }
            }
            if (w == 0 && cc + 1 < 18) { const float* ga_ = GT + (rowbase_n + (dir ? 127 - 2 * lane : 2 * lane)) * 16 + head + 8 * dir; const float* gb_ = GT + (rowbase_n + (dir ? 126 - 2 * lane : 2 * lane + 1)) * 16 + head + 8 * dir; const float g0_ = ga_[0], g1_ = ga_[4], g2_ = gb_[0], g3_ = gb_[4]; ML_SCAN((cc + 1) & 1, g0_, g1_, g2_, g3_); }
        }
    }
    __syncthreads();
}
__device__ __forceinline__ void mlstm_readout_phase(bool with_ctx, const bf16_t* HS0, const bf16_t* HS1, const bf16_t* __restrict__ MLB, bf16_t* MIX, const float* __restrict__ mlw) {
    const int tid = opaque_tid(), l16 = tid & 15, sub = tid >> 4;
    const int npairs = (with_ctx ? MTOT : NLAT) * 4;
    for (int p = blockIdx.x * 32 + sub; p < npairs; p += gridDim.x * 32) {
        const size_t grow = (size_t)(p >> 2); const int head = p & 3;
        const f32x4 gw = *(const f32x4*)(mlw + head * 64 + 4 * l16);
        const size_t off = grow * 256 + head * 64 + 4 * l16;
        const unsigned long long ha = *(const unsigned long long*)(HS0 + off), hb = *(const unsigned long long*)(HS1 + off);
        const f32x4 h = (f32x4){bf2f((unsigned)ha & 0xffffu) + bf2f((unsigned)hb & 0xffffu), bf2f(((unsigned)ha) >> 16) + bf2f(((unsigned)hb) >> 16),
                                bf2f((unsigned)(ha >> 32) & 0xffffu) + bf2f((unsigned)(hb >> 32) & 0xffffu), bf2f((unsigned)(ha >> 48)) + bf2f((unsigned)(hb >> 48))};
        const unsigned long long mo = *(const unsigned long long*)(MLB + grow * 1024 + 768 + head * 64 + 4 * l16);
        float ss = (h[0] * h[0] + h[1] * h[1]) + (h[2] * h[2] + h[3] * h[3]);
        ss += __shfl_xor(ss, 1); ss += __shfl_xor(ss, 2); ss += __shfl_xor(ss, 4); ss += __shfl_xor(ss, 8);
        const float rstd = rsqrtf(ss * (1.0f / 64.0f) + EPS);
        const unsigned mlo = (unsigned)mo, mhi = (unsigned)(mo >> 32);
        const float y0 = h[0] * rstd * gw[0] * sigmoid_f(bf2f(mlo & 0xffffu)), y1 = h[1] * rstd * gw[1] * sigmoid_f(bf2f(mlo >> 16));
        const float y2 = h[2] * rstd * gw[2] * sigmoid_f(bf2f(mhi & 0xffffu)), y3 = h[3] * rstd * gw[3] * sigmoid_f(bf2f(mhi >> 16));
        *(unsigned long long*)(MIX + grow * 1024 + 512 + head * 64 + 4 * l16) = (unsigned long long)pk2(y0, y1) | ((unsigned long long)pk2(y2, y3) << 32);
    }
}
#undef MFMA16
#undef ML_BAR
#undef ML_SCAN
}

__device__ __forceinline__ void pool_item(int u, const bf16_t* __restrict__ PZ, bf16_t* MIX, LAS unsigned char* lds) {
    const int tid = opaque_tid();
    const int r0 = u * 128;
    const int seq0 = (r0 < NLAT) ? (r0 / TLAT) * TLAT : NLAT + ((r0 - NLAT) / TCTX) * TCTX;
    const int len = (r0 < NLAT) ? TLAT : TCTX;
    const int tb = r0 - seq0;
    LAS u32x4* tile = (LAS u32x4*)lds;
#pragma unroll
    for (int q = 0; q < 9; ++q) { const int e = tid + 512 * q, row = e >> 5, ch = e & 31, t = tb - 8 + row;
        u32x4 v = (u32x4){0u, 0u, 0u, 0u};
        if (t >= 0 && t < len) v = *(const u32x4*)(PZ + (size_t)(seq0 + t) * 256 + ch * 8);
        tile[e] = v; }
    __syncthreads();
    const int ch = tid & 31, run = tid >> 5, half = 1 << (ch >> 3);
    float s[8];
#pragma unroll
    for (int e = 0; e < 8; ++e) s[e] = 0.f;
#define POOL_ACC(ROW, SGN) do { const u32x4 v_ = tile[(ROW) * 32 + ch]; \
        s[0] += (SGN) * bf2f(v_.x & 0xffffu); s[1] += (SGN) * bf2f(v_.x >> 16); s[2] += (SGN) * bf2f(v_.y & 0xffffu); s[3] += (SGN) * bf2f(v_.y >> 16); \
        s[4] += (SGN) * bf2f(v_.z & 0xffffu); s[5] += (SGN) * bf2f(v_.z >> 16); s[6] += (SGN) * bf2f(v_.w & 0xffffu); s[7] += (SGN) * bf2f(v_.w >> 16); } while (0)
    const int tl0 = run * 8;
    for (int k = -half; k < half; ++k) POOL_ACC(tl0 + 8 + k, 1.0f);
#pragma unroll
    for (int i = 0; i < 8; ++i) {
        const int tl = tl0 + i, t = tb + tl;
        if (i > 0) { POOL_ACC(tl + 8 + half - 1, 1.0f); POOL_ACC(tl + 8 - half - 1, -1.0f); }
        const int lo = max(t - half, 0), hi = min(t + half, len);
        const float inv = 1.0f / (float)(hi - lo);
        const u32x4 z = tile[(tl + 8) * 32 + ch];
        u32x4 o;
        o.x = pk2(s[0] * inv - bf2f(z.x & 0xffffu), s[1] * inv - bf2f(z.x >> 16)); o.y = pk2(s[2] * inv - bf2f(z.y & 0xffffu), s[3] * inv - bf2f(z.y >> 16));
        o.z = pk2(s[4] * inv - bf2f(z.z & 0xffffu), s[5] * inv - bf2f(z.z >> 16)); o.w = pk2(s[6] * inv - bf2f(z.w & 0xffffu), s[7] * inv - bf2f(z.w >> 16));
        *(u32x4*)(MIX + (size_t)(r0 + tl) * 1024 + 768 + ch * 8) = o;
    }
#undef POOL_ACC
    __syncthreads();
}
#define XB_TMO      128
#define XB_XCNT(j)  (256  + 64 * (j))
#define XB_XSUB(j)  (1280 + 64 * (j))
#define XB_XGEN(j)  (2304 + 64 * (j))
#define XB_TOP      3328
#define XB_TOPGEN   3392
#define XCD_BAR_WORDS 3456
#define XB_SPIN_CAP (1u << 18)

__device__ __forceinline__ unsigned xb_ld(unsigned* p)              { return __hip_atomic_load(p, __ATOMIC_RELAXED, __HIP_MEMORY_SCOPE_AGENT); }
__device__ __forceinline__ unsigned xb_add(unsigned* p, unsigned v) { return __hip_atomic_fetch_add(p, v, __ATOMIC_RELAXED, __HIP_MEMORY_SCOPE_AGENT); }
__device__ __forceinline__ unsigned xb_xcc_id() { return (unsigned)__builtin_amdgcn_s_getreg((3 << 11) | 20) & 0xFu; }
#define XB_SPIN(cond, bar) do { unsigned _sp = 0; while (cond) { __builtin_amdgcn_s_sleep(1); \
    if ((++_sp & 255u) == 0u) { if (xb_ld(&(bar)[XB_TMO])) break; if (_sp > XB_SPIN_CAP) { atomicAdd(&(bar)[XB_TMO], 1u); break; } } } } while (0)

struct XcdBarrier {
    unsigned* bar; unsigned x;
    volatile LAS unsigned* st;
};

__device__ __forceinline__ XcdBarrier xcd_barrier_post(unsigned* bar, volatile LAS unsigned* st) {
    XcdBarrier b; b.bar = bar; b.x = xb_xcc_id(); b.st = st;
    if (threadIdx.x == 0) (void)xb_add(&bar[XB_XCNT(b.x)], 1u);
    return b;
}
__device__ __forceinline__ void xcd_barrier_complete(unsigned* bar, unsigned x, unsigned& nloc, unsigned& nx) {
    const unsigned G = gridDim.x * gridDim.y * gridDim.z;
    unsigned sum, cnt, mine, sp = 0u;
    for (;;) {
        sum = 0u; cnt = 0u; mine = 0u;
#pragma unroll
        for (unsigned j = 0; j < 16; ++j) { const unsigned c = xb_ld(&bar[XB_XCNT(j)]); sum += c; cnt += (c > 0u) ? 1u : 0u; mine = (j == x) ? c : mine; }
        if (sum == G) break;
        __builtin_amdgcn_s_sleep(1);
        if ((++sp & 255u) == 0u) { if (xb_ld(&bar[XB_TMO])) break; if (sp > XB_SPIN_CAP) { atomicAdd(&bar[XB_TMO], 1u); break; } }
    }
    nloc = mine > 0u ? mine : 1u; nx = cnt > 0u ? cnt : 1u;
}

__device__ __forceinline__ void xcd_barrier(const XcdBarrier& b) {
    asm volatile("s_waitcnt vmcnt(0)" ::: "memory");
    __syncthreads();
    if (threadIdx.x == 0) {
        unsigned* bar = b.bar;
        __builtin_amdgcn_s_waitcnt(0);
        unsigned nloc = b.st[0], nx = b.st[1];
        if (nloc == 0u) { xcd_barrier_complete(bar, b.x, nloc, nx); b.st[0] = nloc; b.st[1] = nx; }
        const unsigned old = xb_add(&bar[XB_XSUB(b.x)], 1u);
        const unsigned gen = old / nloc;
        if (old + 1u == (gen + 1u) * nloc) {
            __builtin_amdgcn_fence(__ATOMIC_RELEASE, "agent");
            asm volatile("s_waitcnt vmcnt(0)" ::: "memory");
            const unsigned og = xb_add(&bar[XB_TOP], 1u);
            const unsigned tg = og / nx;
            if (og + 1u == (tg + 1u) * nx) xb_add(&bar[XB_TOPGEN], 1u);
            else XB_SPIN(xb_ld(&bar[XB_TOPGEN]) == tg, bar);
            __builtin_amdgcn_fence(__ATOMIC_ACQUIRE, "agent");
            xb_add(&bar[XB_XGEN(b.x)], 1u);
            asm volatile("s_waitcnt vmcnt(0)" ::: "memory");
        } else {
            XB_SPIN(xb_ld(&bar[XB_XGEN(b.x)]) == gen, bar);
            __builtin_amdgcn_fence(__ATOMIC_ACQUIRE, "agent");
            asm volatile("s_waitcnt vmcnt(0)" ::: "memory");
        }
    }
    __syncthreads();
}
struct Args { const float* in[20]; float* out; unsigned char* ws; };
enum { I_X = 0, I_C, I_CTX, I_CCTX, I_WADA, I_BADA, I_NMIX, I_WIN, I_BG, I_QN, I_KN, I_MLN, I_PW, I_PS, I_WOUT, I_NFFN, I_WG, I_WU, I_WD, I_FN };
constexpr int LDS_BYTES = 147456;
#ifndef REP_N1
#define REP_N1 1
#endif
#ifndef REP_G1
#define REP_G1 1
#endif
#ifndef REP_MIX
#define REP_MIX 1
#endif
#ifndef REP_N2
#define REP_N2 1
#endif
#ifndef REP_G3
#define REP_G3 1
#endif
#ifndef REP_PRO
#define REP_PRO 1
#endif
#ifndef ML_DUP
#define ML_DUP 1
#endif
#ifndef AL_DUP
#define AL_DUP 1
#endif
#ifndef MIXREP_MASK
#define MIXREP_MASK 15
#endif
#ifndef ML_VAR
#define ML_VAR 0
#endif
#ifndef PRO_MASK
#define PRO_MASK 7
#endif
#ifndef REP_SYNC
#define REP_SYNC 1
#endif

__device__ __forceinline__ void tr_item(const float* colp, size_t ld, int K, bf16_t* WT, int r0, int k0, LAS float* scr, int lane) {
    float tv[32];
#pragma unroll
    for (int i = 0; i < 32; ++i) { const int kk = 2 * i + (lane >> 5); tv[i] = colp ? colp[(size_t)(k0 + kk) * ld] : 0.f; }
#pragma unroll
    for (int i = 0; i < 32; ++i) { const int kk = 2 * i + (lane >> 5); scr[kk * 33 + (lane & 31)] = tv[i]; }
    asm volatile("s_waitcnt lgkmcnt(0)" ::: "memory");
    const int c = lane & 7;
#pragma unroll
    for (int j = 0; j < 4; ++j) { const int n = (lane >> 3) + 8 * j; const LAS float* s = scr + (8 * c) * 33 + n;
        u32x4 o; o.x = pk2(s[0 * 33], s[1 * 33]); o.y = pk2(s[2 * 33], s[3 * 33]); o.z = pk2(s[4 * 33], s[5 * 33]); o.w = pk2(s[6 * 33], s[7 * 33]);
        *(u32x4*)(WT + (size_t)(r0 + n) * K + k0 + 8 * c) = o; }
    asm volatile("s_waitcnt lgkmcnt(0)" ::: "memory");
}
__device__ __forceinline__ void tr_item_pool(const float* win, const float* pw, const float* ps, bf16_t* WT, int r0, int k0, LAS float* scr, int lane) {
    const int p = (r0 - 1792) + (lane & 31), oc = 64 * ((p >> 5) & 3) + 32 * (p >> 7) + (p & 31), g = oc >> 6, o = oc & 63;
    const float scl = ps[oc];
    const float* pwc = pw + (size_t)g * 4096 + o;
    float pwr[64];
#pragma unroll
    for (int q = 0; q < 64; ++q) pwr[q] = pwc[q * 64];
    for (int i = 0; i < 8; ++i) { const int kk = 2 * i + (lane >> 5); const float* wr = win + (size_t)(k0 + kk) * INW + 1808 + 64 * g;
        f32x4 w4[16];
#pragma unroll
        for (int q = 0; q < 16; ++q) w4[q] = *(const f32x4*)(wr + 4 * q);
        float s0 = 0.f, s1 = 0.f;
#pragma unroll
        for (int q = 0; q < 16; q += 2) { s0 += (w4[q][0] * pwr[4 * q] + w4[q][1] * pwr[4 * q + 1]) + (w4[q][2] * pwr[4 * q + 2] + w4[q][3] * pwr[4 * q + 3]);
            s1 += (w4[q + 1][0] * pwr[4 * q + 4] + w4[q + 1][1] * pwr[4 * q + 5]) + (w4[q + 1][2] * pwr[4 * q + 6] + w4[q + 1][3] * pwr[4 * q + 7]); }
        scr[kk * 33 + (lane & 31)] = (s0 + s1) * scl; }
    asm volatile("s_waitcnt lgkmcnt(0)" ::: "memory");
    { const int n = lane >> 1, c = lane & 1; const LAS float* s = scr + (8 * c) * 33 + n;
        u32x4 o4; o4.x = pk2(s[0 * 33], s[1 * 33]); o4.y = pk2(s[2 * 33], s[3 * 33]); o4.z = pk2(s[4 * 33], s[5 * 33]); o4.w = pk2(s[6 * 33], s[7 * 33]);
        *(u32x4*)(WT + (size_t)(r0 + n) * 1024 + k0 + 8 * c) = o4; }
    asm volatile("s_waitcnt lgkmcnt(0)" ::: "memory");
}

__device__ __forceinline__ void prologue(const Args& a, LAS unsigned char* lds, const int pmask) {
    const int tid = threadIdx.x, lane = tid & 63, wave = tid >> 6;
    unsigned char* ws = a.ws;
    if (blockIdx.x == 0) {
        for (int e = tid; e < 1024; e += 512) { const int pos = e >> 4, f = e & 15;
            const float invf = exp2f(-(float)(2 * f) * (13.287712379549449f / 32.0f));
            float ang = (float)pos * invf; ang -= 6.283185307179586f * rintf(ang * 0.15915494309189535f);
            float* cs = (float*)(ws + WS_ROPE) + e * 2; cs[0] = __cosf(ang); cs[1] = __sinf(ang); }
    }
    LAS float* scs = (LAS float*)lds;
    LAS float* red = (LAS float*)(lds + 17 * 4096);
    for (int e = tid; e < 17 * 1024; e += 512) { const float v = (e < 16 * 1024) ? a.in[I_C][e] : a.in[I_CCTX][e - 16 * 1024]; scs[e] = silu_f(v); }
    __syncthreads();
    for (int it = blockIdx.x; it < 2 * 192; it += gridDim.x) { if (!(pmask & 1)) break;
        const int l = it / 192, c0 = (it % 192) * 32, col = tid & 31, kp = tid >> 5;
        const float* W = a.in[I_WADA] + ((size_t)l * 1024 + kp * 64) * 6144 + c0 + col;
        float acc[17];
#pragma unroll
        for (int r = 0; r < 17; ++r) acc[r] = 0.f;
#pragma unroll 16
        for (int k4 = 0; k4 < 16; ++k4) { const float w0 = W[(size_t)(4 * k4) * 6144], w1 = W[(size_t)(4 * k4 + 1) * 6144], w2 = W[(size_t)(4 * k4 + 2) * 6144], w3 = W[(size_t)(4 * k4 + 3) * 6144];
#pragma unroll
            for (int r = 0; r < 17; ++r) { const f32x4 s = *(const LAS f32x4*)(scs + r * 1024 + kp * 64 + 4 * k4); acc[r] += (s[0] * w0 + s[1] * w1) + (s[2] * w2 + s[3] * w3); } }
#pragma unroll
        for (int r = 0; r < 17; ++r) red[(kp * 17 + r) * 32 + col] = acc[r];
        __syncthreads();
        for (int e = tid; e < 17 * 32; e += 512) { const int r = e >> 5, cc = e & 31; float s = 0.f;
#pragma unroll
            for (int q = 0; q < 16; ++q) s += red[(q * 17 + r) * 32 + cc];
            ((float*)(ws + WS_MOD))[((size_t)l * 17 + r) * 6144 + c0 + cc] = s + a.in[I_BADA][(size_t)l * 6144 + c0 + cc]; }
        __syncthreads();
    }
    LAS float* scr = (LAS float*)(lds + wave * 8448);
    const int gw = blockIdx.x * 8 + wave, NGW = gridDim.x * 8;
    constexpr int IT_W1 = 64 * 16, IT_WO = 32 * 16, IT_GU = 176 * 16, IT_WD = 32 * 44, IT_L = IT_W1 + IT_WO + IT_GU + IT_WD;
#define TR_DECODE(IT, COLP, LD, KK, WTP, R0, K0) do { const int l_ = (IT) / IT_L; int r_ = (IT) % IT_L; \
        if (r_ < IT_W1) { int rg_ = r_ / 16; if (rg_ >= 56) rg_ += 8; K0 = (r_ % 16) * 64; R0 = rg_ * 32; WTP = (bf16_t*)(ws + WS_W1 + l_ * W1_BYTES); \
            const float* win_ = a.in[I_WIN] + (size_t)l_ * 1024 * INW; const int rr_ = R0 + (lane & 31), pn_ = rr_ >> 8, p_ = rr_ & 255, oc_ = 64 * ((p_ >> 5) & 3) + 32 * (p_ >> 7) + (p_ & 31), cp_ = 256 * pn_ + oc_; \
            COLP = (cp_ < 1792) ? win_ + cp_ : (cp_ >= 2048 && cp_ < 2064) ? win_ + 1792 + (cp_ - 2048) : nullptr; LD = INW; KK = 1024; } \
        else if ((r_ -= IT_W1) < IT_WO) { R0 = (r_ / 16) * 32; K0 = (r_ % 16) * 64; COLP = a.in[I_WOUT] + (size_t)l_ * 1024 * 1024 + R0 + (lane & 31); LD = 1024; KK = 1024; WTP = (bf16_t*)(ws + WS_WO + l_ * WO_BYTES); } \
        else if ((r_ -= IT_WO) < IT_GU) { R0 = (r_ / 16) * 32; K0 = (r_ % 16) * 64; const int rr_ = R0 + (lane & 31), pn_ = rr_ >> 8, p_ = rr_ & 255, hcol_ = 128 * pn_ + (p_ & 127); \
            COLP = ((p_ >> 7) ? a.in[I_WU] : a.in[I_WG]) + (size_t)l_ * 1024 * DFF + hcol_; LD = DFF; KK = 1024; WTP = (bf16_t*)(ws + WS_WGU + l_ * WGU_BYTES); } \
        else { r_ -= IT_GU; R0 = (r_ / 44) * 32; K0 = (r_ % 44) * 64; COLP = a.in[I_WD] + (size_t)l_ * DFF * 1024 + R0 + (lane & 31); LD = 1024; KK = DFF; WTP = (bf16_t*)(ws + WS_WD + l_ * WD_BYTES); } } while (0)
#define TR_LOAD(TV, COLP, LD, K0) do { _Pragma("unroll") for (int i_ = 0; i_ < 32; ++i_) { const int kk_ = 2 * i_ + (lane >> 5); TV[i_] = (COLP) ? (COLP)[(size_t)((K0) + kk_) * (LD)] : 0.f; } } while (0)
    if (pmask & 2) {
        int it = gw;
        const float* colp = nullptr; size_t ld = 0; int KK = 0, r0 = 0, k0 = 0; bf16_t* WT = nullptr;
        float tv[32];
        if (it < 2 * IT_L) { TR_DECODE(it, colp, ld, KK, WT, r0, k0); TR_LOAD(tv, colp, ld, k0); }
        while (it < 2 * IT_L) {
            const int itn = it + NGW;
            const float* colpn = nullptr; size_t ldn = 0; int KKn = 0, r0n = 0, k0n = 0; bf16_t* WTn = nullptr;
            float tn[32];
            if (itn < 2 * IT_L) { TR_DECODE(itn, colpn, ldn, KKn, WTn, r0n, k0n); TR_LOAD(tn, colpn, ldn, k0n); }
#pragma unroll
            for (int i = 0; i < 32; ++i) { const int kk = 2 * i + (lane >> 5); scr[kk * 33 + (lane & 31)] = tv[i]; }
            asm volatile("s_waitcnt lgkmcnt(0)" ::: "memory");
            { const int c = lane & 7;
#pragma unroll
                for (int j = 0; j < 4; ++j) { const int n = (lane >> 3) + 8 * j; const LAS float* s = scr + (8 * c) * 33 + n;
                    u32x4 o; o.x = pk2(s[0 * 33], s[1 * 33]); o.y = pk2(s[2 * 33], s[3 * 33]); o.z = pk2(s[4 * 33], s[5 * 33]); o.w = pk2(s[6 * 33], s[7 * 33]);
                    *(u32x4*)(WT + (size_t)(r0 + n) * KK + k0 + 8 * c) = o; } }
            asm volatile("s_waitcnt lgkmcnt(0)" ::: "memory");
            it = itn; colp = colpn; ld = ldn; KK = KKn; r0 = r0n; k0 = k0n; WT = WTn;
#pragma unroll
            for (int i = 0; i < 32; ++i) tv[i] = tn[i];
        }
    }
#undef TR_DECODE
#undef TR_LOAD
    if (pmask & 4)
    for (int it = gw; it < 1024; it += NGW) { const int l = it >> 9, rg = (it & 511) >> 6, kg = it & 63;
        tr_item_pool(a.in[I_WIN] + (size_t)l * 1024 * INW, a.in[I_PW] + (size_t)l * 4 * 4096, a.in[I_PS] + l * 256, (bf16_t*)(ws + WS_W1 + l * W1_BYTES), 1792 + rg * 32, kg * 16, scr, lane); }
}

__device__ __forceinline__ void norm_phase(const float* xl, const float* xc, const float* gw, const float* mod  , int sh_off, int sc_off, bf16_t* XN, int nrows) {
    const int tid = opaque_tid(), lane = tid & 63, gwv = blockIdx.x * 8 + (tid >> 6), NGW = gridDim.x * 8;
    const int per = (nrows + NGW - 1) / NGW;
    int cur = -1; f32x4 mul[4], add[4];
    for (int q = 0; q < per; ++q) {
        const int row = gwv * per + q; if (row >= nrows) break;
        const int mr = row < NLAT ? row / TLAT : 16;
        if (mr != cur) { cur = mr; const float* mp = mod + (size_t)mr * 6144;
#pragma unroll
            for (int j = 0; j < 4; ++j) { const f32x4 g = *(const f32x4*)(gw + 4 * lane + 256 * j), s = *(const f32x4*)(mp + sc_off + 4 * lane + 256 * j); mul[j] = g * (s + 1.0f); add[j] = *(const f32x4*)(mp + sh_off + 4 * lane + 256 * j); } }
        const float* xr = row < NLAT ? xl + (size_t)row * 1024 : xc + (size_t)(row - NLAT) * 1024;
        f32x4 v[4]; float ss = 0.f;
#pragma unroll
        for (int j = 0; j < 4; ++j) { v[j] = *(const f32x4*)(xr + 4 * lane + 256 * j); ss += (v[j][0] * v[j][0] + v[j][1] * v[j][1]) + (v[j][2] * v[j][2] + v[j][3] * v[j][3]); }
        const float rstd = rsqrtf(wave_sum(ss) * (1.0f / 1024.0f) + EPS);
        unsigned long long* o8 = (unsigned long long*)(XN + (size_t)row * 1024) + lane;
#pragma unroll
        for (int j = 0; j < 4; ++j) { const f32x4 y = v[j] * rstd * mul[j] + add[j]; o8[64 * j] = (unsigned long long)pk2(y[0], y[1]) | ((unsigned long long)pk2(y[2], y[3]) << 32); }
    }
}
__device__ __forceinline__ void ctx_gates_phase(const float* xc, const float* gw, const float* modc, const float* win, const float* bg, float* GT, LAS unsigned char* lds) {
    const int tid = opaque_tid(), lane = tid & 63, gwv = blockIdx.x * 8 + (tid >> 6), NGW = gridDim.x * 8;
    LAS float* wg = (LAS float*)lds;
    for (int e = tid; e < 4096; e += 512) { const int k = e >> 2, q4 = e & 3; *(LAS f32x4*)(wg + k * 16 + q4 * 4) = *(const f32x4*)(win + (size_t)k * INW + 1792 + q4 * 4); }
    __syncthreads();
    for (int r = gwv; r < NCTX; r += NGW) {
        asm volatile("" ::: "memory");
        const float* xr = xc + (size_t)r * 1024; float h[16]; float ss = 0.f;
#pragma unroll
        for (int q = 0; q < 16; ++q) { h[q] = xr[lane + 64 * q]; ss += h[q] * h[q]; }
        const float rstd = rsqrtf(wave_sum(ss) * (1.0f / 1024.0f) + EPS);
        f32x4 acc[4];
#pragma unroll
        for (int q = 0; q < 4; ++q) acc[q] = (f32x4){0.f, 0.f, 0.f, 0.f};
#pragma unroll
        for (int q = 0; q < 16; ++q) { const int c = lane + 64 * q; const float hv = h[q] * rstd * gw[c] * (modc[1024 + c] + 1.0f) + modc[c];
#pragma unroll
            for (int g4 = 0; g4 < 4; ++g4) acc[g4] += *(const LAS f32x4*)(wg + c * 16 + 4 * g4) * hv; }
        float out = 0.f;
#pragma unroll
        for (int q = 0; q < 4; ++q)
#pragma unroll
            for (int i = 0; i < 4; ++i) { const float v = wave_sum(acc[q][i]); if (lane == 4 * q + i) out = v; }
        if (lane < 16) GT[(size_t)(NLAT + r) * 16 + lane] = out + bg[lane];
    }
    __syncthreads();
}
__device__ __forceinline__ void norm_phase_bf(const bf16_t* xs, const float* gw, const float* mod, int sh_off, int sc_off, bf16_t* XN, int nrows, const float* part = nullptr, int nsplit = 0, const float* pgate = nullptr, const float* cbase = nullptr, bf16_t* xs_w = nullptr) {
    const int tid = opaque_tid(), lane = tid & 63, gwv = blockIdx.x * 8 + (tid >> 6), NGW = gridDim.x * 8;
    const int per = (nrows + NGW - 1) / NGW;
    int cur = -1; f32x4 mul[4], add[4];
    for (int q = 0; q < per; ++q) {
        const int row = gwv * per + q; if (row >= nrows) break;
        const int mr = row < NLAT ? row / TLAT : 16;
        if (mr != cur) { cur = mr; const float* mp = mod + (size_t)mr * 6144;
#pragma unroll
            for (int j = 0; j < 4; ++j) { const int c = 8 * lane + 512 * (j >> 1) + 4 * (j & 1); const f32x4 g = *(const f32x4*)(gw + c), s = *(const f32x4*)(mp + sc_off + c); mul[j] = g * (s + 1.0f); add[j] = *(const f32x4*)(mp + sh_off + c); } }
        const bf16_t* xr = xs + (size_t)row * 1024;
        f32x4 v[4]; float ss = 0.f;
#pragma unroll
        for (int j = 0; j < 2; ++j) { const u32x4 w = *(const u32x4*)(xr + 8 * lane + 512 * j);
            v[2 * j] = (f32x4){bf2f(w.x & 0xffffu), bf2f(w.x >> 16), bf2f(w.y & 0xffffu), bf2f(w.y >> 16)}; v[2 * j + 1] = (f32x4){bf2f(w.z & 0xffffu), bf2f(w.z >> 16), bf2f(w.w & 0xffffu), bf2f(w.w >> 16)}; }
        if (part && row >= NLAT) {
#pragma unroll
            for (int j = 0; j < 4; ++j) { const int c = 8 * lane + 512 * (j >> 1) + 4 * (j & 1); f32x4 s = (f32x4){0.f, 0.f, 0.f, 0.f};
                if (cbase) v[j] = *(const f32x4*)(cbase + (size_t)(row - NLAT) * 1024 + c);
                for (int k = 0; k < nsplit; ++k) s += *(const f32x4*)(part + ((size_t)k * NCTX + (row - NLAT)) * 1024 + c);
                v[j] += *(const f32x4*)(pgate + c) * s; }
            if (xs_w) {
#pragma unroll
                for (int j = 0; j < 2; ++j) { u32x4 o; o.x = pk2(v[2 * j][0], v[2 * j][1]); o.y = pk2(v[2 * j][2], v[2 * j][3]); o.z = pk2(v[2 * j + 1][0], v[2 * j + 1][1]); o.w = pk2(v[2 * j + 1][2], v[2 * j + 1][3]);
                    *(u32x4*)(xs_w + (size_t)row * 1024 + 8 * lane + 512 * j) = o; } } }
#pragma unroll
        for (int j = 0; j < 4; ++j) ss += (v[j][0] * v[j][0] + v[j][1] * v[j][1]) + (v[j][2] * v[j][2] + v[j][3] * v[j][3]);
        const float rstd = rsqrtf(wave_sum(ss) * (1.0f / 1024.0f) + EPS);
#pragma unroll
        for (int j = 0; j < 2; ++j) { const f32x4 y0 = v[2 * j] * rstd * mul[2 * j] + add[2 * j], y1 = v[2 * j + 1] * rstd * mul[2 * j + 1] + add[2 * j + 1];
            u32x4 o; o.x = pk2(y0[0], y0[1]); o.y = pk2(y0[2], y0[3]); o.z = pk2(y1[0], y1[1]); o.w = pk2(y1[2], y1[3]);
            *(u32x4*)(XN + (size_t)row * 1024 + 8 * lane + 512 * j) = o; }
    }
}
__device__ __forceinline__ void final_norm_phase(float* x, const float* gw) {
    const int tid = opaque_tid(), lane = tid & 63, gwv = blockIdx.x * 8 + (tid >> 6), NGW = gridDim.x * 8;
    f32x4 g[4];
#pragma unroll
    for (int j = 0; j < 4; ++j) g[j] = *(const f32x4*)(gw + 4 * lane + 256 * j);
    for (int row = gwv; row < NLAT; row += NGW) {
        float* xr = x + (size_t)row * 1024; f32x4 v[4]; float ss = 0.f;
#pragma unroll
        for (int j = 0; j < 4; ++j) { v[j] = *(const f32x4*)(xr + 4 * lane + 256 * j); ss += (v[j][0] * v[j][0] + v[j][1] * v[j][1]) + (v[j][2] * v[j][2] + v[j][3] * v[j][3]); }
        const float rstd = rsqrtf(wave_sum(ss) * (1.0f / 1024.0f) + EPS);
#pragma unroll
        for (int j = 0; j < 4; ++j) *(f32x4*)(xr + 4 * lane + 256 * j) = v[j] * rstd * g[j];
    }
}

__global__ void __launch_bounds__(512, 2) fwd_megakernel(Args a) {
    extern __shared__ __attribute__((aligned(16))) unsigned char lds_raw[];
    LAS unsigned char* lds = (LAS unsigned char*)lds_raw;
    unsigned char* ws = a.ws;
    const int tid = threadIdx.x;
    float* MOD = (float*)(ws + WS_MOD);
    bf16_t* XN = (bf16_t*)(ws + WS_XN); bf16_t* QB = (bf16_t*)(ws + WS_QB); bf16_t* KB = (bf16_t*)(ws + WS_KB); bf16_t* VB = (bf16_t*)(ws + WS_VB);
    bf16_t* MLB = (bf16_t*)(ws + WS_MLB); bf16_t* PZ = (bf16_t*)(ws + WS_PZ); float* GT = (float*)(ws + WS_GT); bf16_t* HS = (bf16_t*)(ws + WS_HS); bf16_t* HS1 = (bf16_t*)(ws + WS_HS1);
    bf16_t* MIX = (bf16_t*)(ws + WS_MIX); bf16_t* HID = (bf16_t*)(ws + WS_HID); bf16_t* XS = (bf16_t*)(ws + WS_XS);
    unsigned* ctl = (unsigned*)(ws + WS_CTL);
    LAS int* item_s = (LAS int*)(lds + 131072 + 1024);
    volatile LAS unsigned* bst = (volatile LAS unsigned*)(lds + 131072 + 2048);
    if (tid < 4) bst[tid] = 0u;
    __syncthreads();
    XcdBarrier xbar = xcd_barrier_post(ctl + 4096, bst);
#define GSYNC() xcd_barrier(xbar)

    for (int rp = 0; rp < REP_PRO; ++rp) { prologue(a, lds, rp == 0 ? 7 : PRO_MASK);
    GSYNC(); }

    for (int l = 0; l < 2; ++l) {
        const float* xl_in = a.in[I_X];
        const float* xc_in = a.in[I_CTX];
        const float* modl = MOD + (size_t)l * 17 * 6144;
        for (int rp = 0; rp < REP_N1; ++rp) { if (l == 0) norm_phase(xl_in, xc_in, a.in[I_NMIX] + l * 1024, modl, 0, 1024, XN, MTOT); else norm_phase_bf(XS, a.in[I_NMIX] + l * 1024, modl, 0, 1024, XN, MTOT, (const float*)(ws + WS_MIX + 32 * MiB), 2, MOD + (size_t)16 * 6144 + 5120);
        if (l == 0) ctx_gates_phase(xc_in, a.in[I_NMIX], modl + 16 * 6144, a.in[I_WIN], a.in[I_BG], GT, lds);
        for (int rs = 0; rs < REP_SYNC; ++rs) GSYNC(); }
        for (int rp = 0; rp < REP_G1; ++rp) {
            pg8::Gemm g{XN, (const bf16_t*)(ws + WS_W1 + l * W1_BYTES), MTOT, N1, 1024}; pg8::G1Order S; S.init(gridDim.x, (int)blockIdx.x, l == 0);
            pg8::EpiIn E{QB, KB, VB, MLB, PZ, GT, a.in[I_QN] + l * 64, a.in[I_KN] + l * 64, a.in[I_BG] + l * 16, (const float*)(ws + WS_ROPE), attn_body::C2};
            pg8::gemm_phase<pg8::EpiIn, pg8::G1Order, true, true>(lds, g, S, E);
        GSYNC(); }
        for (int rp = 0; rp < REP_MIX; ++rp) {
            const int n_ml = 128 * ML_DUP, n_al = 1024 * AL_DUP, n_ac = (l == 0) ? 128 : 0, n_pool = (l == 0) ? 288 : 256, n_all = n_ml + n_al + n_ac + n_pool;
            for (;;) {
                __syncthreads();
                if (tid == 0) item_s[0] = (int)atomicAdd(ctl + 64 * (l * 4 + rp), 1u);
                __syncthreads();
                int it = item_s[0];
                if (it >= n_all) break;
                const int cmask = (rp == 0) ? 15 : MIXREP_MASK;
                if (it < n_ml) { if (!(cmask & 1)) continue; const int itm = it & 127, mb = itm >> 3, mh = (itm >> 1) & 3, md = itm & 1;
                    if (rp == 0) ml::mlstm_item<0>(mb, mh, md, MLB, GT, md ? HS1 : HS, lds); else ml::mlstm_item<ML_VAR>(mb, mh, md, MLB, GT, md ? HS1 : HS, lds);
                    continue; }
                it -= n_ml;
                if (it < n_al) { if (!(cmask & 2)) continue; const int b = (it >> 6) & 15, h = (it >> 3) & 7, qb = it & 7;
                    attn_body::attn_unit<8>((const attn_body::bf16*)(QB + ((size_t)b * TLAT + qb * 256) * 512 + h * 64), (const attn_body::bf16*)(KB + (size_t)b * TKV * 128 + (h >> 2) * 64),
                                            (const attn_body::bf16*)(VB + (size_t)b * TKV * 128 + (h >> 2) * 64), (attn_body::bf16*)(MIX + ((size_t)b * TLAT + qb * 256) * 1024 + h * 64), TKV / 64, (char*)lds_raw);
                    continue; }
                it -= n_al;
                if (it < n_ac) { if (!(cmask & 4)) continue; const int b = it >> 3, h = it & 7;
                    attn_body::attn_unit<8>((const attn_body::bf16*)(QB + ((size_t)NLAT + b * TCTX) * 512 + h * 64), (const attn_body::bf16*)(KB + ((size_t)b * TKV + TLAT) * 128 + (h >> 2) * 64),
                                            (const attn_body::bf16*)(VB + ((size_t)b * TKV + TLAT) * 128 + (h >> 2) * 64), (attn_body::bf16*)(MIX + ((size_t)NLAT + b * TCTX) * 1024 + h * 64), TCTX / 64, (char*)lds_raw);
                    continue; }
                it -= n_ac;
                if (cmask & 8) pool_item(it, PZ, MIX, lds);
            }
        GSYNC(); }
        ml::mlstm_readout_phase(l == 0, HS, HS1, MLB, MIX, a.in[I_MLN] + l * 256);
        GSYNC();
        const int Mrows = (l == 0) ? MTOT : NLAT;
        {
            pg8::Gemm g{MIX, (const bf16_t*)(ws + WS_WO + l * WO_BYTES), Mrows, 1024, 1024, 0}; pg8::StaticOrder S; S.init(Mrows, 1024, gridDim.x, (int)blockIdx.x);
            if (l == 0) { pg8::EpiRes2<false, true> E{xl_in, xc_in, XS, nullptr, modl + 2048}; pg8::gemm_phase<pg8::EpiRes2<false, true>, pg8::StaticOrder, true, true>(lds, g, S, E); }
            else { pg8::EpiRes2<true, true> E{nullptr, nullptr, XS, nullptr, modl + 2048}; pg8::gemm_phase<pg8::EpiRes2<true, true>, pg8::StaticOrder, true, true>(lds, g, S, E); }
        }
        GSYNC();
        for (int rp = 0; rp < REP_N2; ++rp) { norm_phase_bf(XS, a.in[I_NFFN] + l * 1024, modl, 3072, 4096, XN, Mrows);
        GSYNC(); }
        for (int rp = 0; rp < REP_G3; ++rp) {
            pg8::Gemm g{XN, (const bf16_t*)(ws + WS_WGU + l * WGU_BYTES), Mrows, NGU, 1024}; pg8::StaticOrder S; S.init(Mrows, NGU, gridDim.x, (int)blockIdx.x);
            pg8::EpiGU E{HID};
            pg8::gemm_phase<pg8::EpiGU, pg8::StaticOrder, true, true>(lds, g, S, E);
        GSYNC(); }
        {
            pg8::Gemm g{HID, (const bf16_t*)(ws + WS_WD + l * WD_BYTES), NLAT, 1024, DFF, 0}; pg8::StaticOrder S; S.init(NLAT, 1024, gridDim.x, (int)blockIdx.x);
            if (l == 0) { pg8::EpiRes2<true, true> E{nullptr, nullptr, XS, nullptr, modl + 5120}; pg8::gemm_phase<pg8::EpiRes2<true, true>, pg8::StaticOrder, true, true>(lds, g, S, E);
                for (int kc = 0; kc < 2; ++kc) { pg8::Gemm gt{HID + kc * (DFF / 2), (const bf16_t*)(ws + WS_WD) + kc * (DFF / 2), MTOT, 1024, DFF / 2, DFF}; pg8::TailOrder T{(int)blockIdx.x, 64 * kc};
                    pg8::EpiPart EP{(float*)(ws + WS_MIX + 32 * MiB) + (size_t)kc * NCTX * 1024};
                    pg8::gemm_phase<pg8::EpiPart, pg8::TailOrder, true, true>(lds, gt, T, EP); } }
            else { pg8::EpiRes2<true, false> E{nullptr, nullptr, XS, a.out, modl + 5120}; pg8::gemm_phase<pg8::EpiRes2<true, false>, pg8::StaticOrder, true, true>(lds, g, S, E); }
        }
        GSYNC();
    }
    final_norm_phase(a.out, a.in[I_FN]);
}

extern "C" void kernel_launch(void* const* d_in, const int* in_sizes, int n_in, void* d_out, int out_size, void* d_ws, size_t ws_size, hipStream_t stream) {
    static int grid_blocks = 0;
    if (grid_blocks == 0) {
        if (n_in != 20 || ws_size < WS_END) { fprintf(stderr, "kernel_launch: unexpected n_in %d / ws_size %zu\n", n_in, ws_size); grid_blocks = -1; return; }
        int dev = 0, cus = 0, per_cu = 0;
        hipGetDevice(&dev);
        hipDeviceGetAttribute(&cus, hipDeviceAttributeMultiprocessorCount, dev);
        if (hipFuncSetAttribute((const void*)fwd_megakernel, hipFuncAttributeMaxDynamicSharedMemorySize, LDS_BYTES) != hipSuccess) { fprintf(stderr, "kernel_launch: hipFuncSetAttribute failed\n"); grid_blocks = -1; return; }
        if (hipOccupancyMaxActiveBlocksPerMultiprocessor(&per_cu, (const void*)fwd_megakernel, 512, LDS_BYTES) != hipSuccess || per_cu < 1) { fprintf(stderr, "kernel_launch: occupancy query failed (%d)\n", per_cu); grid_blocks = -1; return; }
        grid_blocks = cus * per_cu;
    }
    if (grid_blocks < 0) return;
    hipMemsetAsync((char*)d_ws + WS_CTL, 0, 65536, stream);
    Args a{};
    for (int i = 0; i < 20; ++i) a.in[i] = (const float*)d_in[i];
    a.out = (float*)d_out; a.ws = (unsigned char*)d_ws;
    void* args[] = {&a};
    hipError_t e = hipLaunchCooperativeKernel((const void*)fwd_megakernel, dim3(grid_blocks), dim3(512), args, LDS_BYTES, stream);
    if (e != hipSuccess) fprintf(stderr, "cooperative launch failed: %s (grid %d)\n", hipGetErrorString(e), grid_blocks);
}
```

```cpp
#include <hip/hip_runtime.h>
#include <hip/hip_cooperative_groups.h>
#include <hip/hip_bf16.h>
#include <cstdio>
#include <cstdint>
#include <cmath>
namespace cg = cooperative_groups;

constexpr int DMODEL = 1024, NBATCH = 16, TLAT = 2048, TCTX = 256, NLAT = NBATCH * TLAT, NCTX = NBATCH * TCTX, MTOT = NLAT + NCTX;
constexpr int N1 = 2304, DFF = 2816, NGU = 2 * DFF, TKV = TLAT + TCTX, INW = 2064;
constexpr float EPS = 1e-6f;
constexpr size_t MiB = 1u << 20;
constexpr size_t WS_CTL = 0, WS_MOD = 1 * MiB, WS_ROPE = 2 * MiB, WS_W1 = 4 * MiB, WS_WO = 13 * MiB, WS_WGU = 17 * MiB, WS_WD = 39 * MiB,
                 WS_XC = 50 * MiB, WS_XN = 66 * MiB, WS_QB = 138 * MiB, WS_KB = 174 * MiB, WS_VB = 183 * MiB, WS_MLB = 192 * MiB, WS_PZ = 264 * MiB,
                 WS_GT = 282 * MiB, WS_HS = 285 * MiB, WS_MIX = 321 * MiB, WS_HID = 138 * MiB, WS_HS1 = 393 * MiB, WS_XS = 429 * MiB, WS_END = 501 * MiB;
constexpr size_t W1_BYTES = (size_t)N1 * 1024 * 2, WO_BYTES = (size_t)1024 * 1024 * 2, WGU_BYTES = (size_t)NGU * 1024 * 2, WD_BYTES = (size_t)1024 * DFF * 2;

#define LAS __attribute__((address_space(3)))
typedef unsigned short bf16_t;
typedef float f32x4 __attribute__((ext_vector_type(4)));
typedef unsigned u32x4 __attribute__((ext_vector_type(4)));
typedef short bf16x8 __attribute__((ext_vector_type(8)));

__device__ __forceinline__ unsigned f2bf(float f) { unsigned u = __builtin_bit_cast(unsigned, f); return (u + 0x7fffu + ((u >> 16) & 1u)) >> 16; }
typedef float f32x2_hw __attribute__((ext_vector_type(2))); typedef __bf16 bf16x2_hw __attribute__((ext_vector_type(2)));
__device__ __forceinline__ unsigned pk2(float lo, float hi) { f32x2_hw v = {lo, hi}; bf16x2_hw b = __builtin_convertvector(v, bf16x2_hw); return __builtin_bit_cast(unsigned, b); }
__device__ __forceinline__ unsigned f2bf_hw(float f) { return pk2(f, 0.f) & 0xffffu; }
__device__ __forceinline__ float bf2f(unsigned v) { return __builtin_bit_cast(float, v << 16); }
__device__ __forceinline__ float silu_f(float x) { return x * __builtin_amdgcn_rcpf(1.0f + __expf(-x)); }
__device__ __forceinline__ float sigmoid_f(float x) { return __builtin_amdgcn_rcpf(1.0f + __expf(-x)); }
__device__ __forceinline__ float wave_sum(float v) {
#pragma unroll
    for (int o = 1; o < 64; o <<= 1) v += __shfl_xor(v, o);
    return v;
}
__device__ __forceinline__ int opaque_tid() { int t = threadIdx.x; asm volatile("" : "+v"(t)); return t; }
namespace pg8 {
#define PG8_LAS __attribute__((address_space(3)))
typedef unsigned short bf16_t;
typedef short bf16x8 __attribute__((ext_vector_type(8)));
typedef float f32x4 __attribute__((ext_vector_type(4)));
typedef unsigned u32x4 __attribute__((ext_vector_type(4)));
constexpr int BM = 256, BK = 64, HALF = 128, HTB = HALF * BK * 2  , STAGE_BYTES = 8 * HTB, NXCD = 8, WGM = 8;

__host__ __device__ __forceinline__ int lds_byte(int r, int c) { const int st = (r >> 4) * 2 + (c >> 5), rr = r & 15, cc = c & 31, ob = rr * 64 + cc * 2; return st * 1024 + (ob ^ (((ob >> 9) & 1) << 5)); }
__host__ __device__ __forceinline__ void stage_rc(int b, int& R, int& C) { const int st = b / 1024, sb = b % 1024, swz = sb ^ (((sb >> 9) & 1) << 5); R = (st >> 1) * 16 + swz / 64; C = (st & 1) * 32 + (swz % 64) / 2; }
__host__ __device__ __forceinline__ int perm32(int rho) { const int n = rho >> 4, i = rho & 15; return 8 * (i >> 2) + 4 * n + (i & 3); }

struct Unit { int pm, pn; };
struct Gemm { const bf16_t* A; const bf16_t* Bt; int M, N, K; int ld; };

struct StaticOrder {
    int nM, nN, nwg, G, c;
    __host__ __device__ void init(int M, int N, int G_, int c_) { nM = M / BM; nN = N / BM; nwg = nM * nN; G = G_; c = c_; }
    __host__ __device__ bool next(int i, Unit& u) const {
        const long L = (long)i * G + c; if (L >= nwg) return false;
        int wgid = (int)L; { const int q = nwg / NXCD, r = nwg % NXCD, xcd = wgid % NXCD, off = wgid / NXCD; wgid = (xcd < r ? xcd * (q + 1) : r * (q + 1) + (xcd - r) * q) + off; }
        const int nig = WGM * nN, gid = wgid / nig, fm = gid * WGM, gsz = (nM - fm) < WGM ? (nM - fm) : WGM;
        u.pm = fm + ((wgid % nig) % gsz); u.pn = (wgid % nig) / gsz; return true;
    }
    __device__ __forceinline__ void a_ready(const Unit&) const {}
    __device__ __forceinline__ void done(const Unit&) const {}
};

__device__ __forceinline__ unsigned cvt_pk_bf16(float lo, float hi) { unsigned r; asm volatile("v_cvt_pk_bf16_f32 %0, %1, %2" : "=v"(r) : "v"(lo), "v"(hi)); return r; }
typedef float f32x2 __attribute__((ext_vector_type(2)));
struct G1Order {
    StaticOrder so; int G, c, next_n, npn; int pl0, pl1, pl2, pl3, pl4, pl5, pl6, pl7;
    __device__ void init(int G_, int c_, bool layer0) { so.init(NLAT, N1, G_, c_); G = G_; c = c_;
        if (layer0) { npn = 8; pl0 = 0; pl1 = 1; pl2 = 2; pl3 = 3; pl4 = 4; pl5 = 5; pl6 = 6; pl7 = 7; }
        else { npn = 5; pl0 = 2; pl1 = 3; pl2 = 4; pl3 = 5; pl4 = 8; pl5 = 0; pl6 = 0; pl7 = 0; }
        next_n = 16 * npn; }
    __device__ bool next(int i, Unit& u) const {
        const int L = i * G + c;
        if (L < so.nwg) return so.next(i, u);
        const int e = L - so.nwg; if (e >= next_n) return false;
        const int d = (npn == 8) ? (e >> 3) : ((e * 52429) >> 18); const int q = e - d * npn; u.pm = 128 + d;
        u.pn = (q == 0) ? pl0 : (q == 1) ? pl1 : (q == 2) ? pl2 : (q == 3) ? pl3 : (q == 4) ? pl4 : (q == 5) ? pl5 : (q == 6) ? pl6 : pl7; return true; }
    __device__ __forceinline__ void a_ready(const Unit&) const {}
    __device__ __forceinline__ void done(const Unit&) const {}
};
struct EpiIn {
    static constexpr bool PERM = true, AFTER_DRAIN = false;
    bf16_t *QB, *KB, *VB, *MLB, *PZ; float* GT;
    const float *qn, *kn, *bg; const float* CS;
    float c2;
    __device__ __forceinline__ void operator()(const f32x4 (&acc)[2][2][4][2], const Unit& u, int wr, int wc, int fr, int fq) const {
        const int pn = u.pn, pm = u.pm;
        const bool lat = pm < 128;
        const int rt0 = wr * 64 + fr;
        const size_t grow0 = (size_t)pm * 256 + rt0;
        const size_t kv0 = lat ? ((size_t)(pm >> 3) * TKV + (size_t)(pm & 7) * 256 + rt0) : ((size_t)(pm - 128) * TKV + TLAT + rt0);
        if (pn < 2 || (pn == 2 && wc < 2)) {
            const bool isq = pn < 2;
            const float* nw = isq ? qn : kn;
            f32x4 wv[2][2];
#pragma unroll
            for (int bj = 0; bj < 2; ++bj)
#pragma unroll
                for (int n = 0; n < 2; ++n) wv[bj][n] = *(const f32x4*)(nw + 32 * bj + 8 * fq + 4 * n);
            const float sgn = (fq < 2) ? -1.f : 1.f;
            const float osc = isq ? c2 : 1.f;
#pragma unroll
            for (int ai = 0; ai < 2; ++ai)
#pragma unroll
                for (int m = 0; m < 4; ++m) {
                    float ss = 0.f;
#pragma unroll
                    for (int bj = 0; bj < 2; ++bj)
#pragma unroll
                        for (int n = 0; n < 2; ++n) { const f32x4 v = acc[ai][bj][m][n]; ss += (v[0] * v[0] + v[1] * v[1]) + (v[2] * v[2] + v[3] * v[3]); }
                    ss += __shfl_xor(ss, 16); ss += __shfl_xor(ss, 32);
                    const float rstd = rsqrtf(ss * (1.0f / 64.0f) + EPS);
                    const int roff = ai * 128 + m * 16;
#pragma unroll
                    for (int bj = 0; bj < 2; ++bj) {
                        f32x4 y[2];
#pragma unroll
                        for (int n = 0; n < 2; ++n) y[n] = acc[ai][bj][m][n] * rstd * wv[bj][n];
                        if (lat) {
                            const int pos = (bj == 0) ? ((pm & 7) * 4 + 2 * ai + wr) : (m * 16 + fr);
                            const float* cs = CS + (size_t)pos * 32 + 16 * (fq & 1);
#pragma unroll
                            for (int n = 0; n < 2; ++n) {
                                const f32x4 t0 = *(const f32x4*)(cs + 8 * n), t1 = *(const f32x4*)(cs + 8 * n + 4);
                                f32x4 p;
                                p[0] = __shfl_xor(y[n][0], 32); p[1] = __shfl_xor(y[n][1], 32); p[2] = __shfl_xor(y[n][2], 32); p[3] = __shfl_xor(y[n][3], 32);
                                f32x4 o;
                                o[0] = y[n][0] * t0[0] + sgn * p[0] * t0[1];
                                o[1] = y[n][1] * t0[2] + sgn * p[1] * t0[3];
                                o[2] = y[n][2] * t1[0] + sgn * p[2] * t1[1];
                                o[3] = y[n][3] * t1[2] + sgn * p[3] * t1[3];
                                y[n] = o;
                            }
                        }
                        u32x4 w;
                        w.x = cvt_pk_bf16(y[0][0] * osc, y[0][1] * osc); w.y = cvt_pk_bf16(y[0][2] * osc, y[0][3] * osc);
                        w.z = cvt_pk_bf16(y[1][0] * osc, y[1][1] * osc); w.w = cvt_pk_bf16(y[1][2] * osc, y[1][3] * osc);
                        bf16_t* dst = isq ? (QB + (grow0 + roff) * 512 + (4 * pn + wc) * 64 + 32 * bj + 8 * fq)
                                          : (KB + (kv0 + roff) * 128 + wc * 64 + 32 * bj + 8 * fq);
                        *(u32x4*)dst = w;
                    }
                    asm volatile("" ::: "memory");
                }
        } else if (pn <= 7) {
            bf16_t* base; size_t ld; size_t r0; int cb; float sc = 1.f;
            if (pn == 2) { base = VB; ld = 128; r0 = kv0; cb = (wc - 2) * 64; }
            else if (pn == 7) { base = PZ; ld = 256; r0 = grow0; cb = wc * 64; }
            else { base = MLB; ld = 1024; r0 = grow0; cb = (pn - 3) * 256 + wc * 64; if (pn == 4) sc = 0.125f; }
#pragma unroll
            for (int ai = 0; ai < 2; ++ai)
#pragma unroll
                for (int m = 0; m < 4; ++m)
#pragma unroll
                    for (int bj = 0; bj < 2; ++bj) {
                        const f32x4 v0 = acc[ai][bj][m][0] * sc, v1 = acc[ai][bj][m][1] * sc;
                        u32x4 w; w.x = cvt_pk_bf16(v0[0], v0[1]); w.y = cvt_pk_bf16(v0[2], v0[3]); w.z = cvt_pk_bf16(v1[0], v1[1]); w.w = cvt_pk_bf16(v1[2], v1[3]);
                        *(u32x4*)(base + (r0 + ai * 128 + m * 16) * ld + cb + 32 * bj + 8 * fq) = w;
                    }
        } else {
            if (wc == 0 && fq < 2) {
                const f32x4 b0 = *(const f32x4*)(bg + 8 * fq), b1 = *(const f32x4*)(bg + 8 * fq + 4);
#pragma unroll
                for (int ai = 0; ai < 2; ++ai)
#pragma unroll
                    for (int m = 0; m < 4; ++m) {
                        float* g = GT + (grow0 + ai * 128 + m * 16) * 16 + 8 * fq;
                        *(f32x4*)g = acc[ai][0][m][0] + b0; *(f32x4*)(g + 4) = acc[ai][0][m][1] + b1;
                    }
            }
        }
    }
};
struct EpiRes {
    static constexpr bool PERM = false, AFTER_DRAIN = false;
    const float *base_l, *base_c; float *out_l, *out_c; const float* gate;
    __device__ __forceinline__ void operator()(const f32x4 (&acc)[2][2][4][2], const Unit& u, int wr, int wc, int fr, int fq) const {
        const int pn = u.pn, pm = u.pm; const bool lat = pm < 128;
        const float* gv = gate + (size_t)(lat ? (pm >> 3) : 16) * 6144;
        const float* bp = lat ? base_l + (size_t)pm * 256 * 1024 : base_c + (size_t)(pm - 128) * 256 * 1024;
        float* op = lat ? out_l + (size_t)pm * 256 * 1024 : out_c + (size_t)(pm - 128) * 256 * 1024;
        const int col0 = pn * BM + wc * 32 + 4 * fq;
        f32x4 g4[2][2];
#pragma unroll
        for (int bj = 0; bj < 2; ++bj)
#pragma unroll
            for (int n = 0; n < 2; ++n) g4[bj][n] = *(const f32x4*)(gv + col0 + bj * HALF + n * 16);
#pragma unroll
        for (int ai = 0; ai < 2; ++ai)
#pragma unroll
            for (int m = 0; m < 4; ++m) { const size_t off = (size_t)(ai * HALF + wr * 64 + m * 16 + fr) * 1024 + col0;
#pragma unroll
                for (int bj = 0; bj < 2; ++bj)
#pragma unroll
                    for (int n = 0; n < 2; ++n) { const f32x4 x = *(const f32x4*)(bp + off + bj * HALF + n * 16); *(f32x4*)(op + off + bj * HALF + n * 16) = x + g4[bj][n] * acc[ai][bj][m][n]; }
                if (m & 1) asm volatile("" ::: "memory"); }
    }
};
struct EpiGU {
    static constexpr bool PERM = true, AFTER_DRAIN = false;
    bf16_t* H;
    __device__ __forceinline__ void operator()(const f32x4 (&acc)[2][2][4][2], const Unit& u, int wr, int wc, int fr, int fq) const {
        const size_t row0 = (size_t)u.pm * BM + wr * 64 + fr; const int col0 = u.pn * 128 + wc * 32 + 8 * fq;
#pragma unroll
        for (int ai = 0; ai < 2; ++ai)
#pragma unroll
            for (int m = 0; m < 4; ++m) {
                f32x4 v[2];
#pragma unroll
                for (int n = 0; n < 2; ++n) { const f32x4 g = acc[ai][0][m][n], up = acc[ai][1][m][n];
                    v[n][0] = g[0] * __builtin_amdgcn_rcpf(1.0f + __expf(-g[0])) * up[0]; v[n][1] = g[1] * __builtin_amdgcn_rcpf(1.0f + __expf(-g[1])) * up[1];
                    v[n][2] = g[2] * __builtin_amdgcn_rcpf(1.0f + __expf(-g[2])) * up[2]; v[n][3] = g[3] * __builtin_amdgcn_rcpf(1.0f + __expf(-g[3])) * up[3]; }
                u32x4 w; w.x = cvt_pk_bf16(v[0][0], v[0][1]); w.y = cvt_pk_bf16(v[0][2], v[0][3]); w.z = cvt_pk_bf16(v[1][0], v[1][1]); w.w = cvt_pk_bf16(v[1][2], v[1][3]);
                __builtin_nontemporal_store(w, (u32x4*)(H + (row0 + ai * HALF + m * 16) * DFF + col0));
            }
    }
};
template <bool IN_BF16, bool OUT_BF16> struct EpiRes2 {
    static constexpr bool PERM = true, AFTER_DRAIN = false;
    const float *bl, *bc; bf16_t* xs; float* ol; const float* gate;
    __device__ __forceinline__ void operator()(const f32x4 (&acc)[2][2][4][2], const Unit& u, int wr, int wc, int fr, int fq) const {
        const int pn = u.pn, pm = u.pm; const bool lat = pm < 128;
        const float* gv = gate + (size_t)(lat ? (pm >> 3) : 16) * 6144;
        const int col0 = pn * BM + wc * 32 + 8 * fq;
        const size_t row0 = (size_t)pm * BM + wr * 64 + fr;
        const float* bf = lat ? bl + row0 * 1024 : bc + (row0 - NLAT) * 1024;
        f32x4 g4[2][2];
#pragma unroll
        for (int bj = 0; bj < 2; ++bj)
#pragma unroll
            for (int n = 0; n < 2; ++n) g4[bj][n] = *(const f32x4*)(gv + col0 + bj * HALF + 4 * n);
#pragma unroll
        for (int ai = 0; ai < 2; ++ai)
#pragma unroll
            for (int m = 0; m < 4; ++m) { const size_t ro = (size_t)(ai * HALF + m * 16) * 1024;
#pragma unroll
                for (int bj = 0; bj < 2; ++bj) { const int c = col0 + bj * HALF;
                    f32x4 x0, x1;
                    if (IN_BF16) { const u32x4 v = *(const u32x4*)(xs + row0 * 1024 + ro + c);
                        x0 = (f32x4){__builtin_bit_cast(float, v.x << 16), __builtin_bit_cast(float, v.x & 0xffff0000u), __builtin_bit_cast(float, v.y << 16), __builtin_bit_cast(float, v.y & 0xffff0000u)};
                        x1 = (f32x4){__builtin_bit_cast(float, v.z << 16), __builtin_bit_cast(float, v.z & 0xffff0000u), __builtin_bit_cast(float, v.w << 16), __builtin_bit_cast(float, v.w & 0xffff0000u)}; }
                    else { x0 = *(const f32x4*)(bf + ro + c); x1 = *(const f32x4*)(bf + ro + c + 4); }
                    x0 = x0 + g4[bj][0] * acc[ai][bj][m][0]; x1 = x1 + g4[bj][1] * acc[ai][bj][m][1];
                    if (OUT_BF16) { u32x4 w; w.x = cvt_pk_bf16(x0[0], x0[1]); w.y = cvt_pk_bf16(x0[2], x0[3]); w.z = cvt_pk_bf16(x1[0], x1[1]); w.w = cvt_pk_bf16(x1[2], x1[3]);
                        *(u32x4*)(xs + row0 * 1024 + ro + c) = w; }
                    else { *(f32x4*)(ol + row0 * 1024 + ro + c) = x0; *(f32x4*)(ol + row0 * 1024 + ro + c + 4) = x1; } }
                if (IN_BF16 ? (m == 3) : (m & 1)) asm volatile("" ::: "memory"); }
    }
};
struct TailOrder {
    int c, c0;
    __device__ bool next(int i, Unit& u) const { const int e = c - c0; if (i != 0 || e < 0 || e >= 64) return false; u.pn = e & 3; u.pm = 128 + (e >> 2); return true; }
    __device__ __forceinline__ void a_ready(const Unit&) const {}
    __device__ __forceinline__ void done(const Unit&) const {}
};
struct EpiPart {
    static constexpr bool PERM = true, AFTER_DRAIN = false;
    float* P;
    __device__ __forceinline__ void operator()(const f32x4 (&acc)[2][2][4][2], const Unit& u, int wr, int wc, int fr, int fq) const {
        float* op = P + ((size_t)(u.pm - 128) * BM + wr * 64 + fr) * 1024 + u.pn * BM + wc * 32 + 8 * fq;
#pragma unroll
        for (int ai = 0; ai < 2; ++ai)
#pragma unroll
            for (int m = 0; m < 4; ++m)
#pragma unroll
                for (int bj = 0; bj < 2; ++bj) { float* o = op + (size_t)(ai * HALF + m * 16) * 1024 + bj * HALF; *(f32x4*)o = acc[ai][bj][m][0]; *(f32x4*)(o + 4) = acc[ai][bj][m][1]; }
    }
};
template <class Epi, class Sched, bool ALIGN_EPI = false, bool SP2 = false>
__device__ __forceinline__ void gemm_phase(PG8_LAS unsigned char* lds, const Gemm g, const Sched& S, const Epi& E) {
    const int tid = opaque_tid(), wid = __builtin_amdgcn_readfirstlane(tid >> 6), lane = tid & 63, wr = wid >> 2, wc = wid & 3, fr = lane & 15, fq = lane >> 4;
    const int K = g.ld ? g.ld : g.K, nt = g.K / BK;
    unsigned voffA[2], voffB[2];
#pragma unroll
    for (int i = 0; i < 2; ++i) { int R, C; stage_rc(tid * 16 + i * 8192, R, C); const int Rb = Epi::PERM ? ((R & ~31) + perm32(R & 31)) : R;
        voffA[i] = (unsigned)(R * K + C) * 2u; voffB[i] = (unsigned)(Rb * K + C) * 2u; }
    const size_t kstep = (size_t)(BK * 2);
    const size_t hstep = (size_t)HALF * K * 2;
    const size_t tstep = 2 * hstep;
    const unsigned ldsw = (unsigned)wid * 1024u;
    const int aoff = lds_byte(wr * 64 + fr, fq * 8), boff = lds_byte(wc * 32 + fr, fq * 8);
#define PG8_SA(b, h) (((b) * 2 + (h)) * HTB)
#define PG8_SB(b, h) ((4 + (b) * 2 + (h)) * HTB)
#define PG8_STAGE(bufoff, gbase, voff) do { _Pragma("unroll") for (int _i = 0; _i < 2; ++_i) \
        __builtin_amdgcn_global_load_lds((const unsigned*)((const char*)(gbase) + (voff)[_i]), (PG8_LAS unsigned*)(lds + (bufoff) + ldsw + _i * 8192), 16, 0, 0); } while (0)
#define PG8_LDA(dst, b, h) do { _Pragma("unroll") for (int m = 0; m < 4; ++m) _Pragma("unroll") for (int k = 0; k < 2; ++k) dst[m][k] = *(const PG8_LAS bf16x8*)(lds + PG8_SA(b, h) + aoff + m * 2048 + k * 1024); } while (0)
#define PG8_LDB(dst, b, h) do { _Pragma("unroll") for (int n = 0; n < 2; ++n) _Pragma("unroll") for (int k = 0; k < 2; ++k) dst[n][k] = *(const PG8_LAS bf16x8*)(lds + PG8_SB(b, h) + boff + n * 2048 + k * 1024); } while (0)
#define PG8_MMA(ai, bj, At, Bt) do { __builtin_amdgcn_s_setprio(1); _Pragma("unroll") for (int m = 0; m < 4; ++m) _Pragma("unroll") for (int n = 0; n < 2; ++n) _Pragma("unroll") for (int k = 0; k < 2; ++k) \
        acc[ai][bj][m][n] = __builtin_amdgcn_mfma_f32_16x16x32_bf16(Bt[n][k], At[m][k], acc[ai][bj][m][n], 0, 0, 0); __builtin_amdgcn_s_setprio(0); } while (0)
#define PG8_WAIT_V(n) asm volatile("s_waitcnt vmcnt(" #n ")" ::: "memory")
#define PG8_WAIT_L(n) asm volatile("s_waitcnt lgkmcnt(" #n ")" ::: "memory")
#define PG8_BAR __builtin_amdgcn_s_barrier()
#define PG8_SCHED __builtin_amdgcn_sched_barrier(0)
    Unit cur, nxt; int ui = 0;
    if (!S.next(0, cur)) return;
    f32x4 acc[2][2][4][2];
#pragma unroll
    for (int a = 0; a < 2; ++a)
#pragma unroll
        for (int b = 0; b < 2; ++b)
#pragma unroll
            for (int m = 0; m < 4; ++m)
#pragma unroll
                for (int n = 0; n < 2; ++n) acc[a][b][m][n] = (f32x4){0.f, 0.f, 0.f, 0.f};
    bf16x8 At[4][2], B0[2][2], B1[2][2];
    const char* cA = (const char*)g.A + (size_t)cur.pm * tstep; const char* cB = (const char*)g.Bt + (size_t)cur.pn * tstep;
    S.a_ready(cur);
    if constexpr (SP2) {
        PG8_STAGE(PG8_SB(0, 0), cB, voffB); PG8_STAGE(PG8_SB(0, 1), cB + hstep, voffB); PG8_STAGE(PG8_SA(0, 0), cA, voffA); PG8_STAGE(PG8_SA(0, 1), cA + hstep, voffA);
        if (wr == 1) PG8_BAR;
        PG8_WAIT_V(2); PG8_BAR;
        PG8_STAGE(PG8_SB(1, 0), cB + kstep, voffB); PG8_STAGE(PG8_SA(1, 0), cA + kstep, voffA); PG8_STAGE(PG8_SB(1, 1), cB + hstep + kstep, voffB);
        PG8_WAIT_V(6); PG8_BAR;
    } else {
        PG8_STAGE(PG8_SB(0, 0), cB, voffB); PG8_STAGE(PG8_SA(0, 0), cA, voffA); PG8_STAGE(PG8_SB(0, 1), cB + hstep, voffB); PG8_STAGE(PG8_SA(0, 1), cA + hstep, voffA);
        if (wr == 1) PG8_BAR;
        PG8_WAIT_V(4); PG8_BAR;
        PG8_STAGE(PG8_SB(1, 0), cB + kstep, voffB); PG8_STAGE(PG8_SA(1, 0), cA + kstep, voffA); PG8_STAGE(PG8_SB(1, 1), cB + hstep + kstep, voffB);
        PG8_WAIT_V(6); PG8_BAR;
    }
    for (;;) {
        const bool has_next = S.next(ui + 1, nxt);
        const char* nA = has_next ? (const char*)g.A + (size_t)nxt.pm * tstep : cA; const char* nB = has_next ? (const char*)g.Bt + (size_t)nxt.pn * tstep : cB;
        for (int t = 0; t < nt; t += 2) {
            const bool last = (t == nt - 2);
            const char* a1 = cA + (size_t)(t + 1) * kstep;
            const char* a2 = last ? nA : cA + (size_t)(t + 2) * kstep; const char* b2 = last ? nB : cB + (size_t)(t + 2) * kstep;
            const char* a3 = a2 + kstep; const char* b3 = b2 + kstep;
            if (last && has_next) S.a_ready(nxt);
            if constexpr (SP2) {
            PG8_LDB(B0, 0, 0); PG8_LDB(B1, 0, 1); PG8_SCHED; PG8_LDA(At, 0, 0); PG8_STAGE(PG8_SA(1, 1), a1 + hstep, voffA);
            PG8_WAIT_V(8); PG8_WAIT_L(0); PG8_BAR; PG8_MMA(0, 0, At, B0); PG8_MMA(0, 1, At, B1); PG8_BAR; PG8_SCHED;
            PG8_LDA(At, 0, 1); PG8_STAGE(PG8_SB(0, 0), b2, voffB); PG8_STAGE(PG8_SB(0, 1), b2 + hstep, voffB); PG8_STAGE(PG8_SA(0, 0), a2, voffA);
            PG8_WAIT_V(8); PG8_WAIT_L(0); PG8_BAR; PG8_MMA(1, 0, At, B0); PG8_MMA(1, 1, At, B1); PG8_BAR; PG8_SCHED;
            PG8_LDB(B0, 1, 0); PG8_LDB(B1, 1, 1); PG8_SCHED; PG8_LDA(At, 1, 0); PG8_STAGE(PG8_SA(0, 1), a2 + hstep, voffA);
            PG8_WAIT_V(8); PG8_WAIT_L(0); PG8_BAR; PG8_MMA(0, 0, At, B0); PG8_MMA(0, 1, At, B1); PG8_BAR; PG8_SCHED;
            PG8_LDA(At, 1, 1); PG8_STAGE(PG8_SB(1, 0), b3, voffB); PG8_STAGE(PG8_SB(1, 1), b3 + hstep, voffB); PG8_STAGE(PG8_SA(1, 0), a3, voffA);
            PG8_WAIT_V(8); PG8_WAIT_L(0); PG8_BAR; PG8_MMA(1, 0, At, B0); PG8_MMA(1, 1, At, B1); PG8_BAR; PG8_SCHED;
            } else {
            PG8_LDB(B0, 0, 0); PG8_SCHED; PG8_LDA(At, 0, 0); PG8_STAGE(PG8_SA(1, 1), a1 + hstep, voffA);
            PG8_WAIT_L(8); PG8_BAR; PG8_WAIT_L(0); PG8_MMA(0, 0, At, B0); PG8_BAR; PG8_SCHED;
            PG8_LDB(B1, 0, 1); PG8_STAGE(PG8_SB(0, 0), b2, voffB);
            PG8_BAR; PG8_WAIT_L(0); PG8_MMA(0, 1, At, B1); PG8_BAR;
            PG8_LDA(At, 0, 1); PG8_STAGE(PG8_SA(0, 0), a2, voffA);
            PG8_BAR; PG8_WAIT_L(0); PG8_MMA(1, 0, At, B0); PG8_BAR; PG8_SCHED;
            PG8_STAGE(PG8_SB(0, 1), b2 + hstep, voffB);
            PG8_WAIT_V(6); PG8_BAR; PG8_MMA(1, 1, At, B1); PG8_BAR;
            PG8_LDB(B0, 1, 0); PG8_SCHED; PG8_LDA(At, 1, 0); PG8_STAGE(PG8_SA(0, 1), a2 + hstep, voffA);
            PG8_WAIT_L(8); PG8_BAR; PG8_WAIT_L(0); PG8_MMA(0, 0, At, B0); PG8_BAR; PG8_SCHED;
            PG8_LDB(B1, 1, 1); PG8_STAGE(PG8_SB(1, 0), b3, voffB);
            PG8_BAR; PG8_WAIT_L(0); PG8_MMA(0, 1, At, B1); PG8_BAR;
            PG8_LDA(At, 1, 1); PG8_STAGE(PG8_SA(1, 0), a3, voffA);
            PG8_BAR; PG8_WAIT_L(0); PG8_MMA(1, 0, At, B0); PG8_BAR; PG8_SCHED;
            PG8_STAGE(PG8_SB(1, 1), b3 + hstep, voffB);
            PG8_WAIT_V(6); PG8_BAR; PG8_MMA(1, 1, At, B1); PG8_BAR;
            }
        }
        if constexpr (ALIGN_EPI) { if (wr == 0) PG8_BAR; }
        if constexpr (!Epi::AFTER_DRAIN) { E(acc, cur, wr, wc, fr, fq); S.done(cur); }
        if (!has_next) break;
#pragma unroll
        for (int a = 0; a < 2; ++a)
#pragma unroll
            for (int b = 0; b < 2; ++b)
#pragma unroll
                for (int m = 0; m < 4; ++m)
#pragma unroll
                    for (int n = 0; n < 2; ++n) acc[a][b][m][n] = (f32x4){0.f, 0.f, 0.f, 0.f};
        cur = nxt; cA = nA; cB = nB; ++ui;
        if constexpr (ALIGN_EPI) { if (wr == 1) PG8_BAR; }
    }
    PG8_WAIT_V(0);
    if constexpr (!ALIGN_EPI) { if (wr == 0) PG8_BAR; }
    PG8_BAR;
    if constexpr (Epi::AFTER_DRAIN) { E.fused(acc, cur, wr, wc, fr, fq, lds, wid, lane); S.done(cur); }
#undef PG8_SA
#undef PG8_SB
#undef PG8_STAGE
#undef PG8_LDA
#undef PG8_LDB
#undef PG8_MMA
#undef PG8_WAIT_V
#undef PG8_WAIT_L
#undef PG8_BAR
#undef PG8_SCHED
}
}

namespace attn_body {
using bf16=__hip_bfloat16;
using bf16x8=__attribute__((ext_vector_type(8)))short;
using s16x4=__attribute__((ext_vector_type(4)))short;
using f32x16=__attribute__((ext_vector_type(16)))float;
using u32x4=__attribute__((ext_vector_type(4)))unsigned;
constexpr int D=64,QP=512,KP=128,OP=1024;
constexpr int NW=8,QBLK=32,QB=QBLK*NW,KVBLK=64;
__device__ __forceinline__ int crow(int r,int hi){return (r&3)+8*(r>>2)+4*hi;}
#define SBAR() __builtin_amdgcn_sched_barrier(0)
constexpr int NSLOT=3, SLOTB=8192;
constexpr int LDS_K=0, LDS_V=NSLOT*SLOTB, LDS_WS=2*NSLOT*SLOTB, LDS_OST=LDS_WS+NW*64*4, LDS_BYTES=LDS_OST+NW*4096;
constexpr float C2=0.125f*1.4426950408889634f;
__device__ __forceinline__ void glds16(const void*gsrc,unsigned lds_dst){unsigned keep;
  asm volatile("s_mov_b32 %0, m0\n\ts_mov_b32 m0, %2\n\ts_nop 0\n\tglobal_load_lds_dwordx4 %1, off\n\ts_mov_b32 m0, %0":"=&s"(keep):"v"(gsrc),"s"(lds_dst):"memory");}
__device__ __forceinline__ float max3f(float a,float b,float c){float r;asm("v_max3_f32 %0, %1, %2, %3":"=v"(r):"v"(a),"v"(b),"v"(c));return r;}
__device__ __forceinline__ float max2f(float a,float b){float r;asm("v_max_f32_e32 %0, %1, %2":"=v"(r):"v"(a),"v"(b));return r;}
__device__ __forceinline__ float fadd_s(float a,float b){float r;asm("v_add_f32_e32 %0, %1, %2":"=v"(r):"v"(a),"v"(b));return r;}
__device__ __forceinline__ float fsub_s(float a,float b){float r;asm("v_sub_f32_e32 %0, %1, %2":"=v"(r):"v"(a),"v"(b));return r;}
typedef float f32x2_t __attribute__((ext_vector_type(2))); typedef __bf16 bf16x2_t __attribute__((ext_vector_type(2)));
__device__ __forceinline__ unsigned cvtpk_s(float lo,float hi){f32x2_t v={lo,hi};bf16x2_t b=__builtin_convertvector(v,bf16x2_t);return __builtin_bit_cast(unsigned,b);}
#define WAIT_BAR(N) asm volatile("s_waitcnt vmcnt(" #N ") lgkmcnt(0)\n\ts_barrier":::"memory")

__device__ __forceinline__ void qkt(f32x16&p0,f32x16&p1,const char*Kslot,const bf16x8*qr,const f32x16&negm,int r32,int hi){
  const char*kb=Kslot+hi*1024+r32*16;
  #pragma unroll
  for(int d0=0;d0<4;++d0){
    const bf16x8 b0=*reinterpret_cast<const bf16x8*>(kb+d0*2048);
    const bf16x8 b1=*reinterpret_cast<const bf16x8*>(kb+d0*2048+512);
    if(d0==0){p0=__builtin_amdgcn_mfma_f32_32x32x16_bf16(b0,qr[0],negm,0,0,0);p1=__builtin_amdgcn_mfma_f32_32x32x16_bf16(b1,qr[0],negm,0,0,0);}
    else{p0=__builtin_amdgcn_mfma_f32_32x32x16_bf16(b0,qr[d0],p0,0,0,0);p1=__builtin_amdgcn_mfma_f32_32x32x16_bf16(b1,qr[d0],p1,0,0,0);}}
}
typedef __attribute__((address_space(3))) const char* lds_cptr;
typedef short v4i16_t __attribute__((ext_vector_type(4)));
__device__ __forceinline__ void kload8(bf16x8*kf,lds_cptr kp){
  kf[0]=*(const __attribute__((address_space(3))) bf16x8*)(kp);      kf[1]=*(const __attribute__((address_space(3))) bf16x8*)(kp+512);
  kf[2]=*(const __attribute__((address_space(3))) bf16x8*)(kp+2048); kf[3]=*(const __attribute__((address_space(3))) bf16x8*)(kp+2560);
  kf[4]=*(const __attribute__((address_space(3))) bf16x8*)(kp+4096); kf[5]=*(const __attribute__((address_space(3))) bf16x8*)(kp+4608);
  kf[6]=*(const __attribute__((address_space(3))) bf16x8*)(kp+6144); kf[7]=*(const __attribute__((address_space(3))) bf16x8*)(kp+6656);
}
__device__ __forceinline__ void kload2(bf16x8*kf,lds_cptr kp,int j){ kf[2*j]=*(const __attribute__((address_space(3))) bf16x8*)(kp+j*2048); kf[2*j+1]=*(const __attribute__((address_space(3))) bf16x8*)(kp+j*2048+512); }
__device__ __forceinline__ s16x4 vtr(lds_cptr p){ return __builtin_bit_cast(s16x4,__builtin_amdgcn_ds_read_tr16_b64_v4i16((__attribute__((address_space(3))) v4i16_t*)p)); }
__device__ __forceinline__ float rowmax(const f32x16&p0,const f32x16&p1){
  float a=max3f(p0[0],p0[1],p1[0]),b=max3f(p0[2],p0[3],p1[1]);a=max3f(a,p1[2],p1[3]);
  #pragma unroll
  for(int r=4;r<16;r+=4){a=max3f(a,p0[r],p0[r+1]);b=max3f(b,p0[r+2],p0[r+3]);a=max3f(a,p1[r],p1[r+1]);b=max3f(b,p1[r+2],p1[r+3]);}
  const float m=max2f(a,b);
  auto rr=__builtin_amdgcn_permlane32_swap(__float_as_uint(m),__float_as_uint(m),false,false);
  return max2f(__uint_as_float(rr[0]),__uint_as_float(rr[1]));
}
__device__ __forceinline__ void pv(f32x16*o,int vb,bf16x8 pa0,bf16x8 pa1,bf16x8 pa2,bf16x8 pa3){
  #pragma unroll
  for(int d0=0;d0<2;++d0){s16x4 lo[4],hi[4];
    #pragma unroll
    for(int ks=0;ks<4;++ks){
      asm volatile("ds_read_b64_tr_b16 %0,%1 offset:%c2":"=&v"(lo[ks]):"v"(vb),"i"(d0*4096+ks*1024):"memory");
      asm volatile("ds_read_b64_tr_b16 %0,%1 offset:%c2":"=&v"(hi[ks]):"v"(vb),"i"(d0*4096+ks*1024+512):"memory");}
    asm volatile("s_waitcnt lgkmcnt(0)":::"memory");SBAR();
    #define PK(k) (bf16x8){lo[k][0],lo[k][1],lo[k][2],lo[k][3],hi[k][0],hi[k][1],hi[k][2],hi[k][3]}
    o[d0]=__builtin_amdgcn_mfma_f32_32x32x16_bf16(pa0,PK(0),o[d0],0,0,0);
    o[d0]=__builtin_amdgcn_mfma_f32_32x32x16_bf16(pa1,PK(1),o[d0],0,0,0);
    o[d0]=__builtin_amdgcn_mfma_f32_32x32x16_bf16(pa2,PK(2),o[d0],0,0,0);
    o[d0]=__builtin_amdgcn_mfma_f32_32x32x16_bf16(pa3,PK(3),o[d0],0,0,0);
    #undef PK
  }
}

#ifndef ATTN_STORE16
#define ATTN_STORE16(p,v) (*(u32x4*)(p)=(v))
#endif
template<int THRL> __device__ __forceinline__ void attn_unit(const bf16*Q,const bf16*__restrict__ K,const bf16*__restrict__ V,bf16*O,const int NT,char*shm){
  const int tid=opaque_tid(),lane=tid&63,r32=lane&31,hi=lane>>5; const int wid=__builtin_amdgcn_readfirstlane(tid>>6);
  const bf16*Qw=Q+(long)(wid*QBLK)*QP;
  const bf16*Kh=K,*Vh=V;
  const unsigned lds0=(unsigned)(uintptr_t)shm;
  float*wsf=(float*)(shm+LDS_WS)+wid*64;
  const bf16*ksrc=Kh+(long)lane*KP+wid*8;
  const bf16*vsrc=Vh+(long)(16*(wid&3)+(lane>>2))*KP+(wid>>2)*32+(lane&3)*8;
  const unsigned kdst=lds0+LDS_K+wid*1024, vdst=lds0+LDS_V+wid*1024;
  #define DMA_K(t,slot) glds16(ksrc+(long)(t)*KVBLK*KP,(unsigned)__builtin_amdgcn_readfirstlane(kdst+(slot)))
  #define DMA_V(t,slot) glds16(vsrc+(long)(t)*KVBLK*KP,(unsigned)__builtin_amdgcn_readfirstlane(vdst+(slot)))
  const int vb0=(int)(lds0+LDS_V)+((lane>>4)&1)*32+(lane&3)*8+(4*hi+((lane&15)>>2))*64;
  const char*Kbase=shm+LDS_K; bf16x8 kf[8];
  const lds_cptr shm3=(lds_cptr)shm; const lds_cptr kp0=shm3+LDS_K+hi*1024+r32*16; const lds_cptr vp0=shm3+LDS_V+((lane>>4)&1)*32+(lane&3)*8+(4*hi+((lane&15)>>2))*64;
  DMA_K(0,0);DMA_V(0,0);DMA_K(1,SLOTB);
  bf16x8 qr[4];
  #pragma unroll
  for(int d0=0;d0<4;++d0)qr[d0]=*reinterpret_cast<const bf16x8*>(&Qw[(long)r32*QP+d0*16+hi*8]);
  float mhat=0.f,l_reg=0.f;f32x16 o[2];o[0]=f32x16{};o[1]=f32x16{};f32x16 negm=f32x16{};asm volatile("":"+v"(negm));
  #define CMASK(P0,P1,t) do{}while(0)
  bool resc=false;
  #define START(P0,P1) do{ const float rm=rowmax(P0,P1); resc=false; \
    { const float dl=rm; mhat=fadd_s(mhat,dl); \
      _Pragma("unroll") for(int r=0;r<16;++r){P0[r]=fsub_s(P0[r],dl);P1[r]=fsub_s(P1[r],dl);} \
      _Pragma("unroll") for(int r=0;r<16;++r)negm[r]=-mhat; asm volatile("":"+v"(negm)); } \
    _Pragma("unroll") for(int r=0;r<16;++r)P0[r]=__builtin_amdgcn_exp2f(P0[r]); }while(0)
  #define RESC() do{ if(resc){ asm volatile("s_waitcnt lgkmcnt(0)":::"memory"); \
      _Pragma("unroll") for(int d_=0;d_<2;++d_) _Pragma("unroll") for(int r=0;r<16;++r)o[d_][r]*=wsf[crow(r,hi)]; } }while(0)
  f32x16 pA0,pA1,pB0,pB1;
  int sl_prev=0,sl_cur=0,sl_next=SLOTB;
  #define ROT() do{sl_prev=sl_cur;sl_cur=sl_next;sl_next=(sl_next==(NSLOT-1)*SLOTB)?0:sl_next+SLOTB;}while(0)
  DMA_K(2,2*SLOTB);
  WAIT_BAR(3);
  qkt(pA0,pA1,Kbase,qr,negm,r32,hi);asm volatile("s_nop 15\n\ts_nop 7":"+v"(pA0),"+v"(pA1));CMASK(pA0,pA1,0);
  START(pA0,pA1);
  _Pragma("unroll") for(int r=0;r<16;++r)pA1[r]=__builtin_amdgcn_exp2f(pA1[r]);
  WAIT_BAR(0);
  DMA_K(3,0);DMA_V(1,SLOTB);
  ROT();
  kload8(kf,kp0+sl_cur);
  WAIT_BAR(2);
  s16x4 vlo[8],vhi[8]; u32x4 pw0,pw1,pw2,pw3;
  #define PKW(P,B) cvtpk_s(P[B],P[B+1])
  #define PAF(k) __builtin_bit_cast(bf16x8,pw##k)
  #define VFR(i) (bf16x8){vlo[i][0],vlo[i][1],vlo[i][2],vlo[i][3],vhi[i][0],vhi[i][1],vhi[i][2],vhi[i][3]}
  #define PIN(x) asm volatile("":"+v"(x))
  #define MX3(a,b,c) __builtin_fmaxf(__builtin_fmaxf((a),(b)),(c))
  #define GAPA(MF,A0,A1,A2,A3,W0,W1,PW) do{ MF; sacc+=A0; sacc+=A1; sacc+=A2; sacc+=A3; PIN(sacc); W0; W1; PIN(PW); SBAR(); }while(0)
  #define EX(v) __builtin_amdgcn_exp2f(v)
  #define GAPB(MF,X,B) do{ MF; X[B]=EX(X[B]); X[B+1]=EX(X[B+1]); X[B+2]=EX(X[B+2]); X[B+3]=EX(X[B+3]); PIN(X); SBAR(); }while(0)
  #define VRD(i) do{ vlo[i]=vtr(vp_+(((i)>>2)*4096+((i)&3)*1024)); vhi[i]=vtr(vp_+(((i)>>2)*4096+((i)&3)*1024+512)); }while(0)
  #define KRD(G,j) do{ if(G){ kload2(kf,kp0+sl_next,j); SBAR(); } }while(0)
  #define STEP(C0,C1,P0,P1,t,GK,GV,GL) do{ SBAR(); \
    const lds_cptr vp_=vp0+sl_prev; \
    VRD(0); SBAR(); float sacc=(P0[0]+P0[1]); \
    GAPA(C0=__builtin_amdgcn_mfma_f32_32x32x16_bf16(kf[0],qr[0],negm,0,0,0), P0[2],P0[3],P0[4],P0[5],     pw0[0]=PKW(P0,0), pw0[1]=PKW(P0,2), pw0); \
    VRD(4); SBAR(); GAPA(C1=__builtin_amdgcn_mfma_f32_32x32x16_bf16(kf[1],qr[0],negm,0,0,0), P0[6],P0[7],P0[8],P0[9],     pw0[2]=PKW(P0,4), pw0[3]=PKW(P0,6), pw0); \
    VRD(1); SBAR(); GAPA(C0=__builtin_amdgcn_mfma_f32_32x32x16_bf16(kf[2],qr[1],C0,0,0,0),   P0[10],P0[11],P0[12],P0[13], pw1[0]=PKW(P0,8), pw1[1]=PKW(P0,10), pw1); \
    VRD(5); SBAR(); GAPA(C1=__builtin_amdgcn_mfma_f32_32x32x16_bf16(kf[3],qr[1],C1,0,0,0),   P0[14],P0[15],P1[0],P1[1],   pw1[2]=PKW(P0,12),pw1[3]=PKW(P0,14), pw1); \
    VRD(2); SBAR(); GAPA(C0=__builtin_amdgcn_mfma_f32_32x32x16_bf16(kf[4],qr[2],C0,0,0,0),   P1[2],P1[3],P1[4],P1[5],     pw2[0]=PKW(P1,0), pw2[1]=PKW(P1,2), pw2); \
    VRD(6); SBAR(); GAPA(C1=__builtin_amdgcn_mfma_f32_32x32x16_bf16(kf[5],qr[2],C1,0,0,0),   P1[6],P1[7],P1[8],P1[9],     pw2[2]=PKW(P1,4), pw2[3]=PKW(P1,6), pw2); \
    VRD(3); SBAR(); GAPA(C0=__builtin_amdgcn_mfma_f32_32x32x16_bf16(kf[6],qr[3],C0,0,0,0),   P1[10],P1[11],P1[12],P1[13], pw3[0]=PKW(P1,8), pw3[1]=PKW(P1,10), pw3); \
    VRD(7); SBAR(); GAPA(C1=__builtin_amdgcn_mfma_f32_32x32x16_bf16(kf[7],qr[3],C1,0,0,0),   P1[14],P1[15],0.f,0.f,       pw3[2]=PKW(P1,12),pw3[3]=PKW(P1,14), pw3); \
    l_reg+=sacc; \
    if(GK){DMA_K((t)+3,sl_cur);} if(GV){DMA_V((t)+1,sl_next);} \
    CMASK(C0,C1,t); \
    { float a=MX3(C0[0],C0[1],C1[0]),b=MX3(C0[2],C0[3],C1[1]); a=MX3(a,C1[2],C1[3]); \
      _Pragma("unroll") for(int r=4;r<16;r+=4){a=MX3(a,C0[r],C0[r+1]);b=MX3(b,C0[r+2],C0[r+3]);a=MX3(a,C1[r],C1[r+1]);b=MX3(b,C1[r+2],C1[r+3]);} \
      float rm=__builtin_fmaxf(a,b); { auto rr=__builtin_amdgcn_permlane32_swap(__float_as_uint(rm),__float_as_uint(rm),false,false); rm=__builtin_fmaxf(__uint_as_float(rr[0]),__uint_as_float(rr[1])); } \
      resc=false; \
      if(__builtin_expect(__any(rm>(float)THRL),0)){ const float dl=__builtin_fmaxf(rm,0.f); mhat+=dl; \
        _Pragma("unroll") for(int r=0;r<16;++r){C0[r]-=dl;C1[r]-=dl;} \
        _Pragma("unroll") for(int r=0;r<16;++r)negm[r]=-mhat; asm volatile("":"+v"(negm)); \
        const float f=__builtin_amdgcn_exp2f(-dl); l_reg*=f; if(hi==0)wsf[r32]=f; resc=true; } } \
    SBAR(); \
    GAPB(o[0]=__builtin_amdgcn_mfma_f32_32x32x16_bf16(PAF(0),VFR(0),o[0],0,0,0), C0,0); \
    GAPB(o[1]=__builtin_amdgcn_mfma_f32_32x32x16_bf16(PAF(0),VFR(4),o[1],0,0,0), C0,4); \
    KRD(GL,0); GAPB(o[0]=__builtin_amdgcn_mfma_f32_32x32x16_bf16(PAF(1),VFR(1),o[0],0,0,0), C0,8); \
    KRD(GL,1); GAPB(o[1]=__builtin_amdgcn_mfma_f32_32x32x16_bf16(PAF(1),VFR(5),o[1],0,0,0), C0,12); \
    KRD(GL,2); GAPB(o[0]=__builtin_amdgcn_mfma_f32_32x32x16_bf16(PAF(2),VFR(2),o[0],0,0,0), C1,0); \
    KRD(GL,3); GAPB(o[1]=__builtin_amdgcn_mfma_f32_32x32x16_bf16(PAF(2),VFR(6),o[1],0,0,0), C1,4); \
    GAPB(o[0]=__builtin_amdgcn_mfma_f32_32x32x16_bf16(PAF(3),VFR(3),o[0],0,0,0), C1,8); \
    GAPB(o[1]=__builtin_amdgcn_mfma_f32_32x32x16_bf16(PAF(3),VFR(7),o[1],0,0,0), C1,12); \
    }while(0)
  int t=1;
  #undef CMASK
  #define CMASK(P0,P1,t) do{}while(0)
  for(;t+5<NT;t+=2){
    STEP(pB0,pB1,pA0,pA1,t,true,true,true);     WAIT_BAR(2); RESC(); ROT();
    STEP(pA0,pA1,pB0,pB1,t+1,true,true,true);   WAIT_BAR(2); RESC(); ROT();
  }
  #undef CMASK
  #define CMASK(P0,P1,t) do{}while(0)
  #define ENDW(tt) do{ if((tt)+3<NT){WAIT_BAR(2);} else if((tt)+2<NT){WAIT_BAR(1);} else {WAIT_BAR(0);} }while(0)
  for(;t+1<NT;t+=2){
    STEP(pB0,pB1,pA0,pA1,t,(t+3<NT),(t+1<NT),(t+1<NT));       ENDW(t);   RESC(); ROT();
    STEP(pA0,pA1,pB0,pB1,t+1,(t+4<NT),(t+2<NT),(t+2<NT));     ENDW(t+1); RESC(); ROT();
  }
  STEP(pB0,pB1,pA0,pA1,NT-1,false,false,false); RESC();
  { float sacc=pB0[0]+pB0[1]; _Pragma("unroll") for(int r=2;r<16;++r)sacc+=pB0[r]; _Pragma("unroll") for(int r=0;r<16;++r)sacc+=pB1[r]; l_reg+=sacc;
    pw0=(u32x4){PKW(pB0,0),PKW(pB0,2),PKW(pB0,4),PKW(pB0,6)};pw1=(u32x4){PKW(pB0,8),PKW(pB0,10),PKW(pB0,12),PKW(pB0,14)};pw2=(u32x4){PKW(pB1,0),PKW(pB1,2),PKW(pB1,4),PKW(pB1,6)};pw3=(u32x4){PKW(pB1,8),PKW(pB1,10),PKW(pB1,12),PKW(pB1,14)};
    SBAR(); pv(o,vb0+sl_cur,PAF(0),PAF(1),PAF(2),PAF(3)); }
  #undef PKW
  #undef PAF
  #undef VFR
  #undef PIN
  #undef MX3
  #undef GAPA
  #undef GAPB
  #undef EX
  #undef VRD
  #undef KRD
  #undef STEP
  #undef ENDW
  {auto rr=__builtin_amdgcn_permlane32_swap(__float_as_uint(l_reg),__float_as_uint(l_reg),false,false);l_reg=__uint_as_float(rr[0])+__uint_as_float(rr[1]);}
  if(hi==0)wsf[32+r32]=l_reg;asm volatile("s_waitcnt lgkmcnt(0)":::"memory");
  float rli[16];
  #pragma unroll
  for(int r=0;r<16;++r)rli[r]=__builtin_amdgcn_rcpf(wsf[32+crow(r,hi)]);
  bf16*Ow=O+(long)(wid*QBLK)*OP;
  { bf16*stg=(bf16*)(shm+LDS_OST)+wid*2048;
    #pragma unroll
    for(int r=0;r<16;++r){const int orow=crow(r,hi);
      #pragma unroll
      for(int d0=0;d0<2;++d0)stg[orow*64+d0*32+r32]=__float2bfloat16(o[d0][r]*rli[r]);}
    asm volatile("s_waitcnt lgkmcnt(0)":::"memory");
    #pragma unroll
    for(int i=0;i<4;++i){const int row=i*8+(lane>>3),ch=lane&7; const u32x4 v=*(const u32x4*)(stg+row*64+ch*8); ATTN_STORE16(Ow+(long)row*OP+ch*8,v);} }
  asm volatile("s_waitcnt lgkmcnt(0)\n\ts_barrier":::"memory");
  #undef DMA_K
  #undef DMA_V
  #undef CMASK
  #undef START
  #undef RESC
  #undef ROT
}
#undef SBAR
#undef WAIT_BAR
}
namespace ml {
constexpr int QS = 0, KS = QS + 128 * 144, VT = KS + 128 * 144, KT = VT + 80 * 272, SP = KT + 64 * 272, CB = SP + 128 * 272, GA = CB + 80 * 144, GSET = 6 * 512, END = GA + 2 * GSET;
static_assert(END <= 131072, "mlstm lds");
__device__ __forceinline__ float logsig(float x) { return fminf(x, 0.f) - __logf(1.0f + __expf(-fabsf(x))); }
#define MFMA16(a, b, c) __builtin_amdgcn_mfma_f32_16x16x32_bf16(a, b, c, 0, 0, 0)
#define ML_BAR() do { asm volatile("s_waitcnt lgkmcnt(0)" ::: "memory"); __builtin_amdgcn_s_barrier(); asm volatile("" ::: "memory"); } while (0)
#define ML_SCAN(SET, G0, G1, G2, G3) do { \
                LAS float* a_w = (LAS float*)(lds + GA + (SET) * GSET); \
                const float li0 = (G0), lf0 = logsig(G1), li1 = (G2), lf1 = logsig(G3); \
                const float ps = lf0 + lf1; float inc = ps; \
                _Pragma("unroll") for (int o = 1; o < 64; o <<= 1) { const float t = __shfl_up(inc, o); if (lane >= o) inc += t; } \
                const float b0 = (inc - ps) + lf0, b1 = b0 + lf1; \
                const float a0 = li0 - b0, a1 = li1 - b1; \
                float incm = fmaxf(a0, a1); \
                _Pragma("unroll") for (int o = 1; o < 64; o <<= 1) { const float t = __shfl_up(incm, o); if (lane >= o) incm = fmaxf(incm, t); } \
                float excm = __shfl_up(incm, 1); if (lane == 0) excm = -INFINITY; \
                const float cm0 = fmaxf(mcar, fmaxf(excm, a0)), cm1 = fmaxf(mcar, incm); \
                const float blast = __shfl(b1, 63), cmlast = __shfl(cm1, 63); \
                a_w[2 * lane] = a0; a_w[2 * lane + 1] = a1; a_w[128 + 2 * lane] = cm0; a_w[128 + 2 * lane + 1] = cm1; \
                a_w[256 + 2 * lane] = __expf(mcar - cm0); a_w[256 + 2 * lane + 1] = __expf(mcar - cm1); \
                a_w[384 + 2 * lane] = __expf(-(b0 + cm0)); a_w[384 + 2 * lane + 1] = __expf(-(b1 + cm1)); \
                a_w[512 + 2 * lane] = __expf(a0 - cmlast); a_w[512 + 2 * lane + 1] = __expf(a1 - cmlast); \
                if (lane == 0) a_w[640] = __expf(mcar - cmlast); \
                mcar = blast + cmlast; } while (0)

template <int VAR> __device__ __forceinline__ void mlstm_item(int b, int head, int dir, const bf16_t* __restrict__ MLB, const float* __restrict__ GT, bf16_t* HSd, LAS unsigned char* lds) {
    const int tid = opaque_tid(), lane = tid & 63, w = __builtin_amdgcn_readfirstlane(tid >> 6), fr = lane & 15, fq = lane >> 4;
    LAS bf16_t* Qs = (LAS bf16_t*)(lds + QS); LAS bf16_t* Ks = (LAS bf16_t*)(lds + KS); LAS bf16_t* Vt = (LAS bf16_t*)(lds + VT);
    LAS bf16_t* Kt = (LAS bf16_t*)(lds + KT); LAS bf16_t* Sp = (LAS bf16_t*)(lds + SP); LAS bf16_t* Cb = (LAS bf16_t*)(lds + CB);
    const int ntk = w & 3, mt0 = 2 * (w >> 2);
    {
        __syncthreads();
        for (int i = tid; i < 80 * 144 / 4; i += 512) ((LAS unsigned*)Cb)[i] = 0u;
        for (int i = tid; i < 16 * 136 / 2; i += 512) ((LAS unsigned*)(Vt + 64 * 136))[i] = (i < 68) ? 0x3f803f80u : 0u;
        f32x4 accN = (f32x4){0.f, 0.f, 0.f, 0.f};
        f32x4 accC[2]; accC[0] = (f32x4){0.f, 0.f, 0.f, 0.f}; accC[1] = accC[0];
        float mcar = 0.f;
        u32x4 pq[2], pk[2], pv[2];
        size_t rowbase_n;
        {
            const int ci = dir ? 1 : 0; rowbase_n = (size_t)NLAT + (size_t)b * TCTX + ci * 128;
#pragma unroll
            for (int j = 0; j < 2; ++j) { const int i = 2 * (tid & 63) + j, ch = tid >> 6; const bf16_t* src = MLB + (rowbase_n + i) * 1024 + head * 64 + ch * 8;
                pq[j] = *(const u32x4*)src; pk[j] = *(const u32x4*)(src + 256); pv[j] = *(const u32x4*)(src + 512); }
        }
        if (w == 0) { const float* ga_ = GT + (rowbase_n + (dir ? 127 - 2 * lane : 2 * lane)) * 16 + head + 8 * dir; const float* gb_ = GT + (rowbase_n + (dir ? 126 - 2 * lane : 2 * lane + 1)) * 16 + head + 8 * dir; const float g0_ = ga_[0], g1_ = ga_[4], g2_ = gb_[0], g3_ = gb_[4]; ML_SCAN(0, g0_, g1_, g2_, g3_); }
        for (int cc = 0; cc < 18; ++cc) {
            const size_t rowbase = rowbase_n;
            LAS float* a_s = (LAS float*)(lds + GA + (cc & 1) * GSET); LAS float* cm_s = a_s + 128; LAS float* wi_s = a_s + 256; LAS float* emt_s = a_s + 384; LAS float* wk_s = a_s + 512; LAS float* sc_s = a_s + 640;
            ML_BAR();
            {
                const int i0 = 2 * (tid & 63), ch = tid >> 6, ipa = dir ? 127 - i0 : i0, ipb = dir ? 126 - i0 : i0 + 1, ipe = dir ? 126 - i0 : i0;
                *(LAS u32x4*)(Qs + ipa * 72 + ch * 8) = pq[0]; *(LAS u32x4*)(Qs + ipb * 72 + ch * 8) = pq[1];
                *(LAS u32x4*)(Ks + ipa * 72 + ch * 8) = pk[0]; *(LAS u32x4*)(Ks + ipb * 72 + ch * 8) = pk[1];
                const unsigned ka[4] = {pk[0].x, pk[0].y, pk[0].z, pk[0].w}, kb[4] = {pk[1].x, pk[1].y, pk[1].z, pk[1].w}, va[4] = {pv[0].x, pv[0].y, pv[0].z, pv[0].w}, vb[4] = {pv[1].x, pv[1].y, pv[1].z, pv[1].w};
                const float wkl = wk_s[ipe], wkh = wk_s[ipe + 1];
#pragma unroll
                for (int e2 = 0; e2 < 4; ++e2) { if (VAR & 8) continue;
                    const unsigned kl0 = dir ? kb[e2] : ka[e2], kh0 = dir ? ka[e2] : kb[e2], vl0 = dir ? vb[e2] : va[e2], vh0 = dir ? va[e2] : vb[e2];
                    *(LAS unsigned*)(Kt + (ch * 8 + 2 * e2) * 136 + ipe) = pk2(bf2f(kl0 & 0xffffu) * wkl, bf2f(kh0 & 0xffffu) * wkh);
                    *(LAS unsigned*)(Kt + (ch * 8 + 2 * e2 + 1) * 136 + ipe) = pk2(bf2f(kl0 >> 16) * wkl, bf2f(kh0 >> 16) * wkh);
                    *(LAS unsigned*)(Vt + (ch * 8 + 2 * e2) * 136 + ipe) = (vl0 & 0xffffu) | (vh0 << 16);
                    *(LAS unsigned*)(Vt + (ch * 8 + 2 * e2 + 1) * 136 + ipe) = (vl0 >> 16) | (vh0 & 0xffff0000u); }
            }
            if (cc > 0) {
#pragma unroll
                for (int i = 0; i < 2; ++i)
#pragma unroll
                    for (int j = 0; j < 4; ++j) Cb[(16 * (mt0 + i) + 4 * fq + j) * 72 + 16 * ntk + fr] = (bf16_t)f2bf_hw(accC[i][j]);
                if (w < 4 && fq == 0) Cb[64 * 72 + 16 * w + fr] = (bf16_t)f2bf_hw(accN[0]);
            }
            if (cc + 1 < 18) {
                const int cn = cc + 1;
                if (cn < 2) { const int ci = dir ? 1 - cn : cn; rowbase_n = (size_t)NLAT + (size_t)b * TCTX + ci * 128; }
                else { const int ci = dir ? 17 - cn : cn - 2; rowbase_n = (size_t)b * TLAT + ci * 128; }
#pragma unroll
                for (int j = 0; j < 2; ++j) { const int i = 2 * (tid & 63) + j, ch = tid >> 6; const bf16_t* src = MLB + (rowbase_n + i) * 1024 + head * 64 + ch * 8;
                    pq[j] = *(const u32x4*)src; pk[j] = *(const u32x4*)(src + 256); pv[j] = *(const u32x4*)(src + 512); }
            }
            ML_BAR();
            if (!(VAR & 1)) {
            bf16x8 Qa[2];
            Qa[0] = *(const LAS bf16x8*)(Qs + (16 * w + fr) * 72 + 8 * fq); Qa[1] = *(const LAS bf16x8*)(Qs + (16 * w + fr) * 72 + 32 + 8 * fq);
            float cmt[4], rs[4];
#pragma unroll
            for (int j = 0; j < 4; ++j) { cmt[j] = cm_s[16 * w + 4 * fq + j]; rs[j] = 0.f; }
            for (int st = 0; st <= w; ++st) {
                const bf16x8 Kb0 = *(const LAS bf16x8*)(Ks + (16 * st + fr) * 72 + 8 * fq), Kb1 = *(const LAS bf16x8*)(Ks + (16 * st + fr) * 72 + 32 + 8 * fq);
                f32x4 S = (f32x4){0.f, 0.f, 0.f, 0.f};
                S = MFMA16(Qa[0], Kb0, S); S = MFMA16(Qa[1], Kb1, S);
                const float as = a_s[16 * st + fr];
#pragma unroll
                for (int j = 0; j < 4; ++j) { const bool ok = (st < w) || (fr <= 4 * fq + j); const float wgt = ok ? __expf(as - cmt[j]) : 0.f; const float v = S[j] * wgt;
                    rs[j] += v; Sp[(16 * w + 4 * fq + j) * 136 + 16 * st + fr] = (bf16_t)f2bf_hw(v); }
            }
            if ((w & 1) == 0) {
#pragma unroll
                for (int j = 0; j < 4; ++j) Sp[(16 * w + 4 * fq + j) * 136 + 16 * (w + 1) + fr] = (bf16_t)0;
            }
#pragma unroll
            for (int j = 0; j < 4; ++j) { rs[j] += __shfl_xor(rs[j], 1); rs[j] += __shfl_xor(rs[j], 2); rs[j] += __shfl_xor(rs[j], 4); rs[j] += __shfl_xor(rs[j], 8); }
            f32x4 hi_[4], hc[5];
#pragma unroll
            for (int nt = 0; nt < 4; ++nt) hi_[nt] = (f32x4){0.f, 0.f, 0.f, 0.f};
#pragma unroll
            for (int nt = 0; nt < 5; ++nt) hc[nt] = (f32x4){0.f, 0.f, 0.f, 0.f};
            for (int ks = 0; ks <= (w >> 1); ++ks) {
                const bf16x8 A = *(const LAS bf16x8*)(Sp + (16 * w + fr) * 136 + 32 * ks + 8 * fq);
#pragma unroll
                for (int nt = 0; nt < 4; ++nt) { const bf16x8 B = *(const LAS bf16x8*)(Vt + (16 * nt + fr) * 136 + 32 * ks + 8 * fq); hi_[nt] = MFMA16(A, B, hi_[nt]); }
            }
#pragma unroll
            for (int ks = 0; ks < 2; ++ks)
#pragma unroll
                for (int nt = 0; nt < 5; ++nt) { const bf16x8 B = *(const LAS bf16x8*)(Cb + (16 * nt + fr) * 72 + 32 * ks + 8 * fq); hc[nt] = MFMA16(Qa[ks], B, hc[nt]); }
            float hv[4][4];
#pragma unroll
            for (int j = 0; j < 4; ++j) {
                const int tl = 16 * w + 4 * fq + j;
                const float wi = wi_s[tl], em = emt_s[tl];
                const float qn = __shfl(hc[4][j], lane & 48);
                const float den = wi * qn + rs[j];
                const float inv = 1.0f / fmaxf(fabsf(den), em);
#pragma unroll
                for (int nt = 0; nt < 4; ++nt) hv[nt][j] = (wi * hc[nt][j] + hi_[nt][j]) * inv;
            }
            if (!(VAR & 4)) {
                LAS bf16_t* T = Sp + (16 * w) * 136;
#pragma unroll
                for (int j = 0; j < 4; ++j)
#pragma unroll
                    for (int nt = 0; nt < 4; ++nt) T[(4 * fq + j) * 136 + 16 * nt + fr] = (bf16_t)f2bf_hw(hv[nt][j]);
                asm volatile("s_waitcnt lgkmcnt(0)" ::: "memory");
#pragma unroll
                for (int q = 0; q < 2; ++q) { const int r = (lane >> 3) + 8 * q, c8 = lane & 7, tl = 16 * w + r; const size_t grow = rowbase + (dir ? 127 - tl : tl);
                    const u32x4 v = *(const LAS u32x4*)(T + r * 136 + c8 * 8);
                    *(u32x4*)(HSd + grow * 256 + head * 64 + c8 * 8) = v; }
            }
            }
            if (!(VAR & 2)) {
                const float asc = sc_s[0];
                accC[0] = accC[0] * asc; accC[1] = accC[1] * asc; accN = accN * asc;
#pragma unroll
                for (int ks = 0; ks < 4; ++ks) {
                    const bf16x8 Bs = *(const LAS bf16x8*)(Kt + (16 * ntk + fr) * 136 + 32 * ks + 8 * fq);
#pragma unroll
                    for (int i = 0; i < 2; ++i) { const bf16x8 A = *(const LAS bf16x8*)(Vt + (16 * (mt0 + i) + fr) * 136 + 32 * ks + 8 * fq); accC[i] = MFMA16(A, Bs, accC[i]); }
                    if (w < 4) { const bf16x8 A1 = *(const LAS bf16x8*)(Vt + (64 + fr) * 136 + 32 * ks + 8 * fq); accN = MFMA16(A1, Bs, accN); }
                }
            }
            if (w == 0 && cc + 1 < 18) { const float* ga_ = GT + (rowbase_n + (dir ? 127 - 2 * lane : 2 * lane)) * 16 + head + 8 * dir; const float* gb_ = GT + (rowbase_n + (dir ? 126 - 2 * lane : 2 * lane + 1)) * 16 + head + 8 * dir; const float g0_ = ga_[0], g1_ = ga_[4], g2_ = gb_[0], g3_ = gb_[4]; ML_SCAN((cc + 1) & 1, g0_, g1_, g2_, g3_); }
        }
    }
    __syncthreads();
}
__device__ __forceinline__ void mlstm_readout_phase(bool with_ctx, const bf16_t* HS0, const bf16_t* HS1, const bf16_t* __restrict__ MLB, bf16_t* MIX, const float* __restrict__ mlw) {
    const int tid = opaque_tid(), l16 = tid & 15, sub = tid >> 4;
    const int npairs = (with_ctx ? MTOT : NLAT) * 4;
    for (int p = blockIdx.x * 32 + sub; p < npairs; p += gridDim.x * 32) {
        const size_t grow = (size_t)(p >> 2); const int head = p & 3;
        const f32x4 gw = *(const f32x4*)(mlw + head * 64 + 4 * l16);
        const size_t off = grow * 256 + head * 64 + 4 * l16;
        const unsigned long long ha = *(const unsigned long long*)(HS0 + off), hb = *(const unsigned long long*)(HS1 + off);
        const f32x4 h = (f32x4){bf2f((unsigned)ha & 0xffffu) + bf2f((unsigned)hb & 0xffffu), bf2f(((unsigned)ha) >> 16) + bf2f(((unsigned)hb) >> 16),
                                bf2f((unsigned)(ha >> 32) & 0xffffu) + bf2f((unsigned)(hb >> 32) & 0xffffu), bf2f((unsigned)(ha >> 48)) + bf2f((unsigned)(hb >> 48))};
        const unsigned long long mo = *(const unsigned long long*)(MLB + grow * 1024 + 768 + head * 64 + 4 * l16);
        float ss = (h[0] * h[0] + h[1] * h[1]) + (h[2] * h[2] + h[3] * h[3]);
        ss += __shfl_xor(ss, 1); ss += __shfl_xor(ss, 2); ss += __shfl_xor(ss, 4); ss += __shfl_xor(ss, 8);
        const float rstd = rsqrtf(ss * (1.0f / 64.0f) + EPS);
        const unsigned mlo = (unsigned)mo, mhi = (unsigned)(mo >> 32);
        const float y0 = h[0] * rstd * gw[0] * sigmoid_f(bf2f(mlo & 0xffffu)), y1 = h[1] * rstd * gw[1] * sigmoid_f(bf2f(mlo >> 16));
        const float y2 = h[2] * rstd * gw[2] * sigmoid_f(bf2f(mhi & 0xffffu)), y3 = h[3] * rstd * gw[3] * sigmoid_f(bf2f(mhi >> 16));
        *(unsigned long long*)(MIX + grow * 1024 + 512 + head * 64 + 4 * l16) = (unsigned long long)pk2(y0, y1) | ((unsigned long long)pk2(y2, y3) << 32);
    }
}
#undef MFMA16
#undef ML_BAR
#undef ML_SCAN
}

__device__ __forceinline__ void pool_item(int u, const bf16_t* __restrict__ PZ, bf16_t* MIX, LAS unsigned char* lds) {
    const int tid = opaque_tid();
    const int r0 = u * 128;
    const int seq0 = (r0 < NLAT) ? (r0 / TLAT) * TLAT : NLAT + ((r0 - NLAT) / TCTX) * TCTX;
    const int len = (r0 < NLAT) ? TLAT : TCTX;
    const int tb = r0 - seq0;
    LAS u32x4* tile = (LAS u32x4*)lds;
#pragma unroll
    for (int q = 0; q < 9; ++q) { const int e = tid + 512 * q, row = e >> 5, ch = e & 31, t = tb - 8 + row;
        u32x4 v = (u32x4){0u, 0u, 0u, 0u};
        if (t >= 0 && t < len) v = *(const u32x4*)(PZ + (size_t)(seq0 + t) * 256 + ch * 8);
        tile[e] = v; }
    __syncthreads();
    const int ch = tid & 31, run = tid >> 5, half = 1 << (ch >> 3);
    float s[8];
#pragma unroll
    for (int e = 0; e < 8; ++e) s[e] = 0.f;
#define POOL_ACC(ROW, SGN) do { const u32x4 v_ = tile[(ROW) * 32 + ch]; \
        s[0] += (SGN) * bf2f(v_.x & 0xffffu); s[1] += (SGN) * bf2f(v_.x >> 16); s[2] += (SGN) * bf2f(v_.y & 0xffffu); s[3] += (SGN) * bf2f(v_.y >> 16); \
        s[4] += (SGN) * bf2f(v_.z & 0xffffu); s[5] += (SGN) * bf2f(v_.z >> 16); s[6] += (SGN) * bf2f(v_.w & 0xffffu); s[7] += (SGN) * bf2f(v_.w >> 16); } while (0)
    const int tl0 = run * 8;
    for (int k = -half; k < half; ++k) POOL_ACC(tl0 + 8 + k, 1.0f);
#pragma unroll
    for (int i = 0; i < 8; ++i) {
        const int tl = tl0 + i, t = tb + tl;
        if (i > 0) { POOL_ACC(tl + 8 + half - 1, 1.0f); POOL_ACC(tl + 8 - half - 1, -1.0f); }
        const int lo = max(t - half, 0), hi = min(t + half, len);
        const float inv = 1.0f / (float)(hi - lo);
        const u32x4 z = tile[(tl + 8) * 32 + ch];
        u32x4 o;
        o.x = pk2(s[0] * inv - bf2f(z.x & 0xffffu), s[1] * inv - bf2f(z.x >> 16)); o.y = pk2(s[2] * inv - bf2f(z.y & 0xffffu), s[3] * inv - bf2f(z.y >> 16));
        o.z = pk2(s[4] * inv - bf2f(z.z & 0xffffu), s[5] * inv - bf2f(z.z >> 16)); o.w = pk2(s[6] * inv - bf2f(z.w & 0xffffu), s[7] * inv - bf2f(z.w >> 16));
        *(u32x4*)(MIX + (size_t)(r0 + tl) * 1024 + 768 + ch * 8) = o;
    }
#undef POOL_ACC
    __syncthreads();
}
#define XB_TMO      128
#define XB_XCNT(j)  (256  + 64 * (j))
#define XB_XSUB(j)  (1280 + 64 * (j))
#define XB_XGEN(j)  (2304 + 64 * (j))
#define XB_TOP      3328
#define XB_TOPGEN   3392
#define XCD_BAR_WORDS 3456
#define XB_SPIN_CAP (1u << 18)

__device__ __forceinline__ unsigned xb_ld(unsigned* p)              { return __hip_atomic_load(p, __ATOMIC_RELAXED, __HIP_MEMORY_SCOPE_AGENT); }
__device__ __forceinline__ unsigned xb_add(unsigned* p, unsigned v) { return __hip_atomic_fetch_add(p, v, __ATOMIC_RELAXED, __HIP_MEMORY_SCOPE_AGENT); }
__device__ __forceinline__ unsigned xb_xcc_id() { return (unsigned)__builtin_amdgcn_s_getreg((3 << 11) | 20) & 0xFu; }
#define XB_SPIN(cond, bar) do { unsigned _sp = 0; while (cond) { __builtin_amdgcn_s_sleep(1); \
    if ((++_sp & 255u) == 0u) { if (xb_ld(&(bar)[XB_TMO])) break; if (_sp > XB_SPIN_CAP) { atomicAdd(&(bar)[XB_TMO], 1u); break; } } } } while (0)

struct XcdBarrier {
    unsigned* bar; unsigned x;
    volatile LAS unsigned* st;
};

__device__ __forceinline__ XcdBarrier xcd_barrier_post(unsigned* bar, volatile LAS unsigned* st) {
    XcdBarrier b; b.bar = bar; b.x = xb_xcc_id(); b.st = st;
    if (threadIdx.x == 0) (void)xb_add(&bar[XB_XCNT(b.x)], 1u);
    return b;
}
__device__ __forceinline__ void xcd_barrier_complete(unsigned* bar, unsigned x, unsigned& nloc, unsigned& nx) {
    const unsigned G = gridDim.x * gridDim.y * gridDim.z;
    unsigned sum, cnt, mine, sp = 0u;
    for (;;) {
        sum = 0u; cnt = 0u; mine = 0u;
#pragma unroll
        for (unsigned j = 0; j < 16; ++j) { const unsigned c = xb_ld(&bar[XB_XCNT(j)]); sum += c; cnt += (c > 0u) ? 1u : 0u; mine = (j == x) ? c : mine; }
        if (sum == G) break;
        __builtin_amdgcn_s_sleep(1);
        if ((++sp & 255u) == 0u) { if (xb_ld(&bar[XB_TMO])) break; if (sp > XB_SPIN_CAP) { atomicAdd(&bar[XB_TMO], 1u); break; } }
    }
    nloc = mine > 0u ? mine : 1u; nx = cnt > 0u ? cnt : 1u;
}

__device__ __forceinline__ void xcd_barrier(const XcdBarrier& b) {
    asm volatile("s_waitcnt vmcnt(0)" ::: "memory");
    __syncthreads();
    if (threadIdx.x == 0) {
        unsigned* bar = b.bar;
        __builtin_amdgcn_s_waitcnt(0);
        unsigned nloc = b.st[0], nx = b.st[1];
        if (nloc == 0u) { xcd_barrier_complete(bar, b.x, nloc, nx); b.st[0] = nloc; b.st[1] = nx; }
        const unsigned old = xb_add(&bar[XB_XSUB(b.x)], 1u);
        const unsigned gen = old / nloc;
        if (old + 1u == (gen + 1u) * nloc) {
            __builtin_amdgcn_fence(__ATOMIC_RELEASE, "agent");
            asm volatile("s_waitcnt vmcnt(0)" ::: "memory");
            const unsigned og = xb_add(&bar[XB_TOP], 1u);
            const unsigned tg = og / nx;
            if (og + 1u == (tg + 1u) * nx) xb_add(&bar[XB_TOPGEN], 1u);
            else XB_SPIN(xb_ld(&bar[XB_TOPGEN]) == tg, bar);
            __builtin_amdgcn_fence(__ATOMIC_ACQUIRE, "agent");
            xb_add(&bar[XB_XGEN(b.x)], 1u);
            asm volatile("s_waitcnt vmcnt(0)" ::: "memory");
        } else {
            XB_SPIN(xb_ld(&bar[XB_XGEN(b.x)]) == gen, bar);
            __builtin_amdgcn_fence(__ATOMIC_ACQUIRE, "agent");
            asm volatile("s_waitcnt vmcnt(0)" ::: "memory");
        }
    }
    __syncthreads();
}
struct Args { const float* in[20]; float* out; unsigned char* ws; };
enum { I_X = 0, I_C, I_CTX, I_CCTX, I_WADA, I_BADA, I_NMIX, I_WIN, I_BG, I_QN, I_KN, I_MLN, I_PW, I_PS, I_WOUT, I_NFFN, I_WG, I_WU, I_WD, I_FN };
constexpr int LDS_BYTES = 147456;
#ifndef REP_N1
#define REP_N1 1
#endif
#ifndef REP_G1
#define REP_G1 1
#endif
#ifndef REP_MIX
#define REP_MIX 1
#endif
#ifndef REP_N2
#define REP_N2 1
#endif
#ifndef REP_G3
#define REP_G3 1
#endif
#ifndef REP_PRO
#define REP_PRO 1
#endif
#ifndef ML_DUP
#define ML_DUP 1
#endif
#ifndef AL_DUP
#define AL_DUP 1
#endif
#ifndef MIXREP_MASK
#define MIXREP_MASK 15
#endif
#ifndef ML_VAR
#define ML_VAR 0
#endif
#ifndef PRO_MASK
#define PRO_MASK 7
#endif
#ifndef REP_SYNC
#define REP_SYNC 1
#endif

__device__ __forceinline__ void tr_item(const float* colp, size_t ld, int K, bf16_t* WT, int r0, int k0, LAS float* scr, int lane) {
    float tv[32];
#pragma unroll
    for (int i = 0; i < 32; ++i) { const int kk = 2 * i + (lane >> 5); tv[i] = colp ? colp[(size_t)(k0 + kk) * ld] : 0.f; }
#pragma unroll
    for (int i = 0; i < 32; ++i) { const int kk = 2 * i + (lane >> 5); scr[kk * 33 + (lane & 31)] = tv[i]; }
    asm volatile("s_waitcnt lgkmcnt(0)" ::: "memory");
    const int c = lane & 7;
#pragma unroll
    for (int j = 0; j < 4; ++j) { const int n = (lane >> 3) + 8 * j; const LAS float* s = scr + (8 * c) * 33 + n;
        u32x4 o; o.x = pk2(s[0 * 33], s[1 * 33]); o.y = pk2(s[2 * 33], s[3 * 33]); o.z = pk2(s[4 * 33], s[5 * 33]); o.w = pk2(s[6 * 33], s[7 * 33]);
        *(u32x4*)(WT + (size_t)(r0 + n) * K + k0 + 8 * c) = o; }
    asm volatile("s_waitcnt lgkmcnt(0)" ::: "memory");
}
__device__ __forceinline__ void tr_item_pool(const float* win, const float* pw, const float* ps, bf16_t* WT, int r0, int k0, LAS float* scr, int lane) {
    const int p = (r0 - 1792) + (lane & 31), oc = 64 * ((p >> 5) & 3) + 32 * (p >> 7) + (p & 31), g = oc >> 6, o = oc & 63;
    const float scl = ps[oc];
    const float* pwc = pw + (size_t)g * 4096 + o;
    float pwr[64];
#pragma unroll
    for (int q = 0; q < 64; ++q) pwr[q] = pwc[q * 64];
    for (int i = 0; i < 8; ++i) { const int kk = 2 * i + (lane >> 5); const float* wr = win + (size_t)(k0 + kk) * INW + 1808 + 64 * g;
        f32x4 w4[16];
#pragma unroll
        for (int q = 0; q < 16; ++q) w4[q] = *(const f32x4*)(wr + 4 * q);
        float s0 = 0.f, s1 = 0.f;
#pragma unroll
        for (int q = 0; q < 16; q += 2) { s0 += (w4[q][0] * pwr[4 * q] + w4[q][1] * pwr[4 * q + 1]) + (w4[q][2] * pwr[4 * q + 2] + w4[q][3] * pwr[4 * q + 3]);
            s1 += (w4[q + 1][0] * pwr[4 * q + 4] + w4[q + 1][1] * pwr[4 * q + 5]) + (w4[q + 1][2] * pwr[4 * q + 6] + w4[q + 1][3] * pwr[4 * q + 7]); }
        scr[kk * 33 + (lane & 31)] = (s0 + s1) * scl; }
    asm volatile("s_waitcnt lgkmcnt(0)" ::: "memory");
    { const int n = lane >> 1, c = lane & 1; const LAS float* s = scr + (8 * c) * 33 + n;
        u32x4 o4; o4.x = pk2(s[0 * 33], s[1 * 33]); o4.y = pk2(s[2 * 33], s[3 * 33]); o4.z = pk2(s[4 * 33], s[5 * 33]); o4.w = pk2(s[6 * 33], s[7 * 33]);
        *(u32x4*)(WT + (size_t)(r0 + n) * 1024 + k0 + 8 * c) = o4; }
    asm volatile("s_waitcnt lgkmcnt(0)" ::: "memory");
}

__device__ __forceinline__ void prologue(const Args& a, LAS unsigned char* lds, const int pmask) {
    const int tid = threadIdx.x, lane = tid & 63, wave = tid >> 6;
    unsigned char* ws = a.ws;
    if (blockIdx.x == 0) {
        for (int e = tid; e < 1024; e += 512) { const int pos = e >> 4, f = e & 15;
            const float invf = exp2f(-(float)(2 * f) * (13.287712379549449f / 32.0f));
            float ang = (float)pos * invf; ang -= 6.283185307179586f * rintf(ang * 0.15915494309189535f);
            float* cs = (float*)(ws + WS_ROPE) + e * 2; cs[0] = __cosf(ang); cs[1] = __sinf(ang); }
    }
    LAS float* scs = (LAS float*)lds;
    LAS float* red = (LAS float*)(lds + 17 * 4096);
    for (int e = tid; e < 17 * 1024; e += 512) { const float v = (e < 16 * 1024) ? a.in[I_C][e] : a.in[I_CCTX][e - 16 * 1024]; scs[e] = silu_f(v); }
    __syncthreads();
    for (int it = blockIdx.x; it < 2 * 192; it += gridDim.x) { if (!(pmask & 1)) break;
        const int l = it / 192, c0 = (it % 192) * 32, col = tid & 31, kp = tid >> 5;
        const float* W = a.in[I_WADA] + ((size_t)l * 1024 + kp * 64) * 6144 + c0 + col;
        float acc[17];
#pragma unroll
        for (int r = 0; r < 17; ++r) acc[r] = 0.f;
#pragma unroll 16
        for (int k4 = 0; k4 < 16; ++k4) { const float w0 = W[(size_t)(4 * k4) * 6144], w1 = W[(size_t)(4 * k4 + 1) * 6144], w2 = W[(size_t)(4 * k4 + 2) * 6144], w3 = W[(size_t)(4 * k4 + 3) * 6144];
#pragma unroll
            for (int r = 0; r < 17; ++r) { const f32x4 s = *(const LAS f32x4*)(scs + r * 1024 + kp * 64 + 4 * k4); acc[r] += (s[0] * w0 + s[1] * w1) + (s[2] * w2 + s[3] * w3); } }
#pragma unroll
        for (int r = 0; r < 17; ++r) red[(kp * 17 + r) * 32 + col] = acc[r];
        __syncthreads();
        for (int e = tid; e < 17 * 32; e += 512) { const int r = e >> 5, cc = e & 31; float s = 0.f;
#pragma unroll
            for (int q = 0; q < 16; ++q) s += red[(q * 17 + r) * 32 + cc];
            ((float*)(ws + WS_MOD))[((size_t)l * 17 + r) * 6144 + c0 + cc] = s + a.in[I_BADA][(size_t)l * 6144 + c0 + cc]; }
        __syncthreads();
    }
    LAS float* scr = (LAS float*)(lds + wave * 8448);
    const int gw = blockIdx.x * 8 + wave, NGW = gridDim.x * 8;
    constexpr int IT_W1 = 64 * 16, IT_WO = 32 * 16, IT_GU = 176 * 16, IT_WD = 32 * 44, IT_L = IT_W1 + IT_WO + IT_GU + IT_WD;
#define TR_DECODE(IT, COLP, LD, KK, WTP, R0, K0) do { const int l_ = (IT) / IT_L; int r_ = (IT) % IT_L; \
        if (r_ < IT_W1) { int rg_ = r_ / 16; if (rg_ >= 56) rg_ += 8; K0 = (r_ % 16) * 64; R0 = rg_ * 32; WTP = (bf16_t*)(ws + WS_W1 + l_ * W1_BYTES); \
            const float* win_ = a.in[I_WIN] + (size_t)l_ * 1024 * INW; const int rr_ = R0 + (lane & 31), pn_ = rr_ >> 8, p_ = rr_ & 255, oc_ = 64 * ((p_ >> 5) & 3) + 32 * (p_ >> 7) + (p_ & 31), cp_ = 256 * pn_ + oc_; \
            COLP = (cp_ < 1792) ? win_ + cp_ : (cp_ >= 2048 && cp_ < 2064) ? win_ + 1792 + (cp_ - 2048) : nullptr; LD = INW; KK = 1024; } \
        else if ((r_ -= IT_W1) < IT_WO) { R0 = (r_ / 16) * 32; K0 = (r_ % 16) * 64; COLP = a.in[I_WOUT] + (size_t)l_ * 1024 * 1024 + R0 + (lane & 31); LD = 1024; KK = 1024; WTP = (bf16_t*)(ws + WS_WO + l_ * WO_BYTES); } \
        else if ((r_ -= IT_WO) < IT_GU) { R0 = (r_ / 16) * 32; K0 = (r_ % 16) * 64; const int rr_ = R0 + (lane & 31), pn_ = rr_ >> 8, p_ = rr_ & 255, hcol_ = 128 * pn_ + (p_ & 127); \
            COLP = ((p_ >> 7) ? a.in[I_WU] : a.in[I_WG]) + (size_t)l_ * 1024 * DFF + hcol_; LD = DFF; KK = 1024; WTP = (bf16_t*)(ws + WS_WGU + l_ * WGU_BYTES); } \
        else { r_ -= IT_GU; R0 = (r_ / 44) * 32; K0 = (r_ % 44) * 64; COLP = a.in[I_WD] + (size_t)l_ * DFF * 1024 + R0 + (lane & 31); LD = 1024; KK = DFF; WTP = (bf16_t*)(ws + WS_WD + l_ * WD_BYTES); } } while (0)
#define TR_LOAD(TV, COLP, LD, K0) do { _Pragma("unroll") for (int i_ = 0; i_ < 32; ++i_) { const int kk_ = 2 * i_ + (lane >> 5); TV[i_] = (COLP) ? (COLP)[(size_t)((K0) + kk_) * (LD)] : 0.f; } } while (0)
    if (pmask & 2) {
        int it = gw;
        const float* colp = nullptr; size_t ld = 0; int KK = 0, r0 = 0, k0 = 0; bf16_t* WT = nullptr;
        float tv[32];
        if (it < 2 * IT_L) { TR_DECODE(it, colp, ld, KK, WT, r0, k0); TR_LOAD(tv, colp, ld, k0); }
        while (it < 2 * IT_L) {
            const int itn = it + NGW;
            const float* colpn = nullptr; size_t ldn = 0; int KKn = 0, r0n = 0, k0n = 0; bf16_t* WTn = nullptr;
            float tn[32];
            if (itn < 2 * IT_L) { TR_DECODE(itn, colpn, ldn, KKn, WTn, r0n, k0n); TR_LOAD(tn, colpn, ldn, k0n); }
#pragma unroll
            for (int i = 0; i < 32; ++i) { const int kk = 2 * i + (lane >> 5); scr[kk * 33 + (lane & 31)] = tv[i]; }
            asm volatile("s_waitcnt lgkmcnt(0)" ::: "memory");
            { const int c = lane & 7;
#pragma unroll
                for (int j = 0; j < 4; ++j) { const int n = (lane >> 3) + 8 * j; const LAS float* s = scr + (8 * c) * 33 + n;
                    u32x4 o; o.x = pk2(s[0 * 33], s[1 * 33]); o.y = pk2(s[2 * 33], s[3 * 33]); o.z = pk2(s[4 * 33], s[5 * 33]); o.w = pk2(s[6 * 33], s[7 * 33]);
                    *(u32x4*)(WT + (size_t)(r0 + n) * KK + k0 + 8 * c) = o; } }
            asm volatile("s_waitcnt lgkmcnt(0)" ::: "memory");
            it = itn; colp = colpn; ld = ldn; KK = KKn; r0 = r0n; k0 = k0n; WT = WTn;
#pragma unroll
            for (int i = 0; i < 32; ++i) tv[i] = tn[i];
        }
    }
#undef TR_DECODE
#undef TR_LOAD
    if (pmask & 4)
    for (int it = gw; it < 1024; it += NGW) { const int l = it >> 9, rg = (it & 511) >> 6, kg = it & 63;
        tr_item_pool(a.in[I_WIN] + (size_t)l * 1024 * INW, a.in[I_PW] + (size_t)l * 4 * 4096, a.in[I_PS] + l * 256, (bf16_t*)(ws + WS_W1 + l * W1_BYTES), 1792 + rg * 32, kg * 16, scr, lane); }
}

__device__ __forceinline__ void norm_phase(const float* xl, const float* xc, const float* gw, const float* mod  , int sh_off, int sc_off, bf16_t* XN, int nrows) {
    const int tid = opaque_tid(), lane = tid & 63, gwv = blockIdx.x * 8 + (tid >> 6), NGW = gridDim.x * 8;
    const int per = (nrows + NGW - 1) / NGW;
    int cur = -1; f32x4 mul[4], add[4];
    for (int q = 0; q < per; ++q) {
        const int row = gwv * per + q; if (row >= nrows) break;
        const int mr = row < NLAT ? row / TLAT : 16;
        if (mr != cur) { cur = mr; const float* mp = mod + (size_t)mr * 6144;
#pragma unroll
            for (int j = 0; j < 4; ++j) { const f32x4 g = *(const f32x4*)(gw + 4 * lane + 256 * j), s = *(const f32x4*)(mp + sc_off + 4 * lane + 256 * j); mul[j] = g * (s + 1.0f); add[j] = *(const f32x4*)(mp + sh_off + 4 * lane + 256 * j); } }
        const float* xr = row < NLAT ? xl + (size_t)row * 1024 : xc + (size_t)(row - NLAT) * 1024;
        f32x4 v[4]; float ss = 0.f;
#pragma unroll
        for (int j = 0; j < 4; ++j) { v[j] = __builtin_nontemporal_load((const f32x4*)(xr + 4 * lane + 256 * j)); ss += (v[j][0] * v[j][0] + v[j][1] * v[j][1]) + (v[j][2] * v[j][2] + v[j][3] * v[j][3]); }
        const float rstd = rsqrtf(wave_sum(ss) * (1.0f / 1024.0f) + EPS);
        unsigned long long* o8 = (unsigned long long*)(XN + (size_t)row * 1024) + lane;
#pragma unroll
        for (int j = 0; j < 4; ++j) { const f32x4 y = v[j] * rstd * mul[j] + add[j]; o8[64 * j] = (unsigned long long)pk2(y[0], y[1]) | ((unsigned long long)pk2(y[2], y[3]) << 32); }
    }
}
__device__ __forceinline__ void ctx_gates_phase(const float* xc, const float* gw, const float* modc, const float* win, const float* bg, float* GT, LAS unsigned char* lds) {
    const int tid = opaque_tid(), lane = tid & 63, gwv = blockIdx.x * 8 + (tid >> 6), NGW = gridDim.x * 8;
    LAS float* wg = (LAS float*)lds;
    for (int e = tid; e < 4096; e += 512) { const int k = e >> 2, q4 = e & 3; *(LAS f32x4*)(wg + k * 16 + q4 * 4) = *(const f32x4*)(win + (size_t)k * INW + 1792 + q4 * 4); }
    __syncthreads();
    for (int r = gwv; r < NCTX; r += NGW) {
        asm volatile("" ::: "memory");
        const float* xr = xc + (size_t)r * 1024; float h[16]; float ss = 0.f;
#pragma unroll
        for (int q = 0; q < 16; ++q) { h[q] = xr[lane + 64 * q]; ss += h[q] * h[q]; }
        const float rstd = rsqrtf(wave_sum(ss) * (1.0f / 1024.0f) + EPS);
        f32x4 acc[4];
#pragma unroll
        for (int q = 0; q < 4; ++q) acc[q] = (f32x4){0.f, 0.f, 0.f, 0.f};
#pragma unroll
        for (int q = 0; q < 16; ++q) { const int c = lane + 64 * q; const float hv = h[q] * rstd * gw[c] * (modc[1024 + c] + 1.0f) + modc[c];
#pragma unroll
            for (int g4 = 0; g4 < 4; ++g4) acc[g4] += *(const LAS f32x4*)(wg + c * 16 + 4 * g4) * hv; }
        float out = 0.f;
#pragma unroll
        for (int q = 0; q < 4; ++q)
#pragma unroll
            for (int i = 0; i < 4; ++i) { const float v = wave_sum(acc[q][i]); if (lane == 4 * q + i) out = v; }
        if (lane < 16) GT[(size_t)(NLAT + r) * 16 + lane] = out + bg[lane];
    }
    __syncthreads();
}
__device__ __forceinline__ void norm_phase_bf(const bf16_t* xs, const float* gw, const float* mod, int sh_off, int sc_off, bf16_t* XN, int nrows, const float* part = nullptr, int nsplit = 0, const float* pgate = nullptr, const float* cbase = nullptr, bf16_t* xs_w = nullptr) {
    const int tid = opaque_tid(), lane = tid & 63, gwv = blockIdx.x * 8 + (tid >> 6), NGW = gridDim.x * 8;
    const int per = (nrows + NGW - 1) / NGW;
    int cur = -1; f32x4 mul[4], add[4];
    for (int q = 0; q < per; ++q) {
        const int row = gwv * per + q; if (row >= nrows) break;
        const int mr = row < NLAT ? row / TLAT : 16;
        if (mr != cur) { cur = mr; const float* mp = mod + (size_t)mr * 6144;
#pragma unroll
            for (int j = 0; j < 4; ++j) { const int c = 8 * lane + 512 * (j >> 1) + 4 * (j & 1); const f32x4 g = *(const f32x4*)(gw + c), s = *(const f32x4*)(mp + sc_off + c); mul[j] = g * (s + 1.0f); add[j] = *(const f32x4*)(mp + sh_off + c); } }
        const bf16_t* xr = xs + (size_t)row * 1024;
        f32x4 v[4]; float ss = 0.f;
#pragma unroll
        for (int j = 0; j < 2; ++j) { const u32x4 w = *(const u32x4*)(xr + 8 * lane + 512 * j);
            v[2 * j] = (f32x4){bf2f(w.x & 0xffffu), bf2f(w.x >> 16), bf2f(w.y & 0xffffu), bf2f(w.y >> 16)}; v[2 * j + 1] = (f32x4){bf2f(w.z & 0xffffu), bf2f(w.z >> 16), bf2f(w.w & 0xffffu), bf2f(w.w >> 16)}; }
        if (part && row >= NLAT) {
#pragma unroll
            for (int j = 0; j < 4; ++j) { const int c = 8 * lane + 512 * (j >> 1) + 4 * (j & 1); f32x4 s = (f32x4){0.f, 0.f, 0.f, 0.f};
                if (cbase) v[j] = *(const f32x4*)(cbase + (size_t)(row - NLAT) * 1024 + c);
                for (int k = 0; k < nsplit; ++k) s += *(const f32x4*)(part + ((size_t)k * NCTX + (row - NLAT)) * 1024 + c);
                v[j] += *(const f32x4*)(pgate + c) * s; }
            if (xs_w) {
#pragma unroll
                for (int j = 0; j < 2; ++j) { u32x4 o; o.x = pk2(v[2 * j][0], v[2 * j][1]); o.y = pk2(v[2 * j][2], v[2 * j][3]); o.z = pk2(v[2 * j + 1][0], v[2 * j + 1][1]); o.w = pk2(v[2 * j + 1][2], v[2 * j + 1][3]);
                    *(u32x4*)(xs_w + (size_t)row * 1024 + 8 * lane + 512 * j) = o; } } }
#pragma unroll
        for (int j = 0; j < 4; ++j) ss += (v[j][0] * v[j][0] + v[j][1] * v[j][1]) + (v[j][2] * v[j][2] + v[j][3] * v[j][3]);
        const float rstd = rsqrtf(wave_sum(ss) * (1.0f / 1024.0f) + EPS);
#pragma unroll
        for (int j = 0; j < 2; ++j) { const f32x4 y0 = v[2 * j] * rstd * mul[2 * j] + add[2 * j], y1 = v[2 * j + 1] * rstd * mul[2 * j + 1] + add[2 * j + 1];
            u32x4 o; o.x = pk2(y0[0], y0[1]); o.y = pk2(y0[2], y0[3]); o.z = pk2(y1[0], y1[1]); o.w = pk2(y1[2], y1[3]);
            *(u32x4*)(XN + (size_t)row * 1024 + 8 * lane + 512 * j) = o; }
    }
}
__device__ __forceinline__ void final_norm_phase(float* x, const float* gw) {
    const int tid = opaque_tid(), lane = tid & 63, gwv = blockIdx.x * 8 + (tid >> 6), NGW = gridDim.x * 8;
    f32x4 g[4];
#pragma unroll
    for (int j = 0; j < 4; ++j) g[j] = *(const f32x4*)(gw + 4 * lane + 256 * j);
    for (int row = gwv; row < NLAT; row += NGW) {
        float* xr = x + (size_t)row * 1024; f32x4 v[4]; float ss = 0.f;
#pragma unroll
        for (int j = 0; j < 4; ++j) { v[j] = __builtin_nontemporal_load((const f32x4*)(xr + 4 * lane + 256 * j)); ss += (v[j][0] * v[j][0] + v[j][1] * v[j][1]) + (v[j][2] * v[j][2] + v[j][3] * v[j][3]); }
        const float rstd = rsqrtf(wave_sum(ss) * (1.0f / 1024.0f) + EPS);
#pragma unroll
        for (int j = 0; j < 4; ++j) __builtin_nontemporal_store(v[j] * rstd * g[j], (f32x4*)(xr + 4 * lane + 256 * j));
    }
}

__global__ void __launch_bounds__(512, 2) fwd_megakernel(Args a) {
    extern __shared__ __attribute__((aligned(16))) unsigned char lds_raw[];
    LAS unsigned char* lds = (LAS unsigned char*)lds_raw;
    unsigned char* ws = a.ws;
    const int tid = threadIdx.x;
    float* MOD = (float*)(ws + WS_MOD);
    bf16_t* XN = (bf16_t*)(ws + WS_XN); bf16_t* QB = (bf16_t*)(ws + WS_QB); bf16_t* KB = (bf16_t*)(ws + WS_KB); bf16_t* VB = (bf16_t*)(ws + WS_VB);
    bf16_t* MLB = (bf16_t*)(ws + WS_MLB); bf16_t* PZ = (bf16_t*)(ws + WS_PZ); float* GT = (float*)(ws + WS_GT); bf16_t* HS = (bf16_t*)(ws + WS_HS); bf16_t* HS1 = (bf16_t*)(ws + WS_HS1);
    bf16_t* MIX = (bf16_t*)(ws + WS_MIX); bf16_t* HID = (bf16_t*)(ws + WS_HID); bf16_t* XS = (bf16_t*)(ws + WS_XS);
    unsigned* ctl = (unsigned*)(ws + WS_CTL);
    LAS int* item_s = (LAS int*)(lds + 131072 + 1024);
    volatile LAS unsigned* bst = (volatile LAS unsigned*)(lds + 131072 + 2048);
    if (tid < 4) bst[tid] = 0u;
    __syncthreads();
    XcdBarrier xbar = xcd_barrier_post(ctl + 4096, bst);
#define GSYNC() xcd_barrier(xbar)

    for (int rp = 0; rp < REP_PRO; ++rp) { prologue(a, lds, rp == 0 ? 7 : PRO_MASK);
    GSYNC(); }

    for (int l = 0; l < 2; ++l) {
        const float* xl_in = a.in[I_X];
        const float* xc_in = a.in[I_CTX];
        const float* modl = MOD + (size_t)l * 17 * 6144;
        for (int rp = 0; rp < REP_N1; ++rp) { if (l == 0) norm_phase(xl_in, xc_in, a.in[I_NMIX] + l * 1024, modl, 0, 1024, XN, MTOT); else norm_phase_bf(XS, a.in[I_NMIX] + l * 1024, modl, 0, 1024, XN, MTOT, (const float*)(ws + WS_MIX + 32 * MiB), 2, MOD + (size_t)16 * 6144 + 5120);
        if (l == 0) ctx_gates_phase(xc_in, a.in[I_NMIX], modl + 16 * 6144, a.in[I_WIN], a.in[I_BG], GT, lds);
        for (int rs = 0; rs < REP_SYNC; ++rs) GSYNC(); }
        for (int rp = 0; rp < REP_G1; ++rp) {
            pg8::Gemm g{XN, (const bf16_t*)(ws + WS_W1 + l * W1_BYTES), MTOT, N1, 1024}; pg8::G1Order S; S.init(gridDim.x, (int)blockIdx.x, l == 0);
            pg8::EpiIn E{QB, KB, VB, MLB, PZ, GT, a.in[I_QN] + l * 64, a.in[I_KN] + l * 64, a.in[I_BG] + l * 16, (const float*)(ws + WS_ROPE), attn_body::C2};
            pg8::gemm_phase<pg8::EpiIn, pg8::G1Order, true, true>(lds, g, S, E);
        GSYNC(); }
        for (int rp = 0; rp < REP_MIX; ++rp) {
            const int n_ml = 128 * ML_DUP, n_al = 1024 * AL_DUP, n_ac = (l == 0) ? 128 : 0, n_pool = (l == 0) ? 288 : 256, n_all = n_ml + n_al + n_ac + n_pool;
            for (;;) {
                __syncthreads();
                if (tid == 0) item_s[0] = (int)atomicAdd(ctl + 64 * (l * 4 + rp), 1u);
                __syncthreads();
                int it = item_s[0];
                if (it >= n_all) break;
                const int cmask = (rp == 0) ? 15 : MIXREP_MASK;
                if (it < n_ml) { if (!(cmask & 1)) continue; const int itm = it & 127, mb = itm >> 3, mh = (itm >> 1) & 3, md = itm & 1;
                    if (rp == 0) ml::mlstm_item<0>(mb, mh, md, MLB, GT, md ? HS1 : HS, lds); else ml::mlstm_item<ML_VAR>(mb, mh, md, MLB, GT, md ? HS1 : HS, lds);
                    continue; }
                it -= n_ml;
                if (it < n_al) { if (!(cmask & 2)) continue; const int b = (it >> 6) & 15, h = (it >> 3) & 7, qb = it & 7;
                    attn_body::attn_unit<8>((const attn_body::bf16*)(QB + ((size_t)b * TLAT + qb * 256) * 512 + h * 64), (const attn_body::bf16*)(KB + (size_t)b * TKV * 128 + (h >> 2) * 64),
                                            (const attn_body::bf16*)(VB + (size_t)b * TKV * 128 + (h >> 2) * 64), (attn_body::bf16*)(MIX + ((size_t)b * TLAT + qb * 256) * 1024 + h * 64), TKV / 64, (char*)lds_raw);
                    continue; }
                it -= n_al;
                if (it < n_ac) { if (!(cmask & 4)) continue; const int b = it >> 3, h = it & 7;
                    attn_body::attn_unit<8>((const attn_body::bf16*)(QB + ((size_t)NLAT + b * TCTX) * 512 + h * 64), (const attn_body::bf16*)(KB + ((size_t)b * TKV + TLAT) * 128 + (h >> 2) * 64),
                                            (const attn_body::bf16*)(VB + ((size_t)b * TKV + TLAT) * 128 + (h >> 2) * 64), (attn_body::bf16*)(MIX + ((size_t)NLAT + b * TCTX) * 1024 + h * 64), TCTX / 64, (char*)lds_raw);
                    continue; }
                it -= n_ac;
                if (cmask & 8) pool_item(it, PZ, MIX, lds);
            }
        GSYNC(); }
        ml::mlstm_readout_phase(l == 0, HS, HS1, MLB, MIX, a.in[I_MLN] + l * 256);
        GSYNC();
        const int Mrows = (l == 0) ? MTOT : NLAT;
        {
            pg8::Gemm g{MIX, (const bf16_t*)(ws + WS_WO + l * WO_BYTES), Mrows, 1024, 1024, 0}; pg8::StaticOrder S; S.init(Mrows, 1024, gridDim.x, (int)blockIdx.x);
            if (l == 0) { pg8::EpiRes2<false, true> E{xl_in, xc_in, XS, nullptr, modl + 2048}; pg8::gemm_phase<pg8::EpiRes2<false, true>, pg8::StaticOrder, true, true>(lds, g, S, E); }
            else { pg8::EpiRes2<true, true> E{nullptr, nullptr, XS, nullptr, modl + 2048}; pg8::gemm_phase<pg8::EpiRes2<true, true>, pg8::StaticOrder, true, true>(lds, g, S, E); }
        }
        GSYNC();
        for (int rp = 0; rp < REP_N2; ++rp) { norm_phase_bf(XS, a.in[I_NFFN] + l * 1024, modl, 3072, 4096, XN, Mrows);
        GSYNC(); }
        for (int rp = 0; rp < REP_G3; ++rp) {
            pg8::Gemm g{XN, (const bf16_t*)(ws + WS_WGU + l * WGU_BYTES), Mrows, NGU, 1024}; pg8::StaticOrder S; S.init(Mrows, NGU, gridDim.x, (int)blockIdx.x);
            pg8::EpiGU E{HID};
            pg8::gemm_phase<pg8::EpiGU, pg8::StaticOrder, true, true>(lds, g, S, E);
        GSYNC(); }
        {
            pg8::Gemm g{HID, (const bf16_t*)(ws + WS_WD + l * WD_BYTES), NLAT, 1024, DFF, 0}; pg8::StaticOrder S; S.init(NLAT, 1024, gridDim.x, (int)blockIdx.x);
            if (l == 0) { pg8::EpiRes2<true, true> E{nullptr, nullptr, XS, nullptr, modl + 5120}; pg8::gemm_phase<pg8::EpiRes2<true, true>, pg8::StaticOrder, true, true>(lds, g, S, E);
                for (int kc = 0; kc < 2; ++kc) { pg8::Gemm gt{HID + kc * (DFF / 2), (const bf16_t*)(ws + WS_WD) + kc * (DFF / 2), MTOT, 1024, DFF / 2, DFF}; pg8::TailOrder T{(int)blockIdx.x, 64 * kc};
                    pg8::EpiPart EP{(float*)(ws + WS_MIX + 32 * MiB) + (size_t)kc * NCTX * 1024};
                    pg8::gemm_phase<pg8::EpiPart, pg8::TailOrder, true, true>(lds, gt, T, EP); } }
            else { pg8::EpiRes2<true, false> E{nullptr, nullptr, XS, a.out, modl + 5120}; pg8::gemm_phase<pg8::EpiRes2<true, false>, pg8::StaticOrder, true, true>(lds, g, S, E); }
        }
        GSYNC();
    }
    final_norm_phase(a.out, a.in[I_FN]);
}

extern "C" void kernel_launch(void* const* d_in, const int* in_sizes, int n_in, void* d_out, int out_size, void* d_ws, size_t ws_size, hipStream_t stream) {
    static int grid_blocks = 0;
    if (grid_blocks == 0) {
        if (n_in != 20 || ws_size < WS_END) { fprintf(stderr, "kernel_launch: unexpected n_in %d / ws_size %zu\n", n_in, ws_size); grid_blocks = -1; return; }
        int dev = 0, cus = 0, per_cu = 0;
        hipGetDevice(&dev);
        hipDeviceGetAttribute(&cus, hipDeviceAttributeMultiprocessorCount, dev);
        if (hipFuncSetAttribute((const void*)fwd_megakernel, hipFuncAttributeMaxDynamicSharedMemorySize, LDS_BYTES) != hipSuccess) { fprintf(stderr, "kernel_launch: hipFuncSetAttribute failed\n"); grid_blocks = -1; return; }
        if (hipOccupancyMaxActiveBlocksPerMultiprocessor(&per_cu, (const void*)fwd_megakernel, 512, LDS_BYTES) != hipSuccess || per_cu < 1) { fprintf(stderr, "kernel_launch: occupancy query failed (%d)\n", per_cu); grid_blocks = -1; return; }
        grid_blocks = cus * per_cu;
    }
    if (grid_blocks < 0) return;
    hipMemsetAsync((char*)d_ws + WS_CTL, 0, 65536, stream);
    Args a{};
    for (int i = 0; i < 20; ++i) a.in[i] = (const float*)d_in[i];
    a.out = (float*)d_out; a.ws = (unsigned char*)d_ws;
    void* args[] = {&a};
    hipError_t e = hipLaunchCooperativeKernel((const void*)fwd_megakernel, dim3(grid_blocks), dim3(512), args, LDS_BYTES, stream);
    if (e != hipSuccess) fprintf(stderr, "cooperative launch failed: %s (grid %d)\n", hipGetErrorString(e), grid_blocks);
}
```

```cpp
#include <hip/hip_runtime.h>
#include <hip/hip_cooperative_groups.h>
#include <hip/hip_bf16.h>
#include <cstdio>
#include <cstdint>
#include <cmath>
namespace cg = cooperative_groups;

constexpr int DMODEL = 1024, NBATCH = 16, TLAT = 2048, TCTX = 256, NLAT = NBATCH * TLAT, NCTX = NBATCH * TCTX, MTOT = NLAT + NCTX;
constexpr int N1 = 2304, DFF = 2816, NGU = 2 * DFF, TKV = TLAT + TCTX, INW = 2064;
constexpr float EPS = 1e-6f;
constexpr size_t MiB = 1u << 20;
constexpr size_t WS_CTL = 0, WS_MOD = 1 * MiB, WS_ROPE = 2 * MiB, WS_W1 = 4 * MiB, WS_WO = 13 * MiB, WS_WGU = 17 * MiB, WS_WD = 39 * MiB,
                 WS_XC = 50 * MiB, WS_XN = 66 * MiB, WS_QB = 138 * MiB, WS_KB = 174 * MiB, WS_VB = 183 * MiB, WS_MLB = 192 * MiB, WS_PZ = 264 * MiB,
                 WS_GT = 282 * MiB, WS_HS = 285 * MiB, WS_MIX = 321 * MiB, WS_HID = 138 * MiB, WS_HS1 = 393 * MiB, WS_XS = 429 * MiB, WS_END = 501 * MiB;
constexpr size_t W1_BYTES = (size_t)N1 * 1024 * 2, WO_BYTES = (size_t)1024 * 1024 * 2, WGU_BYTES = (size_t)NGU * 1024 * 2, WD_BYTES = (size_t)1024 * DFF * 2;

#define LAS __attribute__((address_space(3)))
typedef unsigned short bf16_t;
typedef float f32x4 __attribute__((ext_vector_type(4)));
typedef unsigned u32x4 __attribute__((ext_vector_type(4)));
typedef short bf16x8 __attribute__((ext_vector_type(8)));

__device__ __forceinline__ unsigned f2bf(float f) { unsigned u = __builtin_bit_cast(unsigned, f); return (u + 0x7fffu + ((u >> 16) & 1u)) >> 16; }
typedef float f32x2_hw __attribute__((ext_vector_type(2))); typedef __bf16 bf16x2_hw __attribute__((ext_vector_type(2)));
__device__ __forceinline__ unsigned pk2(float lo, float hi) { f32x2_hw v = {lo, hi}; bf16x2_hw b = __builtin_convertvector(v, bf16x2_hw); return __builtin_bit_cast(unsigned, b); }
__device__ __forceinline__ unsigned f2bf_hw(float f) { return pk2(f, 0.f) & 0xffffu; }
__device__ __forceinline__ float bf2f(unsigned v) { return __builtin_bit_cast(float, v << 16); }
__device__ __forceinline__ float silu_f(float x) { return x * __builtin_amdgcn_rcpf(1.0f + __expf(-x)); }
__device__ __forceinline__ float sigmoid_f(float x) { return __builtin_amdgcn_rcpf(1.0f + __expf(-x)); }
__device__ __forceinline__ float wave_sum(float v) {
#pragma unroll
    for (int o = 1; o < 64; o <<= 1) v += __shfl_xor(v, o);
    return v;
}
__device__ __forceinline__ int opaque_tid() { int t = threadIdx.x; asm volatile("" : "+v"(t)); return t; }
namespace pg8 {
#define PG8_LAS __attribute__((address_space(3)))
typedef unsigned short bf16_t;
typedef short bf16x8 __attribute__((ext_vector_type(8)));
typedef float f32x4 __attribute__((ext_vector_type(4)));
typedef unsigned u32x4 __attribute__((ext_vector_type(4)));
constexpr int BM = 256, BK = 64, HALF = 128, HTB = HALF * BK * 2  , STAGE_BYTES = 8 * HTB, NXCD = 8, WGM = 8;

__host__ __device__ __forceinline__ int lds_byte(int r, int c) { const int st = (r >> 4) * 2 + (c >> 5), rr = r & 15, cc = c & 31, ob = rr * 64 + cc * 2; return st * 1024 + (ob ^ (((ob >> 9) & 1) << 5)); }
__host__ __device__ __forceinline__ void stage_rc(int b, int& R, int& C) { const int st = b / 1024, sb = b % 1024, swz = sb ^ (((sb >> 9) & 1) << 5); R = (st >> 1) * 16 + swz / 64; C = (st & 1) * 32 + (swz % 64) / 2; }
__host__ __device__ __forceinline__ int perm32(int rho) { const int n = rho >> 4, i = rho & 15; return 8 * (i >> 2) + 4 * n + (i & 3); }

struct Unit { int pm, pn; };
struct Gemm { const bf16_t* A; const bf16_t* Bt; int M, N, K; int ld; };

struct StaticOrder {
    int nM, nN, nwg, G, c;
    __host__ __device__ void init(int M, int N, int G_, int c_) { nM = M / BM; nN = N / BM; nwg = nM * nN; G = G_; c = c_; }
    __host__ __device__ bool next(int i, Unit& u) const {
        const long L = (long)i * G + c; if (L >= nwg) return false;
        int wgid = (int)L; { const int q = nwg / NXCD, r = nwg % NXCD, xcd = wgid % NXCD, off = wgid / NXCD; wgid = (xcd < r ? xcd * (q + 1) : r * (q + 1) + (xcd - r) * q) + off; }
        const int nig = WGM * nN, gid = wgid / nig, fm = gid * WGM, gsz = (nM - fm) < WGM ? (nM - fm) : WGM;
        u.pm = fm + ((wgid % nig) % gsz); u.pn = (wgid % nig) / gsz; return true;
    }
    __device__ __forceinline__ void a_ready(const Unit&) const {}
    __device__ __forceinline__ void done(const Unit&) const {}
};

__device__ __forceinline__ unsigned cvt_pk_bf16(float lo, float hi) { unsigned r; asm volatile("v_cvt_pk_bf16_f32 %0, %1, %2" : "=v"(r) : "v"(lo), "v"(hi)); return r; }
typedef float f32x2 __attribute__((ext_vector_type(2)));
struct G1Order {
    StaticOrder so; int G, c, next_n, npn; int pl0, pl1, pl2, pl3, pl4, pl5, pl6, pl7;
    __device__ void init(int G_, int c_, bool layer0) { so.init(NLAT, N1, G_, c_); G = G_; c = c_;
        if (layer0) { npn = 8; pl0 = 0; pl1 = 1; pl2 = 2; pl3 = 3; pl4 = 4; pl5 = 5; pl6 = 6; pl7 = 7; }
        else { npn = 5; pl0 = 2; pl1 = 3; pl2 = 4; pl3 = 5; pl4 = 8; pl5 = 0; pl6 = 0; pl7 = 0; }
        next_n = 16 * npn; }
    __device__ bool next(int i, Unit& u) const {
        const int L = i * G + c;
        if (L < so.nwg) return so.next(i, u);
        const int e = L - so.nwg; if (e >= next_n) return false;
        const int d = (npn == 8) ? (e >> 3) : ((e * 52429) >> 18); const int q = e - d * npn; u.pm = 128 + d;
        u.pn = (q == 0) ? pl0 : (q == 1) ? pl1 : (q == 2) ? pl2 : (q == 3) ? pl3 : (q == 4) ? pl4 : (q == 5) ? pl5 : (q == 6) ? pl6 : pl7; return true; }
    __device__ __forceinline__ void a_ready(const Unit&) const {}
    __device__ __forceinline__ void done(const Unit&) const {}
};
struct EpiIn {
    static constexpr bool PERM = true, AFTER_DRAIN = false;
    bf16_t *QB, *KB, *VB, *MLB, *PZ; float* GT;
    const float *qn, *kn, *bg; const float* CS;
    float c2;
    __device__ __forceinline__ void operator()(const f32x4 (&acc)[2][2][4][2], const Unit& u, int wr, int wc, int fr, int fq) const {
        const int pn = u.pn, pm = u.pm;
        const bool lat = pm < 128;
        const int rt0 = wr * 64 + fr;
        const size_t grow0 = (size_t)pm * 256 + rt0;
        const size_t kv0 = lat ? ((size_t)(pm >> 3) * TKV + (size_t)(pm & 7) * 256 + rt0) : ((size_t)(pm - 128) * TKV + TLAT + rt0);
        if (pn < 2 || (pn == 2 && wc < 2)) {
            const bool isq = pn < 2;
            const float* nw = isq ? qn : kn;
            f32x4 wv[2][2];
#pragma unroll
            for (int bj = 0; bj < 2; ++bj)
#pragma unroll
                for (int n = 0; n < 2; ++n) wv[bj][n] = *(const f32x4*)(nw + 32 * bj + 8 * fq + 4 * n);
            const float sgn = (fq < 2) ? -1.f : 1.f;
            const float osc = isq ? c2 : 1.f;
#pragma unroll
            for (int ai = 0; ai < 2; ++ai)
#pragma unroll
                for (int m = 0; m < 4; ++m) {
                    float ss = 0.f;
#pragma unroll
                    for (int bj = 0; bj < 2; ++bj)
#pragma unroll
                        for (int n = 0; n < 2; ++n) { const f32x4 v = acc[ai][bj][m][n]; ss += (v[0] * v[0] + v[1] * v[1]) + (v[2] * v[2] + v[3] * v[3]); }
                    ss += __shfl_xor(ss, 16); ss += __shfl_xor(ss, 32);
                    const float rstd = rsqrtf(ss * (1.0f / 64.0f) + EPS);
                    const int roff = ai * 128 + m * 16;
#pragma unroll
                    for (int bj = 0; bj < 2; ++bj) {
                        f32x4 y[2];
#pragma unroll
                        for (int n = 0; n < 2; ++n) y[n] = acc[ai][bj][m][n] * rstd * wv[bj][n];
                        if (lat) {
                            const int pos = (bj == 0) ? ((pm & 7) * 4 + 2 * ai + wr) : (m * 16 + fr);
                            const float* cs = CS + (size_t)pos * 32 + 16 * (fq & 1);
#pragma unroll
                            for (int n = 0; n < 2; ++n) {
                                const f32x4 t0 = *(const f32x4*)(cs + 8 * n), t1 = *(const f32x4*)(cs + 8 * n + 4);
                                f32x4 p;
                                p[0] = __shfl_xor(y[n][0], 32); p[1] = __shfl_xor(y[n][1], 32); p[2] = __shfl_xor(y[n][2], 32); p[3] = __shfl_xor(y[n][3], 32);
                                f32x4 o;
                                o[0] = y[n][0] * t0[0] + sgn * p[0] * t0[1];
                                o[1] = y[n][1] * t0[2] + sgn * p[1] * t0[3];
                                o[2] = y[n][2] * t1[0] + sgn * p[2] * t1[1];
                                o[3] = y[n][3] * t1[2] + sgn * p[3] * t1[3];
                                y[n] = o;
                            }
                        }
                        u32x4 w;
                        w.x = cvt_pk_bf16(y[0][0] * osc, y[0][1] * osc); w.y = cvt_pk_bf16(y[0][2] * osc, y[0][3] * osc);
                        w.z = cvt_pk_bf16(y[1][0] * osc, y[1][1] * osc); w.w = cvt_pk_bf16(y[1][2] * osc, y[1][3] * osc);
                        bf16_t* dst = isq ? (QB + (grow0 + roff) * 512 + (4 * pn + wc) * 64 + 32 * bj + 8 * fq)
                                          : (KB + (kv0 + roff) * 128 + wc * 64 + 32 * bj + 8 * fq);
                        *(u32x4*)dst = w;
                    }
                    asm volatile("" ::: "memory");
                }
        } else if (pn <= 7) {
            bf16_t* base; size_t ld; size_t r0; int cb; float sc = 1.f;
            if (pn == 2) { base = VB; ld = 128; r0 = kv0; cb = (wc - 2) * 64; }
            else if (pn == 7) { base = PZ; ld = 256; r0 = grow0; cb = wc * 64; }
            else { base = MLB; ld = 1024; r0 = grow0; cb = (pn - 3) * 256 + wc * 64; if (pn == 4) sc = 0.125f; }
#pragma unroll
            for (int ai = 0; ai < 2; ++ai)
#pragma unroll
                for (int m = 0; m < 4; ++m)
#pragma unroll
                    for (int bj = 0; bj < 2; ++bj) {
                        const f32x4 v0 = acc[ai][bj][m][0] * sc, v1 = acc[ai][bj][m][1] * sc;
                        u32x4 w; w.x = cvt_pk_bf16(v0[0], v0[1]); w.y = cvt_pk_bf16(v0[2], v0[3]); w.z = cvt_pk_bf16(v1[0], v1[1]); w.w = cvt_pk_bf16(v1[2], v1[3]);
                        *(u32x4*)(base + (r0 + ai * 128 + m * 16) * ld + cb + 32 * bj + 8 * fq) = w;
                    }
        } else {
            if (wc == 0 && fq < 2) {
                const f32x4 b0 = *(const f32x4*)(bg + 8 * fq), b1 = *(const f32x4*)(bg + 8 * fq + 4);
#pragma unroll
                for (int ai = 0; ai < 2; ++ai)
#pragma unroll
                    for (int m = 0; m < 4; ++m) {
                        float* g = GT + (grow0 + ai * 128 + m * 16) * 16 + 8 * fq;
                        *(f32x4*)g = acc[ai][0][m][0] + b0; *(f32x4*)(g + 4) = acc[ai][0][m][1] + b1;
                    }
            }
        }
    }
};
struct EpiRes {
    static constexpr bool PERM = false, AFTER_DRAIN = false;
    const float *base_l, *base_c; float *out_l, *out_c; const float* gate;
    __device__ __forceinline__ void operator()(const f32x4 (&acc)[2][2][4][2], const Unit& u, int wr, int wc, int fr, int fq) const {
        const int pn = u.pn, pm = u.pm; const bool lat = pm < 128;
        const float* gv = gate + (size_t)(lat ? (pm >> 3) : 16) * 6144;
        const float* bp = lat ? base_l + (size_t)pm * 256 * 1024 : base_c + (size_t)(pm - 128) * 256 * 1024;
        float* op = lat ? out_l + (size_t)pm * 256 * 1024 : out_c + (size_t)(pm - 128) * 256 * 1024;
        const int col0 = pn * BM + wc * 32 + 4 * fq;
        f32x4 g4[2][2];
#pragma unroll
        for (int bj = 0; bj < 2; ++bj)
#pragma unroll
            for (int n = 0; n < 2; ++n) g4[bj][n] = *(const f32x4*)(gv + col0 + bj * HALF + n * 16);
#pragma unroll
        for (int ai = 0; ai < 2; ++ai)
#pragma unroll
            for (int m = 0; m < 4; ++m) { const size_t off = (size_t)(ai * HALF + wr * 64 + m * 16 + fr) * 1024 + col0;
#pragma unroll
                for (int bj = 0; bj < 2; ++bj)
#pragma unroll
                    for (int n = 0; n < 2; ++n) { const f32x4 x = *(const f32x4*)(bp + off + bj * HALF + n * 16); *(f32x4*)(op + off + bj * HALF + n * 16) = x + g4[bj][n] * acc[ai][bj][m][n]; }
                if (m & 1) asm volatile("" ::: "memory"); }
    }
};
struct EpiGU {
    static constexpr bool PERM = true, AFTER_DRAIN = false;
    bf16_t* H;
    __device__ __forceinline__ void operator()(const f32x4 (&acc)[2][2][4][2], const Unit& u, int wr, int wc, int fr, int fq) const {
        const size_t row0 = (size_t)u.pm * BM + wr * 64 + fr; const int col0 = u.pn * 128 + wc * 32 + 8 * fq;
#pragma unroll
        for (int ai = 0; ai < 2; ++ai)
#pragma unroll
            for (int m = 0; m < 4; ++m) {
                f32x4 v[2];
#pragma unroll
                for (int n = 0; n < 2; ++n) { const f32x4 g = acc[ai][0][m][n], up = acc[ai][1][m][n];
                    v[n][0] = g[0] * __builtin_amdgcn_rcpf(1.0f + __expf(-g[0])) * up[0]; v[n][1] = g[1] * __builtin_amdgcn_rcpf(1.0f + __expf(-g[1])) * up[1];
                    v[n][2] = g[2] * __builtin_amdgcn_rcpf(1.0f + __expf(-g[2])) * up[2]; v[n][3] = g[3] * __builtin_amdgcn_rcpf(1.0f + __expf(-g[3])) * up[3]; }
                u32x4 w; w.x = cvt_pk_bf16(v[0][0], v[0][1]); w.y = cvt_pk_bf16(v[0][2], v[0][3]); w.z = cvt_pk_bf16(v[1][0], v[1][1]); w.w = cvt_pk_bf16(v[1][2], v[1][3]);
                __builtin_nontemporal_store(w, (u32x4*)(H + (row0 + ai * HALF + m * 16) * DFF + col0));
            }
    }
};
template <bool IN_BF16, bool OUT_BF16> struct EpiRes2 {
    static constexpr bool PERM = true, AFTER_DRAIN = false;
    const float *bl, *bc; bf16_t* xs; float* ol; const float* gate;
    __device__ __forceinline__ void operator()(const f32x4 (&acc)[2][2][4][2], const Unit& u, int wr, int wc, int fr, int fq) const {
        const int pn = u.pn, pm = u.pm; const bool lat = pm < 128;
        const float* gv = gate + (size_t)(lat ? (pm >> 3) : 16) * 6144;
        const int col0 = pn * BM + wc * 32 + 8 * fq;
        const size_t row0 = (size_t)pm * BM + wr * 64 + fr;
        const float* bf = lat ? bl + row0 * 1024 : bc + (row0 - NLAT) * 1024;
        f32x4 g4[2][2];
#pragma unroll
        for (int bj = 0; bj < 2; ++bj)
#pragma unroll
            for (int n = 0; n < 2; ++n) g4[bj][n] = *(const f32x4*)(gv + col0 + bj * HALF + 4 * n);
#pragma unroll
        for (int ai = 0; ai < 2; ++ai)
#pragma unroll
            for (int m = 0; m < 4; ++m) { const size_t ro = (size_t)(ai * HALF + m * 16) * 1024;
#pragma unroll
                for (int bj = 0; bj < 2; ++bj) { const int c = col0 + bj * HALF;
                    f32x4 x0, x1;
                    if (IN_BF16) { const u32x4 v = *(const u32x4*)(xs + row0 * 1024 + ro + c);
                        x0 = (f32x4){__builtin_bit_cast(float, v.x << 16), __builtin_bit_cast(float, v.x & 0xffff0000u), __builtin_bit_cast(float, v.y << 16), __builtin_bit_cast(float, v.y & 0xffff0000u)};
                        x1 = (f32x4){__builtin_bit_cast(float, v.z << 16), __builtin_bit_cast(float, v.z & 0xffff0000u), __builtin_bit_cast(float, v.w << 16), __builtin_bit_cast(float, v.w & 0xffff0000u)}; }
                    else { x0 = *(const f32x4*)(bf + ro + c); x1 = *(const f32x4*)(bf + ro + c + 4); }
                    x0 = x0 + g4[bj][0] * acc[ai][bj][m][0]; x1 = x1 + g4[bj][1] * acc[ai][bj][m][1];
                    if (OUT_BF16) { u32x4 w; w.x = cvt_pk_bf16(x0[0], x0[1]); w.y = cvt_pk_bf16(x0[2], x0[3]); w.z = cvt_pk_bf16(x1[0], x1[1]); w.w = cvt_pk_bf16(x1[2], x1[3]);
                        *(u32x4*)(xs + row0 * 1024 + ro + c) = w; }
                    else { *(f32x4*)(ol + row0 * 1024 + ro + c) = x0; *(f32x4*)(ol + row0 * 1024 + ro + c + 4) = x1; } }
                if (IN_BF16 ? (m == 3) : (m & 1)) asm volatile("" ::: "memory"); }
    }
};
struct TailOrder {
    int c, c0;
    __device__ bool next(int i, Unit& u) const { const int e = c - c0; if (i != 0 || e < 0 || e >= 64) return false; u.pn = e & 3; u.pm = 128 + (e >> 2); return true; }
    __device__ __forceinline__ void a_ready(const Unit&) const {}
    __device__ __forceinline__ void done(const Unit&) const {}
};
struct EpiPart {
    static constexpr bool PERM = true, AFTER_DRAIN = false;
    float* P;
    __device__ __forceinline__ void operator()(const f32x4 (&acc)[2][2][4][2], const Unit& u, int wr, int wc, int fr, int fq) const {
        float* op = P + ((size_t)(u.pm - 128) * BM + wr * 64 + fr) * 1024 + u.pn * BM + wc * 32 + 8 * fq;
#pragma unroll
        for (int ai = 0; ai < 2; ++ai)
#pragma unroll
            for (int m = 0; m < 4; ++m)
#pragma unroll
                for (int bj = 0; bj < 2; ++bj) { float* o = op + (size_t)(ai * HALF + m * 16) * 1024 + bj * HALF; *(f32x4*)o = acc[ai][bj][m][0]; *(f32x4*)(o + 4) = acc[ai][bj][m][1]; }
    }
};
template <class Epi, class Sched, bool ALIGN_EPI = false, bool SP2 = false>
__device__ __forceinline__ void gemm_phase(PG8_LAS unsigned char* lds, const Gemm g, const Sched& S, const Epi& E) {
    const int tid = opaque_tid(), wid = __builtin_amdgcn_readfirstlane(tid >> 6), lane = tid & 63, wr = wid >> 2, wc = wid & 3, fr = lane & 15, fq = lane >> 4;
    const int K = g.ld ? g.ld : g.K, nt = g.K / BK;
    unsigned voffA[2], voffB[2];
#pragma unroll
    for (int i = 0; i < 2; ++i) { int R, C; stage_rc(tid * 16 + i * 8192, R, C); const int Rb = Epi::PERM ? ((R & ~31) + perm32(R & 31)) : R;
        voffA[i] = (unsigned)(R * K + C) * 2u; voffB[i] = (unsigned)(Rb * K + C) * 2u; }
    const size_t kstep = (size_t)(BK * 2);
    const size_t hstep = (size_t)HALF * K * 2;
    const size_t tstep = 2 * hstep;
    const unsigned ldsw = (unsigned)wid * 1024u;
    const int aoff = lds_byte(wr * 64 + fr, fq * 8), boff = lds_byte(wc * 32 + fr, fq * 8);
#define PG8_SA(b, h) (((b) * 2 + (h)) * HTB)
#define PG8_SB(b, h) ((4 + (b) * 2 + (h)) * HTB)
#define PG8_STAGE(bufoff, gbase, voff) do { _Pragma("unroll") for (int _i = 0; _i < 2; ++_i) \
        __builtin_amdgcn_global_load_lds((const unsigned*)((const char*)(gbase) + (voff)[_i]), (PG8_LAS unsigned*)(lds + (bufoff) + ldsw + _i * 8192), 16, 0, 0); } while (0)
#define PG8_LDA(dst, b, h) do { _Pragma("unroll") for (int m = 0; m < 4; ++m) _Pragma("unroll") for (int k = 0; k < 2; ++k) dst[m][k] = *(const PG8_LAS bf16x8*)(lds + PG8_SA(b, h) + aoff + m * 2048 + k * 1024); } while (0)
#define PG8_LDB(dst, b, h) do { _Pragma("unroll") for (int n = 0; n < 2; ++n) _Pragma("unroll") for (int k = 0; k < 2; ++k) dst[n][k] = *(const PG8_LAS bf16x8*)(lds + PG8_SB(b, h) + boff + n * 2048 + k * 1024); } while (0)
#define PG8_MMA(ai, bj, At, Bt) do { __builtin_amdgcn_s_setprio(1); _Pragma("unroll") for (int m = 0; m < 4; ++m) _Pragma("unroll") for (int n = 0; n < 2; ++n) _Pragma("unroll") for (int k = 0; k < 2; ++k) \
        acc[ai][bj][m][n] = __builtin_amdgcn_mfma_f32_16x16x32_bf16(Bt[n][k], At[m][k], acc[ai][bj][m][n], 0, 0, 0); __builtin_amdgcn_s_setprio(0); } while (0)
#define PG8_WAIT_V(n) asm volatile("s_waitcnt vmcnt(" #n ")" ::: "memory")
#define PG8_WAIT_L(n) asm volatile("s_waitcnt lgkmcnt(" #n ")" ::: "memory")
#define PG8_BAR __builtin_amdgcn_s_barrier()
#define PG8_SCHED __builtin_amdgcn_sched_barrier(0)
    Unit cur, nxt; int ui = 0;
    if (!S.next(0, cur)) return;
    f32x4 acc[2][2][4][2];
#pragma unroll
    for (int a = 0; a < 2; ++a)
#pragma unroll
        for (int b = 0; b < 2; ++b)
#pragma unroll
            for (int m = 0; m < 4; ++m)
#pragma unroll
                for (int n = 0; n < 2; ++n) acc[a][b][m][n] = (f32x4){0.f, 0.f, 0.f, 0.f};
    bf16x8 At[4][2], B0[2][2], B1[2][2];
    const char* cA = (const char*)g.A + (size_t)cur.pm * tstep; const char* cB = (const char*)g.Bt + (size_t)cur.pn * tstep;
    S.a_ready(cur);
    if constexpr (SP2) {
        PG8_STAGE(PG8_SB(0, 0), cB, voffB); PG8_STAGE(PG8_SB(0, 1), cB + hstep, voffB); PG8_STAGE(PG8_SA(0, 0), cA, voffA); PG8_STAGE(PG8_SA(0, 1), cA + hstep, voffA);
        if (wr == 1) PG8_BAR;
        PG8_WAIT_V(2); PG8_BAR;
        PG8_STAGE(PG8_SB(1, 0), cB + kstep, voffB); PG8_STAGE(PG8_SA(1, 0), cA + kstep, voffA); PG8_STAGE(PG8_SB(1, 1), cB + hstep + kstep, voffB);
        PG8_WAIT_V(6); PG8_BAR;
    } else {
        PG8_STAGE(PG8_SB(0, 0), cB, voffB); PG8_STAGE(PG8_SA(0, 0), cA, voffA); PG8_STAGE(PG8_SB(0, 1), cB + hstep, voffB); PG8_STAGE(PG8_SA(0, 1), cA + hstep, voffA);
        if (wr == 1) PG8_BAR;
        PG8_WAIT_V(4); PG8_BAR;
        PG8_STAGE(PG8_SB(1, 0), cB + kstep, voffB); PG8_STAGE(PG8_SA(1, 0), cA + kstep, voffA); PG8_STAGE(PG8_SB(1, 1), cB + hstep + kstep, voffB);
        PG8_WAIT_V(6); PG8_BAR;
    }
    for (;;) {
        const bool has_next = S.next(ui + 1, nxt);
        const char* nA = has_next ? (const char*)g.A + (size_t)nxt.pm * tstep : cA; const char* nB = has_next ? (const char*)g.Bt + (size_t)nxt.pn * tstep : cB;
        for (int t = 0; t < nt; t += 2) {
            const bool last = (t == nt - 2);
            const char* a1 = cA + (size_t)(t + 1) * kstep;
            const char* a2 = last ? nA : cA + (size_t)(t + 2) * kstep; const char* b2 = last ? nB : cB + (size_t)(t + 2) * kstep;
            const char* a3 = a2 + kstep; const char* b3 = b2 + kstep;
            if (last && has_next) S.a_ready(nxt);
            if constexpr (SP2) {
            PG8_LDB(B0, 0, 0); PG8_LDB(B1, 0, 1); PG8_SCHED; PG8_LDA(At, 0, 0); PG8_STAGE(PG8_SA(1, 1), a1 + hstep, voffA);
            PG8_WAIT_V(8); PG8_WAIT_L(0); PG8_BAR; PG8_MMA(0, 0, At, B0); PG8_MMA(0, 1, At, B1); PG8_BAR; PG8_SCHED;
            PG8_LDA(At, 0, 1); PG8_STAGE(PG8_SB(0, 0), b2, voffB); PG8_STAGE(PG8_SB(0, 1), b2 + hstep, voffB); PG8_STAGE(PG8_SA(0, 0), a2, voffA);
            PG8_WAIT_V(8); PG8_WAIT_L(0); PG8_BAR; PG8_MMA(1, 0, At, B0); PG8_MMA(1, 1, At, B1); PG8_BAR; PG8_SCHED;
            PG8_LDB(B0, 1, 0); PG8_LDB(B1, 1, 1); PG8_SCHED; PG8_LDA(At, 1, 0); PG8_STAGE(PG8_SA(0, 1), a2 + hstep, voffA);
            PG8_WAIT_V(8); PG8_WAIT_L(0); PG8_BAR; PG8_MMA(0, 0, At, B0); PG8_MMA(0, 1, At, B1); PG8_BAR; PG8_SCHED;
            PG8_LDA(At, 1, 1); PG8_STAGE(PG8_SB(1, 0), b3, voffB); PG8_STAGE(PG8_SB(1, 1), b3 + hstep, voffB); PG8_STAGE(PG8_SA(1, 0), a3, voffA);
            PG8_WAIT_V(8); PG8_WAIT_L(0); PG8_BAR; PG8_MMA(1, 0, At, B0); PG8_MMA(1, 1, At, B1); PG8_BAR; PG8_SCHED;
            } else {
            PG8_LDB(B0, 0, 0); PG8_SCHED; PG8_LDA(At, 0, 0); PG8_STAGE(PG8_SA(1, 1), a1 + hstep, voffA);
            PG8_WAIT_L(8); PG8_BAR; PG8_WAIT_L(0); PG8_MMA(0, 0, At, B0); PG8_BAR; PG8_SCHED;
            PG8_LDB(B1, 0, 1); PG8_STAGE(PG8_SB(0, 0), b2, voffB);
            PG8_BAR; PG8_WAIT_L(0); PG8_MMA(0, 1, At, B1); PG8_BAR;
            PG8_LDA(At, 0, 1); PG8_STAGE(PG8_SA(0, 0), a2, voffA);
            PG8_BAR; PG8_WAIT_L(0); PG8_MMA(1, 0, At, B0); PG8_BAR; PG8_SCHED;
            PG8_STAGE(PG8_SB(0, 1), b2 + hstep, voffB);
            PG8_WAIT_V(6); PG8_BAR; PG8_MMA(1, 1, At, B1); PG8_BAR;
            PG8_LDB(B0, 1, 0); PG8_SCHED; PG8_LDA(At, 1, 0); PG8_STAGE(PG8_SA(0, 1), a2 + hstep, voffA);
            PG8_WAIT_L(8); PG8_BAR; PG8_WAIT_L(0); PG8_MMA(0, 0, At, B0); PG8_BAR; PG8_SCHED;
            PG8_LDB(B1, 1, 1); PG8_STAGE(PG8_SB(1, 0), b3, voffB);
            PG8_BAR; PG8_WAIT_L(0); PG8_MMA(0, 1, At, B1); PG8_BAR;
            PG8_LDA(At, 1, 1); PG8_STAGE(PG8_SA(1, 0), a3, voffA);
            PG8_BAR; PG8_WAIT_L(0); PG8_MMA(1, 0, At, B0); PG8_BAR; PG8_SCHED;
            PG8_STAGE(PG8_SB(1, 1), b3 + hstep, voffB);
            PG8_WAIT_V(6); PG8_BAR; PG8_MMA(1, 1, At, B1); PG8_BAR;
            }
        }
        if constexpr (ALIGN_EPI) { if (wr == 0) PG8_BAR; }
        if constexpr (!Epi::AFTER_DRAIN) { E(acc, cur, wr, wc, fr, fq); S.done(cur); }
        if (!has_next) break;
#pragma unroll
        for (int a = 0; a < 2; ++a)
#pragma unroll
            for (int b = 0; b < 2; ++b)
#pragma unroll
                for (int m = 0; m < 4; ++m)
#pragma unroll
                    for (int n = 0; n < 2; ++n) acc[a][b][m][n] = (f32x4){0.f, 0.f, 0.f, 0.f};
        cur = nxt; cA = nA; cB = nB; ++ui;
        if constexpr (ALIGN_EPI) { if (wr == 1) PG8_BAR; }
    }
    PG8_WAIT_V(0);
    if constexpr (!ALIGN_EPI) { if (wr == 0) PG8_BAR; }
    PG8_BAR;
    if constexpr (Epi::AFTER_DRAIN) { E.fused(acc, cur, wr, wc, fr, fq, lds, wid, lane); S.done(cur); }
#undef PG8_SA
#undef PG8_SB
#undef PG8_STAGE
#undef PG8_LDA
#undef PG8_LDB
#undef PG8_MMA
#undef PG8_WAIT_V
#undef PG8_WAIT_L
#undef PG8_BAR
#undef PG8_SCHED
}
}

namespace attn_body {
using bf16=__hip_bfloat16;
using bf16x8=__attribute__((ext_vector_type(8)))short;
using s16x4=__attribute__((ext_vector_type(4)))short;
using f32x16=__attribute__((ext_vector_type(16)))float;
using u32x4=__attribute__((ext_vector_type(4)))unsigned;
constexpr int D=64,QP=512,KP=128,OP=1024;
constexpr int NW=8,QBLK=32,QB=QBLK*NW,KVBLK=64;
__device__ __forceinline__ int crow(int r,int hi){return (r&3)+8*(r>>2)+4*hi;}
#define SBAR() __builtin_amdgcn_sched_barrier(0)
constexpr int NSLOT=3, SLOTB=8192;
constexpr int LDS_K=0, LDS_V=NSLOT*SLOTB, LDS_WS=2*NSLOT*SLOTB, LDS_OST=LDS_WS+NW*64*4, LDS_BYTES=LDS_OST+NW*4096;
constexpr float C2=0.125f*1.4426950408889634f;
__device__ __forceinline__ void glds16(const void*gsrc,unsigned lds_dst){unsigned keep;
  asm volatile("s_mov_b32 %0, m0\n\ts_mov_b32 m0, %2\n\ts_nop 0\n\tglobal_load_lds_dwordx4 %1, off\n\ts_mov_b32 m0, %0":"=&s"(keep):"v"(gsrc),"s"(lds_dst):"memory");}
__device__ __forceinline__ float max3f(float a,float b,float c){float r;asm("v_max3_f32 %0, %1, %2, %3":"=v"(r):"v"(a),"v"(b),"v"(c));return r;}
__device__ __forceinline__ float max2f(float a,float b){float r;asm("v_max_f32_e32 %0, %1, %2":"=v"(r):"v"(a),"v"(b));return r;}
__device__ __forceinline__ float fadd_s(float a,float b){float r;asm("v_add_f32_e32 %0, %1, %2":"=v"(r):"v"(a),"v"(b));return r;}
__device__ __forceinline__ float fsub_s(float a,float b){float r;asm("v_sub_f32_e32 %0, %1, %2":"=v"(r):"v"(a),"v"(b));return r;}
typedef float f32x2_t __attribute__((ext_vector_type(2))); typedef __bf16 bf16x2_t __attribute__((ext_vector_type(2)));
__device__ __forceinline__ unsigned cvtpk_s(float lo,float hi){f32x2_t v={lo,hi};bf16x2_t b=__builtin_convertvector(v,bf16x2_t);return __builtin_bit_cast(unsigned,b);}
#define WAIT_BAR(N) asm volatile("s_waitcnt vmcnt(" #N ") lgkmcnt(0)\n\ts_barrier":::"memory")

__device__ __forceinline__ void qkt(f32x16&p0,f32x16&p1,const char*Kslot,const bf16x8*qr,const f32x16&negm,int r32,int hi){
  const char*kb=Kslot+hi*1024+r32*16;
  #pragma unroll
  for(int d0=0;d0<4;++d0){
    const bf16x8 b0=*reinterpret_cast<const bf16x8*>(kb+d0*2048);
    const bf16x8 b1=*reinterpret_cast<const bf16x8*>(kb+d0*2048+512);
    if(d0==0){p0=__builtin_amdgcn_mfma_f32_32x32x16_bf16(b0,qr[0],negm,0,0,0);p1=__builtin_amdgcn_mfma_f32_32x32x16_bf16(b1,qr[0],negm,0,0,0);}
    else{p0=__builtin_amdgcn_mfma_f32_32x32x16_bf16(b0,qr[d0],p0,0,0,0);p1=__builtin_amdgcn_mfma_f32_32x32x16_bf16(b1,qr[d0],p1,0,0,0);}}
}
typedef __attribute__((address_space(3))) const char* lds_cptr;
typedef short v4i16_t __attribute__((ext_vector_type(4)));
__device__ __forceinline__ void kload8(bf16x8*kf,lds_cptr kp){
  kf[0]=*(const __attribute__((address_space(3))) bf16x8*)(kp);      kf[1]=*(const __attribute__((address_space(3))) bf16x8*)(kp+512);
  kf[2]=*(const __attribute__((address_space(3))) bf16x8*)(kp+2048); kf[3]=*(const __attribute__((address_space(3))) bf16x8*)(kp+2560);
  kf[4]=*(const __attribute__((address_space(3))) bf16x8*)(kp+4096); kf[5]=*(const __attribute__((address_space(3))) bf16x8*)(kp+4608);
  kf[6]=*(const __attribute__((address_space(3))) bf16x8*)(kp+6144); kf[7]=*(const __attribute__((address_space(3))) bf16x8*)(kp+6656);
}
__device__ __forceinline__ void kload2(bf16x8*kf,lds_cptr kp,int j){ kf[2*j]=*(const __attribute__((address_space(3))) bf16x8*)(kp+j*2048); kf[2*j+1]=*(const __attribute__((address_space(3))) bf16x8*)(kp+j*2048+512); }
__device__ __forceinline__ s16x4 vtr(lds_cptr p){ return __builtin_bit_cast(s16x4,__builtin_amdgcn_ds_read_tr16_b64_v4i16((__attribute__((address_space(3))) v4i16_t*)p)); }
__device__ __forceinline__ float rowmax(const f32x16&p0,const f32x16&p1){
  float a=max3f(p0[0],p0[1],p1[0]),b=max3f(p0[2],p0[3],p1[1]);a=max3f(a,p1[2],p1[3]);
  #pragma unroll
  for(int r=4;r<16;r+=4){a=max3f(a,p0[r],p0[r+1]);b=max3f(b,p0[r+2],p0[r+3]);a=max3f(a,p1[r],p1[r+1]);b=max3f(b,p1[r+2],p1[r+3]);}
  const float m=max2f(a,b);
  auto rr=__builtin_amdgcn_permlane32_swap(__float_as_uint(m),__float_as_uint(m),false,false);
  return max2f(__uint_as_float(rr[0]),__uint_as_float(rr[1]));
}
__device__ __forceinline__ void pv(f32x16*o,int vb,bf16x8 pa0,bf16x8 pa1,bf16x8 pa2,bf16x8 pa3){
  #pragma unroll
  for(int d0=0;d0<2;++d0){s16x4 lo[4],hi[4];
    #pragma unroll
    for(int ks=0;ks<4;++ks){
      asm volatile("ds_read_b64_tr_b16 %0,%1 offset:%c2":"=&v"(lo[ks]):"v"(vb),"i"(d0*4096+ks*1024):"memory");
      asm volatile("ds_read_b64_tr_b16 %0,%1 offset:%c2":"=&v"(hi[ks]):"v"(vb),"i"(d0*4096+ks*1024+512):"memory");}
    asm volatile("s_waitcnt lgkmcnt(0)":::"memory");SBAR();
    #define PK(k) (bf16x8){lo[k][0],lo[k][1],lo[k][2],lo[k][3],hi[k][0],hi[k][1],hi[k][2],hi[k][3]}
    o[d0]=__builtin_amdgcn_mfma_f32_32x32x16_bf16(pa0,PK(0),o[d0],0,0,0);
    o[d0]=__builtin_amdgcn_mfma_f32_32x32x16_bf16(pa1,PK(1),o[d0],0,0,0);
    o[d0]=__builtin_amdgcn_mfma_f32_32x32x16_bf16(pa2,PK(2),o[d0],0,0,0);
    o[d0]=__builtin_amdgcn_mfma_f32_32x32x16_bf16(pa3,PK(3),o[d0],0,0,0);
    #undef PK
  }
}

#ifndef ATTN_STORE16
#define ATTN_STORE16(p,v) (*(u32x4*)(p)=(v))
#endif
template<int THRL> __device__ __forceinline__ void attn_unit(const bf16*Q,const bf16*__restrict__ K,const bf16*__restrict__ V,bf16*O,const int NT,char*shm){
  const int tid=opaque_tid(),lane=tid&63,r32=lane&31,hi=lane>>5; const int wid=__builtin_amdgcn_readfirstlane(tid>>6);
  const bf16*Qw=Q+(long)(wid*QBLK)*QP;
  const bf16*Kh=K,*Vh=V;
  const unsigned lds0=(unsigned)(uintptr_t)shm;
  float*wsf=(float*)(shm+LDS_WS)+wid*64;
  const bf16*ksrc=Kh+(long)lane*KP+wid*8;
  const bf16*vsrc=Vh+(long)(16*(wid&3)+(lane>>2))*KP+(wid>>2)*32+(lane&3)*8;
  const unsigned kdst=lds0+LDS_K+wid*1024, vdst=lds0+LDS_V+wid*1024;
  #define DMA_K(t,slot) glds16(ksrc+(long)(t)*KVBLK*KP,(unsigned)__builtin_amdgcn_readfirstlane(kdst+(slot)))
  #define DMA_V(t,slot) glds16(vsrc+(long)(t)*KVBLK*KP,(unsigned)__builtin_amdgcn_readfirstlane(vdst+(slot)))
  const int vb0=(int)(lds0+LDS_V)+((lane>>4)&1)*32+(lane&3)*8+(4*hi+((lane&15)>>2))*64;
  const char*Kbase=shm+LDS_K; bf16x8 kf[8];
  const lds_cptr shm3=(lds_cptr)shm; const lds_cptr kp0=shm3+LDS_K+hi*1024+r32*16; const lds_cptr vp0=shm3+LDS_V+((lane>>4)&1)*32+(lane&3)*8+(4*hi+((lane&15)>>2))*64;
  DMA_K(0,0);DMA_V(0,0);DMA_K(1,SLOTB);
  bf16x8 qr[4];
  #pragma unroll
  for(int d0=0;d0<4;++d0)qr[d0]=*reinterpret_cast<const bf16x8*>(&Qw[(long)r32*QP+d0*16+hi*8]);
  float mhat=0.f,l_reg=0.f;f32x16 o[2];o[0]=f32x16{};o[1]=f32x16{};f32x16 negm=f32x16{};asm volatile("":"+v"(negm));
  #define CMASK(P0,P1,t) do{}while(0)
  bool resc=false;
  #define START(P0,P1) do{ const float rm=rowmax(P0,P1); resc=false; \
    { const float dl=rm; mhat=fadd_s(mhat,dl); \
      _Pragma("unroll") for(int r=0;r<16;++r){P0[r]=fsub_s(P0[r],dl);P1[r]=fsub_s(P1[r],dl);} \
      _Pragma("unroll") for(int r=0;r<16;++r)negm[r]=-mhat; asm volatile("":"+v"(negm)); } \
    _Pragma("unroll") for(int r=0;r<16;++r)P0[r]=__builtin_amdgcn_exp2f(P0[r]); }while(0)
  #define RESC() do{ if(resc){ asm volatile("s_waitcnt lgkmcnt(0)":::"memory"); \
      _Pragma("unroll") for(int d_=0;d_<2;++d_) _Pragma("unroll") for(int r=0;r<16;++r)o[d_][r]*=wsf[crow(r,hi)]; } }while(0)
  f32x16 pA0,pA1,pB0,pB1;
  int sl_prev=0,sl_cur=0,sl_next=SLOTB;
  #define ROT() do{sl_prev=sl_cur;sl_cur=sl_next;sl_next=(sl_next==(NSLOT-1)*SLOTB)?0:sl_next+SLOTB;}while(0)
  DMA_K(2,2*SLOTB);
  WAIT_BAR(3);
  qkt(pA0,pA1,Kbase,qr,negm,r32,hi);asm volatile("s_nop 15\n\ts_nop 7":"+v"(pA0),"+v"(pA1));CMASK(pA0,pA1,0);
  START(pA0,pA1);
  _Pragma("unroll") for(int r=0;r<16;++r)pA1[r]=__builtin_amdgcn_exp2f(pA1[r]);
  WAIT_BAR(0);
  DMA_K(3,0);DMA_V(1,SLOTB);
  ROT();
  kload8(kf,kp0+sl_cur);
  WAIT_BAR(2);
  s16x4 vlo[8],vhi[8]; u32x4 pw0,pw1,pw2,pw3;
  #define PKW(P,B) cvtpk_s(P[B],P[B+1])
  #define PAF(k) __builtin_bit_cast(bf16x8,pw##k)
  #define VFR(i) (bf16x8){vlo[i][0],vlo[i][1],vlo[i][2],vlo[i][3],vhi[i][0],vhi[i][1],vhi[i][2],vhi[i][3]}
  #define PIN(x) asm volatile("":"+v"(x))
  #define MX3(a,b,c) __builtin_fmaxf(__builtin_fmaxf((a),(b)),(c))
  #define GAPA(MF,A0,A1,A2,A3,W0,W1,PW) do{ MF; sacc+=A0; sacc+=A1; sacc+=A2; sacc+=A3; PIN(sacc); W0; W1; PIN(PW); SBAR(); }while(0)
  #define EX(v) __builtin_amdgcn_exp2f(v)
  #define GAPB(MF,X,B) do{ MF; X[B]=EX(X[B]); X[B+1]=EX(X[B+1]); X[B+2]=EX(X[B+2]); X[B+3]=EX(X[B+3]); PIN(X); SBAR(); }while(0)
  #define VRD(i) do{ vlo[i]=vtr(vp_+(((i)>>2)*4096+((i)&3)*1024)); vhi[i]=vtr(vp_+(((i)>>2)*4096+((i)&3)*1024+512)); }while(0)
  #define KRD(G,j) do{ if(G){ kload2(kf,kp0+sl_next,j); SBAR(); } }while(0)
  #define STEP(C0,C1,P0,P1,t,GK,GV,GL) do{ SBAR(); \
    const lds_cptr vp_=vp0+sl_prev; \
    VRD(0); SBAR(); float sacc=(P0[0]+P0[1]); \
    GAPA(C0=__builtin_amdgcn_mfma_f32_32x32x16_bf16(kf[0],qr[0],negm,0,0,0), P0[2],P0[3],P0[4],P0[5],     pw0[0]=PKW(P0,0), pw0[1]=PKW(P0,2), pw0); \
    VRD(4); SBAR(); GAPA(C1=__builtin_amdgcn_mfma_f32_32x32x16_bf16(kf[1],qr[0],negm,0,0,0), P0[6],P0[7],P0[8],P0[9],     pw0[2]=PKW(P0,4), pw0[3]=PKW(P0,6), pw0); \
    VRD(1); SBAR(); GAPA(C0=__builtin_amdgcn_mfma_f32_32x32x16_bf16(kf[2],qr[1],C0,0,0,0),   P0[10],P0[11],P0[12],P0[13], pw1[0]=PKW(P0,8), pw1[1]=PKW(P0,10), pw1); \
    VRD(5); SBAR(); GAPA(C1=__builtin_amdgcn_mfma_f32_32x32x16_bf16(kf[3],qr[1],C1,0,0,0),   P0[14],P0[15],P1[0],P1[1],   pw1[2]=PKW(P0,12),pw1[3]=PKW(P0,14), pw1); \
    VRD(2); SBAR(); GAPA(C0=__builtin_amdgcn_mfma_f32_32x32x16_bf16(kf[4],qr[2],C0,0,0,0),   P1[2],P1[3],P1[4],P1[5],     pw2[0]=PKW(P1,0), pw2[1]=PKW(P1,2), pw2); \
    VRD(6); SBAR(); GAPA(C1=__builtin_amdgcn_mfma_f32_32x32x16_bf16(kf[5],qr[2],C1,0,0,0),   P1[6],P1[7],P1[8],P1[9],     pw2[2]=PKW(P1,4), pw2[3]=PKW(P1,6), pw2); \
    VRD(3); SBAR(); GAPA(C0=__builtin_amdgcn_mfma_f32_32x32x16_bf16(kf[6],qr[3],C0,0,0,0),   P1[10],P1[11],P1[12],P1[13], pw3[0]=PKW(P1,8), pw3[1]=PKW(P1,10), pw3); \
    VRD(7); SBAR(); GAPA(C1=__builtin_amdgcn_mfma_f32_32x32x16_bf16(kf[7],qr[3],C1,0,0,0),   P1[14],P1[15],0.f,0.f,       pw3[2]=PKW(P1,12),pw3[3]=PKW(P1,14), pw3); \
    l_reg+=sacc; \
    if(GK){DMA_K((t)+3,sl_cur);} if(GV){DMA_V((t)+1,sl_next);} \
    CMASK(C0,C1,t); \
    { float a=MX3(C0[0],C0[1],C1[0]),b=MX3(C0[2],C0[3],C1[1]); a=MX3(a,C1[2],C1[3]); \
      _Pragma("unroll") for(int r=4;r<16;r+=4){a=MX3(a,C0[r],C0[r+1]);b=MX3(b,C0[r+2],C0[r+3]);a=MX3(a,C1[r],C1[r+1]);b=MX3(b,C1[r+2],C1[r+3]);} \
      float rm=__builtin_fmaxf(a,b); { auto rr=__builtin_amdgcn_permlane32_swap(__float_as_uint(rm),__float_as_uint(rm),false,false); rm=__builtin_fmaxf(__uint_as_float(rr[0]),__uint_as_float(rr[1])); } \
      resc=false; \
      if(__builtin_expect(__any(rm>(float)THRL),0)){ const float dl=__builtin_fmaxf(rm,0.f); mhat+=dl; \
        _Pragma("unroll") for(int r=0;r<16;++r){C0[r]-=dl;C1[r]-=dl;} \
        _Pragma("unroll") for(int r=0;r<16;++r)negm[r]=-mhat; asm volatile("":"+v"(negm)); \
        const float f=__builtin_amdgcn_exp2f(-dl); l_reg*=f; if(hi==0)wsf[r32]=f; resc=true; } } \
    SBAR(); \
    GAPB(o[0]=__builtin_amdgcn_mfma_f32_32x32x16_bf16(PAF(0),VFR(0),o[0],0,0,0), C0,0); \
    GAPB(o[1]=__builtin_amdgcn_mfma_f32_32x32x16_bf16(PAF(0),VFR(4),o[1],0,0,0), C0,4); \
    KRD(GL,0); GAPB(o[0]=__builtin_amdgcn_mfma_f32_32x32x16_bf16(PAF(1),VFR(1),o[0],0,0,0), C0,8); \
    KRD(GL,1); GAPB(o[1]=__builtin_amdgcn_mfma_f32_32x32x16_bf16(PAF(1),VFR(5),o[1],0,0,0), C0,12); \
    KRD(GL,2); GAPB(o[0]=__builtin_amdgcn_mfma_f32_32x32x16_bf16(PAF(2),VFR(2),o[0],0,0,0), C1,0); \
    KRD(GL,3); GAPB(o[1]=__builtin_amdgcn_mfma_f32_32x32x16_bf16(PAF(2),VFR(6),o[1],0,0,0), C1,4); \
    GAPB(o[0]=__builtin_amdgcn_mfma_f32_32x32x16_bf16(PAF(3),VFR(3),o[0],0,0,0), C1,8); \
    GAPB(o[1]=__builtin_amdgcn_mfma_f32_32x32x16_bf16(PAF(3),VFR(7),o[1],0,0,0), C1,12); \
    }while(0)
  int t=1;
  #undef CMASK
  #define CMASK(P0,P1,t) do{}while(0)
  for(;t+5<NT;t+=2){
    STEP(pB0,pB1,pA0,pA1,t,true,true,true);     WAIT_BAR(2); RESC(); ROT();
    STEP(pA0,pA1,pB0,pB1,t+1,true,true,true);   WAIT_BAR(2); RESC(); ROT();
  }
  #undef CMASK
  #define CMASK(P0,P1,t) do{}while(0)
  #define ENDW(tt) do{ if((tt)+3<NT){WAIT_BAR(2);} else if((tt)+2<NT){WAIT_BAR(1);} else {WAIT_BAR(0);} }while(0)
  for(;t+1<NT;t+=2){
    STEP(pB0,pB1,pA0,pA1,t,(t+3<NT),(t+1<NT),(t+1<NT));       ENDW(t);   RESC(); ROT();
    STEP(pA0,pA1,pB0,pB1,t+1,(t+4<NT),(t+2<NT),(t+2<NT));     ENDW(t+1); RESC(); ROT();
  }
  STEP(pB0,pB1,pA0,pA1,NT-1,false,false,false); RESC();
  { float sacc=pB0[0]+pB0[1]; _Pragma("unroll") for(int r=2;r<16;++r)sacc+=pB0[r]; _Pragma("unroll") for(int r=0;r<16;++r)sacc+=pB1[r]; l_reg+=sacc;
    pw0=(u32x4){PKW(pB0,0),PKW(pB0,2),PKW(pB0,4),PKW(pB0,6)};pw1=(u32x4){PKW(pB0,8),PKW(pB0,10),PKW(pB0,12),PKW(pB0,14)};pw2=(u32x4){PKW(pB1,0),PKW(pB1,2),PKW(pB1,4),PKW(pB1,6)};pw3=(u32x4){PKW(pB1,8),PKW(pB1,10),PKW(pB1,12),PKW(pB1,14)};
    SBAR(); pv(o,vb0+sl_cur,PAF(0),PAF(1),PAF(2),PAF(3)); }
  #undef PKW
  #undef PAF
  #undef VFR
  #undef PIN
  #undef MX3
  #undef GAPA
  #undef GAPB
  #undef EX
  #undef VRD
  #undef KRD
  #undef STEP
  #undef ENDW
  {auto rr=__builtin_amdgcn_permlane32_swap(__float_as_uint(l_reg),__float_as_uint(l_reg),false,false);l_reg=__uint_as_float(rr[0])+__uint_as_float(rr[1]);}
  if(hi==0)wsf[32+r32]=l_reg;asm volatile("s_waitcnt lgkmcnt(0)":::"memory");
  float rli[16];
  #pragma unroll
  for(int r=0;r<16;++r)rli[r]=__builtin_amdgcn_rcpf(wsf[32+crow(r,hi)]);
  bf16*Ow=O+(long)(wid*QBLK)*OP;
  { bf16*stg=(bf16*)(shm+LDS_OST)+wid*2048;
    #pragma unroll
    for(int r=0;r<16;++r){const int orow=crow(r,hi);
      #pragma unroll
      for(int d0=0;d0<2;++d0)stg[orow*64+d0*32+r32]=__float2bfloat16(o[d0][r]*rli[r]);}
    asm volatile("s_waitcnt lgkmcnt(0)":::"memory");
    #pragma unroll
    for(int i=0;i<4;++i){const int row=i*8+(lane>>3),ch=lane&7; const u32x4 v=*(const u32x4*)(stg+row*64+ch*8); ATTN_STORE16(Ow+(long)row*OP+ch*8,v);} }
  asm volatile("s_waitcnt lgkmcnt(0)\n\ts_barrier":::"memory");
  #undef DMA_K
  #undef DMA_V
  #undef CMASK
  #undef START
  #undef RESC
  #undef ROT
}
#undef SBAR
#undef WAIT_BAR
}
namespace ml {
constexpr int QS = 0, KS = QS + 128 * 144, VT = KS + 128 * 144, KT = VT + 80 * 272, SP = KT + 64 * 272, CB = SP + 128 * 272, GA = CB + 80 * 144, GSET = 6 * 512, END = GA + 2 * GSET;
static_assert(END <= 131072, "mlstm lds");
__device__ __forceinline__ float logsig(float x) { return fminf(x, 0.f) - __logf(1.0f + __expf(-fabsf(x))); }
#define MFMA16(a, b, c) __builtin_amdgcn_mfma_f32_16x16x32_bf16(a, b, c, 0, 0, 0)
#define ML_BAR() do { asm volatile("s_waitcnt lgkmcnt(0)" ::: "memory"); __builtin_amdgcn_s_barrier(); asm volatile("" ::: "memory"); } while (0)
#define ML_SCAN(SET, G0, G1, G2, G3) do { \
                LAS float* a_w = (LAS float*)(lds + GA + (SET) * GSET); \
                const float li0 = (G0), lf0 = logsig(G1), li1 = (G2), lf1 = logsig(G3); \
                const float ps = lf0 + lf1; float inc = ps; \
                _Pragma("unroll") for (int o = 1; o < 64; o <<= 1) { const float t = __shfl_up(inc, o); if (lane >= o) inc += t; } \
                const float b0 = (inc - ps) + lf0, b1 = b0 + lf1; \
                const float a0 = li0 - b0, a1 = li1 - b1; \
                float incm = fmaxf(a0, a1); \
                _Pragma("unroll") for (int o = 1; o < 64; o <<= 1) { const float t = __shfl_up(incm, o); if (lane >= o) incm = fmaxf(incm, t); } \
                float excm = __shfl_up(incm, 1); if (lane == 0) excm = -INFINITY; \
                const float cm0 = fmaxf(mcar, fmaxf(excm, a0)), cm1 = fmaxf(mcar, incm); \
                const float blast = __shfl(b1, 63), cmlast = __shfl(cm1, 63); \
                a_w[2 * lane] = a0; a_w[2 * lane + 1] = a1; a_w[128 + 2 * lane] = cm0; a_w[128 + 2 * lane + 1] = cm1; \
                a_w[256 + 2 * lane] = __expf(mcar - cm0); a_w[256 + 2 * lane + 1] = __expf(mcar - cm1); \
                a_w[384 + 2 * lane] = __expf(-(b0 + cm0)); a_w[384 + 2 * lane + 1] = __expf(-(b1 + cm1)); \
                a_w[512 + 2 * lane] = __expf(a0 - cmlast); a_w[512 + 2 * lane + 1] = __expf(a1 - cmlast); \
                if (lane == 0) a_w[640] = __expf(mcar - cmlast); \
                mcar = blast + cmlast; } while (0)

template <int VAR> __device__ __forceinline__ void mlstm_item(int b, int head, int dir, const bf16_t* __restrict__ MLB, const float* __restrict__ GT, bf16_t* HSd, LAS unsigned char* lds) {
    const int tid = opaque_tid(), lane = tid & 63, w = __builtin_amdgcn_readfirstlane(tid >> 6), fr = lane & 15, fq = lane >> 4;
    LAS bf16_t* Qs = (LAS bf16_t*)(lds + QS); LAS bf16_t* Ks = (LAS bf16_t*)(lds + KS); LAS bf16_t* Vt = (LAS bf16_t*)(lds + VT);
    LAS bf16_t* Kt = (LAS bf16_t*)(lds + KT); LAS bf16_t* Sp = (LAS bf16_t*)(lds + SP); LAS bf16_t* Cb = (LAS bf16_t*)(lds + CB);
    const int ntk = w & 3, mt0 = 2 * (w >> 2);
    {
        __syncthreads();
        for (int i = tid; i < 80 * 144 / 4; i += 512) ((LAS unsigned*)Cb)[i] = 0u;
        for (int i = tid; i < 16 * 136 / 2; i += 512) ((LAS unsigned*)(Vt + 64 * 136))[i] = (i < 68) ? 0x3f803f80u : 0u;
        f32x4 accN = (f32x4){0.f, 0.f, 0.f, 0.f};
        f32x4 accC[2]; accC[0] = (f32x4){0.f, 0.f, 0.f, 0.f}; accC[1] = accC[0];
        float mcar = 0.f;
        u32x4 pq[2], pk[2], pv[2];
        size_t rowbase_n;
        {
            const int ci = dir ? 1 : 0; rowbase_n = (size_t)NLAT + (size_t)b * TCTX + ci * 128;
#pragma unroll
            for (int j = 0; j < 2; ++j) { const int i = 2 * (tid & 63) + j, ch = tid >> 6; const bf16_t* src = MLB + (rowbase_n + i) * 1024 + head * 64 + ch * 8;
                pq[j] = *(const u32x4*)src; pk[j] = *(const u32x4*)(src + 256); pv[j] = *(const u32x4*)(src + 512); }
        }
        if (w == 0) { const float* ga_ = GT + (rowbase_n + (dir ? 127 - 2 * lane : 2 * lane)) * 16 + head + 8 * dir; const float* gb_ = GT + (rowbase_n + (dir ? 126 - 2 * lane : 2 * lane + 1)) * 16 + head + 8 * dir; const float g0_ = ga_[0], g1_ = ga_[4], g2_ = gb_[0], g3_ = gb_[4]; ML_SCAN(0, g0_, g1_, g2_, g3_); }
        for (int cc = 0; cc < 18; ++cc) {
            const size_t rowbase = rowbase_n;
            LAS float* a_s = (LAS float*)(lds + GA + (cc & 1) * GSET); LAS float* cm_s = a_s + 128; LAS float* wi_s = a_s + 256; LAS float* emt_s = a_s + 384; LAS float* wk_s = a_s + 512; LAS float* sc_s = a_s + 640;
            ML_BAR();
            {
                const int i0 = 2 * (tid & 63), ch = tid >> 6, ipa = dir ? 127 - i0 : i0, ipb = dir ? 126 - i0 : i0 + 1, ipe = dir ? 126 - i0 : i0;
                *(LAS u32x4*)(Qs + ipa * 72 + ch * 8) = pq[0]; *(LAS u32x4*)(Qs + ipb * 72 + ch * 8) = pq[1];
                *(LAS u32x4*)(Ks + ipa * 72 + ch * 8) = pk[0]; *(LAS u32x4*)(Ks + ipb * 72 + ch * 8) = pk[1];
                const unsigned ka[4] = {pk[0].x, pk[0].y, pk[0].z, pk[0].w}, kb[4] = {pk[1].x, pk[1].y, pk[1].z, pk[1].w}, va[4] = {pv[0].x, pv[0].y, pv[0].z, pv[0].w}, vb[4] = {pv[1].x, pv[1].y, pv[1].z, pv[1].w};
                const float wkl = wk_s[ipe], wkh = wk_s[ipe + 1];
#pragma unroll
                for (int e2 = 0; e2 < 4; ++e2) { if (VAR & 8) continue;
                    const unsigned kl0 = dir ? kb[e2] : ka[e2], kh0 = dir ? ka[e2] : kb[e2], vl0 = dir ? vb[e2] : va[e2], vh0 = dir ? va[e2] : vb[e2];
                    *(LAS unsigned*)(Kt + (ch * 8 + 2 * e2) * 136 + ipe) = pk2(bf2f(kl0 & 0xffffu) * wkl, bf2f(kh0 & 0xffffu) * wkh);
                    *(LAS unsigned*)(Kt + (ch * 8 + 2 * e2 + 1) * 136 + ipe) = pk2(bf2f(kl0 >> 16) * wkl, bf2f(kh0 >> 16) * wkh);
                    *(LAS unsigned*)(Vt + (ch * 8 + 2 * e2) * 136 + ipe) = (vl0 & 0xffffu) | (vh0 << 16);
                    *(LAS unsigned*)(Vt + (ch * 8 + 2 * e2 + 1) * 136 + ipe) = (vl0 >> 16) | (vh0 & 0xffff0000u); }
            }
            if (cc > 0) {
#pragma unroll
                for (int i = 0; i < 2; ++i)
#pragma unroll
                    for (int j = 0; j < 4; ++j) Cb[(16 * (mt0 + i) + 4 * fq + j) * 72 + 16 * ntk + fr] = (bf16_t)f2bf_hw(accC[i][j]);
                if (w < 4 && fq == 0) Cb[64 * 72 + 16 * w + fr] = (bf16_t)f2bf_hw(accN[0]);
            }
            if (cc + 1 < 18) {
                const int cn = cc + 1;
                if (cn < 2) { const int ci = dir ? 1 - cn : cn; rowbase_n = (size_t)NLAT + (size_t)b * TCTX + ci * 128; }
                else { const int ci = dir ? 17 - cn : cn - 2; rowbase_n = (size_t)b * TLAT + ci * 128; }
#pragma unroll
                for (int j = 0; j < 2; ++j) { const int i = 2 * (tid & 63) + j, ch = tid >> 6; const bf16_t* src = MLB + (rowbase_n + i) * 1024 + head * 64 + ch * 8;
                    pq[j] = *(const u32x4*)src; pk[j] = *(const u32x4*)(src + 256); pv[j] = *(const u32x4*)(src + 512); }
            }
            ML_BAR();
            if (!(VAR & 1)) {
            bf16x8 Qa[2];
            Qa[0] = *(const LAS bf16x8*)(Qs + (16 * w + fr) * 72 + 8 * fq); Qa[1] = *(const LAS bf16x8*)(Qs + (16 * w + fr) * 72 + 32 + 8 * fq);
            float cmt[4], rs[4];
#pragma unroll
            for (int j = 0; j < 4; ++j) { cmt[j] = cm_s[16 * w + 4 * fq + j]; rs[j] = 0.f; }
            for (int st = 0; st <= w; ++st) {
                const bf16x8 Kb0 = *(const LAS bf16x8*)(Ks + (16 * st + fr) * 72 + 8 * fq), Kb1 = *(const LAS bf16x8*)(Ks + (16 * st + fr) * 72 + 32 + 8 * fq);
                f32x4 S = (f32x4){0.f, 0.f, 0.f, 0.f};
                S = MFMA16(Qa[0], Kb0, S); S = MFMA16(Qa[1], Kb1, S);
                const float as = a_s[16 * st + fr];
#pragma unroll
                for (int j = 0; j < 4; ++j) { const bool ok = (st < w) || (fr <= 4 * fq + j); const float wgt = ok ? __expf(as - cmt[j]) : 0.f; const float v = S[j] * wgt;
                    rs[j] += v; Sp[(16 * w + 4 * fq + j) * 136 + 16 * st + fr] = (bf16_t)f2bf_hw(v); }
            }
            if ((w & 1) == 0) {
#pragma unroll
                for (int j = 0; j < 4; ++j) Sp[(16 * w + 4 * fq + j) * 136 + 16 * (w + 1) + fr] = (bf16_t)0;
            }
#pragma unroll
            for (int j = 0; j < 4; ++j) { rs[j] += __shfl_xor(rs[j], 1); rs[j] += __shfl_xor(rs[j], 2); rs[j] += __shfl_xor(rs[j], 4); rs[j] += __shfl_xor(rs[j], 8); }
            f32x4 hi_[4], hc[5];
#pragma unroll
            for (int nt = 0; nt < 4; ++nt) hi_[nt] = (f32x4){0.f, 0.f, 0.f, 0.f};
#pragma unroll
            for (int nt = 0; nt < 5; ++nt) hc[nt] = (f32x4){0.f, 0.f, 0.f, 0.f};
            for (int ks = 0; ks <= (w >> 1); ++ks) {
                const bf16x8 A = *(const LAS bf16x8*)(Sp + (16 * w + fr) * 136 + 32 * ks + 8 * fq);
#pragma unroll
                for (int nt = 0; nt < 4; ++nt) { const bf16x8 B = *(const LAS bf16x8*)(Vt + (16 * nt + fr) * 136 + 32 * ks + 8 * fq); hi_[nt] = MFMA16(A, B, hi_[nt]); }
            }
#pragma unroll
            for (int ks = 0; ks < 2; ++ks)
#pragma unroll
                for (int nt = 0; nt < 5; ++nt) { const bf16x8 B = *(const LAS bf16x8*)(Cb + (16 * nt + fr) * 72 + 32 * ks + 8 * fq); hc[nt] = MFMA16(Qa[ks], B, hc[nt]); }
            float hv[4][4];
#pragma unroll
            for (int j = 0; j < 4; ++j) {
                const int tl = 16 * w + 4 * fq + j;
                const float wi = wi_s[tl], em = emt_s[tl];
                const float qn = __shfl(hc[4][j], lane & 48);
                const float den = wi * qn + rs[j];
                const float inv = 1.0f / fmaxf(fabsf(den), em);
#pragma unroll
                for (int nt = 0; nt < 4; ++nt) hv[nt][j] = (wi * hc[nt][j] + hi_[nt][j]) * inv;
            }
            if (!(VAR & 4)) {
                LAS bf16_t* T = Sp + (16 * w) * 136;
#pragma unroll
                for (int j = 0; j < 4; ++j)
#pragma unroll
                    for (int nt = 0; nt < 4; ++nt) T[(4 * fq + j) * 136 + 16 * nt + fr] = (bf16_t)f2bf_hw(hv[nt][j]);
                asm volatile("s_waitcnt lgkmcnt(0)" ::: "memory");
#pragma unroll
                for (int q = 0; q < 2; ++q) { const int r = (lane >> 3) + 8 * q, c8 = lane & 7, tl = 16 * w + r; const size_t grow = rowbase + (dir ? 127 - tl : tl);
                    const u32x4 v = *(const LAS u32x4*)(T + r * 136 + c8 * 8);
                    *(u32x4*)(HSd + grow * 256 + head * 64 + c8 * 8) = v; }
            }
            }
            if (!(VAR & 2)) {
                const float asc = sc_s[0];
                accC[0] = accC[0] * asc; accC[1] = accC[1] * asc; accN = accN * asc;
#pragma unroll
                for (int ks = 0; ks < 4; ++ks) {
                    const bf16x8 Bs = *(const LAS bf16x8*)(Kt + (16 * ntk + fr) * 136 + 32 * ks + 8 * fq);
#pragma unroll
                    for (int i = 0; i < 2; ++i) { const bf16x8 A = *(const LAS bf16x8*)(Vt + (16 * (mt0 + i) + fr) * 136 + 32 * ks + 8 * fq); accC[i] = MFMA16(A, Bs, accC[i]); }
                    if (w < 4) { const bf16x8 A1 = *(const LAS bf16x8*)(Vt + (64 + fr) * 136 + 32 * ks + 8 * fq); accN = MFMA16(A1, Bs, accN); }
                }
            }
            if (w == 0 && cc + 1 < 18) { const float* ga_ = GT + (rowbase_n + (dir ? 127 - 2 * lane : 2 * lane)) * 16 + head + 8 * dir; const float* gb_ = GT + (rowbase_n + (dir ? 126 - 2 * lane : 2 * lane + 1)) * 16 + head + 8 * dir; const float g0_ = ga_[0], g1_ = ga_[4], g2_ = gb_[0], g3_ = gb_[4]; ML_SCAN((cc + 1) & 1, g0_, g1_, g2_, g3_); }
        }
    }
    __syncthreads();
}
__device__ __forceinline__ void mlstm_readout_phase(bool with_ctx, const bf16_t* HS0, const bf16_t* HS1, const bf16_t* __restrict__ MLB, bf16_t* MIX, const float* __restrict__ mlw) {
    const int tid = opaque_tid(), l16 = tid & 15, sub = tid >> 4;
    const int npairs = (with_ctx ? MTOT : NLAT) * 4;
    for (int p = blockIdx.x * 32 + sub; p < npairs; p += gridDim.x * 32) {
        const size_t grow = (size_t)(p >> 2); const int head = p & 3;
        const f32x4 gw = *(const f32x4*)(mlw + head * 64 + 4 * l16);
        const size_t off = grow * 256 + head * 64 + 4 * l16;
        const unsigned long long ha = *(const unsigned long long*)(HS0 + off), hb = *(const unsigned long long*)(HS1 + off);
        const f32x4 h = (f32x4){bf2f((unsigned)ha & 0xffffu) + bf2f((unsigned)hb & 0xffffu), bf2f(((unsigned)ha) >> 16) + bf2f(((unsigned)hb) >> 16),
                                bf2f((unsigned)(ha >> 32) & 0xffffu) + bf2f((unsigned)(hb >> 32) & 0xffffu), bf2f((unsigned)(ha >> 48)) + bf2f((unsigned)(hb >> 48))};
        const unsigned long long mo = *(const unsigned long long*)(MLB + grow * 1024 + 768 + head * 64 + 4 * l16);
        float ss = (h[0] * h[0] + h[1] * h[1]) + (h[2] * h[2] + h[3] * h[3]);
        ss += __shfl_xor(ss, 1); ss += __shfl_xor(ss, 2); ss += __shfl_xor(ss, 4); ss += __shfl_xor(ss, 8);
        const float rstd = rsqrtf(ss * (1.0f / 64.0f) + EPS);
        const unsigned mlo = (unsigned)mo, mhi = (unsigned)(mo >> 32);
        const float y0 = h[0] * rstd * gw[0] * sigmoid_f(bf2f(mlo & 0xffffu)), y1 = h[1] * rstd * gw[1] * sigmoid_f(bf2f(mlo >> 16));
        const float y2 = h[2] * rstd * gw[2] * sigmoid_f(bf2f(mhi & 0xffffu)), y3 = h[3] * rstd * gw[3] * sigmoid_f(bf2f(mhi >> 16));
        *(unsigned long long*)(MIX + grow * 1024 + 512 + head * 64 + 4 * l16) = (unsigned long long)pk2(y0, y1) | ((unsigned long long)pk2(y2, y3) << 32);
    }
}
#undef MFMA16
#undef ML_BAR
#undef ML_SCAN
}

__device__ __forceinline__ void pool_item(int u, const bf16_t* __restrict__ PZ, bf16_t* MIX, LAS unsigned char* lds) {
    const int tid = opaque_tid();
    const int r0 = u * 128;
    const int seq0 = (r0 < NLAT) ? (r0 / TLAT) * TLAT : NLAT + ((r0 - NLAT) / TCTX) * TCTX;
    const int len = (r0 < NLAT) ? TLAT : TCTX;
    const int tb = r0 - seq0;
    LAS u32x4* tile = (LAS u32x4*)lds;
#pragma unroll
    for (int q = 0; q < 9; ++q) { const int e = tid + 512 * q, row = e >> 5, ch = e & 31, t = tb - 8 + row;
        u32x4 v = (u32x4){0u, 0u, 0u, 0u};
        if (t >= 0 && t < len) v = *(const u32x4*)(PZ + (size_t)(seq0 + t) * 256 + ch * 8);
        tile[e] = v; }
    __syncthreads();
    const int ch = tid & 31, run = tid >> 5, half = 1 << (ch >> 3);
    float s[8];
#pragma unroll
    for (int e = 0; e < 8; ++e) s[e] = 0.f;
#define POOL_ACC(ROW, SGN) do { const u32x4 v_ = tile[(ROW) * 32 + ch]; \
        s[0] += (SGN) * bf2f(v_.x & 0xffffu); s[1] += (SGN) * bf2f(v_.x >> 16); s[2] += (SGN) * bf2f(v_.y & 0xffffu); s[3] += (SGN) * bf2f(v_.y >> 16); \
        s[4] += (SGN) * bf2f(v_.z & 0xffffu); s[5] += (SGN) * bf2f(v_.z >> 16); s[6] += (SGN) * bf2f(v_.w & 0xffffu); s[7] += (SGN) * bf2f(v_.w >> 16); } while (0)
    const int tl0 = run * 8;
    for (int k = -half; k < half; ++k) POOL_ACC(tl0 + 8 + k, 1.0f);
#pragma unroll
    for (int i = 0; i < 8; ++i) {
        const int tl = tl0 + i, t = tb + tl;
        if (i > 0) { POOL_ACC(tl + 8 + half - 1, 1.0f); POOL_ACC(tl + 8 - half - 1, -1.0f); }
        const int lo = max(t - half, 0), hi = min(t + half, len);
        const float inv = 1.0f / (float)(hi - lo);
        const u32x4 z = tile[(tl + 8) * 32 + ch];
        u32x4 o;
        o.x = pk2(s[0] * inv - bf2f(z.x & 0xffffu), s[1] * inv - bf2f(z.x >> 16)); o.y = pk2(s[2] * inv - bf2f(z.y & 0xffffu), s[3] * inv - bf2f(z.y >> 16));
        o.z = pk2(s[4] * inv - bf2f(z.z & 0xffffu), s[5] * inv - bf2f(z.z >> 16)); o.w = pk2(s[6] * inv - bf2f(z.w & 0xffffu), s[7] * inv - bf2f(z.w >> 16));
        *(u32x4*)(MIX + (size_t)(r0 + tl) * 1024 + 768 + ch * 8) = o;
    }
#undef POOL_ACC
    __syncthreads();
}
#define XB_TMO      128
#define XB_XCNT(j)  (256  + 64 * (j))
#define XB_XSUB(j)  (1280 + 64 * (j))
#define XB_XGEN(j)  (2304 + 64 * (j))
#define XB_TOP      3328
#define XB_TOPGEN   3392
#define XCD_BAR_WORDS 3456
#define XB_SPIN_CAP (1u << 18)

__device__ __forceinline__ unsigned xb_ld(unsigned* p)              { return __hip_atomic_load(p, __ATOMIC_RELAXED, __HIP_MEMORY_SCOPE_AGENT); }
__device__ __forceinline__ unsigned xb_add(unsigned* p, unsigned v) { return __hip_atomic_fetch_add(p, v, __ATOMIC_RELAXED, __HIP_MEMORY_SCOPE_AGENT); }
__device__ __forceinline__ unsigned xb_xcc_id() { return (unsigned)__builtin_amdgcn_s_getreg((3 << 11) | 20) & 0xFu; }
#define XB_SPIN(cond, bar) do { unsigned _sp = 0; while (cond) { __builtin_amdgcn_s_sleep(1); \
    if ((++_sp & 255u) == 0u) { if (xb_ld(&(bar)[XB_TMO])) break; if (_sp > XB_SPIN_CAP) { atomicAdd(&(bar)[XB_TMO], 1u); break; } } } } while (0)

struct XcdBarrier {
    unsigned* bar; unsigned x;
    volatile LAS unsigned* st;
};

__device__ __forceinline__ XcdBarrier xcd_barrier_post(unsigned* bar, volatile LAS unsigned* st) {
    XcdBarrier b; b.bar = bar; b.x = xb_xcc_id(); b.st = st;
    if (threadIdx.x == 0) (void)xb_add(&bar[XB_XCNT(b.x)], 1u);
    return b;
}
__device__ __forceinline__ void xcd_barrier_complete(unsigned* bar, unsigned x, unsigned& nloc, unsigned& nx) {
    const unsigned G = gridDim.x * gridDim.y * gridDim.z;
    unsigned sum, cnt, mine, sp = 0u;
    for (;;) {
        sum = 0u; cnt = 0u; mine = 0u;
#pragma unroll
        for (unsigned j = 0; j < 16; ++j) { const unsigned c = xb_ld(&bar[XB_XCNT(j)]); sum += c; cnt += (c > 0u) ? 1u : 0u; mine = (j == x) ? c : mine; }
        if (sum == G) break;
        __builtin_amdgcn_s_sleep(1);
        if ((++sp & 255u) == 0u) { if (xb_ld(&bar[XB_TMO])) break; if (sp > XB_SPIN_CAP) { atomicAdd(&bar[XB_TMO], 1u); break; } }
    }
    nloc = mine > 0u ? mine : 1u; nx = cnt > 0u ? cnt : 1u;
}

__device__ __forceinline__ void xcd_barrier(const XcdBarrier& b) {
    asm volatile("s_waitcnt vmcnt(0)" ::: "memory");
    __syncthreads();
    if (threadIdx.x == 0) {
        unsigned* bar = b.bar;
        __builtin_amdgcn_s_waitcnt(0);
        unsigned nloc = b.st[0], nx = b.st[1];
        if (nloc == 0u) { xcd_barrier_complete(bar, b.x, nloc, nx); b.st[0] = nloc; b.st[1] = nx; }
        const unsigned old = xb_add(&bar[XB_XSUB(b.x)], 1u);
        const unsigned gen = old / nloc;
        if (old + 1u == (gen + 1u) * nloc) {
            __builtin_amdgcn_fence(__ATOMIC_RELEASE, "agent");
            asm volatile("s_waitcnt vmcnt(0)" ::: "memory");
            const unsigned og = xb_add(&bar[XB_TOP], 1u);
            const unsigned tg = og / nx;
            if (og + 1u == (tg + 1u) * nx) xb_add(&bar[XB_TOPGEN], 1u);
            else XB_SPIN(xb_ld(&bar[XB_TOPGEN]) == tg, bar);
            __builtin_amdgcn_fence(__ATOMIC_ACQUIRE, "agent");
            xb_add(&bar[XB_XGEN(b.x)], 1u);
            asm volatile("s_waitcnt vmcnt(0)" ::: "memory");
        } else {
            XB_SPIN(xb_ld(&bar[XB_XGEN(b.x)]) == gen, bar);
            __builtin_amdgcn_fence(__ATOMIC_ACQUIRE, "agent");
            asm volatile("s_waitcnt vmcnt(0)" ::: "memory");
        }
    }
    __syncthreads();
}
struct Args { const float* in[20]; float* out; unsigned char* ws; };
enum { I_X = 0, I_C, I_CTX, I_CCTX, I_WADA, I_BADA, I_NMIX, I_WIN, I_BG, I_QN, I_KN, I_MLN, I_PW, I_PS, I_WOUT, I_NFFN, I_WG, I_WU, I_WD, I_FN };
constexpr int LDS_BYTES = 147456;
#ifndef REP_N1
#define REP_N1 1
#endif
#ifndef REP_G1
#define REP_G1 1
#endif
#ifndef REP_MIX
#define REP_MIX 1
#endif
#ifndef REP_N2
#define REP_N2 1
#endif
#ifndef REP_G3
#define REP_G3 1
#endif
#ifndef REP_PRO
#define REP_PRO 1
#endif
#ifndef ML_DUP
#define ML_DUP 1
#endif
#ifndef AL_DUP
#define AL_DUP 1
#endif
#ifndef MIXREP_MASK
#define MIXREP_MASK 15
#endif
#ifndef ML_VAR
#define ML_VAR 0
#endif
#ifndef PRO_MASK
#define PRO_MASK 7
#endif
#ifndef REP_SYNC
#define REP_SYNC 1
#endif

__device__ __forceinline__ void tr_item(const float* colp, size_t ld, int K, bf16_t* WT, int r0, int k0, LAS float* scr, int lane) {
    float tv[32];
#pragma unroll
    for (int i = 0; i < 32; ++i) { const int kk = 2 * i + (lane >> 5); tv[i] = colp ? colp[(size_t)(k0 + kk) * ld] : 0.f; }
#pragma unroll
    for (int i = 0; i < 32; ++i) { const int kk = 2 * i + (lane >> 5); scr[kk * 33 + (lane & 31)] = tv[i]; }
    asm volatile("s_waitcnt lgkmcnt(0)" ::: "memory");
    const int c = lane & 7;
#pragma unroll
    for (int j = 0; j < 4; ++j) { const int n = (lane >> 3) + 8 * j; const LAS float* s = scr + (8 * c) * 33 + n;
        u32x4 o; o.x = pk2(s[0 * 33], s[1 * 33]); o.y = pk2(s[2 * 33], s[3 * 33]); o.z = pk2(s[4 * 33], s[5 * 33]); o.w = pk2(s[6 * 33], s[7 * 33]);
        *(u32x4*)(WT + (size_t)(r0 + n) * K + k0 + 8 * c) = o; }
    asm volatile("s_waitcnt lgkmcnt(0)" ::: "memory");
}
__device__ __forceinline__ void tr_item_pool(const float* win, const float* pw, const float* ps, bf16_t* WT, int r0, int k0, LAS float* scr, int lane) {
    const int p = (r0 - 1792) + (lane & 31), oc = 64 * ((p >> 5) & 3) + 32 * (p >> 7) + (p & 31), g = oc >> 6, o = oc & 63;
    const float scl = ps[oc];
    const float* pwc = pw + (size_t)g * 4096 + o;
    float pwr[64];
#pragma unroll
    for (int q = 0; q < 64; ++q) pwr[q] = pwc[q * 64];
    for (int i = 0; i < 8; ++i) { const int kk = 2 * i + (lane >> 5); const float* wr = win + (size_t)(k0 + kk) * INW + 1808 + 64 * g;
        f32x4 w4[16];
#pragma unroll
        for (int q = 0; q < 16; ++q) w4[q] = *(const f32x4*)(wr + 4 * q);
        float s0 = 0.f, s1 = 0.f;
#pragma unroll
        for (int q = 0; q < 16; q += 2) { s0 += (w4[q][0] * pwr[4 * q] + w4[q][1] * pwr[4 * q + 1]) + (w4[q][2] * pwr[4 * q + 2] + w4[q][3] * pwr[4 * q + 3]);
            s1 += (w4[q + 1][0] * pwr[4 * q + 4] + w4[q + 1][1] * pwr[4 * q + 5]) + (w4[q + 1][2] * pwr[4 * q + 6] + w4[q + 1][3] * pwr[4 * q + 7]); }
        scr[kk * 33 + (lane & 31)] = (s0 + s1) * scl; }
    asm volatile("s_waitcnt lgkmcnt(0)" ::: "memory");
    { const int n = lane >> 1, c = lane & 1; const LAS float* s = scr + (8 * c) * 33 + n;
        u32x4 o4; o4.x = pk2(s[0 * 33], s[1 * 33]); o4.y = pk2(s[2 * 33], s[3 * 33]); o4.z = pk2(s[4 * 33], s[5 * 33]); o4.w = pk2(s[6 * 33], s[7 * 33]);
        *(u32x4*)(WT + (size_t)(r0 + n) * 1024 + k0 + 8 * c) = o4; }
    asm volatile("s_waitcnt lgkmcnt(0)" ::: "memory");
}

__device__ __forceinline__ void prologue(const Args& a, LAS unsigned char* lds, const int pmask) {
    const int tid = threadIdx.x, lane = tid & 63, wave = tid >> 6;
    unsigned char* ws = a.ws;
    if (blockIdx.x == 0) {
        for (int e = tid; e < 1024; e += 512) { const int pos = e >> 4, f = e & 15;
            const float invf = exp2f(-(float)(2 * f) * (13.287712379549449f / 32.0f));
            float ang = (float)pos * invf; ang -= 6.283185307179586f * rintf(ang * 0.15915494309189535f);
            float* cs = (float*)(ws + WS_ROPE) + e * 2; cs[0] = __cosf(ang); cs[1] = __sinf(ang); }
    }
    LAS float* scs = (LAS float*)lds;
    LAS float* red = (LAS float*)(lds + 17 * 4096);
    for (int e = tid; e < 17 * 1024; e += 512) { const float v = (e < 16 * 1024) ? a.in[I_C][e] : a.in[I_CCTX][e - 16 * 1024]; scs[e] = silu_f(v); }
    __syncthreads();
    for (int it = blockIdx.x; it < 2 * 192; it += gridDim.x) { if (!(pmask & 1)) break;
        const int l = it / 192, c0 = (it % 192) * 32, col = tid & 31, kp = tid >> 5;
        const float* W = a.in[I_WADA] + ((size_t)l * 1024 + kp * 64) * 6144 + c0 + col;
        float acc[17];
#pragma unroll
        for (int r = 0; r < 17; ++r) acc[r] = 0.f;
#pragma unroll 16
        for (int k4 = 0; k4 < 16; ++k4) { const float w0 = W[(size_t)(4 * k4) * 6144], w1 = W[(size_t)(4 * k4 + 1) * 6144], w2 = W[(size_t)(4 * k4 + 2) * 6144], w3 = W[(size_t)(4 * k4 + 3) * 6144];
#pragma unroll
            for (int r = 0; r < 17; ++r) { const f32x4 s = *(const LAS f32x4*)(scs + r * 1024 + kp * 64 + 4 * k4); acc[r] += (s[0] * w0 + s[1] * w1) + (s[2] * w2 + s[3] * w3); } }
#pragma unroll
        for (int r = 0; r < 17; ++r) red[(kp * 17 + r) * 32 + col] = acc[r];
        __syncthreads();
        for (int e = tid; e < 17 * 32; e += 512) { const int r = e >> 5, cc = e & 31; float s = 0.f;
#pragma unroll
            for (int q = 0; q < 16; ++q) s += red[(q * 17 + r) * 32 + cc];
            ((float*)(ws + WS_MOD))[((size_t)l * 17 + r) * 6144 + c0 + cc] = s + a.in[I_BADA][(size_t)l * 6144 + c0 + cc]; }
        __syncthreads();
    }
    LAS float* scr = (LAS float*)(lds + wave * 8448);
    const int gw = blockIdx.x * 8 + wave, NGW = gridDim.x * 8;
    constexpr int IT_W1 = 64 * 16, IT_WO = 32 * 16, IT_GU = 176 * 16, IT_WD = 32 * 44, IT_L = IT_W1 + IT_WO + IT_GU + IT_WD;
#define TR_DECODE(IT, COLP, LD, KK, WTP, R0, K0) do { const int l_ = (IT) / IT_L; int r_ = (IT) % IT_L; \
        if (r_ < IT_W1) { int rg_ = r_ / 16; if (rg_ >= 56) rg_ += 8; K0 = (r_ % 16) * 64; R0 = rg_ * 32; WTP = (bf16_t*)(ws + WS_W1 + l_ * W1_BYTES); \
            const float* win_ = a.in[I_WIN] + (size_t)l_ * 1024 * INW; const int rr_ = R0 + (lane & 31), pn_ = rr_ >> 8, p_ = rr_ & 255, oc_ = 64 * ((p_ >> 5) & 3) + 32 * (p_ >> 7) + (p_ & 31), cp_ = 256 * pn_ + oc_; \
            COLP = (cp_ < 1792) ? win_ + cp_ : (cp_ >= 2048 && cp_ < 2064) ? win_ + 1792 + (cp_ - 2048) : nullptr; LD = INW; KK = 1024; } \
        else if ((r_ -= IT_W1) < IT_WO) { R0 = (r_ / 16) * 32; K0 = (r_ % 16) * 64; COLP = a.in[I_WOUT] + (size_t)l_ * 1024 * 1024 + R0 + (lane & 31); LD = 1024; KK = 1024; WTP = (bf16_t*)(ws + WS_WO + l_ * WO_BYTES); } \
        else if ((r_ -= IT_WO) < IT_GU) { R0 = (r_ / 16) * 32; K0 = (r_ % 16) * 64; const int rr_ = R0 + (lane & 31), pn_ = rr_ >> 8, p_ = rr_ & 255, hcol_ = 128 * pn_ + (p_ & 127); \
            COLP = ((p_ >> 7) ? a.in[I_WU] : a.in[I_WG]) + (size_t)l_ * 1024 * DFF + hcol_; LD = DFF; KK = 1024; WTP = (bf16_t*)(ws + WS_WGU + l_ * WGU_BYTES); } \
        else { r_ -= IT_GU; R0 = (r_ / 44) * 32; K0 = (r_ % 44) * 64; COLP = a.in[I_WD] + (size_t)l_ * DFF * 1024 + R0 + (lane & 31); LD = 1024; KK = DFF; WTP = (bf16_t*)(ws + WS_WD + l_ * WD_BYTES); } } while (0)
#define TR_LOAD(TV, COLP, LD, K0) do { _Pragma("unroll") for (int i_ = 0; i_ < 32; ++i_) { const int kk_ = 2 * i_ + (lane >> 5); TV[i_] = (COLP) ? (COLP)[(size_t)((K0) + kk_) * (LD)] : 0.f; } } while (0)
    if (pmask & 2) {
        int it = gw;
        const float* colp = nullptr; size_t ld = 0; int KK = 0, r0 = 0, k0 = 0; bf16_t* WT = nullptr;
        float tv[32];
        if (it < 2 * IT_L) { TR_DECODE(it, colp, ld, KK, WT, r0, k0); TR_LOAD(tv, colp, ld, k0); }
        while (it < 2 * IT_L) {
            const int itn = it + NGW;
            const float* colpn = nullptr; size_t ldn = 0; int KKn = 0, r0n = 0, k0n = 0; bf16_t* WTn = nullptr;
            float tn[32];
            if (itn < 2 * IT_L) { TR_DECODE(itn, colpn, ldn, KKn, WTn, r0n, k0n); TR_LOAD(tn, colpn, ldn, k0n); }
#pragma unroll
            for (int i = 0; i < 32; ++i) { const int kk = 2 * i + (lane >> 5); scr[kk * 33 + (lane & 31)] = tv[i]; }
            asm volatile("s_waitcnt lgkmcnt(0)" ::: "memory");
            { const int c = lane & 7;
#pragma unroll
                for (int j = 0; j < 4; ++j) { const int n = (lane >> 3) + 8 * j; const LAS float* s = scr + (8 * c) * 33 + n;
                    u32x4 o; o.x = pk2(s[0 * 33], s[1 * 33]); o.y = pk2(s[2 * 33], s[3 * 33]); o.z = pk2(s[4 * 33], s[5 * 33]); o.w = pk2(s[6 * 33], s[7 * 33]);
                    *(u32x4*)(WT + (size_t)(r0 + n) * KK + k0 + 8 * c) = o; } }
            asm volatile("s_waitcnt lgkmcnt(0)" ::: "memory");
            it = itn; colp = colpn; ld = ldn; KK = KKn; r0 = r0n; k0 = k0n; WT = WTn;
#pragma unroll
            for (int i = 0; i < 32; ++i) tv[i] = tn[i];
        }
    }
#undef TR_DECODE
#undef TR_LOAD
    if (pmask & 4)
    for (int it = gw; it < 1024; it += NGW) { const int l = it >> 9, rg = (it & 511) >> 6, kg = it & 63;
        tr_item_pool(a.in[I_WIN] + (size_t)l * 1024 * INW, a.in[I_PW] + (size_t)l * 4 * 4096, a.in[I_PS] + l * 256, (bf16_t*)(ws + WS_W1 + l * W1_BYTES), 1792 + rg * 32, kg * 16, scr, lane); }
}

__device__ __forceinline__ void norm_phase(const float* xl, const float* xc, const float* gw, const float* mod  , int sh_off, int sc_off, bf16_t* XN, int nrows) {
    const int tid = opaque_tid(), lane = tid & 63, gwv = blockIdx.x * 8 + (tid >> 6), NGW = gridDim.x * 8;
    const int per = (nrows + NGW - 1) / NGW;
    int cur = -1; f32x4 mul[4], add[4];
    for (int q = 0; q < per; ++q) {
        const int row = gwv * per + q; if (row >= nrows) break;
        const int mr = row < NLAT ? row / TLAT : 16;
        if (mr != cur) { cur = mr; const float* mp = mod + (size_t)mr * 6144;
#pragma unroll
            for (int j = 0; j < 4; ++j) { const f32x4 g = *(const f32x4*)(gw + 4 * lane + 256 * j), s = *(const f32x4*)(mp + sc_off + 4 * lane + 256 * j); mul[j] = g * (s + 1.0f); add[j] = *(const f32x4*)(mp + sh_off + 4 * lane + 256 * j); } }
        const float* xr = row < NLAT ? xl + (size_t)row * 1024 : xc + (size_t)(row - NLAT) * 1024;
        f32x4 v[4]; float ss = 0.f;
#pragma unroll
        for (int j = 0; j < 4; ++j) { v[j] = __builtin_nontemporal_load((const f32x4*)(xr + 4 * lane + 256 * j)); ss += (v[j][0] * v[j][0] + v[j][1] * v[j][1]) + (v[j][2] * v[j][2] + v[j][3] * v[j][3]); }
        const float rstd = rsqrtf(wave_sum(ss) * (1.0f / 1024.0f) + EPS);
        unsigned long long* o8 = (unsigned long long*)(XN + (size_t)row * 1024) + lane;
#pragma unroll
        for (int j = 0; j < 4; ++j) { const f32x4 y = v[j] * rstd * mul[j] + add[j]; o8[64 * j] = (unsigned long long)pk2(y[0], y[1]) | ((unsigned long long)pk2(y[2], y[3]) << 32); }
    }
}
__device__ __forceinline__ void ctx_gates_phase(const float* xc, const float* gw, const float* modc, const float* win, const float* bg, float* GT, LAS unsigned char* lds) {
    const int tid = opaque_tid(), lane = tid & 63, gwv = blockIdx.x * 8 + (tid >> 6), NGW = gridDim.x * 8;
    LAS float* wg = (LAS float*)lds;
    for (int e = tid; e < 4096; e += 512) { const int k = e >> 2, q4 = e & 3; *(LAS f32x4*)(wg + k * 16 + q4 * 4) = *(const f32x4*)(win + (size_t)k * INW + 1792 + q4 * 4); }
    __syncthreads();
    for (int r = gwv; r < NCTX; r += NGW) {
        asm volatile("" ::: "memory");
        const float* xr = xc + (size_t)r * 1024; float h[16]; float ss = 0.f;
#pragma unroll
        for (int q = 0; q < 16; ++q) { h[q] = xr[lane + 64 * q]; ss += h[q] * h[q]; }
        const float rstd = rsqrtf(wave_sum(ss) * (1.0f / 1024.0f) + EPS);
        f32x4 acc[4];
#pragma unroll
        for (int q = 0; q < 4; ++q) acc[q] = (f32x4){0.f, 0.f, 0.f, 0.f};
#pragma unroll
        for (int q = 0; q < 16; ++q) { const int c = lane + 64 * q; const float hv = h[q] * rstd * gw[c] * (modc[1024 + c] + 1.0f) + modc[c];
#pragma unroll
            for (int g4 = 0; g4 < 4; ++g4) acc[g4] += *(const LAS f32x4*)(wg + c * 16 + 4 * g4) * hv; }
        float out = 0.f;
#pragma unroll
        for (int q = 0; q < 4; ++q)
#pragma unroll
            for (int i = 0; i < 4; ++i) { const float v = wave_sum(acc[q][i]); if (lane == 4 * q + i) out = v; }
        if (lane < 16) GT[(size_t)(NLAT + r) * 16 + lane] = out + bg[lane];
    }
    __syncthreads();
}
__device__ __forceinline__ void norm_phase_bf(const bf16_t* xs, const float* gw, const float* mod, int sh_off, int sc_off, bf16_t* XN, int nrows, const float* part = nullptr, int nsplit = 0, const float* pgate = nullptr, const float* cbase = nullptr, bf16_t* xs_w = nullptr) {
    const int tid = opaque_tid(), lane = tid & 63, gwv = blockIdx.x * 8 + (tid >> 6), NGW = gridDim.x * 8;
    const int per = (nrows + NGW - 1) / NGW;
    int cur = -1; f32x4 mul[4], add[4];
    for (int q = 0; q < per; ++q) {
        const int row = gwv * per + q; if (row >= nrows) break;
        const int mr = row < NLAT ? row / TLAT : 16;
        if (mr != cur) { cur = mr; const float* mp = mod + (size_t)mr * 6144;
#pragma unroll
            for (int j = 0; j < 4; ++j) { const int c = 8 * lane + 512 * (j >> 1) + 4 * (j & 1); const f32x4 g = *(const f32x4*)(gw + c), s = *(const f32x4*)(mp + sc_off + c); mul[j] = g * (s + 1.0f); add[j] = *(const f32x4*)(mp + sh_off + c); } }
        const bf16_t* xr = xs + (size_t)row * 1024;
        f32x4 v[4]; float ss = 0.f;
#pragma unroll
        for (int j = 0; j < 2; ++j) { const u32x4 w = *(const u32x4*)(xr + 8 * lane + 512 * j);
            v[2 * j] = (f32x4){bf2f(w.x & 0xffffu), bf2f(w.x >> 16), bf2f(w.y & 0xffffu), bf2f(w.y >> 16)}; v[2 * j + 1] = (f32x4){bf2f(w.z & 0xffffu), bf2f(w.z >> 16), bf2f(w.w & 0xffffu), bf2f(w.w >> 16)}; }
        if (part && row >= NLAT) {
#pragma unroll
            for (int j = 0; j < 4; ++j) { const int c = 8 * lane + 512 * (j >> 1) + 4 * (j & 1); f32x4 s = (f32x4){0.f, 0.f, 0.f, 0.f};
                if (cbase) v[j] = *(const f32x4*)(cbase + (size_t)(row - NLAT) * 1024 + c);
                for (int k = 0; k < nsplit; ++k) s += *(const f32x4*)(part + ((size_t)k * NCTX + (row - NLAT)) * 1024 + c);
                v[j] += *(const f32x4*)(pgate + c) * s; }
            if (xs_w) {
#pragma unroll
                for (int j = 0; j < 2; ++j) { u32x4 o; o.x = pk2(v[2 * j][0], v[2 * j][1]); o.y = pk2(v[2 * j][2], v[2 * j][3]); o.z = pk2(v[2 * j + 1][0], v[2 * j + 1][1]); o.w = pk2(v[2 * j + 1][2], v[2 * j + 1][3]);
                    *(u32x4*)(xs_w + (size_t)row * 1024 + 8 * lane + 512 * j) = o; } } }
#pragma unroll
        for (int j = 0; j < 4; ++j) ss += (v[j][0] * v[j][0] + v[j][1] * v[j][1]) + (v[j][2] * v[j][2] + v[j][3] * v[j][3]);
        const float rstd = rsqrtf(wave_sum(ss) * (1.0f / 1024.0f) + EPS);
#pragma unroll
        for (int j = 0; j < 2; ++j) { const f32x4 y0 = v[2 * j] * rstd * mul[2 * j] + add[2 * j], y1 = v[2 * j + 1] * rstd * mul[2 * j + 1] + add[2 * j + 1];
            u32x4 o; o.x = pk2(y0[0], y0[1]); o.y = pk2(y0[2], y0[3]); o.z = pk2(y1[0], y1[1]); o.w = pk2(y1[2], y1[3]);
            *(u32x4*)(XN + (size_t)row * 1024 + 8 * lane + 512 * j) = o; }
    }
}
__device__ __forceinline__ void final_norm_phase_bf(const bf16_t* xs, float* out, const float* gw) {
    const int tid = opaque_tid(), lane = tid & 63, gwv = blockIdx.x * 8 + (tid >> 6), NGW = gridDim.x * 8;
    f32x4 g[4];
#pragma unroll
    for (int j = 0; j < 4; ++j) g[j] = *(const f32x4*)(gw + 8 * lane + 512 * (j >> 1) + 4 * (j & 1));
    for (int row = gwv; row < NLAT; row += NGW) {
        const bf16_t* xr = xs + (size_t)row * 1024; f32x4 v[4]; float ss = 0.f;
#pragma unroll
        for (int j = 0; j < 2; ++j) { const u32x4 w = *(const u32x4*)(xr + 8 * lane + 512 * j);
            v[2 * j] = (f32x4){bf2f(w.x & 0xffffu), bf2f(w.x >> 16), bf2f(w.y & 0xffffu), bf2f(w.y >> 16)}; v[2 * j + 1] = (f32x4){bf2f(w.z & 0xffffu), bf2f(w.z >> 16), bf2f(w.w & 0xffffu), bf2f(w.w >> 16)}; }
#pragma unroll
        for (int j = 0; j < 4; ++j) ss += (v[j][0] * v[j][0] + v[j][1] * v[j][1]) + (v[j][2] * v[j][2] + v[j][3] * v[j][3]);
        const float rstd = rsqrtf(wave_sum(ss) * (1.0f / 1024.0f) + EPS);
#pragma unroll
        for (int j = 0; j < 4; ++j) __builtin_nontemporal_store(v[j] * rstd * g[j], (f32x4*)(out + (size_t)row * 1024 + 8 * lane + 512 * (j >> 1) + 4 * (j & 1)));
    }
}
__device__ __forceinline__ void final_norm_phase(float* x, const float* gw) {
    const int tid = opaque_tid(), lane = tid & 63, gwv = blockIdx.x * 8 + (tid >> 6), NGW = gridDim.x * 8;
    f32x4 g[4];
#pragma unroll
    for (int j = 0; j < 4; ++j) g[j] = *(const f32x4*)(gw + 4 * lane + 256 * j);
    for (int row = gwv; row < NLAT; row += NGW) {
        float* xr = x + (size_t)row * 1024; f32x4 v[4]; float ss = 0.f;
#pragma unroll
        for (int j = 0; j < 4; ++j) { v[j] = __builtin_nontemporal_load((const f32x4*)(xr + 4 * lane + 256 * j)); ss += (v[j][0] * v[j][0] + v[j][1] * v[j][1]) + (v[j][2] * v[j][2] + v[j][3] * v[j][3]); }
        const float rstd = rsqrtf(wave_sum(ss) * (1.0f / 1024.0f) + EPS);
#pragma unroll
        for (int j = 0; j < 4; ++j) __builtin_nontemporal_store(v[j] * rstd * g[j], (f32x4*)(xr + 4 * lane + 256 * j));
    }
}

__global__ void __launch_bounds__(512, 2) fwd_megakernel(Args a) {
    extern __shared__ __attribute__((aligned(16))) unsigned char lds_raw[];
    LAS unsigned char* lds = (LAS unsigned char*)lds_raw;
    unsigned char* ws = a.ws;
    const int tid = threadIdx.x;
    float* MOD = (float*)(ws + WS_MOD);
    bf16_t* XN = (bf16_t*)(ws + WS_XN); bf16_t* QB = (bf16_t*)(ws + WS_QB); bf16_t* KB = (bf16_t*)(ws + WS_KB); bf16_t* VB = (bf16_t*)(ws + WS_VB);
    bf16_t* MLB = (bf16_t*)(ws + WS_MLB); bf16_t* PZ = (bf16_t*)(ws + WS_PZ); float* GT = (float*)(ws + WS_GT); bf16_t* HS = (bf16_t*)(ws + WS_HS); bf16_t* HS1 = (bf16_t*)(ws + WS_HS1);
    bf16_t* MIX = (bf16_t*)(ws + WS_MIX); bf16_t* HID = (bf16_t*)(ws + WS_HID); bf16_t* XS = (bf16_t*)(ws + WS_XS);
    unsigned* ctl = (unsigned*)(ws + WS_CTL);
    LAS int* item_s = (LAS int*)(lds + 131072 + 1024);
    volatile LAS unsigned* bst = (volatile LAS unsigned*)(lds + 131072 + 2048);
    if (tid < 4) bst[tid] = 0u;
    __syncthreads();
    XcdBarrier xbar = xcd_barrier_post(ctl + 4096, bst);
#define GSYNC() xcd_barrier(xbar)

    for (int rp = 0; rp < REP_PRO; ++rp) { prologue(a, lds, rp == 0 ? 7 : PRO_MASK);
    GSYNC(); }

    for (int l = 0; l < 2; ++l) {
        const float* xl_in = a.in[I_X];
        const float* xc_in = a.in[I_CTX];
        const float* modl = MOD + (size_t)l * 17 * 6144;
        for (int rp = 0; rp < REP_N1; ++rp) { if (l == 0) norm_phase(xl_in, xc_in, a.in[I_NMIX] + l * 1024, modl, 0, 1024, XN, MTOT); else norm_phase_bf(XS, a.in[I_NMIX] + l * 1024, modl, 0, 1024, XN, MTOT, (const float*)(ws + WS_MIX + 32 * MiB), 2, MOD + (size_t)16 * 6144 + 5120);
        if (l == 0) ctx_gates_phase(xc_in, a.in[I_NMIX], modl + 16 * 6144, a.in[I_WIN], a.in[I_BG], GT, lds);
        for (int rs = 0; rs < REP_SYNC; ++rs) GSYNC(); }
        for (int rp = 0; rp < REP_G1; ++rp) {
            pg8::Gemm g{XN, (const bf16_t*)(ws + WS_W1 + l * W1_BYTES), MTOT, N1, 1024}; pg8::G1Order S; S.init(gridDim.x, (int)blockIdx.x, l == 0);
            pg8::EpiIn E{QB, KB, VB, MLB, PZ, GT, a.in[I_QN] + l * 64, a.in[I_KN] + l * 64, a.in[I_BG] + l * 16, (const float*)(ws + WS_ROPE), attn_body::C2};
            pg8::gemm_phase<pg8::EpiIn, pg8::G1Order, true, true>(lds, g, S, E);
        GSYNC(); }
        for (int rp = 0; rp < REP_MIX; ++rp) {
            const int n_ml = 128 * ML_DUP, n_al = 1024 * AL_DUP, n_ac = (l == 0) ? 128 : 0, n_pool = (l == 0) ? 288 : 256, n_all = n_ml + n_al + n_ac + n_pool;
            for (;;) {
                __syncthreads();
                if (tid == 0) item_s[0] = (int)atomicAdd(ctl + 64 * (l * 4 + rp), 1u);
                __syncthreads();
                int it = item_s[0];
                if (it >= n_all) break;
                const int cmask = (rp == 0) ? 15 : MIXREP_MASK;
                if (it < n_ml) { if (!(cmask & 1)) continue; const int itm = it & 127, mb = itm >> 3, mh = (itm >> 1) & 3, md = itm & 1;
                    if (rp == 0) ml::mlstm_item<0>(mb, mh, md, MLB, GT, md ? HS1 : HS, lds); else ml::mlstm_item<ML_VAR>(mb, mh, md, MLB, GT, md ? HS1 : HS, lds);
                    continue; }
                it -= n_ml;
                if (it < n_al) { if (!(cmask & 2)) continue; const int b = (it >> 6) & 15, h = (it >> 3) & 7, qb = it & 7;
                    attn_body::attn_unit<8>((const attn_body::bf16*)(QB + ((size_t)b * TLAT + qb * 256) * 512 + h * 64), (const attn_body::bf16*)(KB + (size_t)b * TKV * 128 + (h >> 2) * 64),
                                            (const attn_body::bf16*)(VB + (size_t)b * TKV * 128 + (h >> 2) * 64), (attn_body::bf16*)(MIX + ((size_t)b * TLAT + qb * 256) * 1024 + h * 64), TKV / 64, (char*)lds_raw);
                    continue; }
                it -= n_al;
                if (it < n_ac) { if (!(cmask & 4)) continue; const int b = it >> 3, h = it & 7;
                    attn_body::attn_unit<8>((const attn_body::bf16*)(QB + ((size_t)NLAT + b * TCTX) * 512 + h * 64), (const attn_body::bf16*)(KB + ((size_t)b * TKV + TLAT) * 128 + (h >> 2) * 64),
                                            (const attn_body::bf16*)(VB + ((size_t)b * TKV + TLAT) * 128 + (h >> 2) * 64), (attn_body::bf16*)(MIX + ((size_t)NLAT + b * TCTX) * 1024 + h * 64), TCTX / 64, (char*)lds_raw);
                    continue; }
                it -= n_ac;
                if (cmask & 8) pool_item(it, PZ, MIX, lds);
            }
        GSYNC(); }
        ml::mlstm_readout_phase(l == 0, HS, HS1, MLB, MIX, a.in[I_MLN] + l * 256);
        GSYNC();
        const int Mrows = (l == 0) ? MTOT : NLAT;
        {
            pg8::Gemm g{MIX, (const bf16_t*)(ws + WS_WO + l * WO_BYTES), Mrows, 1024, 1024, 0}; pg8::StaticOrder S; S.init(Mrows, 1024, gridDim.x, (int)blockIdx.x);
            if (l == 0) { pg8::EpiRes2<false, true> E{xl_in, xc_in, XS, nullptr, modl + 2048}; pg8::gemm_phase<pg8::EpiRes2<false, true>, pg8::StaticOrder, true, true>(lds, g, S, E); }
            else { pg8::EpiRes2<true, true> E{nullptr, nullptr, XS, nullptr, modl + 2048}; pg8::gemm_phase<pg8::EpiRes2<true, true>, pg8::StaticOrder, true, true>(lds, g, S, E); }
        }
        GSYNC();
        for (int rp = 0; rp < REP_N2; ++rp) { norm_phase_bf(XS, a.in[I_NFFN] + l * 1024, modl, 3072, 4096, XN, Mrows);
        GSYNC(); }
        for (int rp = 0; rp < REP_G3; ++rp) {
            pg8::Gemm g{XN, (const bf16_t*)(ws + WS_WGU + l * WGU_BYTES), Mrows, NGU, 1024}; pg8::StaticOrder S; S.init(Mrows, NGU, gridDim.x, (int)blockIdx.x);
            pg8::EpiGU E{HID};
            pg8::gemm_phase<pg8::EpiGU, pg8::StaticOrder, true, true>(lds, g, S, E);
        GSYNC(); }
        {
            pg8::Gemm g{HID, (const bf16_t*)(ws + WS_WD + l * WD_BYTES), NLAT, 1024, DFF, 0}; pg8::StaticOrder S; S.init(NLAT, 1024, gridDim.x, (int)blockIdx.x);
            if (l == 0) { pg8::EpiRes2<true, true> E{nullptr, nullptr, XS, nullptr, modl + 5120}; pg8::gemm_phase<pg8::EpiRes2<true, true>, pg8::StaticOrder, true, true>(lds, g, S, E);
                for (int kc = 0; kc < 2; ++kc) { pg8::Gemm gt{HID + kc * (DFF / 2), (const bf16_t*)(ws + WS_WD) + kc * (DFF / 2), MTOT, 1024, DFF / 2, DFF}; pg8::TailOrder T{(int)blockIdx.x, 64 * kc};
                    pg8::EpiPart EP{(float*)(ws + WS_MIX + 32 * MiB) + (size_t)kc * NCTX * 1024};
                    pg8::gemm_phase<pg8::EpiPart, pg8::TailOrder, true, true>(lds, gt, T, EP); } }
            else { pg8::EpiRes2<true, true> E{nullptr, nullptr, XS, nullptr, modl + 5120}; pg8::gemm_phase<pg8::EpiRes2<true, true>, pg8::StaticOrder, true, true>(lds, g, S, E); }
        }
        GSYNC();
    }
    final_norm_phase_bf(XS, a.out, a.in[I_FN]);
}

extern "C" void kernel_launch(void* const* d_in, const int* in_sizes, int n_in, void* d_out, int out_size, void* d_ws, size_t ws_size, hipStream_t stream) {
    static int grid_blocks = 0;
    if (grid_blocks == 0) {
        if (n_in != 20 || ws_size < WS_END) { fprintf(stderr, "kernel_launch: unexpected n_in %d / ws_size %zu\n", n_in, ws_size); grid_blocks = -1; return; }
        int dev = 0, cus = 0, per_cu = 0;
        hipGetDevice(&dev);
        hipDeviceGetAttribute(&cus, hipDeviceAttributeMultiprocessorCount, dev);
        if (hipFuncSetAttribute((const void*)fwd_megakernel, hipFuncAttributeMaxDynamicSharedMemorySize, LDS_BYTES) != hipSuccess) { fprintf(stderr, "kernel_launch: hipFuncSetAttribute failed\n"); grid_blocks = -1; return; }
        if (hipOccupancyMaxActiveBlocksPerMultiprocessor(&per_cu, (const void*)fwd_megakernel, 512, LDS_BYTES) != hipSuccess || per_cu < 1) { fprintf(stderr, "kernel_launch: occupancy query failed (%d)\n", per_cu); grid_blocks = -1; return; }
        grid_blocks = cus * per_cu;
    }
    if (grid_blocks < 0) return;
    hipMemsetAsync((char*)d_ws + WS_CTL, 0, 65536, stream);
    Args a{};
    for (int i = 0; i < 20; ++i) a.in[i] = (const float*)d_in[i];
    a.out = (float*)d_out; a.ws = (unsigned char*)d_ws;
    void* args[] = {&a};
    hipError_t e = hipLaunchCooperativeKernel((const void*)fwd_megakernel, dim3(grid_blocks), dim3(512), args, LDS_BYTES, stream);
    if (e != hipSuccess) fprintf(stderr, "cooperative launch failed: %s (grid %d)\n", hipGetErrorString(e), grid_blocks);
}
```

```cpp
#include <hip/hip_runtime.h>
#include <hip/hip_cooperative_groups.h>
#include <hip/hip_bf16.h>
#include <cstdio>
#include <cstdint>
#include <cmath>
namespace cg = cooperative_groups;

constexpr int DMODEL = 1024, NBATCH = 16, TLAT = 2048, TCTX = 256, NLAT = NBATCH * TLAT, NCTX = NBATCH * TCTX, MTOT = NLAT + NCTX;
constexpr int N1 = 2304, DFF = 2816, NGU = 2 * DFF, TKV = TLAT + TCTX, INW = 2064;
constexpr float EPS = 1e-6f;
constexpr size_t MiB = 1u << 20;
constexpr size_t WS_CTL = 0, WS_MOD = 1 * MiB, WS_ROPE = 2 * MiB, WS_W1 = 4 * MiB, WS_WO = 13 * MiB, WS_WGU = 17 * MiB, WS_WD = 39 * MiB,
                 WS_XC = 50 * MiB, WS_XN = 66 * MiB, WS_QB = 138 * MiB, WS_KB = 174 * MiB, WS_VB = 183 * MiB, WS_MLB = 192 * MiB, WS_PZ = 264 * MiB,
                 WS_GT = 282 * MiB, WS_HS = 285 * MiB, WS_MIX = 321 * MiB, WS_HID = 138 * MiB, WS_HS1 = 393 * MiB, WS_XS = 429 * MiB, WS_END = 501 * MiB;
constexpr size_t W1_BYTES = (size_t)N1 * 1024 * 2, WO_BYTES = (size_t)1024 * 1024 * 2, WGU_BYTES = (size_t)NGU * 1024 * 2, WD_BYTES = (size_t)1024 * DFF * 2;

#define LAS __attribute__((address_space(3)))
typedef unsigned short bf16_t;
typedef float f32x4 __attribute__((ext_vector_type(4)));
typedef unsigned u32x4 __attribute__((ext_vector_type(4)));
typedef short bf16x8 __attribute__((ext_vector_type(8)));

__device__ __forceinline__ unsigned f2bf(float f) { unsigned u = __builtin_bit_cast(unsigned, f); return (u + 0x7fffu + ((u >> 16) & 1u)) >> 16; }
typedef float f32x2_hw __attribute__((ext_vector_type(2))); typedef __bf16 bf16x2_hw __attribute__((ext_vector_type(2)));
__device__ __forceinline__ unsigned pk2(float lo, float hi) { f32x2_hw v = {lo, hi}; bf16x2_hw b = __builtin_convertvector(v, bf16x2_hw); return __builtin_bit_cast(unsigned, b); }
__device__ __forceinline__ unsigned f2bf_hw(float f) { return pk2(f, 0.f) & 0xffffu; }
__device__ __forceinline__ float bf2f(unsigned v) { return __builtin_bit_cast(float, v << 16); }
__device__ __forceinline__ float silu_f(float x) { return x * __builtin_amdgcn_rcpf(1.0f + __expf(-x)); }
__device__ __forceinline__ float sigmoid_f(float x) { return __builtin_amdgcn_rcpf(1.0f + __expf(-x)); }
__device__ __forceinline__ float wave_sum(float v) {
#pragma unroll
    for (int o = 1; o < 64; o <<= 1) v += __shfl_xor(v, o);
    return v;
}
__device__ __forceinline__ int opaque_tid() { int t = threadIdx.x; asm volatile("" : "+v"(t)); return t; }
namespace pg8 {
#define PG8_LAS __attribute__((address_space(3)))
typedef unsigned short bf16_t;
typedef short bf16x8 __attribute__((ext_vector_type(8)));
typedef float f32x4 __attribute__((ext_vector_type(4)));
typedef unsigned u32x4 __attribute__((ext_vector_type(4)));
constexpr int BM = 256, BK = 64, HALF = 128, HTB = HALF * BK * 2  , STAGE_BYTES = 8 * HTB, NXCD = 8, WGM = 8;

__host__ __device__ __forceinline__ int lds_byte(int r, int c) { const int st = (r >> 4) * 2 + (c >> 5), rr = r & 15, cc = c & 31, ob = rr * 64 + cc * 2; return st * 1024 + (ob ^ (((ob >> 9) & 1) << 5)); }
__host__ __device__ __forceinline__ void stage_rc(int b, int& R, int& C) { const int st = b / 1024, sb = b % 1024, swz = sb ^ (((sb >> 9) & 1) << 5); R = (st >> 1) * 16 + swz / 64; C = (st & 1) * 32 + (swz % 64) / 2; }
__host__ __device__ __forceinline__ int perm32(int rho) { const int n = rho >> 4, i = rho & 15; return 8 * (i >> 2) + 4 * n + (i & 3); }

struct Unit { int pm, pn; };
struct Gemm { const bf16_t* A; const bf16_t* Bt; int M, N, K; int ld; };

struct StaticOrder {
    int nM, nN, nwg, G, c;
    __host__ __device__ void init(int M, int N, int G_, int c_) { nM = M / BM; nN = N / BM; nwg = nM * nN; G = G_; c = c_; }
    __host__ __device__ bool next(int i, Unit& u) const {
        const long L = (long)i * G + c; if (L >= nwg) return false;
        int wgid = (int)L; { const int q = nwg / NXCD, r = nwg % NXCD, xcd = wgid % NXCD, off = wgid / NXCD; wgid = (xcd < r ? xcd * (q + 1) : r * (q + 1) + (xcd - r) * q) + off; }
        const int nig = WGM * nN, gid = wgid / nig, fm = gid * WGM, gsz = (nM - fm) < WGM ? (nM - fm) : WGM;
        u.pm = fm + ((wgid % nig) % gsz); u.pn = (wgid % nig) / gsz; return true;
    }
    __device__ __forceinline__ void a_ready(const Unit&) const {}
    __device__ __forceinline__ void done(const Unit&) const {}
};

__device__ __forceinline__ unsigned cvt_pk_bf16(float lo, float hi) { unsigned r; asm volatile("v_cvt_pk_bf16_f32 %0, %1, %2" : "=v"(r) : "v"(lo), "v"(hi)); return r; }
typedef float f32x2 __attribute__((ext_vector_type(2)));
struct G1Order {
    StaticOrder so; int G, c, next_n, npn; int pl0, pl1, pl2, pl3, pl4, pl5, pl6, pl7;
    __device__ void init(int G_, int c_, bool layer0) { so.init(NLAT, N1, G_, c_); G = G_; c = c_;
        if (layer0) { npn = 8; pl0 = 0; pl1 = 1; pl2 = 2; pl3 = 3; pl4 = 4; pl5 = 5; pl6 = 6; pl7 = 7; }
        else { npn = 5; pl0 = 2; pl1 = 3; pl2 = 4; pl3 = 5; pl4 = 8; pl5 = 0; pl6 = 0; pl7 = 0; }
        next_n = 16 * npn; }
    __device__ bool next(int i, Unit& u) const {
        const int L = i * G + c;
        if (L < so.nwg) return so.next(i, u);
        const int e = L - so.nwg; if (e >= next_n) return false;
        const int d = (npn == 8) ? (e >> 3) : ((e * 52429) >> 18); const int q = e - d * npn; u.pm = 128 + d;
        u.pn = (q == 0) ? pl0 : (q == 1) ? pl1 : (q == 2) ? pl2 : (q == 3) ? pl3 : (q == 4) ? pl4 : (q == 5) ? pl5 : (q == 6) ? pl6 : pl7; return true; }
    __device__ __forceinline__ void a_ready(const Unit&) const {}
    __device__ __forceinline__ void done(const Unit&) const {}
};
struct EpiIn {
    static constexpr bool PERM = true, AFTER_DRAIN = false;
    bf16_t *QB, *KB, *VB, *MLB, *PZ; float* GT;
    const float *qn, *kn, *bg; const __attribute__((address_space(3))) float* CS;
    float c2;
    __device__ __forceinline__ void operator()(const f32x4 (&acc)[2][2][4][2], const Unit& u, int wr, int wc, int fr, int fq) const {
        const int pn = u.pn, pm = u.pm;
        const bool lat = pm < 128;
        const int rt0 = wr * 64 + fr;
        const size_t grow0 = (size_t)pm * 256 + rt0;
        const size_t kv0 = lat ? ((size_t)(pm >> 3) * TKV + (size_t)(pm & 7) * 256 + rt0) : ((size_t)(pm - 128) * TKV + TLAT + rt0);
        if (pn < 2 || (pn == 2 && wc < 2)) {
            const bool isq = pn < 2;
            const float* nw = isq ? qn : kn;
            f32x4 wv[2][2];
#pragma unroll
            for (int bj = 0; bj < 2; ++bj)
#pragma unroll
                for (int n = 0; n < 2; ++n) wv[bj][n] = *(const f32x4*)(nw + 32 * bj + 8 * fq + 4 * n);
            const float sgn = (fq < 2) ? -1.f : 1.f;
            const float osc = isq ? c2 : 1.f;
#pragma unroll
            for (int ai = 0; ai < 2; ++ai)
#pragma unroll
                for (int m = 0; m < 4; ++m) {
                    float ss = 0.f;
#pragma unroll
                    for (int bj = 0; bj < 2; ++bj)
#pragma unroll
                        for (int n = 0; n < 2; ++n) { const f32x4 v = acc[ai][bj][m][n]; ss += (v[0] * v[0] + v[1] * v[1]) + (v[2] * v[2] + v[3] * v[3]); }
                    ss += __shfl_xor(ss, 16); ss += __shfl_xor(ss, 32);
                    const float rstd = rsqrtf(ss * (1.0f / 64.0f) + EPS);
                    const int roff = ai * 128 + m * 16;
#pragma unroll
                    for (int bj = 0; bj < 2; ++bj) {
                        f32x4 y[2];
#pragma unroll
                        for (int n = 0; n < 2; ++n) y[n] = acc[ai][bj][m][n] * rstd * wv[bj][n];
                        if (lat) {
                            const int pos = (bj == 0) ? ((pm & 7) * 4 + 2 * ai + wr) : (m * 16 + fr);
                            const __attribute__((address_space(3))) float* cs = CS + pos * 32 + 16 * (fq & 1);
#pragma unroll
                            for (int n = 0; n < 2; ++n) {
                                const f32x4 t0 = *(const __attribute__((address_space(3))) f32x4*)(cs + 8 * n), t1 = *(const __attribute__((address_space(3))) f32x4*)(cs + 8 * n + 4);
                                f32x4 p;
                                p[0] = __shfl_xor(y[n][0], 32); p[1] = __shfl_xor(y[n][1], 32); p[2] = __shfl_xor(y[n][2], 32); p[3] = __shfl_xor(y[n][3], 32);
                                f32x4 o;
                                o[0] = y[n][0] * t0[0] + sgn * p[0] * t0[1];
                                o[1] = y[n][1] * t0[2] + sgn * p[1] * t0[3];
                                o[2] = y[n][2] * t1[0] + sgn * p[2] * t1[1];
                                o[3] = y[n][3] * t1[2] + sgn * p[3] * t1[3];
                                y[n] = o;
                            }
                        }
                        u32x4 w;
                        w.x = cvt_pk_bf16(y[0][0] * osc, y[0][1] * osc); w.y = cvt_pk_bf16(y[0][2] * osc, y[0][3] * osc);
                        w.z = cvt_pk_bf16(y[1][0] * osc, y[1][1] * osc); w.w = cvt_pk_bf16(y[1][2] * osc, y[1][3] * osc);
                        bf16_t* dst = isq ? (QB + (grow0 + roff) * 512 + (4 * pn + wc) * 64 + 32 * bj + 8 * fq)
                                          : (KB + (kv0 + roff) * 128 + wc * 64 + 32 * bj + 8 * fq);
                        *(u32x4*)dst = w;
                    }
                    asm volatile("" ::: "memory");
                }
        } else if (pn <= 7) {
            bf16_t* base; size_t ld; size_t r0; int cb; float sc = 1.f;
            if (pn == 2) { base = VB; ld = 128; r0 = kv0; cb = (wc - 2) * 64; }
            else if (pn == 7) { base = PZ; ld = 256; r0 = grow0; cb = wc * 64; }
            else { base = MLB; ld = 1024; r0 = grow0; cb = (pn - 3) * 256 + wc * 64; if (pn == 4) sc = 0.125f; }
#pragma unroll
            for (int ai = 0; ai < 2; ++ai)
#pragma unroll
                for (int m = 0; m < 4; ++m)
#pragma unroll
                    for (int bj = 0; bj < 2; ++bj) {
                        const f32x4 v0 = acc[ai][bj][m][0] * sc, v1 = acc[ai][bj][m][1] * sc;
                        u32x4 w; w.x = cvt_pk_bf16(v0[0], v0[1]); w.y = cvt_pk_bf16(v0[2], v0[3]); w.z = cvt_pk_bf16(v1[0], v1[1]); w.w = cvt_pk_bf16(v1[2], v1[3]);
                        *(u32x4*)(base + (r0 + ai * 128 + m * 16) * ld + cb + 32 * bj + 8 * fq) = w;
                    }
        } else {
            if (wc == 0 && fq < 2) {
                const f32x4 b0 = *(const f32x4*)(bg + 8 * fq), b1 = *(const f32x4*)(bg + 8 * fq + 4);
#pragma unroll
                for (int ai = 0; ai < 2; ++ai)
#pragma unroll
                    for (int m = 0; m < 4; ++m) {
                        float* g = GT + (grow0 + ai * 128 + m * 16) * 16 + 8 * fq;
                        *(f32x4*)g = acc[ai][0][m][0] + b0; *(f32x4*)(g + 4) = acc[ai][0][m][1] + b1;
                    }
            }
        }
    }
};
struct EpiRes {
    static constexpr bool PERM = false, AFTER_DRAIN = false;
    const float *base_l, *base_c; float *out_l, *out_c; const float* gate;
    __device__ __forceinline__ void operator()(const f32x4 (&acc)[2][2][4][2], const Unit& u, int wr, int wc, int fr, int fq) const {
        const int pn = u.pn, pm = u.pm; const bool lat = pm < 128;
        const float* gv = gate + (size_t)(lat ? (pm >> 3) : 16) * 6144;
        const float* bp = lat ? base_l + (size_t)pm * 256 * 1024 : base_c + (size_t)(pm - 128) * 256 * 1024;
        float* op = lat ? out_l + (size_t)pm * 256 * 1024 : out_c + (size_t)(pm - 128) * 256 * 1024;
        const int col0 = pn * BM + wc * 32 + 4 * fq;
        f32x4 g4[2][2];
#pragma unroll
        for (int bj = 0; bj < 2; ++bj)
#pragma unroll
            for (int n = 0; n < 2; ++n) g4[bj][n] = *(const f32x4*)(gv + col0 + bj * HALF + n * 16);
#pragma unroll
        for (int ai = 0; ai < 2; ++ai)
#pragma unroll
            for (int m = 0; m < 4; ++m) { const size_t off = (size_t)(ai * HALF + wr * 64 + m * 16 + fr) * 1024 + col0;
#pragma unroll
                for (int bj = 0; bj < 2; ++bj)
#pragma unroll
                    for (int n = 0; n < 2; ++n) { const f32x4 x = *(const f32x4*)(bp + off + bj * HALF + n * 16); *(f32x4*)(op + off + bj * HALF + n * 16) = x + g4[bj][n] * acc[ai][bj][m][n]; }
                if (m & 1) asm volatile("" ::: "memory"); }
    }
};
struct EpiGU {
    static constexpr bool PERM = true, AFTER_DRAIN = false;
    bf16_t* H;
    __device__ __forceinline__ void operator()(const f32x4 (&acc)[2][2][4][2], const Unit& u, int wr, int wc, int fr, int fq) const {
        const size_t row0 = (size_t)u.pm * BM + wr * 64 + fr; const int col0 = u.pn * 128 + wc * 32 + 8 * fq;
#pragma unroll
        for (int ai = 0; ai < 2; ++ai)
#pragma unroll
            for (int m = 0; m < 4; ++m) {
                f32x4 v[2];
#pragma unroll
                for (int n = 0; n < 2; ++n) { const f32x4 g = acc[ai][0][m][n], up = acc[ai][1][m][n];
                    v[n][0] = g[0] * __builtin_amdgcn_rcpf(1.0f + __expf(-g[0])) * up[0]; v[n][1] = g[1] * __builtin_amdgcn_rcpf(1.0f + __expf(-g[1])) * up[1];
                    v[n][2] = g[2] * __builtin_amdgcn_rcpf(1.0f + __expf(-g[2])) * up[2]; v[n][3] = g[3] * __builtin_amdgcn_rcpf(1.0f + __expf(-g[3])) * up[3]; }
                u32x4 w; w.x = cvt_pk_bf16(v[0][0], v[0][1]); w.y = cvt_pk_bf16(v[0][2], v[0][3]); w.z = cvt_pk_bf16(v[1][0], v[1][1]); w.w = cvt_pk_bf16(v[1][2], v[1][3]);
                __builtin_nontemporal_store(w, (u32x4*)(H + (row0 + ai * HALF + m * 16) * DFF + col0));
            }
    }
};
template <bool IN_BF16, bool OUT_BF16> struct EpiRes2 {
    static constexpr bool PERM = true, AFTER_DRAIN = false;
    const float *bl, *bc; bf16_t* xs; float* ol; const float* gate;
    __device__ __forceinline__ void operator()(const f32x4 (&acc)[2][2][4][2], const Unit& u, int wr, int wc, int fr, int fq) const {
        const int pn = u.pn, pm = u.pm; const bool lat = pm < 128;
        const float* gv = gate + (size_t)(lat ? (pm >> 3) : 16) * 6144;
        const int col0 = pn * BM + wc * 32 + 8 * fq;
        const size_t row0 = (size_t)pm * BM + wr * 64 + fr;
        const float* bf = lat ? bl + row0 * 1024 : bc + (row0 - NLAT) * 1024;
        f32x4 g4[2][2];
#pragma unroll
        for (int bj = 0; bj < 2; ++bj)
#pragma unroll
            for (int n = 0; n < 2; ++n) g4[bj][n] = *(const f32x4*)(gv + col0 + bj * HALF + 4 * n);
#pragma unroll
        for (int ai = 0; ai < 2; ++ai)
#pragma unroll
            for (int m = 0; m < 4; ++m) { const size_t ro = (size_t)(ai * HALF + m * 16) * 1024;
#pragma unroll
                for (int bj = 0; bj < 2; ++bj) { const int c = col0 + bj * HALF;
                    f32x4 x0, x1;
                    if (IN_BF16) { const u32x4 v = *(const u32x4*)(xs + row0 * 1024 + ro + c);
                        x0 = (f32x4){__builtin_bit_cast(float, v.x << 16), __builtin_bit_cast(float, v.x & 0xffff0000u), __builtin_bit_cast(float, v.y << 16), __builtin_bit_cast(float, v.y & 0xffff0000u)};
                        x1 = (f32x4){__builtin_bit_cast(float, v.z << 16), __builtin_bit_cast(float, v.z & 0xffff0000u), __builtin_bit_cast(float, v.w << 16), __builtin_bit_cast(float, v.w & 0xffff0000u)}; }
                    else { x0 = *(const f32x4*)(bf + ro + c); x1 = *(const f32x4*)(bf + ro + c + 4); }
                    x0 = x0 + g4[bj][0] * acc[ai][bj][m][0]; x1 = x1 + g4[bj][1] * acc[ai][bj][m][1];
                    if (OUT_BF16) { u32x4 w; w.x = cvt_pk_bf16(x0[0], x0[1]); w.y = cvt_pk_bf16(x0[2], x0[3]); w.z = cvt_pk_bf16(x1[0], x1[1]); w.w = cvt_pk_bf16(x1[2], x1[3]);
                        *(u32x4*)(xs + row0 * 1024 + ro + c) = w; }
                    else { *(f32x4*)(ol + row0 * 1024 + ro + c) = x0; *(f32x4*)(ol + row0 * 1024 + ro + c + 4) = x1; } }
                if (IN_BF16 ? (m == 3) : (m & 1)) asm volatile("" ::: "memory"); }
    }
};
struct TailOrder {
    int c, c0;
    __device__ bool next(int i, Unit& u) const { const int e = c - c0; if (i != 0 || e < 0 || e >= 64) return false; u.pn = e & 3; u.pm = 128 + (e >> 2); return true; }
    __device__ __forceinline__ void a_ready(const Unit&) const {}
    __device__ __forceinline__ void done(const Unit&) const {}
};
struct EpiPart {
    static constexpr bool PERM = true, AFTER_DRAIN = false;
    float* P;
    __device__ __forceinline__ void operator()(const f32x4 (&acc)[2][2][4][2], const Unit& u, int wr, int wc, int fr, int fq) const {
        float* op = P + ((size_t)(u.pm - 128) * BM + wr * 64 + fr) * 1024 + u.pn * BM + wc * 32 + 8 * fq;
#pragma unroll
        for (int ai = 0; ai < 2; ++ai)
#pragma unroll
            for (int m = 0; m < 4; ++m)
#pragma unroll
                for (int bj = 0; bj < 2; ++bj) { float* o = op + (size_t)(ai * HALF + m * 16) * 1024 + bj * HALF; *(f32x4*)o = acc[ai][bj][m][0]; *(f32x4*)(o + 4) = acc[ai][bj][m][1]; }
    }
};
template <class Epi, class Sched, bool ALIGN_EPI = false, bool SP2 = false>
__device__ __forceinline__ void gemm_phase(PG8_LAS unsigned char* lds, const Gemm g, const Sched& S, const Epi& E) {
    const int tid = opaque_tid(), wid = __builtin_amdgcn_readfirstlane(tid >> 6), lane = tid & 63, wr = wid >> 2, wc = wid & 3, fr = lane & 15, fq = lane >> 4;
    const int K = g.ld ? g.ld : g.K, nt = g.K / BK;
    unsigned voffA[2], voffB[2];
#pragma unroll
    for (int i = 0; i < 2; ++i) { int R, C; stage_rc(tid * 16 + i * 8192, R, C); const int Rb = Epi::PERM ? ((R & ~31) + perm32(R & 31)) : R;
        voffA[i] = (unsigned)(R * K + C) * 2u; voffB[i] = (unsigned)(Rb * K + C) * 2u; }
    const size_t kstep = (size_t)(BK * 2);
    const size_t hstep = (size_t)HALF * K * 2;
    const size_t tstep = 2 * hstep;
    const unsigned ldsw = (unsigned)wid * 1024u;
    const int aoff = lds_byte(wr * 64 + fr, fq * 8), boff = lds_byte(wc * 32 + fr, fq * 8);
#define PG8_SA(b, h) (((b) * 2 + (h)) * HTB)
#define PG8_SB(b, h) ((4 + (b) * 2 + (h)) * HTB)
#define PG8_STAGE(bufoff, gbase, voff) do { _Pragma("unroll") for (int _i = 0; _i < 2; ++_i) \
        __builtin_amdgcn_global_load_lds((const unsigned*)((const char*)(gbase) + (voff)[_i]), (PG8_LAS unsigned*)(lds + (bufoff) + ldsw + _i * 8192), 16, 0, 0); } while (0)
#define PG8_LDA(dst, b, h) do { _Pragma("unroll") for (int m = 0; m < 4; ++m) _Pragma("unroll") for (int k = 0; k < 2; ++k) dst[m][k] = *(const PG8_LAS bf16x8*)(lds + PG8_SA(b, h) + aoff + m * 2048 + k * 1024); } while (0)
#define PG8_LDB(dst, b, h) do { _Pragma("unroll") for (int n = 0; n < 2; ++n) _Pragma("unroll") for (int k = 0; k < 2; ++k) dst[n][k] = *(const PG8_LAS bf16x8*)(lds + PG8_SB(b, h) + boff + n * 2048 + k * 1024); } while (0)
#define PG8_MMA(ai, bj, At, Bt) do { __builtin_amdgcn_s_setprio(1); _Pragma("unroll") for (int m = 0; m < 4; ++m) _Pragma("unroll") for (int n = 0; n < 2; ++n) _Pragma("unroll") for (int k = 0; k < 2; ++k) \
        acc[ai][bj][m][n] = __builtin_amdgcn_mfma_f32_16x16x32_bf16(Bt[n][k], At[m][k], acc[ai][bj][m][n], 0, 0, 0); __builtin_amdgcn_s_setprio(0); } while (0)
#define PG8_WAIT_V(n) asm volatile("s_waitcnt vmcnt(" #n ")" ::: "memory")
#define PG8_WAIT_L(n) asm volatile("s_waitcnt lgkmcnt(" #n ")" ::: "memory")
#define PG8_BAR __builtin_amdgcn_s_barrier()
#define PG8_SCHED __builtin_amdgcn_sched_barrier(0)
    Unit cur, nxt; int ui = 0;
    if (!S.next(0, cur)) return;
    f32x4 acc[2][2][4][2];
#pragma unroll
    for (int a = 0; a < 2; ++a)
#pragma unroll
        for (int b = 0; b < 2; ++b)
#pragma unroll
            for (int m = 0; m < 4; ++m)
#pragma unroll
                for (int n = 0; n < 2; ++n) acc[a][b][m][n] = (f32x4){0.f, 0.f, 0.f, 0.f};
    bf16x8 At[4][2], B0[2][2], B1[2][2];
    const char* cA = (const char*)g.A + (size_t)cur.pm * tstep; const char* cB = (const char*)g.Bt + (size_t)cur.pn * tstep;
    S.a_ready(cur);
    if constexpr (SP2) {
        PG8_STAGE(PG8_SB(0, 0), cB, voffB); PG8_STAGE(PG8_SB(0, 1), cB + hstep, voffB); PG8_STAGE(PG8_SA(0, 0), cA, voffA); PG8_STAGE(PG8_SA(0, 1), cA + hstep, voffA);
        if (wr == 1) PG8_BAR;
        PG8_WAIT_V(2); PG8_BAR;
        PG8_STAGE(PG8_SB(1, 0), cB + kstep, voffB); PG8_STAGE(PG8_SA(1, 0), cA + kstep, voffA); PG8_STAGE(PG8_SB(1, 1), cB + hstep + kstep, voffB);
        PG8_WAIT_V(6); PG8_BAR;
    } else {
        PG8_STAGE(PG8_SB(0, 0), cB, voffB); PG8_STAGE(PG8_SA(0, 0), cA, voffA); PG8_STAGE(PG8_SB(0, 1), cB + hstep, voffB); PG8_STAGE(PG8_SA(0, 1), cA + hstep, voffA);
        if (wr == 1) PG8_BAR;
        PG8_WAIT_V(4); PG8_BAR;
        PG8_STAGE(PG8_SB(1, 0), cB + kstep, voffB); PG8_STAGE(PG8_SA(1, 0), cA + kstep, voffA); PG8_STAGE(PG8_SB(1, 1), cB + hstep + kstep, voffB);
        PG8_WAIT_V(6); PG8_BAR;
    }
    for (;;) {
        const bool has_next = S.next(ui + 1, nxt);
        const char* nA = has_next ? (const char*)g.A + (size_t)nxt.pm * tstep : cA; const char* nB = has_next ? (const char*)g.Bt + (size_t)nxt.pn * tstep : cB;
        for (int t = 0; t < nt; t += 2) {
            const bool last = (t == nt - 2);
            const char* a1 = cA + (size_t)(t + 1) * kstep;
            const char* a2 = last ? nA : cA + (size_t)(t + 2) * kstep; const char* b2 = last ? nB : cB + (size_t)(t + 2) * kstep;
            const char* a3 = a2 + kstep; const char* b3 = b2 + kstep;
            if (last && has_next) S.a_ready(nxt);
            if constexpr (SP2) {
            PG8_LDB(B0, 0, 0); PG8_LDB(B1, 0, 1); PG8_SCHED; PG8_LDA(At, 0, 0); PG8_STAGE(PG8_SA(1, 1), a1 + hstep, voffA);
            PG8_WAIT_V(8); PG8_WAIT_L(0); PG8_BAR; PG8_MMA(0, 0, At, B0); PG8_MMA(0, 1, At, B1); PG8_BAR; PG8_SCHED;
            PG8_LDA(At, 0, 1); PG8_STAGE(PG8_SB(0, 0), b2, voffB); PG8_STAGE(PG8_SB(0, 1), b2 + hstep, voffB); PG8_STAGE(PG8_SA(0, 0), a2, voffA);
            PG8_WAIT_V(8); PG8_WAIT_L(0); PG8_BAR; PG8_MMA(1, 0, At, B0); PG8_MMA(1, 1, At, B1); PG8_BAR; PG8_SCHED;
            PG8_LDB(B0, 1, 0); PG8_LDB(B1, 1, 1); PG8_SCHED; PG8_LDA(At, 1, 0); PG8_STAGE(PG8_SA(0, 1), a2 + hstep, voffA);
            PG8_WAIT_V(8); PG8_WAIT_L(0); PG8_BAR; PG8_MMA(0, 0, At, B0); PG8_MMA(0, 1, At, B1); PG8_BAR; PG8_SCHED;
            PG8_LDA(At, 1, 1); PG8_STAGE(PG8_SB(1, 0), b3, voffB); PG8_STAGE(PG8_SB(1, 1), b3 + hstep, voffB); PG8_STAGE(PG8_SA(1, 0), a3, voffA);
            PG8_WAIT_V(8); PG8_WAIT_L(0); PG8_BAR; PG8_MMA(1, 0, At, B0); PG8_MMA(1, 1, At, B1); PG8_BAR; PG8_SCHED;
            } else {
            PG8_LDB(B0, 0, 0); PG8_SCHED; PG8_LDA(At, 0, 0); PG8_STAGE(PG8_SA(1, 1), a1 + hstep, voffA);
            PG8_WAIT_L(8); PG8_BAR; PG8_WAIT_L(0); PG8_MMA(0, 0, At, B0); PG8_BAR; PG8_SCHED;
            PG8_LDB(B1, 0, 1); PG8_STAGE(PG8_SB(0, 0), b2, voffB);
            PG8_BAR; PG8_WAIT_L(0); PG8_MMA(0, 1, At, B1); PG8_BAR;
            PG8_LDA(At, 0, 1); PG8_STAGE(PG8_SA(0, 0), a2, voffA);
            PG8_BAR; PG8_WAIT_L(0); PG8_MMA(1, 0, At, B0); PG8_BAR; PG8_SCHED;
            PG8_STAGE(PG8_SB(0, 1), b2 + hstep, voffB);
            PG8_WAIT_V(6); PG8_BAR; PG8_MMA(1, 1, At, B1); PG8_BAR;
            PG8_LDB(B0, 1, 0); PG8_SCHED; PG8_LDA(At, 1, 0); PG8_STAGE(PG8_SA(0, 1), a2 + hstep, voffA);
            PG8_WAIT_L(8); PG8_BAR; PG8_WAIT_L(0); PG8_MMA(0, 0, At, B0); PG8_BAR; PG8_SCHED;
            PG8_LDB(B1, 1, 1); PG8_STAGE(PG8_SB(1, 0), b3, voffB);
            PG8_BAR; PG8_WAIT_L(0); PG8_MMA(0, 1, At, B1); PG8_BAR;
            PG8_LDA(At, 1, 1); PG8_STAGE(PG8_SA(1, 0), a3, voffA);
            PG8_BAR; PG8_WAIT_L(0); PG8_MMA(1, 0, At, B0); PG8_BAR; PG8_SCHED;
            PG8_STAGE(PG8_SB(1, 1), b3 + hstep, voffB);
            PG8_WAIT_V(6); PG8_BAR; PG8_MMA(1, 1, At, B1); PG8_BAR;
            }
        }
        if constexpr (ALIGN_EPI) { if (wr == 0) PG8_BAR; }
        if constexpr (!Epi::AFTER_DRAIN) { E(acc, cur, wr, wc, fr, fq); S.done(cur); }
        if (!has_next) break;
#pragma unroll
        for (int a = 0; a < 2; ++a)
#pragma unroll
            for (int b = 0; b < 2; ++b)
#pragma unroll
                for (int m = 0; m < 4; ++m)
#pragma unroll
                    for (int n = 0; n < 2; ++n) acc[a][b][m][n] = (f32x4){0.f, 0.f, 0.f, 0.f};
        cur = nxt; cA = nA; cB = nB; ++ui;
        if constexpr (ALIGN_EPI) { if (wr == 1) PG8_BAR; }
    }
    PG8_WAIT_V(0);
    if constexpr (!ALIGN_EPI) { if (wr == 0) PG8_BAR; }
    PG8_BAR;
    if constexpr (Epi::AFTER_DRAIN) { E.fused(acc, cur, wr, wc, fr, fq, lds, wid, lane); S.done(cur); }
#undef PG8_SA
#undef PG8_SB
#undef PG8_STAGE
#undef PG8_LDA
#undef PG8_LDB
#undef PG8_MMA
#undef PG8_WAIT_V
#undef PG8_WAIT_L
#undef PG8_BAR
#undef PG8_SCHED
}
}

namespace attn_body {
using bf16=__hip_bfloat16;
using bf16x8=__attribute__((ext_vector_type(8)))short;
using s16x4=__attribute__((ext_vector_type(4)))short;
using f32x16=__attribute__((ext_vector_type(16)))float;
using u32x4=__attribute__((ext_vector_type(4)))unsigned;
constexpr int D=64,QP=512,KP=128,OP=1024;
constexpr int NW=8,QBLK=32,QB=QBLK*NW,KVBLK=64;
__device__ __forceinline__ int crow(int r,int hi){return (r&3)+8*(r>>2)+4*hi;}
#define SBAR() __builtin_amdgcn_sched_barrier(0)
constexpr int NSLOT=3, SLOTB=8192;
constexpr int LDS_K=0, LDS_V=NSLOT*SLOTB, LDS_WS=2*NSLOT*SLOTB, LDS_OST=LDS_WS+NW*64*4, LDS_BYTES=LDS_OST+NW*4096;
constexpr float C2=0.125f*1.4426950408889634f;
__device__ __forceinline__ void glds16(const void*gsrc,unsigned lds_dst){unsigned keep;
  asm volatile("s_mov_b32 %0, m0\n\ts_mov_b32 m0, %2\n\ts_nop 0\n\tglobal_load_lds_dwordx4 %1, off\n\ts_mov_b32 m0, %0":"=&s"(keep):"v"(gsrc),"s"(lds_dst):"memory");}
__device__ __forceinline__ float max3f(float a,float b,float c){float r;asm("v_max3_f32 %0, %1, %2, %3":"=v"(r):"v"(a),"v"(b),"v"(c));return r;}
__device__ __forceinline__ float max2f(float a,float b){float r;asm("v_max_f32_e32 %0, %1, %2":"=v"(r):"v"(a),"v"(b));return r;}
__device__ __forceinline__ float fadd_s(float a,float b){float r;asm("v_add_f32_e32 %0, %1, %2":"=v"(r):"v"(a),"v"(b));return r;}
__device__ __forceinline__ float fsub_s(float a,float b){float r;asm("v_sub_f32_e32 %0, %1, %2":"=v"(r):"v"(a),"v"(b));return r;}
typedef float f32x2_t __attribute__((ext_vector_type(2))); typedef __bf16 bf16x2_t __attribute__((ext_vector_type(2)));
__device__ __forceinline__ unsigned cvtpk_s(float lo,float hi){f32x2_t v={lo,hi};bf16x2_t b=__builtin_convertvector(v,bf16x2_t);return __builtin_bit_cast(unsigned,b);}
#define WAIT_BAR(N) asm volatile("s_waitcnt vmcnt(" #N ") lgkmcnt(0)\n\ts_barrier":::"memory")

__device__ __forceinline__ void qkt(f32x16&p0,f32x16&p1,const char*Kslot,const bf16x8*qr,const f32x16&negm,int r32,int hi){
  const char*kb=Kslot+hi*1024+r32*16;
  #pragma unroll
  for(int d0=0;d0<4;++d0){
    const bf16x8 b0=*reinterpret_cast<const bf16x8*>(kb+d0*2048);
    const bf16x8 b1=*reinterpret_cast<const bf16x8*>(kb+d0*2048+512);
    if(d0==0){p0=__builtin_amdgcn_mfma_f32_32x32x16_bf16(b0,qr[0],negm,0,0,0);p1=__builtin_amdgcn_mfma_f32_32x32x16_bf16(b1,qr[0],negm,0,0,0);}
    else{p0=__builtin_amdgcn_mfma_f32_32x32x16_bf16(b0,qr[d0],p0,0,0,0);p1=__builtin_amdgcn_mfma_f32_32x32x16_bf16(b1,qr[d0],p1,0,0,0);}}
}
typedef __attribute__((address_space(3))) const char* lds_cptr;
typedef short v4i16_t __attribute__((ext_vector_type(4)));
__device__ __forceinline__ void kload8(bf16x8*kf,lds_cptr kp){
  kf[0]=*(const __attribute__((address_space(3))) bf16x8*)(kp);      kf[1]=*(const __attribute__((address_space(3))) bf16x8*)(kp+512);
  kf[2]=*(const __attribute__((address_space(3))) bf16x8*)(kp+2048); kf[3]=*(const __attribute__((address_space(3))) bf16x8*)(kp+2560);
  kf[4]=*(const __attribute__((address_space(3))) bf16x8*)(kp+4096); kf[5]=*(const __attribute__((address_space(3))) bf16x8*)(kp+4608);
  kf[6]=*(const __attribute__((address_space(3))) bf16x8*)(kp+6144); kf[7]=*(const __attribute__((address_space(3))) bf16x8*)(kp+6656);
}
__device__ __forceinline__ void kload2(bf16x8*kf,lds_cptr kp,int j){ kf[2*j]=*(const __attribute__((address_space(3))) bf16x8*)(kp+j*2048); kf[2*j+1]=*(const __attribute__((address_space(3))) bf16x8*)(kp+j*2048+512); }
__device__ __forceinline__ s16x4 vtr(lds_cptr p){ return __builtin_bit_cast(s16x4,__builtin_amdgcn_ds_read_tr16_b64_v4i16((__attribute__((address_space(3))) v4i16_t*)p)); }
__device__ __forceinline__ float rowmax(const f32x16&p0,const f32x16&p1){
  float a=max3f(p0[0],p0[1],p1[0]),b=max3f(p0[2],p0[3],p1[1]);a=max3f(a,p1[2],p1[3]);
  #pragma unroll
  for(int r=4;r<16;r+=4){a=max3f(a,p0[r],p0[r+1]);b=max3f(b,p0[r+2],p0[r+3]);a=max3f(a,p1[r],p1[r+1]);b=max3f(b,p1[r+2],p1[r+3]);}
  const float m=max2f(a,b);
  auto rr=__builtin_amdgcn_permlane32_swap(__float_as_uint(m),__float_as_uint(m),false,false);
  return max2f(__uint_as_float(rr[0]),__uint_as_float(rr[1]));
}
__device__ __forceinline__ void pv(f32x16*o,int vb,bf16x8 pa0,bf16x8 pa1,bf16x8 pa2,bf16x8 pa3){
  #pragma unroll
  for(int d0=0;d0<2;++d0){s16x4 lo[4],hi[4];
    #pragma unroll
    for(int ks=0;ks<4;++ks){
      asm volatile("ds_read_b64_tr_b16 %0,%1 offset:%c2":"=&v"(lo[ks]):"v"(vb),"i"(d0*4096+ks*1024):"memory");
      asm volatile("ds_read_b64_tr_b16 %0,%1 offset:%c2":"=&v"(hi[ks]):"v"(vb),"i"(d0*4096+ks*1024+512):"memory");}
    asm volatile("s_waitcnt lgkmcnt(0)":::"memory");SBAR();
    #define PK(k) (bf16x8){lo[k][0],lo[k][1],lo[k][2],lo[k][3],hi[k][0],hi[k][1],hi[k][2],hi[k][3]}
    o[d0]=__builtin_amdgcn_mfma_f32_32x32x16_bf16(pa0,PK(0),o[d0],0,0,0);
    o[d0]=__builtin_amdgcn_mfma_f32_32x32x16_bf16(pa1,PK(1),o[d0],0,0,0);
    o[d0]=__builtin_amdgcn_mfma_f32_32x32x16_bf16(pa2,PK(2),o[d0],0,0,0);
    o[d0]=__builtin_amdgcn_mfma_f32_32x32x16_bf16(pa3,PK(3),o[d0],0,0,0);
    #undef PK
  }
}

#ifndef ATTN_STORE16
#define ATTN_STORE16(p,v) (*(u32x4*)(p)=(v))
#endif
template<int THRL> __device__ __forceinline__ void attn_unit(const bf16*Q,const bf16*__restrict__ K,const bf16*__restrict__ V,bf16*O,const int NT,char*shm){
  const int tid=opaque_tid(),lane=tid&63,r32=lane&31,hi=lane>>5; const int wid=__builtin_amdgcn_readfirstlane(tid>>6);
  const bf16*Qw=Q+(long)(wid*QBLK)*QP;
  const bf16*Kh=K,*Vh=V;
  const unsigned lds0=(unsigned)(uintptr_t)shm;
  float*wsf=(float*)(shm+LDS_WS)+wid*64;
  const bf16*ksrc=Kh+(long)lane*KP+wid*8;
  const bf16*vsrc=Vh+(long)(16*(wid&3)+(lane>>2))*KP+(wid>>2)*32+(lane&3)*8;
  const unsigned kdst=lds0+LDS_K+wid*1024, vdst=lds0+LDS_V+wid*1024;
  #define DMA_K(t,slot) glds16(ksrc+(long)(t)*KVBLK*KP,(unsigned)__builtin_amdgcn_readfirstlane(kdst+(slot)))
  #define DMA_V(t,slot) glds16(vsrc+(long)(t)*KVBLK*KP,(unsigned)__builtin_amdgcn_readfirstlane(vdst+(slot)))
  const int vb0=(int)(lds0+LDS_V)+((lane>>4)&1)*32+(lane&3)*8+(4*hi+((lane&15)>>2))*64;
  const char*Kbase=shm+LDS_K; bf16x8 kf[8];
  const lds_cptr shm3=(lds_cptr)shm; const lds_cptr kp0=shm3+LDS_K+hi*1024+r32*16; const lds_cptr vp0=shm3+LDS_V+((lane>>4)&1)*32+(lane&3)*8+(4*hi+((lane&15)>>2))*64;
  DMA_K(0,0);DMA_V(0,0);DMA_K(1,SLOTB);
  bf16x8 qr[4];
  #pragma unroll
  for(int d0=0;d0<4;++d0)qr[d0]=*reinterpret_cast<const bf16x8*>(&Qw[(long)r32*QP+d0*16+hi*8]);
  float mhat=0.f,l_reg=0.f;f32x16 o[2];o[0]=f32x16{};o[1]=f32x16{};f32x16 negm=f32x16{};asm volatile("":"+v"(negm));
  #define CMASK(P0,P1,t) do{}while(0)
  bool resc=false;
  #define START(P0,P1) do{ const float rm=rowmax(P0,P1); resc=false; \
    { const float dl=rm; mhat=fadd_s(mhat,dl); \
      _Pragma("unroll") for(int r=0;r<16;++r){P0[r]=fsub_s(P0[r],dl);P1[r]=fsub_s(P1[r],dl);} \
      _Pragma("unroll") for(int r=0;r<16;++r)negm[r]=-mhat; asm volatile("":"+v"(negm)); } \
    _Pragma("unroll") for(int r=0;r<16;++r)P0[r]=__builtin_amdgcn_exp2f(P0[r]); }while(0)
  #define RESC() do{ if(resc){ asm volatile("s_waitcnt lgkmcnt(0)":::"memory"); \
      _Pragma("unroll") for(int d_=0;d_<2;++d_) _Pragma("unroll") for(int r=0;r<16;++r)o[d_][r]*=wsf[crow(r,hi)]; } }while(0)
  f32x16 pA0,pA1,pB0,pB1;
  int sl_prev=0,sl_cur=0,sl_next=SLOTB;
  #define ROT() do{sl_prev=sl_cur;sl_cur=sl_next;sl_next=(sl_next==(NSLOT-1)*SLOTB)?0:sl_next+SLOTB;}while(0)
  DMA_K(2,2*SLOTB);
  WAIT_BAR(3);
  qkt(pA0,pA1,Kbase,qr,negm,r32,hi);asm volatile("s_nop 15\n\ts_nop 7":"+v"(pA0),"+v"(pA1));CMASK(pA0,pA1,0);
  START(pA0,pA1);
  _Pragma("unroll") for(int r=0;r<16;++r)pA1[r]=__builtin_amdgcn_exp2f(pA1[r]);
  WAIT_BAR(0);
  DMA_K(3,0);DMA_V(1,SLOTB);
  ROT();
  kload8(kf,kp0+sl_cur);
  WAIT_BAR(2);
  s16x4 vlo[8],vhi[8]; u32x4 pw0,pw1,pw2,pw3;
  #define PKW(P,B) cvtpk_s(P[B],P[B+1])
  #define PAF(k) __builtin_bit_cast(bf16x8,pw##k)
  #define VFR(i) (bf16x8){vlo[i][0],vlo[i][1],vlo[i][2],vlo[i][3],vhi[i][0],vhi[i][1],vhi[i][2],vhi[i][3]}
  #define PIN(x) asm volatile("":"+v"(x))
  #define MX3(a,b,c) __builtin_fmaxf(__builtin_fmaxf((a),(b)),(c))
  #define GAPA(MF,A0,A1,A2,A3,W0,W1,PW) do{ MF; sacc+=A0; sacc+=A1; sacc+=A2; sacc+=A3; PIN(sacc); W0; W1; PIN(PW); SBAR(); }while(0)
  #define EX(v) __builtin_amdgcn_exp2f(v)
  #define GAPB(MF,X,B) do{ MF; X[B]=EX(X[B]); X[B+1]=EX(X[B+1]); X[B+2]=EX(X[B+2]); X[B+3]=EX(X[B+3]); PIN(X); SBAR(); }while(0)
  #define VRD(i) do{ vlo[i]=vtr(vp_+(((i)>>2)*4096+((i)&3)*1024)); vhi[i]=vtr(vp_+(((i)>>2)*4096+((i)&3)*1024+512)); }while(0)
  #define KRD(G,j) do{ if(G){ kload2(kf,kp0+sl_next,j); SBAR(); } }while(0)
  #define STEP(C0,C1,P0,P1,t,GK,GV,GL) do{ SBAR(); \
    const lds_cptr vp_=vp0+sl_prev; \
    VRD(0); SBAR(); float sacc=(P0[0]+P0[1]); \
    GAPA(C0=__builtin_amdgcn_mfma_f32_32x32x16_bf16(kf[0],qr[0],negm,0,0,0), P0[2],P0[3],P0[4],P0[5],     pw0[0]=PKW(P0,0), pw0[1]=PKW(P0,2), pw0); \
    VRD(4); SBAR(); GAPA(C1=__builtin_amdgcn_mfma_f32_32x32x16_bf16(kf[1],qr[0],negm,0,0,0), P0[6],P0[7],P0[8],P0[9],     pw0[2]=PKW(P0,4), pw0[3]=PKW(P0,6), pw0); \
    VRD(1); SBAR(); GAPA(C0=__builtin_amdgcn_mfma_f32_32x32x16_bf16(kf[2],qr[1],C0,0,0,0),   P0[10],P0[11],P0[12],P0[13], pw1[0]=PKW(P0,8), pw1[1]=PKW(P0,10), pw1); \
    VRD(5); SBAR(); GAPA(C1=__builtin_amdgcn_mfma_f32_32x32x16_bf16(kf[3],qr[1],C1,0,0,0),   P0[14],P0[15],P1[0],P1[1],   pw1[2]=PKW(P0,12),pw1[3]=PKW(P0,14), pw1); \
    VRD(2); SBAR(); GAPA(C0=__builtin_amdgcn_mfma_f32_32x32x16_bf16(kf[4],qr[2],C0,0,0,0),   P1[2],P1[3],P1[4],P1[5],     pw2[0]=PKW(P1,0), pw2[1]=PKW(P1,2), pw2); \
    VRD(6); SBAR(); GAPA(C1=__builtin_amdgcn_mfma_f32_32x32x16_bf16(kf[5],qr[2],C1,0,0,0),   P1[6],P1[7],P1[8],P1[9],     pw2[2]=PKW(P1,4), pw2[3]=PKW(P1,6), pw2); \
    VRD(3); SBAR(); GAPA(C0=__builtin_amdgcn_mfma_f32_32x32x16_bf16(kf[6],qr[3],C0,0,0,0),   P1[10],P1[11],P1[12],P1[13], pw3[0]=PKW(P1,8), pw3[1]=PKW(P1,10), pw3); \
    VRD(7); SBAR(); GAPA(C1=__builtin_amdgcn_mfma_f32_32x32x16_bf16(kf[7],qr[3],C1,0,0,0),   P1[14],P1[15],0.f,0.f,       pw3[2]=PKW(P1,12),pw3[3]=PKW(P1,14), pw3); \
    l_reg+=sacc; \
    if(GK){DMA_K((t)+3,sl_cur);} if(GV){DMA_V((t)+1,sl_next);} \
    CMASK(C0,C1,t); \
    { float a=MX3(C0[0],C0[1],C1[0]),b=MX3(C0[2],C0[3],C1[1]); a=MX3(a,C1[2],C1[3]); \
      _Pragma("unroll") for(int r=4;r<16;r+=4){a=MX3(a,C0[r],C0[r+1]);b=MX3(b,C0[r+2],C0[r+3]);a=MX3(a,C1[r],C1[r+1]);b=MX3(b,C1[r+2],C1[r+3]);} \
      float rm=__builtin_fmaxf(a,b); { auto rr=__builtin_amdgcn_permlane32_swap(__float_as_uint(rm),__float_as_uint(rm),false,false); rm=__builtin_fmaxf(__uint_as_float(rr[0]),__uint_as_float(rr[1])); } \
      resc=false; \
      if(__builtin_expect(__any(rm>(float)THRL),0)){ const float dl=__builtin_fmaxf(rm,0.f); mhat+=dl; \
        _Pragma("unroll") for(int r=0;r<16;++r){C0[r]-=dl;C1[r]-=dl;} \
        _Pragma("unroll") for(int r=0;r<16;++r)negm[r]=-mhat; asm volatile("":"+v"(negm)); \
        const float f=__builtin_amdgcn_exp2f(-dl); l_reg*=f; if(hi==0)wsf[r32]=f; resc=true; } } \
    SBAR(); \
    GAPB(o[0]=__builtin_amdgcn_mfma_f32_32x32x16_bf16(PAF(0),VFR(0),o[0],0,0,0), C0,0); \
    GAPB(o[1]=__builtin_amdgcn_mfma_f32_32x32x16_bf16(PAF(0),VFR(4),o[1],0,0,0), C0,4); \
    KRD(GL,0); GAPB(o[0]=__builtin_amdgcn_mfma_f32_32x32x16_bf16(PAF(1),VFR(1),o[0],0,0,0), C0,8); \
    KRD(GL,1); GAPB(o[1]=__builtin_amdgcn_mfma_f32_32x32x16_bf16(PAF(1),VFR(5),o[1],0,0,0), C0,12); \
    KRD(GL,2); GAPB(o[0]=__builtin_amdgcn_mfma_f32_32x32x16_bf16(PAF(2),VFR(2),o[0],0,0,0), C1,0); \
    KRD(GL,3); GAPB(o[1]=__builtin_amdgcn_mfma_f32_32x32x16_bf16(PAF(2),VFR(6),o[1],0,0,0), C1,4); \
    GAPB(o[0]=__builtin_amdgcn_mfma_f32_32x32x16_bf16(PAF(3),VFR(3),o[0],0,0,0), C1,8); \
    GAPB(o[1]=__builtin_amdgcn_mfma_f32_32x32x16_bf16(PAF(3),VFR(7),o[1],0,0,0), C1,12); \
    }while(0)
  int t=1;
  #undef CMASK
  #define CMASK(P0,P1,t) do{}while(0)
  for(;t+5<NT;t+=2){
    STEP(pB0,pB1,pA0,pA1,t,true,true,true);     WAIT_BAR(2); RESC(); ROT();
    STEP(pA0,pA1,pB0,pB1,t+1,true,true,true);   WAIT_BAR(2); RESC(); ROT();
  }
  #undef CMASK
  #define CMASK(P0,P1,t) do{}while(0)
  #define ENDW(tt) do{ if((tt)+3<NT){WAIT_BAR(2);} else if((tt)+2<NT){WAIT_BAR(1);} else {WAIT_BAR(0);} }while(0)
  for(;t+1<NT;t+=2){
    STEP(pB0,pB1,pA0,pA1,t,(t+3<NT),(t+1<NT),(t+1<NT));       ENDW(t);   RESC(); ROT();
    STEP(pA0,pA1,pB0,pB1,t+1,(t+4<NT),(t+2<NT),(t+2<NT));     ENDW(t+1); RESC(); ROT();
  }
  STEP(pB0,pB1,pA0,pA1,NT-1,false,false,false); RESC();
  { float sacc=pB0[0]+pB0[1]; _Pragma("unroll") for(int r=2;r<16;++r)sacc+=pB0[r]; _Pragma("unroll") for(int r=0;r<16;++r)sacc+=pB1[r]; l_reg+=sacc;
    pw0=(u32x4){PKW(pB0,0),PKW(pB0,2),PKW(pB0,4),PKW(pB0,6)};pw1=(u32x4){PKW(pB0,8),PKW(pB0,10),PKW(pB0,12),PKW(pB0,14)};pw2=(u32x4){PKW(pB1,0),PKW(pB1,2),PKW(pB1,4),PKW(pB1,6)};pw3=(u32x4){PKW(pB1,8),PKW(pB1,10),PKW(pB1,12),PKW(pB1,14)};
    SBAR(); pv(o,vb0+sl_cur,PAF(0),PAF(1),PAF(2),PAF(3)); }
  #undef PKW
  #undef PAF
  #undef VFR
  #undef PIN
  #undef MX3
  #undef GAPA
  #undef GAPB
  #undef EX
  #undef VRD
  #undef KRD
  #undef STEP
  #undef ENDW
  {auto rr=__builtin_amdgcn_permlane32_swap(__float_as_uint(l_reg),__float_as_uint(l_reg),false,false);l_reg=__uint_as_float(rr[0])+__uint_as_float(rr[1]);}
  if(hi==0)wsf[32+r32]=l_reg;asm volatile("s_waitcnt lgkmcnt(0)":::"memory");
  float rli[16];
  #pragma unroll
  for(int r=0;r<16;++r)rli[r]=__builtin_amdgcn_rcpf(wsf[32+crow(r,hi)]);
  bf16*Ow=O+(long)(wid*QBLK)*OP;
  { bf16*stg=(bf16*)(shm+LDS_OST)+wid*2048;
    #pragma unroll
    for(int r=0;r<16;++r){const int orow=crow(r,hi);
      #pragma unroll
      for(int d0=0;d0<2;++d0)stg[orow*64+d0*32+r32]=__float2bfloat16(o[d0][r]*rli[r]);}
    asm volatile("s_waitcnt lgkmcnt(0)":::"memory");
    #pragma unroll
    for(int i=0;i<4;++i){const int row=i*8+(lane>>3),ch=lane&7; const u32x4 v=*(const u32x4*)(stg+row*64+ch*8); ATTN_STORE16(Ow+(long)row*OP+ch*8,v);} }
  asm volatile("s_waitcnt lgkmcnt(0)\n\ts_barrier":::"memory");
  #undef DMA_K
  #undef DMA_V
  #undef CMASK
  #undef START
  #undef RESC
  #undef ROT
}
#undef SBAR
#undef WAIT_BAR
}
namespace ml {
constexpr int QS = 0, KS = QS + 128 * 144, VT = KS + 128 * 144, KT = VT + 80 * 272, SP = KT + 64 * 272, CB = SP + 128 * 272, GA = CB + 80 * 144, GSET = 6 * 512, END = GA + 2 * GSET;
static_assert(END <= 131072, "mlstm lds");
__device__ __forceinline__ float logsig(float x) { return fminf(x, 0.f) - __logf(1.0f + __expf(-fabsf(x))); }
#define MFMA16(a, b, c) __builtin_amdgcn_mfma_f32_16x16x32_bf16(a, b, c, 0, 0, 0)
#define ML_BAR() do { asm volatile("s_waitcnt lgkmcnt(0)" ::: "memory"); __builtin_amdgcn_s_barrier(); asm volatile("" ::: "memory"); } while (0)
#define ML_SCAN(SET, G0, G1, G2, G3) do { \
                LAS float* a_w = (LAS float*)(lds + GA + (SET) * GSET); \
                const float li0 = (G0), lf0 = logsig(G1), li1 = (G2), lf1 = logsig(G3); \
                const float ps = lf0 + lf1; float inc = ps; \
                _Pragma("unroll") for (int o = 1; o < 64; o <<= 1) { const float t = __shfl_up(inc, o); if (lane >= o) inc += t; } \
                const float b0 = (inc - ps) + lf0, b1 = b0 + lf1; \
                const float a0 = li0 - b0, a1 = li1 - b1; \
                float incm = fmaxf(a0, a1); \
                _Pragma("unroll") for (int o = 1; o < 64; o <<= 1) { const float t = __shfl_up(incm, o); if (lane >= o) incm = fmaxf(incm, t); } \
                float excm = __shfl_up(incm, 1); if (lane == 0) excm = -INFINITY; \
                const float cm0 = fmaxf(mcar, fmaxf(excm, a0)), cm1 = fmaxf(mcar, incm); \
                const float blast = __shfl(b1, 63), cmlast = __shfl(cm1, 63); \
                a_w[2 * lane] = a0; a_w[2 * lane + 1] = a1; a_w[128 + 2 * lane] = cm0; a_w[128 + 2 * lane + 1] = cm1; \
                a_w[256 + 2 * lane] = __expf(mcar - cm0); a_w[256 + 2 * lane + 1] = __expf(mcar - cm1); \
                a_w[384 + 2 * lane] = __expf(-(b0 + cm0)); a_w[384 + 2 * lane + 1] = __expf(-(b1 + cm1)); \
                a_w[512 + 2 * lane] = __expf(a0 - cmlast); a_w[512 + 2 * lane + 1] = __expf(a1 - cmlast); \
                if (lane == 0) a_w[640] = __expf(mcar - cmlast); \
                mcar = blast + cmlast; } while (0)

template <int VAR> __device__ __forceinline__ void mlstm_item(int b, int head, int dir, const bf16_t* __restrict__ MLB, const float* __restrict__ GT, bf16_t* HSd, LAS unsigned char* lds) {
    const int tid = opaque_tid(), lane = tid & 63, w = __builtin_amdgcn_readfirstlane(tid >> 6), fr = lane & 15, fq = lane >> 4;
    LAS bf16_t* Qs = (LAS bf16_t*)(lds + QS); LAS bf16_t* Ks = (LAS bf16_t*)(lds + KS); LAS bf16_t* Vt = (LAS bf16_t*)(lds + VT);
    LAS bf16_t* Kt = (LAS bf16_t*)(lds + KT); LAS bf16_t* Sp = (LAS bf16_t*)(lds + SP); LAS bf16_t* Cb = (LAS bf16_t*)(lds + CB);
    const int ntk = w & 3, mt0 = 2 * (w >> 2);
    {
        __syncthreads();
        for (int i = tid; i < 80 * 144 / 4; i += 512) ((LAS unsigned*)Cb)[i] = 0u;
        for (int i = tid; i < 16 * 136 / 2; i += 512) ((LAS unsigned*)(Vt + 64 * 136))[i] = (i < 68) ? 0x3f803f80u : 0u;
        f32x4 accN = (f32x4){0.f, 0.f, 0.f, 0.f};
        f32x4 accC[2]; accC[0] = (f32x4){0.f, 0.f, 0.f, 0.f}; accC[1] = accC[0];
        float mcar = 0.f;
        u32x4 pq[2], pk[2], pv[2];
        size_t rowbase_n;
        {
            const int ci = dir ? 1 : 0; rowbase_n = (size_t)NLAT + (size_t)b * TCTX + ci * 128;
#pragma unroll
            for (int j = 0; j < 2; ++j) { const int i = 2 * (tid & 63) + j, ch = tid >> 6; const bf16_t* src = MLB + (rowbase_n + i) * 1024 + head * 64 + ch * 8;
                pq[j] = *(const u32x4*)src; pk[j] = *(const u32x4*)(src + 256); pv[j] = *(const u32x4*)(src + 512); }
        }
        if (w == 0) { const float* ga_ = GT + (rowbase_n + (dir ? 127 - 2 * lane : 2 * lane)) * 16 + head + 8 * dir; const float* gb_ = GT + (rowbase_n + (dir ? 126 - 2 * lane : 2 * lane + 1)) * 16 + head + 8 * dir; const float g0_ = ga_[0], g1_ = ga_[4], g2_ = gb_[0], g3_ = gb_[4]; ML_SCAN(0, g0_, g1_, g2_, g3_); }
        for (int cc = 0; cc < 18; ++cc) {
            const size_t rowbase = rowbase_n;
            LAS float* a_s = (LAS float*)(lds + GA + (cc & 1) * GSET); LAS float* cm_s = a_s + 128; LAS float* wi_s = a_s + 256; LAS float* emt_s = a_s + 384; LAS float* wk_s = a_s + 512; LAS float* sc_s = a_s + 640;
            ML_BAR();
            {
                const int i0 = 2 * (tid & 63), ch = tid >> 6, ipa = dir ? 127 - i0 : i0, ipb = dir ? 126 - i0 : i0 + 1, ipe = dir ? 126 - i0 : i0;
                *(LAS u32x4*)(Qs + ipa * 72 + ch * 8) = pq[0]; *(LAS u32x4*)(Qs + ipb * 72 + ch * 8) = pq[1];
                *(LAS u32x4*)(Ks + ipa * 72 + ch * 8) = pk[0]; *(LAS u32x4*)(Ks + ipb * 72 + ch * 8) = pk[1];
                const unsigned ka[4] = {pk[0].x, pk[0].y, pk[0].z, pk[0].w}, kb[4] = {pk[1].x, pk[1].y, pk[1].z, pk[1].w}, va[4] = {pv[0].x, pv[0].y, pv[0].z, pv[0].w}, vb[4] = {pv[1].x, pv[1].y, pv[1].z, pv[1].w};
                const float wkl = wk_s[ipe], wkh = wk_s[ipe + 1];
#pragma unroll
                for (int e2 = 0; e2 < 4; ++e2) { if (VAR & 8) continue;
                    const unsigned kl0 = dir ? kb[e2] : ka[e2], kh0 = dir ? ka[e2] : kb[e2], vl0 = dir ? vb[e2] : va[e2], vh0 = dir ? va[e2] : vb[e2];
                    *(LAS unsigned*)(Kt + (ch * 8 + 2 * e2) * 136 + ipe) = pk2(bf2f(kl0 & 0xffffu) * wkl, bf2f(kh0 & 0xffffu) * wkh);
                    *(LAS unsigned*)(Kt + (ch * 8 + 2 * e2 + 1) * 136 + ipe) = pk2(bf2f(kl0 >> 16) * wkl, bf2f(kh0 >> 16) * wkh);
                    *(LAS unsigned*)(Vt + (ch * 8 + 2 * e2) * 136 + ipe) = (vl0 & 0xffffu) | (vh0 << 16);
                    *(LAS unsigned*)(Vt + (ch * 8 + 2 * e2 + 1) * 136 + ipe) = (vl0 >> 16) | (vh0 & 0xffff0000u); }
            }
            if (cc > 0) {
#pragma unroll
                for (int i = 0; i < 2; ++i)
#pragma unroll
                    for (int j = 0; j < 4; ++j) Cb[(16 * (mt0 + i) + 4 * fq + j) * 72 + 16 * ntk + fr] = (bf16_t)f2bf_hw(accC[i][j]);
                if (w < 4 && fq == 0) Cb[64 * 72 + 16 * w + fr] = (bf16_t)f2bf_hw(accN[0]);
            }
            if (cc + 1 < 18) {
                const int cn = cc + 1;
                if (cn < 2) { const int ci = dir ? 1 - cn : cn; rowbase_n = (size_t)NLAT + (size_t)b * TCTX + ci * 128; }
                else { const int ci = dir ? 17 - cn : cn - 2; rowbase_n = (size_t)b * TLAT + ci * 128; }
#pragma unroll
                for (int j = 0; j < 2; ++j) { const int i = 2 * (tid & 63) + j, ch = tid >> 6; const bf16_t* src = MLB + (rowbase_n + i) * 1024 + head * 64 + ch * 8;
                    pq[j] = *(const u32x4*)src; pk[j] = *(const u32x4*)(src + 256); pv[j] = *(const u32x4*)(src + 512); }
            }
            ML_BAR();
            if (!(VAR & 1)) {
            bf16x8 Qa[2];
            Qa[0] = *(const LAS bf16x8*)(Qs + (16 * w + fr) * 72 + 8 * fq); Qa[1] = *(const LAS bf16x8*)(Qs + (16 * w + fr) * 72 + 32 + 8 * fq);
            float cmt[4], rs[4];
#pragma unroll
            for (int j = 0; j < 4; ++j) { cmt[j] = cm_s[16 * w + 4 * fq + j]; rs[j] = 0.f; }
            for (int st = 0; st <= w; ++st) {
                const bf16x8 Kb0 = *(const LAS bf16x8*)(Ks + (16 * st + fr) * 72 + 8 * fq), Kb1 = *(const LAS bf16x8*)(Ks + (16 * st + fr) * 72 + 32 + 8 * fq);
                f32x4 S = (f32x4){0.f, 0.f, 0.f, 0.f};
                S = MFMA16(Qa[0], Kb0, S); S = MFMA16(Qa[1], Kb1, S);
                const float as = a_s[16 * st + fr];
#pragma unroll
                for (int j = 0; j < 4; ++j) { const bool ok = (st < w) || (fr <= 4 * fq + j); const float wgt = ok ? __expf(as - cmt[j]) : 0.f; const float v = S[j] * wgt;
                    rs[j] += v; Sp[(16 * w + 4 * fq + j) * 136 + 16 * st + fr] = (bf16_t)f2bf_hw(v); }
            }
            if ((w & 1) == 0) {
#pragma unroll
                for (int j = 0; j < 4; ++j) Sp[(16 * w + 4 * fq + j) * 136 + 16 * (w + 1) + fr] = (bf16_t)0;
            }
#pragma unroll
            for (int j = 0; j < 4; ++j) { rs[j] += __shfl_xor(rs[j], 1); rs[j] += __shfl_xor(rs[j], 2); rs[j] += __shfl_xor(rs[j], 4); rs[j] += __shfl_xor(rs[j], 8); }
            f32x4 hi_[4], hc[5];
#pragma unroll
            for (int nt = 0; nt < 4; ++nt) hi_[nt] = (f32x4){0.f, 0.f, 0.f, 0.f};
#pragma unroll
            for (int nt = 0; nt < 5; ++nt) hc[nt] = (f32x4){0.f, 0.f, 0.f, 0.f};
            for (int ks = 0; ks <= (w >> 1); ++ks) {
                const bf16x8 A = *(const LAS bf16x8*)(Sp + (16 * w + fr) * 136 + 32 * ks + 8 * fq);
#pragma unroll
                for (int nt = 0; nt < 4; ++nt) { const bf16x8 B = *(const LAS bf16x8*)(Vt + (16 * nt + fr) * 136 + 32 * ks + 8 * fq); hi_[nt] = MFMA16(A, B, hi_[nt]); }
            }
#pragma unroll
            for (int ks = 0; ks < 2; ++ks)
#pragma unroll
                for (int nt = 0; nt < 5; ++nt) { const bf16x8 B = *(const LAS bf16x8*)(Cb + (16 * nt + fr) * 72 + 32 * ks + 8 * fq); hc[nt] = MFMA16(Qa[ks], B, hc[nt]); }
            float hv[4][4];
#pragma unroll
            for (int j = 0; j < 4; ++j) {
                const int tl = 16 * w + 4 * fq + j;
                const float wi = wi_s[tl], em = emt_s[tl];
                const float qn = __shfl(hc[4][j], lane & 48);
                const float den = wi * qn + rs[j];
                const float inv = 1.0f / fmaxf(fabsf(den), em);
#pragma unroll
                for (int nt = 0; nt < 4; ++nt) hv[nt][j] = (wi * hc[nt][j] + hi_[nt][j]) * inv;
            }
            if (!(VAR & 4)) {
                LAS bf16_t* T = Sp + (16 * w) * 136;
#pragma unroll
                for (int j = 0; j < 4; ++j)
#pragma unroll
                    for (int nt = 0; nt < 4; ++nt) T[(4 * fq + j) * 136 + 16 * nt + fr] = (bf16_t)f2bf_hw(hv[nt][j]);
                asm volatile("s_waitcnt lgkmcnt(0)" ::: "memory");
#pragma unroll
                for (int q = 0; q < 2; ++q) { const int r = (lane >> 3) + 8 * q, c8 = lane & 7, tl = 16 * w + r; const size_t grow = rowbase + (dir ? 127 - tl : tl);
                    const u32x4 v = *(const LAS u32x4*)(T + r * 136 + c8 * 8);
                    *(u32x4*)(HSd + grow * 256 + head * 64 + c8 * 8) = v; }
            }
            }
            if (!(VAR & 2)) {
                const float asc = sc_s[0];
                accC[0] = accC[0] * asc; accC[1] = accC[1] * asc; accN = accN * asc;
#pragma unroll
                for (int ks = 0; ks < 4; ++ks) {
                    const bf16x8 Bs = *(const LAS bf16x8*)(Kt + (16 * ntk + fr) * 136 + 32 * ks + 8 * fq);
#pragma unroll
                    for (int i = 0; i < 2; ++i) { const bf16x8 A = *(const LAS bf16x8*)(Vt + (16 * (mt0 + i) + fr) * 136 + 32 * ks + 8 * fq); accC[i] = MFMA16(A, Bs, accC[i]); }
                    if (w < 4) { const bf16x8 A1 = *(const LAS bf16x8*)(Vt + (64 + fr) * 136 + 32 * ks + 8 * fq); accN = MFMA16(A1, Bs, accN); }
                }
            }
            if (w == 0 && cc + 1 < 18) { const float* ga_ = GT + (rowbase_n + (dir ? 127 - 2 * lane : 2 * lane)) * 16 + head + 8 * dir; const float* gb_ = GT + (rowbase_n + (dir ? 126 - 2 * lane : 2 * lane + 1)) * 16 + head + 8 * dir; const float g0_ = ga_[0], g1_ = ga_[4], g2_ = gb_[0], g3_ = gb_[4]; ML_SCAN((cc + 1) & 1, g0_, g1_, g2_, g3_); }
        }
    }
    __syncthreads();
}
__device__ __forceinline__ void mlstm_readout_phase(bool with_ctx, const bf16_t* HS0, const bf16_t* HS1, const bf16_t* __restrict__ MLB, bf16_t* MIX, const float* __restrict__ mlw) {
    const int tid = opaque_tid(), l16 = tid & 15, sub = tid >> 4;
    const int npairs = (with_ctx ? MTOT : NLAT) * 4;
    for (int p = blockIdx.x * 32 + sub; p < npairs; p += gridDim.x * 32) {
        const size_t grow = (size_t)(p >> 2); const int head = p & 3;
        const f32x4 gw = *(const f32x4*)(mlw + head * 64 + 4 * l16);
        const size_t off = grow * 256 + head * 64 + 4 * l16;
        const unsigned long long ha = *(const unsigned long long*)(HS0 + off), hb = *(const unsigned long long*)(HS1 + off);
        const f32x4 h = (f32x4){bf2f((unsigned)ha & 0xffffu) + bf2f((unsigned)hb & 0xffffu), bf2f(((unsigned)ha) >> 16) + bf2f(((unsigned)hb) >> 16),
                                bf2f((unsigned)(ha >> 32) & 0xffffu) + bf2f((unsigned)(hb >> 32) & 0xffffu), bf2f((unsigned)(ha >> 48)) + bf2f((unsigned)(hb >> 48))};
        const unsigned long long mo = *(const unsigned long long*)(MLB + grow * 1024 + 768 + head * 64 + 4 * l16);
        float ss = (h[0] * h[0] + h[1] * h[1]) + (h[2] * h[2] + h[3] * h[3]);
        ss += __shfl_xor(ss, 1); ss += __shfl_xor(ss, 2); ss += __shfl_xor(ss, 4); ss += __shfl_xor(ss, 8);
        const float rstd = rsqrtf(ss * (1.0f / 64.0f) + EPS);
        const unsigned mlo = (unsigned)mo, mhi = (unsigned)(mo >> 32);
        const float y0 = h[0] * rstd * gw[0] * sigmoid_f(bf2f(mlo & 0xffffu)), y1 = h[1] * rstd * gw[1] * sigmoid_f(bf2f(mlo >> 16));
        const float y2 = h[2] * rstd * gw[2] * sigmoid_f(bf2f(mhi & 0xffffu)), y3 = h[3] * rstd * gw[3] * sigmoid_f(bf2f(mhi >> 16));
        *(unsigned long long*)(MIX + grow * 1024 + 512 + head * 64 + 4 * l16) = (unsigned long long)pk2(y0, y1) | ((unsigned long long)pk2(y2, y3) << 32);
    }
}
#undef MFMA16
#undef ML_BAR
#undef ML_SCAN
}

__device__ __forceinline__ void pool_item(int u, const bf16_t* __restrict__ PZ, bf16_t* MIX, LAS unsigned char* lds) {
    const int tid = opaque_tid();
    const int r0 = u * 128;
    const int seq0 = (r0 < NLAT) ? (r0 / TLAT) * TLAT : NLAT + ((r0 - NLAT) / TCTX) * TCTX;
    const int len = (r0 < NLAT) ? TLAT : TCTX;
    const int tb = r0 - seq0;
    LAS u32x4* tile = (LAS u32x4*)lds;
#pragma unroll
    for (int q = 0; q < 9; ++q) { const int e = tid + 512 * q, row = e >> 5, ch = e & 31, t = tb - 8 + row;
        u32x4 v = (u32x4){0u, 0u, 0u, 0u};
        if (t >= 0 && t < len) v = *(const u32x4*)(PZ + (size_t)(seq0 + t) * 256 + ch * 8);
        tile[e] = v; }
    __syncthreads();
    const int ch = tid & 31, run = tid >> 5, half = 1 << (ch >> 3);
    float s[8];
#pragma unroll
    for (int e = 0; e < 8; ++e) s[e] = 0.f;
#define POOL_ACC(ROW, SGN) do { const u32x4 v_ = tile[(ROW) * 32 + ch]; \
        s[0] += (SGN) * bf2f(v_.x & 0xffffu); s[1] += (SGN) * bf2f(v_.x >> 16); s[2] += (SGN) * bf2f(v_.y & 0xffffu); s[3] += (SGN) * bf2f(v_.y >> 16); \
        s[4] += (SGN) * bf2f(v_.z & 0xffffu); s[5] += (SGN) * bf2f(v_.z >> 16); s[6] += (SGN) * bf2f(v_.w & 0xffffu); s[7] += (SGN) * bf2f(v_.w >> 16); } while (0)
    const int tl0 = run * 8;
    for (int k = -half; k < half; ++k) POOL_ACC(tl0 + 8 + k, 1.0f);
#pragma unroll
    for (int i = 0; i < 8; ++i) {
        const int tl = tl0 + i, t = tb + tl;
        if (i > 0) { POOL_ACC(tl + 8 + half - 1, 1.0f); POOL_ACC(tl + 8 - half - 1, -1.0f); }
        const int lo = max(t - half, 0), hi = min(t + half, len);
        const float inv = 1.0f / (float)(hi - lo);
        const u32x4 z = tile[(tl + 8) * 32 + ch];
        u32x4 o;
        o.x = pk2(s[0] * inv - bf2f(z.x & 0xffffu), s[1] * inv - bf2f(z.x >> 16)); o.y = pk2(s[2] * inv - bf2f(z.y & 0xffffu), s[3] * inv - bf2f(z.y >> 16));
        o.z = pk2(s[4] * inv - bf2f(z.z & 0xffffu), s[5] * inv - bf2f(z.z >> 16)); o.w = pk2(s[6] * inv - bf2f(z.w & 0xffffu), s[7] * inv - bf2f(z.w >> 16));
        *(u32x4*)(MIX + (size_t)(r0 + tl) * 1024 + 768 + ch * 8) = o;
    }
#undef POOL_ACC
    __syncthreads();
}
#define XB_TMO      128
#define XB_XCNT(j)  (256  + 64 * (j))
#define XB_XSUB(j)  (1280 + 64 * (j))
#define XB_XGEN(j)  (2304 + 64 * (j))
#define XB_TOP      3328
#define XB_TOPGEN   3392
#define XCD_BAR_WORDS 3456
#define XB_SPIN_CAP (1u << 18)

__device__ __forceinline__ unsigned xb_ld(unsigned* p)              { return __hip_atomic_load(p, __ATOMIC_RELAXED, __HIP_MEMORY_SCOPE_AGENT); }
__device__ __forceinline__ unsigned xb_add(unsigned* p, unsigned v) { return __hip_atomic_fetch_add(p, v, __ATOMIC_RELAXED, __HIP_MEMORY_SCOPE_AGENT); }
__device__ __forceinline__ unsigned xb_xcc_id() { return (unsigned)__builtin_amdgcn_s_getreg((3 << 11) | 20) & 0xFu; }
#define XB_SPIN(cond, bar) do { unsigned _sp = 0; while (cond) { __builtin_amdgcn_s_sleep(1); \
    if ((++_sp & 255u) == 0u) { if (xb_ld(&(bar)[XB_TMO])) break; if (_sp > XB_SPIN_CAP) { atomicAdd(&(bar)[XB_TMO], 1u); break; } } } } while (0)

struct XcdBarrier {
    unsigned* bar; unsigned x;
    volatile LAS unsigned* st;
};

__device__ __forceinline__ XcdBarrier xcd_barrier_post(unsigned* bar, volatile LAS unsigned* st) {
    XcdBarrier b; b.bar = bar; b.x = xb_xcc_id(); b.st = st;
    if (threadIdx.x == 0) (void)xb_add(&bar[XB_XCNT(b.x)], 1u);
    return b;
}
__device__ __forceinline__ void xcd_barrier_complete(unsigned* bar, unsigned x, unsigned& nloc, unsigned& nx) {
    const unsigned G = gridDim.x * gridDim.y * gridDim.z;
    unsigned sum, cnt, mine, sp = 0u;
    for (;;) {
        sum = 0u; cnt = 0u; mine = 0u;
#pragma unroll
        for (unsigned j = 0; j < 16; ++j) { const unsigned c = xb_ld(&bar[XB_XCNT(j)]); sum += c; cnt += (c > 0u) ? 1u : 0u; mine = (j == x) ? c : mine; }
        if (sum == G) break;
        __builtin_amdgcn_s_sleep(1);
        if ((++sp & 255u) == 0u) { if (xb_ld(&bar[XB_TMO])) break; if (sp > XB_SPIN_CAP) { atomicAdd(&bar[XB_TMO], 1u); break; } }
    }
    nloc = mine > 0u ? mine : 1u; nx = cnt > 0u ? cnt : 1u;
}

__device__ __forceinline__ void xcd_barrier(const XcdBarrier& b) {
    asm volatile("s_waitcnt vmcnt(0)" ::: "memory");
    __syncthreads();
    if (threadIdx.x == 0) {
        unsigned* bar = b.bar;
        __builtin_amdgcn_s_waitcnt(0);
        unsigned nloc = b.st[0], nx = b.st[1];
        if (nloc == 0u) { xcd_barrier_complete(bar, b.x, nloc, nx); b.st[0] = nloc; b.st[1] = nx; }
        const unsigned old = xb_add(&bar[XB_XSUB(b.x)], 1u);
        const unsigned gen = old / nloc;
        if (old + 1u == (gen + 1u) * nloc) {
            __builtin_amdgcn_fence(__ATOMIC_RELEASE, "agent");
            asm volatile("s_waitcnt vmcnt(0)" ::: "memory");
            const unsigned og = xb_add(&bar[XB_TOP], 1u);
            const unsigned tg = og / nx;
            if (og + 1u == (tg + 1u) * nx) xb_add(&bar[XB_TOPGEN], 1u);
            else XB_SPIN(xb_ld(&bar[XB_TOPGEN]) == tg, bar);
            __builtin_amdgcn_fence(__ATOMIC_ACQUIRE, "agent");
            xb_add(&bar[XB_XGEN(b.x)], 1u);
            asm volatile("s_waitcnt vmcnt(0)" ::: "memory");
        } else {
            XB_SPIN(xb_ld(&bar[XB_XGEN(b.x)]) == gen, bar);
            __builtin_amdgcn_fence(__ATOMIC_ACQUIRE, "agent");
            asm volatile("s_waitcnt vmcnt(0)" ::: "memory");
        }
    }
    __syncthreads();
}
struct Args { const float* in[20]; float* out; unsigned char* ws; };
enum { I_X = 0, I_C, I_CTX, I_CCTX, I_WADA, I_BADA, I_NMIX, I_WIN, I_BG, I_QN, I_KN, I_MLN, I_PW, I_PS, I_WOUT, I_NFFN, I_WG, I_WU, I_WD, I_FN };
constexpr int LDS_BYTES = 147456;
#ifndef REP_N1
#define REP_N1 1
#endif
#ifndef REP_G1
#define REP_G1 1
#endif
#ifndef REP_MIX
#define REP_MIX 1
#endif
#ifndef REP_N2
#define REP_N2 1
#endif
#ifndef REP_G3
#define REP_G3 1
#endif
#ifndef REP_PRO
#define REP_PRO 1
#endif
#ifndef ML_DUP
#define ML_DUP 1
#endif
#ifndef AL_DUP
#define AL_DUP 1
#endif
#ifndef MIXREP_MASK
#define MIXREP_MASK 15
#endif
#ifndef ML_VAR
#define ML_VAR 0
#endif
#ifndef PRO_MASK
#define PRO_MASK 7
#endif
#ifndef REP_SYNC
#define REP_SYNC 1
#endif

__device__ __forceinline__ void tr_item(const float* colp, size_t ld, int K, bf16_t* WT, int r0, int k0, LAS float* scr, int lane) {
    float tv[32];
#pragma unroll
    for (int i = 0; i < 32; ++i) { const int kk = 2 * i + (lane >> 5); tv[i] = colp ? colp[(size_t)(k0 + kk) * ld] : 0.f; }
#pragma unroll
    for (int i = 0; i < 32; ++i) { const int kk = 2 * i + (lane >> 5); scr[kk * 33 + (lane & 31)] = tv[i]; }
    asm volatile("s_waitcnt lgkmcnt(0)" ::: "memory");
    const int c = lane & 7;
#pragma unroll
    for (int j = 0; j < 4; ++j) { const int n = (lane >> 3) + 8 * j; const LAS float* s = scr + (8 * c) * 33 + n;
        u32x4 o; o.x = pk2(s[0 * 33], s[1 * 33]); o.y = pk2(s[2 * 33], s[3 * 33]); o.z = pk2(s[4 * 33], s[5 * 33]); o.w = pk2(s[6 * 33], s[7 * 33]);
        *(u32x4*)(WT + (size_t)(r0 + n) * K + k0 + 8 * c) = o; }
    asm volatile("s_waitcnt lgkmcnt(0)" ::: "memory");
}
__device__ __forceinline__ void tr_item_pool(const float* win, const float* pw, const float* ps, bf16_t* WT, int r0, int k0, LAS float* scr, int lane) {
    const int p = (r0 - 1792) + (lane & 31), oc = 64 * ((p >> 5) & 3) + 32 * (p >> 7) + (p & 31), g = oc >> 6, o = oc & 63;
    const float scl = ps[oc];
    const float* pwc = pw + (size_t)g * 4096 + o;
    float pwr[64];
#pragma unroll
    for (int q = 0; q < 64; ++q) pwr[q] = pwc[q * 64];
    for (int i = 0; i < 8; ++i) { const int kk = 2 * i + (lane >> 5); const float* wr = win + (size_t)(k0 + kk) * INW + 1808 + 64 * g;
        f32x4 w4[16];
#pragma unroll
        for (int q = 0; q < 16; ++q) w4[q] = *(const f32x4*)(wr + 4 * q);
        float s0 = 0.f, s1 = 0.f;
#pragma unroll
        for (int q = 0; q < 16; q += 2) { s0 += (w4[q][0] * pwr[4 * q] + w4[q][1] * pwr[4 * q + 1]) + (w4[q][2] * pwr[4 * q + 2] + w4[q][3] * pwr[4 * q + 3]);
            s1 += (w4[q + 1][0] * pwr[4 * q + 4] + w4[q + 1][1] * pwr[4 * q + 5]) + (w4[q + 1][2] * pwr[4 * q + 6] + w4[q + 1][3] * pwr[4 * q + 7]); }
        scr[kk * 33 + (lane & 31)] = (s0 + s1) * scl; }
    asm volatile("s_waitcnt lgkmcnt(0)" ::: "memory");
    { const int n = lane >> 1, c = lane & 1; const LAS float* s = scr + (8 * c) * 33 + n;
        u32x4 o4; o4.x = pk2(s[0 * 33], s[1 * 33]); o4.y = pk2(s[2 * 33], s[3 * 33]); o4.z = pk2(s[4 * 33], s[5 * 33]); o4.w = pk2(s[6 * 33], s[7 * 33]);
        *(u32x4*)(WT + (size_t)(r0 + n) * 1024 + k0 + 8 * c) = o4; }
    asm volatile("s_waitcnt lgkmcnt(0)" ::: "memory");
}

__device__ __forceinline__ void prologue(const Args& a, LAS unsigned char* lds, const int pmask) {
    const int tid = threadIdx.x, lane = tid & 63, wave = tid >> 6;
    unsigned char* ws = a.ws;
    if (blockIdx.x == 0) {
        for (int e = tid; e < 1024; e += 512) { const int pos = e >> 4, f = e & 15;
            const float invf = exp2f(-(float)(2 * f) * (13.287712379549449f / 32.0f));
            float ang = (float)pos * invf; ang -= 6.283185307179586f * rintf(ang * 0.15915494309189535f);
            float* cs = (float*)(ws + WS_ROPE) + e * 2; cs[0] = __cosf(ang); cs[1] = __sinf(ang); }
    }
    LAS float* scs = (LAS float*)lds;
    LAS float* red = (LAS float*)(lds + 17 * 4096);
    for (int e = tid; e < 17 * 1024; e += 512) { const float v = (e < 16 * 1024) ? a.in[I_C][e] : a.in[I_CCTX][e - 16 * 1024]; scs[e] = silu_f(v); }
    __syncthreads();
    for (int it = blockIdx.x; it < 2 * 192; it += gridDim.x) { if (!(pmask & 1)) break;
        const int l = it / 192, c0 = (it % 192) * 32, col = tid & 31, kp = tid >> 5;
        const float* W = a.in[I_WADA] + ((size_t)l * 1024 + kp * 64) * 6144 + c0 + col;
        float acc[17];
#pragma unroll
        for (int r = 0; r < 17; ++r) acc[r] = 0.f;
#pragma unroll 16
        for (int k4 = 0; k4 < 16; ++k4) { const float w0 = W[(size_t)(4 * k4) * 6144], w1 = W[(size_t)(4 * k4 + 1) * 6144], w2 = W[(size_t)(4 * k4 + 2) * 6144], w3 = W[(size_t)(4 * k4 + 3) * 6144];
#pragma unroll
            for (int r = 0; r < 17; ++r) { const f32x4 s = *(const LAS f32x4*)(scs + r * 1024 + kp * 64 + 4 * k4); acc[r] += (s[0] * w0 + s[1] * w1) + (s[2] * w2 + s[3] * w3); } }
#pragma unroll
        for (int r = 0; r < 17; ++r) red[(kp * 17 + r) * 32 + col] = acc[r];
        __syncthreads();
        for (int e = tid; e < 17 * 32; e += 512) { const int r = e >> 5, cc = e & 31; float s = 0.f;
#pragma unroll
            for (int q = 0; q < 16; ++q) s += red[(q * 17 + r) * 32 + cc];
            ((float*)(ws + WS_MOD))[((size_t)l * 17 + r) * 6144 + c0 + cc] = s + a.in[I_BADA][(size_t)l * 6144 + c0 + cc]; }
        __syncthreads();
    }
    LAS float* scr = (LAS float*)(lds + wave * 8448);
    const int gw = blockIdx.x * 8 + wave, NGW = gridDim.x * 8;
    constexpr int IT_W1 = 64 * 16, IT_WO = 32 * 16, IT_GU = 176 * 16, IT_WD = 32 * 44, IT_L = IT_W1 + IT_WO + IT_GU + IT_WD;
#define TR_DECODE(IT, COLP, LD, KK, WTP, R0, K0) do { const int l_ = (IT) / IT_L; int r_ = (IT) % IT_L; \
        if (r_ < IT_W1) { int rg_ = r_ / 16; if (rg_ >= 56) rg_ += 8; K0 = (r_ % 16) * 64; R0 = rg_ * 32; WTP = (bf16_t*)(ws + WS_W1 + l_ * W1_BYTES); \
            const float* win_ = a.in[I_WIN] + (size_t)l_ * 1024 * INW; const int rr_ = R0 + (lane & 31), pn_ = rr_ >> 8, p_ = rr_ & 255, oc_ = 64 * ((p_ >> 5) & 3) + 32 * (p_ >> 7) + (p_ & 31), cp_ = 256 * pn_ + oc_; \
            COLP = (cp_ < 1792) ? win_ + cp_ : (cp_ >= 2048 && cp_ < 2064) ? win_ + 1792 + (cp_ - 2048) : nullptr; LD = INW; KK = 1024; } \
        else if ((r_ -= IT_W1) < IT_WO) { R0 = (r_ / 16) * 32; K0 = (r_ % 16) * 64; COLP = a.in[I_WOUT] + (size_t)l_ * 1024 * 1024 + R0 + (lane & 31); LD = 1024; KK = 1024; WTP = (bf16_t*)(ws + WS_WO + l_ * WO_BYTES); } \
        else if ((r_ -= IT_WO) < IT_GU) { R0 = (r_ / 16) * 32; K0 = (r_ % 16) * 64; const int rr_ = R0 + (lane & 31), pn_ = rr_ >> 8, p_ = rr_ & 255, hcol_ = 128 * pn_ + (p_ & 127); \
            COLP = ((p_ >> 7) ? a.in[I_WU] : a.in[I_WG]) + (size_t)l_ * 1024 * DFF + hcol_; LD = DFF; KK = 1024; WTP = (bf16_t*)(ws + WS_WGU + l_ * WGU_BYTES); } \
        else { r_ -= IT_GU; R0 = (r_ / 44) * 32; K0 = (r_ % 44) * 64; COLP = a.in[I_WD] + (size_t)l_ * DFF * 1024 + R0 + (lane & 31); LD = 1024; KK = DFF; WTP = (bf16_t*)(ws + WS_WD + l_ * WD_BYTES); } } while (0)
#define TR_LOAD(TV, COLP, LD, K0) do { _Pragma("unroll") for (int i_ = 0; i_ < 32; ++i_) { const int kk_ = 2 * i_ + (lane >> 5); TV[i_] = (COLP) ? (COLP)[(size_t)((K0) + kk_) * (LD)] : 0.f; } } while (0)
    if (pmask & 2) {
        int it = gw;
        const float* colp = nullptr; size_t ld = 0; int KK = 0, r0 = 0, k0 = 0; bf16_t* WT = nullptr;
        float tv[32];
        if (it < 2 * IT_L) { TR_DECODE(it, colp, ld, KK, WT, r0, k0); TR_LOAD(tv, colp, ld, k0); }
        while (it < 2 * IT_L) {
            const int itn = it + NGW;
            const float* colpn = nullptr; size_t ldn = 0; int KKn = 0, r0n = 0, k0n = 0; bf16_t* WTn = nullptr;
            float tn[32];
            if (itn < 2 * IT_L) { TR_DECODE(itn, colpn, ldn, KKn, WTn, r0n, k0n); TR_LOAD(tn, colpn, ldn, k0n); }
#pragma unroll
            for (int i = 0; i < 32; ++i) { const int kk = 2 * i + (lane >> 5); scr[kk * 33 + (lane & 31)] = tv[i]; }
            asm volatile("s_waitcnt lgkmcnt(0)" ::: "memory");
            { const int c = lane & 7;
#pragma unroll
                for (int j = 0; j < 4; ++j) { const int n = (lane >> 3) + 8 * j; const LAS float* s = scr + (8 * c) * 33 + n;
                    u32x4 o; o.x = pk2(s[0 * 33], s[1 * 33]); o.y = pk2(s[2 * 33], s[3 * 33]); o.z = pk2(s[4 * 33], s[5 * 33]); o.w = pk2(s[6 * 33], s[7 * 33]);
                    *(u32x4*)(WT + (size_t)(r0 + n) * KK + k0 + 8 * c) = o; } }
            asm volatile("s_waitcnt lgkmcnt(0)" ::: "memory");
            it = itn; colp = colpn; ld = ldn; KK = KKn; r0 = r0n; k0 = k0n; WT = WTn;
#pragma unroll
            for (int i = 0; i < 32; ++i) tv[i] = tn[i];
        }
    }
#undef TR_DECODE
#undef TR_LOAD
    if (pmask & 4)
    for (int it = gw; it < 1024; it += NGW) { const int l = it >> 9, rg = (it & 511) >> 6, kg = it & 63;
        tr_item_pool(a.in[I_WIN] + (size_t)l * 1024 * INW, a.in[I_PW] + (size_t)l * 4 * 4096, a.in[I_PS] + l * 256, (bf16_t*)(ws + WS_W1 + l * W1_BYTES), 1792 + rg * 32, kg * 16, scr, lane); }
}

__device__ __forceinline__ void norm_phase(const float* xl, const float* xc, const float* gw, const float* mod  , int sh_off, int sc_off, bf16_t* XN, int nrows) {
    const int tid = opaque_tid(), lane = tid & 63, gwv = blockIdx.x * 8 + (tid >> 6), NGW = gridDim.x * 8;
    const int per = (nrows + NGW - 1) / NGW;
    int cur = -1; f32x4 mul[4], add[4];
    for (int q = 0; q < per; ++q) {
        const int row = gwv * per + q; if (row >= nrows) break;
        const int mr = row < NLAT ? row / TLAT : 16;
        if (mr != cur) { cur = mr; const float* mp = mod + (size_t)mr * 6144;
#pragma unroll
            for (int j = 0; j < 4; ++j) { const f32x4 g = *(const f32x4*)(gw + 4 * lane + 256 * j), s = *(const f32x4*)(mp + sc_off + 4 * lane + 256 * j); mul[j] = g * (s + 1.0f); add[j] = *(const f32x4*)(mp + sh_off + 4 * lane + 256 * j); } }
        const float* xr = row < NLAT ? xl + (size_t)row * 1024 : xc + (size_t)(row - NLAT) * 1024;
        f32x4 v[4]; float ss = 0.f;
#pragma unroll
        for (int j = 0; j < 4; ++j) { v[j] = __builtin_nontemporal_load((const f32x4*)(xr + 4 * lane + 256 * j)); ss += (v[j][0] * v[j][0] + v[j][1] * v[j][1]) + (v[j][2] * v[j][2] + v[j][3] * v[j][3]); }
        const float rstd = rsqrtf(wave_sum(ss) * (1.0f / 1024.0f) + EPS);
        unsigned long long* o8 = (unsigned long long*)(XN + (size_t)row * 1024) + lane;
#pragma unroll
        for (int j = 0; j < 4; ++j) { const f32x4 y = v[j] * rstd * mul[j] + add[j]; o8[64 * j] = (unsigned long long)pk2(y[0], y[1]) | ((unsigned long long)pk2(y[2], y[3]) << 32); }
    }
}
__device__ __forceinline__ void ctx_gates_phase(const float* xc, const float* gw, const float* modc, const float* win, const float* bg, float* GT, LAS unsigned char* lds) {
    const int tid = opaque_tid(), lane = tid & 63, gwv = blockIdx.x * 8 + (tid >> 6), NGW = gridDim.x * 8;
    LAS float* wg = (LAS float*)lds;
    for (int e = tid; e < 4096; e += 512) { const int k = e >> 2, q4 = e & 3; *(LAS f32x4*)(wg + k * 16 + q4 * 4) = *(const f32x4*)(win + (size_t)k * INW + 1792 + q4 * 4); }
    __syncthreads();
    for (int r = gwv; r < NCTX; r += NGW) {
        asm volatile("" ::: "memory");
        const float* xr = xc + (size_t)r * 1024; float h[16]; float ss = 0.f;
#pragma unroll
        for (int q = 0; q < 16; ++q) { h[q] = xr[lane + 64 * q]; ss += h[q] * h[q]; }
        const float rstd = rsqrtf(wave_sum(ss) * (1.0f / 1024.0f) + EPS);
        f32x4 acc[4];
#pragma unroll
        for (int q = 0; q < 4; ++q) acc[q] = (f32x4){0.f, 0.f, 0.f, 0.f};
#pragma unroll
        for (int q = 0; q < 16; ++q) { const int c = lane + 64 * q; const float hv = h[q] * rstd * gw[c] * (modc[1024 + c] + 1.0f) + modc[c];
#pragma unroll
            for (int g4 = 0; g4 < 4; ++g4) acc[g4] += *(const LAS f32x4*)(wg + c * 16 + 4 * g4) * hv; }
        float out = 0.f;
#pragma unroll
        for (int q = 0; q < 4; ++q)
#pragma unroll
            for (int i = 0; i < 4; ++i) { const float v = wave_sum(acc[q][i]); if (lane == 4 * q + i) out = v; }
        if (lane < 16) GT[(size_t)(NLAT + r) * 16 + lane] = out + bg[lane];
    }
    __syncthreads();
}
__device__ __forceinline__ void norm_phase_bf(const bf16_t* xs, const float* gw, const float* mod, int sh_off, int sc_off, bf16_t* XN, int nrows, const float* part = nullptr, int nsplit = 0, const float* pgate = nullptr, const float* cbase = nullptr, bf16_t* xs_w = nullptr) {
    const int tid = opaque_tid(), lane = tid & 63, gwv = blockIdx.x * 8 + (tid >> 6), NGW = gridDim.x * 8;
    const int per = (nrows + NGW - 1) / NGW;
    int cur = -1; f32x4 mul[4], add[4];
    for (int q = 0; q < per; ++q) {
        const int row = gwv * per + q; if (row >= nrows) break;
        const int mr = row < NLAT ? row / TLAT : 16;
        if (mr != cur) { cur = mr; const float* mp = mod + (size_t)mr * 6144;
#pragma unroll
            for (int j = 0; j < 4; ++j) { const int c = 8 * lane + 512 * (j >> 1) + 4 * (j & 1); const f32x4 g = *(const f32x4*)(gw + c), s = *(const f32x4*)(mp + sc_off + c); mul[j] = g * (s + 1.0f); add[j] = *(const f32x4*)(mp + sh_off + c); } }
        const bf16_t* xr = xs + (size_t)row * 1024;
        f32x4 v[4]; float ss = 0.f;
#pragma unroll
        for (int j = 0; j < 2; ++j) { const u32x4 w = *(const u32x4*)(xr + 8 * lane + 512 * j);
            v[2 * j] = (f32x4){bf2f(w.x & 0xffffu), bf2f(w.x >> 16), bf2f(w.y & 0xffffu), bf2f(w.y >> 16)}; v[2 * j + 1] = (f32x4){bf2f(w.z & 0xffffu), bf2f(w.z >> 16), bf2f(w.w & 0xffffu), bf2f(w.w >> 16)}; }
        if (part && row >= NLAT) {
#pragma unroll
            for (int j = 0; j < 4; ++j) { const int c = 8 * lane + 512 * (j >> 1) + 4 * (j & 1); f32x4 s = (f32x4){0.f, 0.f, 0.f, 0.f};
                if (cbase) v[j] = *(const f32x4*)(cbase + (size_t)(row - NLAT) * 1024 + c);
                for (int k = 0; k < nsplit; ++k) s += *(const f32x4*)(part + ((size_t)k * NCTX + (row - NLAT)) * 1024 + c);
                v[j] += *(const f32x4*)(pgate + c) * s; }
            if (xs_w) {
#pragma unroll
                for (int j = 0; j < 2; ++j) { u32x4 o; o.x = pk2(v[2 * j][0], v[2 * j][1]); o.y = pk2(v[2 * j][2], v[2 * j][3]); o.z = pk2(v[2 * j + 1][0], v[2 * j + 1][1]); o.w = pk2(v[2 * j + 1][2], v[2 * j + 1][3]);
                    *(u32x4*)(xs_w + (size_t)row * 1024 + 8 * lane + 512 * j) = o; } } }
#pragma unroll
        for (int j = 0; j < 4; ++j) ss += (v[j][0] * v[j][0] + v[j][1] * v[j][1]) + (v[j][2] * v[j][2] + v[j][3] * v[j][3]);
        const float rstd = rsqrtf(wave_sum(ss) * (1.0f / 1024.0f) + EPS);
#pragma unroll
        for (int j = 0; j < 2; ++j) { const f32x4 y0 = v[2 * j] * rstd * mul[2 * j] + add[2 * j], y1 = v[2 * j + 1] * rstd * mul[2 * j + 1] + add[2 * j + 1];
            u32x4 o; o.x = pk2(y0[0], y0[1]); o.y = pk2(y0[2], y0[3]); o.z = pk2(y1[0], y1[1]); o.w = pk2(y1[2], y1[3]);
            *(u32x4*)(XN + (size_t)row * 1024 + 8 * lane + 512 * j) = o; }
    }
}
__device__ __forceinline__ void final_norm_phase_bf(const bf16_t* xs, float* out, const float* gw) {
    const int tid = opaque_tid(), lane = tid & 63, gwv = blockIdx.x * 8 + (tid >> 6), NGW = gridDim.x * 8;
    f32x4 g[4];
#pragma unroll
    for (int j = 0; j < 4; ++j) g[j] = *(const f32x4*)(gw + 8 * lane + 512 * (j >> 1) + 4 * (j & 1));
    for (int row = gwv; row < NLAT; row += NGW) {
        const bf16_t* xr = xs + (size_t)row * 1024; f32x4 v[4]; float ss = 0.f;
#pragma unroll
        for (int j = 0; j < 2; ++j) { const u32x4 w = *(const u32x4*)(xr + 8 * lane + 512 * j);
            v[2 * j] = (f32x4){bf2f(w.x & 0xffffu), bf2f(w.x >> 16), bf2f(w.y & 0xffffu), bf2f(w.y >> 16)}; v[2 * j + 1] = (f32x4){bf2f(w.z & 0xffffu), bf2f(w.z >> 16), bf2f(w.w & 0xffffu), bf2f(w.w >> 16)}; }
#pragma unroll
        for (int j = 0; j < 4; ++j) ss += (v[j][0] * v[j][0] + v[j][1] * v[j][1]) + (v[j][2] * v[j][2] + v[j][3] * v[j][3]);
        const float rstd = rsqrtf(wave_sum(ss) * (1.0f / 1024.0f) + EPS);
#pragma unroll
        for (int j = 0; j < 4; ++j) __builtin_nontemporal_store(v[j] * rstd * g[j], (f32x4*)(out + (size_t)row * 1024 + 8 * lane + 512 * (j >> 1) + 4 * (j & 1)));
    }
}
__device__ __forceinline__ void final_norm_phase(float* x, const float* gw) {
    const int tid = opaque_tid(), lane = tid & 63, gwv = blockIdx.x * 8 + (tid >> 6), NGW = gridDim.x * 8;
    f32x4 g[4];
#pragma unroll
    for (int j = 0; j < 4; ++j) g[j] = *(const f32x4*)(gw + 4 * lane + 256 * j);
    for (int row = gwv; row < NLAT; row += NGW) {
        float* xr = x + (size_t)row * 1024; f32x4 v[4]; float ss = 0.f;
#pragma unroll
        for (int j = 0; j < 4; ++j) { v[j] = __builtin_nontemporal_load((const f32x4*)(xr + 4 * lane + 256 * j)); ss += (v[j][0] * v[j][0] + v[j][1] * v[j][1]) + (v[j][2] * v[j][2] + v[j][3] * v[j][3]); }
        const float rstd = rsqrtf(wave_sum(ss) * (1.0f / 1024.0f) + EPS);
#pragma unroll
        for (int j = 0; j < 4; ++j) __builtin_nontemporal_store(v[j] * rstd * g[j], (f32x4*)(xr + 4 * lane + 256 * j));
    }
}

__global__ void __launch_bounds__(512, 2) fwd_megakernel(Args a) {
    extern __shared__ __attribute__((aligned(16))) unsigned char lds_raw[];
    LAS unsigned char* lds = (LAS unsigned char*)lds_raw;
    unsigned char* ws = a.ws;
    const int tid = threadIdx.x;
    float* MOD = (float*)(ws + WS_MOD);
    bf16_t* XN = (bf16_t*)(ws + WS_XN); bf16_t* QB = (bf16_t*)(ws + WS_QB); bf16_t* KB = (bf16_t*)(ws + WS_KB); bf16_t* VB = (bf16_t*)(ws + WS_VB);
    bf16_t* MLB = (bf16_t*)(ws + WS_MLB); bf16_t* PZ = (bf16_t*)(ws + WS_PZ); float* GT = (float*)(ws + WS_GT); bf16_t* HS = (bf16_t*)(ws + WS_HS); bf16_t* HS1 = (bf16_t*)(ws + WS_HS1);
    bf16_t* MIX = (bf16_t*)(ws + WS_MIX); bf16_t* HID = (bf16_t*)(ws + WS_HID); bf16_t* XS = (bf16_t*)(ws + WS_XS);
    unsigned* ctl = (unsigned*)(ws + WS_CTL);
    LAS int* item_s = (LAS int*)(lds + 131072 + 1024);
    volatile LAS unsigned* bst = (volatile LAS unsigned*)(lds + 131072 + 2048);
    if (tid < 4) bst[tid] = 0u;
    __syncthreads();
    XcdBarrier xbar = xcd_barrier_post(ctl + 4096, bst);
#define GSYNC() xcd_barrier(xbar)

    for (int rp = 0; rp < REP_PRO; ++rp) { prologue(a, lds, rp == 0 ? 7 : PRO_MASK);
    GSYNC(); }

    for (int l = 0; l < 2; ++l) {
        const float* xl_in = a.in[I_X];
        const float* xc_in = a.in[I_CTX];
        const float* modl = MOD + (size_t)l * 17 * 6144;
        for (int rp = 0; rp < REP_N1; ++rp) { if (l == 0) norm_phase(xl_in, xc_in, a.in[I_NMIX] + l * 1024, modl, 0, 1024, XN, MTOT); else norm_phase_bf(XS, a.in[I_NMIX] + l * 1024, modl, 0, 1024, XN, MTOT, (const float*)(ws + WS_MIX + 32 * MiB), 2, MOD + (size_t)16 * 6144 + 5120);
        if (l == 0) ctx_gates_phase(xc_in, a.in[I_NMIX], modl + 16 * 6144, a.in[I_WIN], a.in[I_BG], GT, lds);
        for (int rs = 0; rs < REP_SYNC; ++rs) GSYNC(); }
        for (int rp = 0; rp < REP_G1; ++rp) {
            ((LAS u32x4*)(lds + 131072 + 4096))[tid] = ((const u32x4*)(ws + WS_ROPE))[tid]; __syncthreads();
            pg8::Gemm g{XN, (const bf16_t*)(ws + WS_W1 + l * W1_BYTES), MTOT, N1, 1024}; pg8::G1Order S; S.init(gridDim.x, (int)blockIdx.x, l == 0);
            pg8::EpiIn E{QB, KB, VB, MLB, PZ, GT, a.in[I_QN] + l * 64, a.in[I_KN] + l * 64, a.in[I_BG] + l * 16, (const LAS float*)(lds + 131072 + 4096), attn_body::C2};
            pg8::gemm_phase<pg8::EpiIn, pg8::G1Order, true, true>(lds, g, S, E);
        GSYNC(); }
        for (int rp = 0; rp < REP_MIX; ++rp) {
            const int n_ml = 128 * ML_DUP, n_al = 1024 * AL_DUP, n_ac = (l == 0) ? 128 : 0, n_pool = (l == 0) ? 288 : 256, n_all = n_ml + n_al + n_ac + n_pool;
            for (;;) {
                __syncthreads();
                if (tid == 0) item_s[0] = (int)atomicAdd(ctl + 64 * (l * 4 + rp), 1u);
                __syncthreads();
                int it = item_s[0];
                if (it >= n_all) break;
                const int cmask = (rp == 0) ? 15 : MIXREP_MASK;
                if (it < n_ml) { if (!(cmask & 1)) continue; const int itm = it & 127, mb = itm >> 3, mh = (itm >> 1) & 3, md = itm & 1;
                    if (rp == 0) ml::mlstm_item<0>(mb, mh, md, MLB, GT, md ? HS1 : HS, lds); else ml::mlstm_item<ML_VAR>(mb, mh, md, MLB, GT, md ? HS1 : HS, lds);
                    continue; }
                it -= n_ml;
                if (it < n_al) { if (!(cmask & 2)) continue; const int b = (it >> 6) & 15, h = (it >> 3) & 7, qb = it & 7;
                    attn_body::attn_unit<8>((const attn_body::bf16*)(QB + ((size_t)b * TLAT + qb * 256) * 512 + h * 64), (const attn_body::bf16*)(KB + (size_t)b * TKV * 128 + (h >> 2) * 64),
                                            (const attn_body::bf16*)(VB + (size_t)b * TKV * 128 + (h >> 2) * 64), (attn_body::bf16*)(MIX + ((size_t)b * TLAT + qb * 256) * 1024 + h * 64), TKV / 64, (char*)lds_raw);
                    continue; }
                it -= n_al;
                if (it < n_ac) { if (!(cmask & 4)) continue; const int b = it >> 3, h = it & 7;
                    attn_body::attn_unit<8>((const attn_body::bf16*)(QB + ((size_t)NLAT + b * TCTX) * 512 + h * 64), (const attn_body::bf16*)(KB + ((size_t)b * TKV + TLAT) * 128 + (h >> 2) * 64),
                                            (const attn_body::bf16*)(VB + ((size_t)b * TKV + TLAT) * 128 + (h >> 2) * 64), (attn_body::bf16*)(MIX + ((size_t)NLAT + b * TCTX) * 1024 + h * 64), TCTX / 64, (char*)lds_raw);
                    continue; }
                it -= n_ac;
                if (cmask & 8) pool_item(it, PZ, MIX, lds);
            }
        GSYNC(); }
        ml::mlstm_readout_phase(l == 0, HS, HS1, MLB, MIX, a.in[I_MLN] + l * 256);
        GSYNC();
        const int Mrows = (l == 0) ? MTOT : NLAT;
        {
            pg8::Gemm g{MIX, (const bf16_t*)(ws + WS_WO + l * WO_BYTES), Mrows, 1024, 1024, 0}; pg8::StaticOrder S; S.init(Mrows, 1024, gridDim.x, (int)blockIdx.x);
            if (l == 0) { pg8::EpiRes2<false, true> E{xl_in, xc_in, XS, nullptr, modl + 2048}; pg8::gemm_phase<pg8::EpiRes2<false, true>, pg8::StaticOrder, true, true>(lds, g, S, E); }
            else { pg8::EpiRes2<true, true> E{nullptr, nullptr, XS, nullptr, modl + 2048}; pg8::gemm_phase<pg8::EpiRes2<true, true>, pg8::StaticOrder, true, true>(lds, g, S, E); }
        }
        GSYNC();
        for (int rp = 0; rp < REP_N2; ++rp) { norm_phase_bf(XS, a.in[I_NFFN] + l * 1024, modl, 3072, 4096, XN, Mrows);
        GSYNC(); }
        for (int rp = 0; rp < REP_G3; ++rp) {
            pg8::Gemm g{XN, (const bf16_t*)(ws + WS_WGU + l * WGU_BYTES), Mrows, NGU, 1024}; pg8::StaticOrder S; S.init(Mrows, NGU, gridDim.x, (int)blockIdx.x);
            pg8::EpiGU E{HID};
            pg8::gemm_phase<pg8::EpiGU, pg8::StaticOrder, true, true>(lds, g, S, E);
        GSYNC(); }
        {
            pg8::Gemm g{HID, (const bf16_t*)(ws + WS_WD + l * WD_BYTES), NLAT, 1024, DFF, 0}; pg8::StaticOrder S; S.init(NLAT, 1024, gridDim.x, (int)blockIdx.x);
            if (l == 0) { pg8::EpiRes2<true, true> E{nullptr, nullptr, XS, nullptr, modl + 5120}; pg8::gemm_phase<pg8::EpiRes2<true, true>, pg8::StaticOrder, true, true>(lds, g, S, E);
                for (int kc = 0; kc < 2; ++kc) { pg8::Gemm gt{HID + kc * (DFF / 2), (const bf16_t*)(ws + WS_WD) + kc * (DFF / 2), MTOT, 1024, DFF / 2, DFF}; pg8::TailOrder T{(int)blockIdx.x, 64 * kc};
                    pg8::EpiPart EP{(float*)(ws + WS_MIX + 32 * MiB) + (size_t)kc * NCTX * 1024};
                    pg8::gemm_phase<pg8::EpiPart, pg8::TailOrder, true, true>(lds, gt, T, EP); } }
            else { pg8::EpiRes2<true, true> E{nullptr, nullptr, XS, nullptr, modl + 5120}; pg8::gemm_phase<pg8::EpiRes2<true, true>, pg8::StaticOrder, true, true>(lds, g, S, E); }
        }
        GSYNC();
    }
    final_norm_phase_bf(XS, a.out, a.in[I_FN]);
}

extern "C" void kernel_launch(void* const* d_in, const int* in_sizes, int n_in, void* d_out, int out_size, void* d_ws, size_t ws_size, hipStream_t stream) {
    static int grid_blocks = 0;
    if (grid_blocks == 0) {
        if (n_in != 20 || ws_size < WS_END) { fprintf(stderr, "kernel_launch: unexpected n_in %d / ws_size %zu\n", n_in, ws_size); grid_blocks = -1; return; }
        int dev = 0, cus = 0, per_cu = 0;
        hipGetDevice(&dev);
        hipDeviceGetAttribute(&cus, hipDeviceAttributeMultiprocessorCount, dev);
        if (hipFuncSetAttribute((const void*)fwd_megakernel, hipFuncAttributeMaxDynamicSharedMemorySize, LDS_BYTES) != hipSuccess) { fprintf(stderr, "kernel_launch: hipFuncSetAttribute failed\n"); grid_blocks = -1; return; }
        if (hipOccupancyMaxActiveBlocksPerMultiprocessor(&per_cu, (const void*)fwd_megakernel, 512, LDS_BYTES) != hipSuccess || per_cu < 1) { fprintf(stderr, "kernel_launch: occupancy query failed (%d)\n", per_cu); grid_blocks = -1; return; }
        grid_blocks = cus * per_cu;
    }
    if (grid_blocks < 0) return;
    hipMemsetAsync((char*)d_ws + WS_CTL, 0, 65536, stream);
    Args a{};
    for (int i = 0; i < 20; ++i) a.in[i] = (const float*)d_in[i];
    a.out = (float*)d_out; a.ws = (unsigned char*)d_ws;
    void* args[] = {&a};
    hipError_t e = hipLaunchCooperativeKernel((const void*)fwd_megakernel, dim3(grid_blocks), dim3(512), args, LDS_BYTES, stream);
    if (e != hipSuccess) fprintf(stderr, "cooperative launch failed: %s (grid %d)\n", hipGetErrorString(e), grid_blocks);
}
```
